# Optimizing an MI355X kernel written in HIP

```python
import jax, jax.numpy as jnp
from jax import lax
import numpy as np


D_MODEL = 1024
BATCH = 2
SEQ = 8192
DEPTH = 1

EPS = 1e-6
CONV_WIDTH = 3
D_CONV = D_MODEL
GLA_HEADS = 4
GLA_DK = D_MODEL // 2
GLA_DV = D_MODEL
GLA_HEAD_DK = GLA_DK // GLA_HEADS
GLA_HEAD_DV = GLA_DV // GLA_HEADS
GLA_LOWRANK = 16
GLA_TAU = 16.0
GLA_CHUNK = 64
PEER_HEADS = 8
PEER_NKEYS = 128
PEER_EXPERTS = PEER_NKEYS ** 2
PEER_TOPK = 16
PEER_QDIM = 256
PEER_TOK_BLOCK = 128
IN_SIZES = (D_CONV, D_CONV, D_CONV,
            GLA_DK, GLA_DK, GLA_DV, GLA_DV,
            GLA_LOWRANK, GLA_LOWRANK,
            D_MODEL, D_MODEL)
IN_SPLITS = tuple(int(s) for s in np.cumsum(IN_SIZES)[:-1])
W_IN_COLS = int(sum(IN_SIZES))

kernel_name = 'hybrid_shortconv_gla_peer_encoder_block'


def _rmsnorm(x, g):
    xf = x.astype(jnp.float32)
    xf = xf * lax.rsqrt(jnp.mean(xf * xf, axis=-1, keepdims=True) + EPS)
    return (xf * g.astype(jnp.float32)).astype(x.dtype)


def _centred_depthwise_conv(u, w, b):
    pad = CONV_WIDTH // 2
    T = u.shape[1]
    up = jnp.pad(u, ((0, 0), (pad, pad), (0, 0)))
    y = b
    for j in range(CONV_WIDTH):
        y = y + up[:, j:j + T] * w[j]
    return y


def _gla_one_direction(q, k, v, log_a):
    Bsz, T, H, dk = q.shape
    dv = v.shape[-1]
    n = T // GLA_CHUNK
    f32 = jnp.float32

    def chunks(t):
        return t.astype(f32).reshape(Bsz, n, GLA_CHUNK, H, t.shape[-1])

    q, k, v, la = chunks(q), chunks(k), chunks(v), chunks(log_a)
    b = jnp.cumsum(la, axis=2)
    b_last = b[:, :, -1]
    b_ref = b[:, :, GLA_CHUNK // 2][:, :, None]
    q_in = q * jnp.exp(b - b_ref)
    k_in = k * jnp.exp(b_ref - b)
    mask = jnp.tril(jnp.ones((GLA_CHUNK, GLA_CHUNK), dtype=bool))
    scores = jnp.einsum('bnihd,bnjhd->bnhij', q_in, k_in)
    scores = jnp.where(mask, scores, 0.0)
    o_intra = jnp.einsum('bnhij,bnjhe->bnihe', scores, v)
    k_to_end = k * jnp.exp(b_last[:, :, None] - b)
    u = jnp.einsum('bnjhd,bnjhe->bnhde', k_to_end, v)
    decay = jnp.exp(b_last)

    def step(S, inp):
        dec, uc = inp
        return dec[..., None] * S + uc, S

    S0 = jnp.zeros((Bsz, H, dk, dv), f32)
    _, S_prev = lax.scan(step, S0, (jnp.moveaxis(decay, 1, 0), jnp.moveaxis(u, 1, 0)))
    S_prev = jnp.moveaxis(S_prev, 0, 1)
    o_inter = jnp.einsum('bnihd,bnhde->bnihe', q * jnp.exp(b), S_prev)
    return (o_intra + o_inter).reshape(Bsz, T, H, dv)


def _bidirectional_gla(q, k, v, la_f, la_b):
    o_f = _gla_one_direction(q, k, v, la_f)

    def flip(t):
        return jnp.flip(t, axis=1)

    o_b = flip(_gla_one_direction(flip(q), flip(k), flip(v), flip(la_b)))
    return o_f + o_b


def _mixer(xn, w_in, conv_w, conv_b, wa_proj, decay_up_f, decay_bias_f, decay_up_b,
           decay_bias_b, gla_norm_g, wb_proj, gate_bias, w_out):
    Bsz, T, _ = xn.shape
    h = xn @ w_in
    xa, ba, ca, q, k, v, r, zf, zb, ga, gb = jnp.split(h, IN_SPLITS, axis=-1)

    ya = ba * _centred_depthwise_conv(ca * xa, conv_w, conv_b)
    out_a = ya @ wa_proj

    def heads(t, d):
        return t.reshape(Bsz, T, GLA_HEADS, d)

    qh = heads(q, GLA_HEAD_DK) * (GLA_HEAD_DK ** -0.5)
    kh = heads(k, GLA_HEAD_DK)
    vh = heads(v, GLA_HEAD_DV)
    la_f = jax.nn.log_sigmoid((zf @ decay_up_f + decay_bias_f).astype(jnp.float32)) / GLA_TAU
    la_b = jax.nn.log_sigmoid((zb @ decay_up_b + decay_bias_b).astype(jnp.float32)) / GLA_TAU
    o = _bidirectional_gla(qh, kh, vh, heads(la_f, GLA_HEAD_DK), heads(la_b, GLA_HEAD_DK))
    o = _rmsnorm(o, gla_norm_g.reshape(GLA_HEADS, GLA_HEAD_DV))
    o = o.reshape(Bsz, T, GLA_DV).astype(xn.dtype) * jax.nn.silu(r)
    out_b = o @ wb_proj

    gate_a = jax.nn.sigmoid(ga + gate_bias[0])
    gate_b = jax.nn.sigmoid(gb + gate_bias[1])
    return (gate_a * out_a + gate_b * out_b) @ w_out


def _peer(xn, wq, keys, u_tab, v_tab):
    Bsz, T, D = xn.shape
    BT = Bsz * T
    xt = xn.reshape(BT, D)
    q = (xt @ wq).reshape(BT, PEER_HEADS, 2, PEER_QDIM // 2)
    s = jnp.einsum('thpd,hpkd->thpk', q, keys).astype(jnp.float32)
    top_s, top_i = lax.top_k(s, PEER_TOPK)
    cand = (top_s[:, :, 0, :, None] + top_s[:, :, 1, None, :]).reshape(BT, PEER_HEADS, PEER_TOPK * PEER_TOPK)
    best_s, best_c = lax.top_k(cand, PEER_TOPK)
    i1 = jnp.take_along_axis(top_i[:, :, 0], best_c // PEER_TOPK, axis=-1)
    i2 = jnp.take_along_axis(top_i[:, :, 1], best_c % PEER_TOPK, axis=-1)
    experts = (i1 * PEER_NKEYS + i2).reshape(BT, PEER_HEADS * PEER_TOPK)
    gates = jax.nn.softmax(best_s, axis=-1).reshape(BT, PEER_HEADS * PEER_TOPK).astype(xn.dtype)
    nb = BT // PEER_TOK_BLOCK

    def block(args):
        xb, eb, gbk = args
        hidden = jax.nn.gelu(jnp.einsum('td,tkd->tk', xb, u_tab[eb]), approximate=False)
        return jnp.einsum('tk,tkd->td', gbk * hidden, v_tab[eb])

    out = lax.map(block, (xt.reshape(nb, PEER_TOK_BLOCK, D),
                          experts.reshape(nb, PEER_TOK_BLOCK, -1),
                          gates.reshape(nb, PEER_TOK_BLOCK, -1)))
    return out.reshape(Bsz, T, D)


def setup_inputs(seed: int = 0) -> dict:
    key = jax.random.key(seed)
    ks = jax.random.split(key, 24)

    def nrm(k, shape, scale):
        return jax.random.normal(k, shape, jnp.float32) * scale

    L = DEPTH
    return {
        'x': nrm(ks[0], (BATCH, SEQ, D_MODEL), 1.0),
        'norm1_g': 1.0 + nrm(ks[1], (L, D_MODEL), 0.02),
        'w_in': nrm(ks[2], (L, D_MODEL, W_IN_COLS), D_MODEL ** -0.5),
        'conv_w': nrm(ks[3], (L, CONV_WIDTH, D_CONV), CONV_WIDTH ** -0.5),
        'conv_b': nrm(ks[4], (L, D_CONV), 0.01),
        'wa_proj': nrm(ks[5], (L, D_CONV, D_MODEL), D_CONV ** -0.5),
        'decay_up_f': nrm(ks[6], (L, GLA_LOWRANK, GLA_DK), GLA_LOWRANK ** -0.5),
        'decay_bias_f': 1.0 + nrm(ks[7], (L, GLA_DK), 0.5),
        'decay_up_b': nrm(ks[8], (L, GLA_LOWRANK, GLA_DK), GLA_LOWRANK ** -0.5),
        'decay_bias_b': 1.0 + nrm(ks[9], (L, GLA_DK), 0.5),
        'gla_norm_g': 1.0 + nrm(ks[10], (L, GLA_DV), 0.02),
        'wb_proj': nrm(ks[11], (L, GLA_DV, D_MODEL), GLA_DV ** -0.5),
        'gate_bias': nrm(ks[12], (L, 2, D_MODEL), 0.01),
        'w_out': nrm(ks[13], (L, D_MODEL, D_MODEL), D_MODEL ** -0.5),
        'norm2_g': 1.0 + nrm(ks[14], (L, D_MODEL), 0.02),
        'peer_wq': nrm(ks[15], (L, D_MODEL, PEER_HEADS * PEER_QDIM), D_MODEL ** -0.5),
        'peer_keys': nrm(ks[16], (L, PEER_HEADS, 2, PEER_NKEYS, PEER_QDIM // 2), (PEER_QDIM // 2) ** -0.5),
        'peer_u': nrm(ks[17], (L, PEER_EXPERTS, D_MODEL), D_MODEL ** -0.5),
        'peer_v': nrm(ks[18], (L, PEER_EXPERTS, D_MODEL), (PEER_HEADS * PEER_TOPK) ** -0.5),
        'final_norm_g': 1.0 + nrm(ks[19], (D_MODEL,), 0.02),
    }


def reference(x, norm1_g, w_in, conv_w, conv_b, wa_proj, decay_up_f, decay_bias_f,
              decay_up_b, decay_bias_b, gla_norm_g, wb_proj, gate_bias, w_out, norm2_g,
              peer_wq, peer_keys, peer_u, peer_v, final_norm_g):
    for l in range(DEPTH):
        xn = _rmsnorm(x, norm1_g[l])
        x = x + _mixer(xn, w_in[l], conv_w[l], conv_b[l], wa_proj[l], decay_up_f[l],
                       decay_bias_f[l], decay_up_b[l], decay_bias_b[l], gla_norm_g[l],
                       wb_proj[l], gate_bias[l], w_out[l])
        xn = _rmsnorm(x, norm2_g[l])
        x = x + _peer(xn, peer_wq[l], peer_keys[l], peer_u[l], peer_v[l])
    return _rmsnorm(x, final_norm_g)
```

```cpp
#include <hip/hip_runtime.h>
#include <hip/hip_cooperative_groups.h>
#include <cstdio>
namespace cg = cooperative_groups;

typedef unsigned short u16;
typedef unsigned int u32;
using bf16x8 = __attribute__((ext_vector_type(8))) short;
using f32x4 = __attribute__((ext_vector_type(4))) float;

#ifndef ONLY_PHASE
#define ONLY_PHASE -1
#endif
#define PH_ON(k) (ONLY_PHASE < 0 || ONLY_PHASE == (k))
#ifndef MULTI_LAUNCH
#define MULTI_LAUNCH 0
#endif

constexpr int BT = 16384, SEQ = 8192;
constexpr int LDS_BYTES = 80896;
constexpr int NPHASE = 15;

struct Params {
  const float *x, *norm1_g, *w_in, *conv_w, *conv_b, *wa, *dupf, *dbf, *dupb, *dbb, *gng, *wb, *gbias, *wo,
      *norm2_g, *wq, *keys, *pu, *pv, *fng;
  float* out;
  u16 *WinT, *WaT, *WbT, *WoT, *WqT, *KeysB;
  u16 *R1, *R2, *R3, *R4, *R5, *R6;
  float *R7, *z, *Dd;
  unsigned* bar;
};

__device__ __forceinline__ u16 f2b(float f) { u32 u = __float_as_uint(f); u += 0x7fffu + ((u >> 16) & 1u); return (u16)(u >> 16); }
__device__ __forceinline__ float b2f(u16 h) { return __uint_as_float(((u32)h) << 16); }
__device__ __forceinline__ u32 pack2(float a, float b) { return (u32)f2b(a) | ((u32)f2b(b) << 16); }
__device__ __forceinline__ float blo(u32 w) { return __uint_as_float(w << 16); }
__device__ __forceinline__ float bhi(u32 w) { return __uint_as_float(w & 0xffff0000u); }
__device__ __forceinline__ float wave_sum(float v) {
#pragma unroll
  for (int o = 32; o > 0; o >>= 1) v += __shfl_xor(v, o);
  return v;
}
__device__ __forceinline__ float sigmoidf_(float v) { return 1.f / (1.f + __expf(-v)); }
__device__ __forceinline__ u32 ordf(float v) { u32 u = __float_as_uint(v); return (u & 0x80000000u) ? ~u : (u | 0x80000000u); }
__device__ __forceinline__ float unordf(u32 k) { return __uint_as_float((k & 0x80000000u) ? (k ^ 0x80000000u) : ~k); }

template <int MT, int NT, int KT>
__device__ __forceinline__ void mma_nt(f32x4 (&acc)[MT][NT], const u16* A, int sa, const u16* B, int sb, int lane) {
  const int fr = lane & 15, fq = lane >> 4;
  const u16* pa = A + fr * sa + fq * 8;
  const u16* pb = B + fr * sb + fq * 8;
#pragma unroll
  for (int k = 0; k < KT; k++) {
    bf16x8 a[MT], b[NT];
#pragma unroll
    for (int m = 0; m < MT; m++) a[m] = *(const bf16x8*)(pa + m * 16 * sa + k * 32);
#pragma unroll
    for (int n = 0; n < NT; n++) b[n] = *(const bf16x8*)(pb + n * 16 * sb + k * 32);
#pragma unroll
    for (int m = 0; m < MT; m++)
#pragma unroll
      for (int n = 0; n < NT; n++) acc[m][n] = __builtin_amdgcn_mfma_f32_16x16x32_bf16(a[m], b[n], acc[m][n], 0, 0, 0);
  }
}

template <int MT, int NT>
__device__ __forceinline__ void mma_sw64(f32x4 (&acc)[MT][NT], const u16* A, const u16* B, int lane) {
  const int fr = lane & 15, fq = lane >> 4;
  const int cb = fq ^ ((fr >> 1) & 7);
  const u16* pa = A + fr * 64;
  const u16* pb = B + fr * 64;
#pragma unroll
  for (int k = 0; k < 2; k++) {
    const int co = (cb ^ (k * 4)) * 8;
    bf16x8 a[MT], b[NT];
#pragma unroll
    for (int m = 0; m < MT; m++) a[m] = *(const bf16x8*)(pa + m * 16 * 64 + co);
#pragma unroll
    for (int n = 0; n < NT; n++) b[n] = *(const bf16x8*)(pb + n * 16 * 64 + co);
#pragma unroll
    for (int m = 0; m < MT; m++)
#pragma unroll
      for (int n = 0; n < NT; n++) acc[m][n] = __builtin_amdgcn_mfma_f32_16x16x32_bf16(a[m], b[n], acc[m][n], 0, 0, 0);
  }
}

#define ST_DECL(S) uint4 S##a0, S##a1, S##a2, S##a3, S##b0, S##b1, S##b2, S##b3
#define ST_LOAD(S, PA, PB)                                                                                           \
  do {                                                                                                               \
    const char* pa_ = (const char*)(PA);                                                                             \
    const char* pb_ = (const char*)(PB);                                                                             \
    S##a0 = *(const uint4*)(pa_ + voffA); S##a1 = *(const uint4*)(pa_ + (size_t)64 * lda + voffA);                   \
    S##a2 = *(const uint4*)(pa_ + (size_t)128 * lda + voffA); S##a3 = *(const uint4*)(pa_ + (size_t)192 * lda + voffA); \
    S##b0 = *(const uint4*)(pb_ + voffB); S##b1 = *(const uint4*)(pb_ + (size_t)64 * ldb + voffB);                   \
    S##b2 = *(const uint4*)(pb_ + (size_t)128 * ldb + voffB); S##b3 = *(const uint4*)(pb_ + (size_t)192 * ldb + voffB); \
  } while (0)
#define ST_WRITE(S, WA, WB)                                                                                          \
  do {                                                                                                               \
    *(uint4*)(WA) = S##a0; *(uint4*)((WA) + 32 * 64) = S##a1; *(uint4*)((WA) + 64 * 64) = S##a2; *(uint4*)((WA) + 96 * 64) = S##a3; \
    *(uint4*)(WB) = S##b0; *(uint4*)((WB) + 32 * 64) = S##b1; *(uint4*)((WB) + 64 * 64) = S##b2; *(uint4*)((WB) + 96 * 64) = S##b3; \
  } while (0)

#define GLDS16(G, L) __builtin_amdgcn_global_load_lds((const void*)(G), (__attribute__((address_space(3))) void*)(L), 16, 0, 0)
__device__ __forceinline__ void gemm_acc_db(f32x4 (&acc)[4][4], const u16* __restrict__ A, int lda, const u16* __restrict__ B,
                                            int ldb, int K, char* smem) {
  const int t = threadIdx.x, lane = t & 63, w = t >> 6, wr = w >> 1, wc = w & 1;
  const int lr = t >> 3;
  const int gc = ((t & 7) ^ ((lr >> 1) & 7)) * 8;
  const u16* pa = A + (size_t)lr * lda + gc;
  const u16* pb = B + (size_t)lr * ldb + gc;
  char* l0 = smem + t * 16;
  u16* b0 = (u16*)smem;
  u16* b1 = b0 + 2 * 128 * 64;
#define ISSUE_TILE(KT, BUFOFF)                                                                     \
  do {                                                                                             \
    const u16* qa = pa + (KT) * 64;                                                                \
    const u16* qb = pb + (KT) * 64;                                                                \
    char* lb = l0 + (BUFOFF);                                                                      \
    GLDS16(qa, lb); GLDS16(qa + (size_t)32 * lda, lb + 4096);                                      \
    GLDS16(qa + (size_t)64 * lda, lb + 8192); GLDS16(qa + (size_t)96 * lda, lb + 12288);           \
    GLDS16(qb, lb + 16384); GLDS16(qb + (size_t)32 * ldb, lb + 16384 + 4096);                      \
    GLDS16(qb + (size_t)64 * ldb, lb + 16384 + 8192); GLDS16(qb + (size_t)96 * ldb, lb + 16384 + 12288); \
  } while (0)
  const int nk = K >> 6;
  __syncthreads();
  ISSUE_TILE(0, 0);
#define KSTEP(BUF, ISSUE_STMT)                                                 \
  do {                                                                         \
    asm volatile("s_waitcnt vmcnt(0)" ::: "memory");                          \
    __builtin_amdgcn_s_barrier();                                              \
    asm volatile("" ::: "memory");                                             \
    ISSUE_STMT;                                                                \
    mma_sw64<4, 4>(acc, BUF + wr * 64 * 64, BUF + 128 * 64 + wc * 64 * 64, lane); \
  } while (0)
  for (int kt = 0; kt + 2 < nk; kt += 2) {
    KSTEP(b0, ISSUE_TILE(kt + 1, 32768));
    KSTEP(b1, ISSUE_TILE(kt + 2, 0));
  }
  KSTEP(b0, ISSUE_TILE(nk - 1, 32768));
  KSTEP(b1, (void)0);
  asm volatile("s_waitcnt lgkmcnt(0)" ::: "memory");
#undef KSTEP
#undef ISSUE_TILE
}

struct TileIter {
  int i, step, lim, NT, xcd; bool swz;
  __device__ __forceinline__ TileIter(int nt_) {
    NT = nt_;
    swz = (gridDim.x & 7) == 0;
    if (swz) { xcd = blockIdx.x & 7; i = blockIdx.x >> 3; step = gridDim.x >> 3; lim = 16 * NT; }
    else { xcd = 0; i = blockIdx.x; step = gridDim.x; lim = 128 * NT; }
  }
  __device__ __forceinline__ bool next(int& mt, int& nt) {
    if (i >= lim) return false;
    if (swz) { int mg = i / (NT * 8), rem = i - mg * NT * 8; nt = rem >> 3; mt = xcd * 16 + mg * 8 + (rem & 7); }
    else { mt = i & 127; nt = i >> 7; }
    i += step;
    return true;
  }
};

__device__ __forceinline__ void zero_acc(f32x4 (&acc)[4][4]) {
#pragma unroll
  for (int m = 0; m < 4; m++)
#pragma unroll
    for (int n = 0; n < 4; n++) acc[m][n] = f32x4{0.f, 0.f, 0.f, 0.f};
}

__device__ __forceinline__ int winmap(int r) {
  if (r < 2048) { int tile = r >> 7, w = r & 127, grp = w >> 5; int ch = tile * 64 + (grp >> 1) * 32 + (w & 31); return ((grp & 1) ? 2048 : 0) + ch; }
  if (r < 3072) return r - 1024;
  if (r < 6176) return r;
  if (r < 6272) return -1;
  return r - 96;
}

__device__ __forceinline__ void tr_tile(const float* __restrict__ src, int ld, int col0, u16* __restrict__ dst, int r0, int k0, float* sT) {
  const int t = threadIdx.x;
  const int r = t >> 3, kc = t & 7;
  if (col0 < 0) {
    *(uint4*)(dst + (size_t)(r0 + r) * 1024 + k0 + kc * 8) = make_uint4(0, 0, 0, 0);
    return;
  }
  __syncthreads();
#pragma unroll
  for (int i = 0; i < 8; i++) {
    int k = (t >> 5) + i * 8, rr = t & 31;
    sT[k * 33 + rr] = src[(size_t)(k0 + k) * ld + col0 + rr];
  }
  __syncthreads();
  u32 wv[4];
#pragma unroll
  for (int j = 0; j < 4; j++) wv[j] = pack2(sT[(kc * 8 + 2 * j) * 33 + r], sT[(kc * 8 + 2 * j + 1) * 33 + r]);
  *(uint4*)(dst + (size_t)(r0 + r) * 1024 + k0 + kc * 8) = make_uint4(wv[0], wv[1], wv[2], wv[3]);
}

__device__ __forceinline__ void rms_row(const float* __restrict__ src, const float* __restrict__ g, u16* __restrict__ dst, int lane) {
  float4 v[4];
  float ss = 0.f;
#pragma unroll
  for (int i = 0; i < 4; i++) {
    v[i] = *(const float4*)(src + i * 256 + lane * 4);
    ss += v[i].x * v[i].x + v[i].y * v[i].y + v[i].z * v[i].z + v[i].w * v[i].w;
  }
  ss = wave_sum(ss);
  const float rstd = rsqrtf(ss * (1.f / 1024.f) + 1e-6f);
#pragma unroll
  for (int i = 0; i < 4; i++) {
    float4 gg = *(const float4*)(g + i * 256 + lane * 4);
    uint2 o;
    o.x = pack2(v[i].x * rstd * gg.x, v[i].y * rstd * gg.y);
    o.y = pack2(v[i].z * rstd * gg.z, v[i].w * rstd * gg.w);
    *(uint2*)(dst + i * 256 + lane * 4) = o;
  }
}

__device__ void phase0(const Params& p, char* smem) {
  float* sT = (float*)smem;
  const int t = threadIdx.x, lane = t & 63, w = t >> 6;
  u16* xn = (u16*)p.out;
  constexpr int J0 = 4160, J4 = J0 + 4096;
  for (int job = blockIdx.x; job < J4; job += gridDim.x) {
    if (job < J0) {
      int rb = job >> 4, kb = job & 15;
      tr_tile(p.w_in, 8224, winmap(rb * 32), p.WinT, rb * 32, kb * 64, sT);
    } else {
      int row = (job - J0) * 4 + w;
      rms_row(p.x + (size_t)row * 1024, p.norm1_g, xn + (size_t)row * 1024, lane);
    }
  }
}
__device__ void weights_late(const Params& p, char* smem) {
  float* sT = (float*)smem;
  const int t = threadIdx.x;
  constexpr int J1 = 1536, J2 = J1 + 1024, J3 = J2 + 128;
  for (int job = blockIdx.x; job < J3; job += gridDim.x) {
    if (job < J1) {
      int which = job >> 9, rb = (job & 511) >> 4, kb = job & 15;
      const float* src = which == 0 ? p.wa : (which == 1 ? p.wb : p.wo);
      u16* dst = which == 0 ? p.WaT : (which == 1 ? p.WbT : p.WoT);
      tr_tile(src, 1024, rb * 32, dst, rb * 32, kb * 64, sT);
    } else if (job < J2) {
      int j = job - J1, rb = j >> 4, kb = j & 15;
      tr_tile(p.wq, 2048, rb * 32, p.WqT, rb * 32, kb * 64, sT);
    } else {
      int j = job - J2;
      int base = (j * 256 + t) * 8;
      float4 a = *(const float4*)(p.keys + base), b = *(const float4*)(p.keys + base + 4);
      *(uint4*)(p.KeysB + base) = make_uint4(pack2(a.x, a.y), pack2(a.z, a.w), pack2(b.x, b.y), pack2(b.z, b.w));
    }
  }
}

__device__ void la_prep(const Params& p, char* smem) {
  float* sZ = (float*)smem;
  float* sPart = sZ + 1024;
  const int t = threadIdx.x, lane = t & 63, w = t >> 6, fr = lane & 15, fq = lane >> 4;
  const u16* xn = (const u16*)p.out;
  const u16* Wz = p.WinT + (size_t)6144 * 1024;
  u32* la16 = (u32*)p.R6;
  float uf0[16], uf1[16], ub0[16], ub1[16];
#pragma unroll
  for (int r = 0; r < 16; r++) {
    uf0[r] = p.dupf[r * 512 + 2 * t]; uf1[r] = p.dupf[r * 512 + 2 * t + 1];
    ub0[r] = p.dupb[r * 512 + 2 * t]; ub1[r] = p.dupb[r * 512 + 2 * t + 1];
  }
  const float bf0 = p.dbf[2 * t], bf1 = p.dbf[2 * t + 1], bb0 = p.dbb[2 * t], bb1 = p.dbb[2 * t + 1];
  for (int job = blockIdx.x; job < BT / 32; job += gridDim.x) {
    f32x4 az[2][2];
#pragma unroll
    for (int m = 0; m < 2; m++)
#pragma unroll
      for (int n = 0; n < 2; n++) az[m][n] = f32x4{0.f, 0.f, 0.f, 0.f};
    {
      const u16* ap = xn + (size_t)(job * 32 + fr) * 1024 + w * 256 + fq * 8;
      const u16* bp = Wz + (size_t)fr * 1024 + w * 256 + fq * 8;
#pragma unroll
      for (int ks = 0; ks < 8; ks++) {
        bf16x8 a0 = *(const bf16x8*)(ap + ks * 32), a1 = *(const bf16x8*)(ap + 16 * 1024 + ks * 32);
        bf16x8 b0 = *(const bf16x8*)(bp + ks * 32), b1 = *(const bf16x8*)(bp + 16 * 1024 + ks * 32);
        az[0][0] = __builtin_amdgcn_mfma_f32_16x16x32_bf16(a0, b0, az[0][0], 0, 0, 0);
        az[0][1] = __builtin_amdgcn_mfma_f32_16x16x32_bf16(a0, b1, az[0][1], 0, 0, 0);
        az[1][0] = __builtin_amdgcn_mfma_f32_16x16x32_bf16(a1, b0, az[1][0], 0, 0, 0);
        az[1][1] = __builtin_amdgcn_mfma_f32_16x16x32_bf16(a1, b1, az[1][1], 0, 0, 0);
      }
    }
    __syncthreads();
#pragma unroll
    for (int m = 0; m < 2; m++)
#pragma unroll
      for (int n = 0; n < 2; n++)
#pragma unroll
        for (int j = 0; j < 4; j++) sPart[w * 1024 + (m * 16 + fq * 4 + j) * 32 + n * 16 + fr] = az[m][n][j];
    __syncthreads();
    {
      const float4 q0 = *(const float4*)(sPart + t * 4), q1 = *(const float4*)(sPart + 1024 + t * 4), q2 = *(const float4*)(sPart + 2048 + t * 4),
                   q3 = *(const float4*)(sPart + 3072 + t * 4);
      *(float4*)(sZ + t * 4) = make_float4(q0.x + q1.x + q2.x + q3.x, q0.y + q1.y + q2.y + q3.y, q0.z + q1.z + q2.z + q3.z, q0.w + q1.w + q2.w + q3.w);
    }
    __syncthreads();
    for (int i = 0; i < 32; i++) {
      const float* zr = sZ + i * 32;
      float a0 = bf0, a1 = bf1, c0 = bb0, c1 = bb1;
#pragma unroll
      for (int r = 0; r < 16; r++) {
        const float zf = zr[r], zb = zr[16 + r];
        a0 += zf * uf0[r]; a1 += zf * uf1[r];
        c0 += zb * ub0[r]; c1 += zb * ub1[r];
      }
      const float l0 = (fminf(a0, 0.f) - __logf(1.f + __expf(-fabsf(a0)))) * 0.0625f;
      const float l1 = (fminf(a1, 0.f) - __logf(1.f + __expf(-fabsf(a1)))) * 0.0625f;
      const float m0 = (fminf(c0, 0.f) - __logf(1.f + __expf(-fabsf(c0)))) * 0.0625f;
      const float m1 = (fminf(c1, 0.f) - __logf(1.f + __expf(-fabsf(c1)))) * 0.0625f;
      const int tok = job * 32 + i;
      la16[(size_t)tok * 256 + t] = (u32)__builtin_bit_cast(unsigned short, (_Float16)l0) | ((u32)__builtin_bit_cast(unsigned short, (_Float16)l1) << 16);
      la16[(size_t)(BT + tok) * 256 + t] = (u32)__builtin_bit_cast(unsigned short, (_Float16)m0) | ((u32)__builtin_bit_cast(unsigned short, (_Float16)m1) << 16);
    }
  }
}

__device__ void phase1(const Params& p, char* smem) {
  u16* sA = (u16*)smem;
  u16* sB = sA + 128 * 64;
  const int t = threadIdx.x, lane = t & 63, w = t >> 6, wr = w >> 1, wc = w & 1, fr = lane & 15, fq = lane >> 4;
  const u16* xn = (const u16*)p.out;
  la_prep(p, smem);
  TileIter ti(48);
  int mt, nt;
  while (ti.next(mt, nt)) {
    f32x4 acc[4][4];
    zero_acc(acc);
    gemm_acc_db(acc, xn + (size_t)mt * 128 * 1024, 1024, p.WinT + (size_t)nt * 128 * 1024, 1024, 1024, smem);
    const int row0 = mt * 128 + wr * 64 + fq * 4;
    if (nt < 16) {
#pragma unroll
      for (int m = 0; m < 4; m++)
#pragma unroll
        for (int n = 0; n < 2; n++)
#pragma unroll
          for (int j = 0; j < 4; j++) {
            int ch = nt * 64 + wc * 32 + n * 16 + fr;
            p.R1[(size_t)(row0 + m * 16 + j) * 1024 + ch] = f2b(acc[m][n][j] * acc[m][n + 2][j]);
          }
    } else {
      const int g = (nt - 16) >> 3;
      u16* dst = g == 0 ? p.R2 : (g == 1 ? p.R3 : (g == 2 ? p.R4 : p.R5));
      const int cb = ((nt - 16) & 7) * 128 + wc * 64;
      const float sc = (g == 1 && cb < 512) ? 0.08838834764831845f : 1.f;
#pragma unroll
      for (int m = 0; m < 4; m++)
#pragma unroll
        for (int n = 0; n < 4; n++)
#pragma unroll
          for (int j = 0; j < 4; j++)
            dst[(size_t)(row0 + m * 16 + j) * 1024 + cb + n * 16 + fr] = f2b(acc[m][n][j] * sc);
    }
  }
}

#define XB_TMO      128
#define XB_XCNT(j)  (256  + 64 * (j))
#define XB_XSUB(j)  (1280 + 64 * (j))
#define XB_XGEN(j)  (2304 + 64 * (j))
#define XB_TOP      3328
#define XB_TOPGEN   3392
#define XCD_BAR_WORDS 3456
#define XB_SPIN_CAP (1u << 20)
#define LAS __attribute__((address_space(3)))
__device__ __forceinline__ unsigned xb_ld(unsigned* p) { return __hip_atomic_load(p, __ATOMIC_RELAXED, __HIP_MEMORY_SCOPE_AGENT); }
__device__ __forceinline__ unsigned xb_add(unsigned* p, unsigned v) { return __hip_atomic_fetch_add(p, v, __ATOMIC_RELAXED, __HIP_MEMORY_SCOPE_AGENT); }
__device__ __forceinline__ unsigned xb_xcc_id() { return (unsigned)__builtin_amdgcn_s_getreg((3 << 11) | 20) & 0xFu; }
#define XB_SPIN(cond, bar) do { unsigned _sp = 0; while (cond) { __builtin_amdgcn_s_sleep(1); \
    if ((++_sp & 255u) == 0u) { if (xb_ld(&(bar)[XB_TMO])) break; if (_sp > XB_SPIN_CAP) { atomicAdd(&(bar)[XB_TMO], 1u); break; } } } } while (0)
struct XcdBarrier { unsigned* bar; unsigned x; volatile LAS unsigned* st; };
__device__ __forceinline__ XcdBarrier xcd_barrier_post(unsigned* bar, volatile LAS unsigned* st) {
  XcdBarrier b; b.bar = bar; b.x = xb_xcc_id(); b.st = st;
  if (threadIdx.x == 0) (void)xb_add(&bar[XB_XCNT(b.x)], 1u);
  return b;
}
__device__ __forceinline__ void xcd_barrier_complete(unsigned* bar, unsigned x, unsigned& nloc, unsigned& nx) {
  const unsigned G = gridDim.x * gridDim.y * gridDim.z;
  unsigned sum, cnt, mine, sp = 0u;
  for (;;) {
    sum = 0u; cnt = 0u; mine = 0u;
#pragma unroll
    for (unsigned j = 0; j < 16; ++j) { const unsigned c = xb_ld(&bar[XB_XCNT(j)]); sum += c; cnt += (c > 0u) ? 1u : 0u; mine = (j == x) ? c : mine; }
    if (sum == G) break;
    __builtin_amdgcn_s_sleep(1);
    if ((++sp & 255u) == 0u) { if (xb_ld(&bar[XB_TMO])) break; if (sp > XB_SPIN_CAP) { atomicAdd(&bar[XB_TMO], 1u); break; } }
  }
  nloc = mine > 0u ? mine : 1u; nx = cnt > 0u ? cnt : 1u;
}
__device__ __forceinline__ void xcd_barrier(const XcdBarrier& b) {
  asm volatile("s_waitcnt vmcnt(0)" ::: "memory");
  __syncthreads();
  if (threadIdx.x == 0) {
    unsigned* bar = b.bar;
    __builtin_amdgcn_s_waitcnt(0);
    unsigned nloc = b.st[0], nx = b.st[1];
    if (nloc == 0u) { xcd_barrier_complete(bar, b.x, nloc, nx); b.st[0] = nloc; b.st[1] = nx; }
    const unsigned old = xb_add(&bar[XB_XSUB(b.x)], 1u);
    const unsigned gen = old / nloc;
    if (old + 1u == (gen + 1u) * nloc) {
      __builtin_amdgcn_fence(__ATOMIC_RELEASE, "agent");
      asm volatile("s_waitcnt vmcnt(0)" ::: "memory");
      const unsigned og = xb_add(&bar[XB_TOP], 1u);
      const unsigned tg = og / nx;
      if (og + 1u == (tg + 1u) * nx) xb_add(&bar[XB_TOPGEN], 1u);
      else XB_SPIN(xb_ld(&bar[XB_TOPGEN]) == tg, bar);
      __builtin_amdgcn_fence(__ATOMIC_ACQUIRE, "agent");
      xb_add(&bar[XB_XGEN(b.x)], 1u);
      asm volatile("s_waitcnt vmcnt(0)" ::: "memory");
    } else {
      XB_SPIN(xb_ld(&bar[XB_XGEN(b.x)]) == gen, bar);
      __builtin_amdgcn_fence(__ATOMIC_ACQUIRE, "agent");
      asm volatile("s_waitcnt vmcnt(0)" ::: "memory");
    }
  }
  __syncthreads();
}

__device__ void gla_item(const Params& p, int item, int pass, char* smem) {
  const int dvp = item & 1, seg = (item >> 1) & 15, dir = (item >> 5) & 1, h = (item >> 6) & 3, b = item >> 8;
  const int bhd = (b * 4 + h) * 2 + dir;
  u16* sQ = (u16*)smem;
  u16* sK = sQ + 64 * 136;
  u16* sKT = sK + 64 * 136;
  u16* sVT = sKT + 128 * 72;
  u16* sST = sVT + 64 * 72;
  float* sDec = (float*)(sST + 64 * 136);
  float* sTot = (float*)sVT;
  const int t = threadIdx.x, lane = t & 63, w = __builtin_amdgcn_readfirstlane(t >> 6), wr = w >> 1, wc = w & 1, fr = lane & 15, fq = lane >> 4;
  const int d0 = lane * 2;
  const u32* la16 = (const u32*)p.R6 + (size_t)dir * BT * 256 + h * 64 + lane;
  const u16* qk = p.R3;
  const u16* vv = p.R4;
  u16* obuf = dir ? p.R2 : p.R1;
  float* Lp = p.R7 + (size_t)(bhd * 16 + seg) * 32768 + (size_t)dvp * 128 * 128;

  f32x4 accS[2][2][4];
#pragma unroll
  for (int s = 0; s < 2; s++)
#pragma unroll
    for (int m = 0; m < 2; m++)
#pragma unroll
      for (int n = 0; n < 4; n++)
#pragma unroll
        for (int j = 0; j < 4; j++)
          accS[s][m][n][j] = (pass == 2) ? Lp[(s * 64 + wr * 32 + m * 16 + fq * 4 + j) * 128 + wc * 64 + n * 16 + fr] : 0.f;
  float dsum0 = 0.f, dsum1 = 0.f;

  for (int ci = 0; ci < 8; ci++) {
    const int c = seg * 8 + ci;
    __syncthreads();
    u32 qv[16], kv[16], lav[16], vreg[2][16];
#pragma unroll
    for (int ii = 0; ii < 16; ii++) {
      int f = c * 64 + w * 16 + ii;
      int pos = dir ? (SEQ - 1 - f) : f;
      size_t tokoff = (size_t)(b * SEQ + pos) * 1024;
      kv[ii] = *(const u32*)(qk + tokoff + 512 + h * 128 + d0);
      if (pass == 2) qv[ii] = *(const u32*)(qk + tokoff + h * 128 + d0);
      lav[ii] = la16[(size_t)(b * SEQ + pos) * 256];
      vreg[0][ii] = vv[tokoff + h * 256 + dvp * 128 + lane];
      vreg[1][ii] = vv[tokoff + h * 256 + dvp * 128 + 64 + lane];
    }
    float bl0[16], bl1[16];
    {
      float run0 = 0.f, run1 = 0.f;
#pragma unroll
      for (int ii = 0; ii < 16; ii++) {
        run0 += (float)__builtin_bit_cast(_Float16, (unsigned short)(lav[ii] & 0xffffu));
        run1 += (float)__builtin_bit_cast(_Float16, (unsigned short)(lav[ii] >> 16));
        bl0[ii] = run0; bl1[ii] = run1;
      }
      sTot[w * 128 + d0] = run0;
      sTot[w * 128 + d0 + 1] = run1;
    }
    __syncthreads();
    {
      float off0 = 0.f, off1 = 0.f, tot0 = 0.f, tot1 = 0.f;
#pragma unroll
      for (int ww = 0; ww < 4; ww++) {
        float a = sTot[ww * 128 + d0], bb = sTot[ww * 128 + d0 + 1];
        if (ww < w) { off0 += a; off1 += bb; }
        tot0 += a; tot1 += bb;
      }
      dsum0 += tot0; dsum1 += tot1;
      const float et0 = __expf(tot0), et1 = __expf(tot1);
      if (w == 0) { sDec[d0] = et0; sDec[d0 + 1] = et1; }
#pragma unroll
      for (int ii = 0; ii < 16; ii += 2) {
        float ke0[2], ke1[2];
#pragma unroll
        for (int s = 0; s < 2; s++) {
          const int i2 = ii + s;
          const float b0 = bl0[i2] + off0, b1 = bl1[i2] + off1;
          const float k0 = blo(kv[i2]), k1 = bhi(kv[i2]);
          const int i = w * 16 + i2;
          const float e0 = __expf(b0), e1 = __expf(b1);
          const float kt0 = k0 * __builtin_amdgcn_rcpf(e0), kt1 = k1 * __builtin_amdgcn_rcpf(e1);
          if (pass == 2) {
            *(u32*)(sQ + i * 136 + d0) = pack2(blo(qv[i2]) * e0, bhi(qv[i2]) * e1);
            *(u32*)(sK + i * 136 + d0) = pack2(kt0, kt1);
          }
          ke0[s] = kt0 * et0;
          ke1[s] = kt1 * et1;
        }
        *(u32*)(sKT + d0 * 72 + w * 16 + ii) = pack2(ke0[0], ke0[1]);
        *(u32*)(sKT + (d0 + 1) * 72 + w * 16 + ii) = pack2(ke1[0], ke1[1]);
      }
    }
    __syncthreads();
    u16* sP = sK;
    if (pass == 2) {
      f32x4 accP[2][2];
#pragma unroll
      for (int m = 0; m < 2; m++)
#pragma unroll
        for (int n = 0; n < 2; n++) accP[m][n] = f32x4{0.f, 0.f, 0.f, 0.f};
      mma_nt<2, 2, 4>(accP, sQ + wr * 32 * 136, 136, sK + wc * 32 * 136, 136, lane);
      __syncthreads();
#pragma unroll
      for (int m = 0; m < 2; m++)
#pragma unroll
        for (int n = 0; n < 2; n++)
#pragma unroll
          for (int j = 0; j < 4; j++) {
            int i = wr * 32 + m * 16 + fq * 4 + j, jj = wc * 32 + n * 16 + fr;
            sP[i * 72 + jj] = (i >= jj) ? f2b(accP[m][n][j]) : (u16)0;
          }
    }
#pragma unroll
    for (int s = 0; s < 2; s++) {
      if (pass == 2) {
#pragma unroll
        for (int m = 0; m < 2; m++)
#pragma unroll
          for (int n = 0; n < 4; n++)
#pragma unroll
            for (int j = 0; j < 4; j++) sST[(wr * 32 + m * 16 + fq * 4 + j) * 136 + wc * 64 + n * 16 + fr] = f2b(accS[s][m][n][j]);
      }
      {
        uint4 v0 = make_uint4(vreg[s][0] | (vreg[s][1] << 16), vreg[s][2] | (vreg[s][3] << 16), vreg[s][4] | (vreg[s][5] << 16),
                              vreg[s][6] | (vreg[s][7] << 16));
        uint4 v1 = make_uint4(vreg[s][8] | (vreg[s][9] << 16), vreg[s][10] | (vreg[s][11] << 16), vreg[s][12] | (vreg[s][13] << 16),
                              vreg[s][14] | (vreg[s][15] << 16));
        *(uint4*)(sVT + lane * 72 + w * 16) = v0;
        *(uint4*)(sVT + lane * 72 + w * 16 + 8) = v1;
      }
      __syncthreads();
      if (pass == 2) {
        f32x4 accO[2][2];
#pragma unroll
        for (int m = 0; m < 2; m++)
#pragma unroll
          for (int n = 0; n < 2; n++) accO[m][n] = f32x4{0.f, 0.f, 0.f, 0.f};
        mma_nt<2, 2, 4>(accO, sQ + wr * 32 * 136, 136, sST + wc * 32 * 136, 136, lane);
        mma_nt<2, 2, 2>(accO, sP + wr * 32 * 72, 72, sVT + wc * 32 * 72, 72, lane);
#pragma unroll
        for (int m = 0; m < 2; m++)
#pragma unroll
          for (int j = 0; j < 4; j++) {
            int i = wr * 32 + m * 16 + fq * 4 + j;
            int f = c * 64 + i;
            int pos = dir ? (SEQ - 1 - f) : f;
            size_t o = (size_t)(b * SEQ + pos) * 1024 + h * 256 + dvp * 128 + s * 64 + wc * 32 + fr;
#pragma unroll
            for (int n = 0; n < 2; n++) obuf[o + n * 16] = f2b(accO[m][n][j]);
          }
      }
#pragma unroll
      for (int n = 0; n < 4; n++) {
        float dc = sDec[wc * 64 + n * 16 + fr];
#pragma unroll
        for (int m = 0; m < 2; m++)
#pragma unroll
          for (int j = 0; j < 4; j++) accS[s][m][n][j] *= dc;
      }
      mma_nt<2, 4, 2>(accS[s], sVT + wr * 32 * 72, 72, sKT + wc * 64 * 72, 72, lane);
      if (s == 0) __syncthreads();
    }
  }
  if (pass == 1) {
#pragma unroll
    for (int s = 0; s < 2; s++)
#pragma unroll
      for (int m = 0; m < 2; m++)
#pragma unroll
        for (int n = 0; n < 4; n++)
#pragma unroll
          for (int j = 0; j < 4; j++) Lp[(s * 64 + wr * 32 + m * 16 + fq * 4 + j) * 128 + wc * 64 + n * 16 + fr] = accS[s][m][n][j];
    if (dvp == 0 && w == 0) {
      p.Dd[(bhd * 16 + seg) * 128 + d0] = __expf(dsum0);
      p.Dd[(bhd * 16 + seg) * 128 + d0 + 1] = __expf(dsum1);
    }
  }
}

__device__ void phase2(const Params& p, char* smem, const XcdBarrier& xb) {
  const int t = threadIdx.x;
  (void)xb;
  u16* ya = (u16*)p.out + (size_t)BT * 1024;
  for (int job = blockIdx.x; job < 512 + 2048; job += gridDim.x) {
    if (job < 512) {
      gla_item(p, job, 1, smem);
    } else {
      const int j = job - 512;
      const int ch = (t & 127) * 8;
      float w0[8], w1[8], w2[8], cb[8];
#pragma unroll
      for (int e = 0; e < 8; e++) { w0[e] = p.conv_w[ch + e]; w1[e] = p.conv_w[1024 + ch + e]; w2[e] = p.conv_w[2048 + ch + e]; cb[e] = p.conv_b[ch + e]; }
#pragma unroll
      for (int it = 0; it < 4; it++) {
        const int tok = j * 8 + it * 2 + (t >> 7);
        const int pos = tok & (SEQ - 1);
        const size_t o = (size_t)tok * 1024 + ch;
        uint4 pc = *(const uint4*)(p.R1 + o);
        uint4 pp = make_uint4(0, 0, 0, 0), pn = make_uint4(0, 0, 0, 0);
        if (pos > 0) pp = *(const uint4*)(p.R1 + o - 1024);
        if (pos < SEQ - 1) pn = *(const uint4*)(p.R1 + o + 1024);
        uint4 bb = *(const uint4*)(p.R2 + o);
        const u32 pcs[4] = {pc.x, pc.y, pc.z, pc.w}, pps[4] = {pp.x, pp.y, pp.z, pp.w}, pns[4] = {pn.x, pn.y, pn.z, pn.w},
                  bbs[4] = {bb.x, bb.y, bb.z, bb.w};
        u32 ov[4];
#pragma unroll
        for (int q = 0; q < 4; q++) {
          float y0 = cb[2 * q] + w0[2 * q] * blo(pps[q]) + w1[2 * q] * blo(pcs[q]) + w2[2 * q] * blo(pns[q]);
          float y1 = cb[2 * q + 1] + w0[2 * q + 1] * bhi(pps[q]) + w1[2 * q + 1] * bhi(pcs[q]) + w2[2 * q + 1] * bhi(pns[q]);
          ov[q] = pack2(blo(bbs[q]) * y0, bhi(bbs[q]) * y1);
        }
        *(uint4*)(ya + o) = make_uint4(ov[0], ov[1], ov[2], ov[3]);
      }
    }
  }
}

__device__ void phase3(const Params& p) {
  for (int gid = blockIdx.x * 256 + threadIdx.x; gid < 16 * 32768; gid += gridDim.x * 256) {
    const int bhd = gid >> 15, e = gid & 32767, dk = e & 127;
    float carry = 0.f;
    for (int s = 0; s < 16; s++) {
      float* lp = p.R7 + (size_t)(bhd * 16 + s) * 32768 + e;
      float tmp = *lp;
      *lp = carry;
      carry = p.Dd[(bhd * 16 + s) * 128 + dk] * carry + tmp;
    }
  }
}

__device__ void phase5(const Params& p) {
  const int t = threadIdx.x, lane = t & 63, w = t >> 6;
  for (int it = blockIdx.x * 4 + w; it < BT * 4; it += gridDim.x * 4) {
    const int tok = it >> 2, h = it & 3;
    const size_t o = (size_t)tok * 1024 + h * 256 + lane * 4;
    uint2 a = *(const uint2*)(p.R1 + o), b = *(const uint2*)(p.R2 + o), r = *(const uint2*)(p.R5 + o);
    float ov[4] = {blo(a.x) + blo(b.x), bhi(a.x) + bhi(b.x), blo(a.y) + blo(b.y), bhi(a.y) + bhi(b.y)};
    float rv[4] = {blo(r.x), bhi(r.x), blo(r.y), bhi(r.y)};
    float ss = ov[0] * ov[0] + ov[1] * ov[1] + ov[2] * ov[2] + ov[3] * ov[3];
    ss = wave_sum(ss);
    const float rstd = rsqrtf(ss * (1.f / 256.f) + 1e-6f);
    float4 g = *(const float4*)(p.gng + h * 256 + lane * 4);
    const float gv[4] = {g.x, g.y, g.z, g.w};
    float res[4];
#pragma unroll
    for (int e = 0; e < 4; e++) res[e] = ov[e] * rstd * gv[e] * (rv[e] * sigmoidf_(rv[e]));
    uint2 out;
    out.x = pack2(res[0], res[1]);
    out.y = pack2(res[2], res[3]);
    *(uint2*)(p.R6 + o) = out;
  }
}

__device__ void phase6(const Params& p, char* smem) {
  const int t = threadIdx.x, lane = t & 63, w = t >> 6, wr = w >> 1, wc = w & 1, fr = lane & 15, fq = lane >> 4;
  const u16* xn = (const u16*)p.out;
  const u16* ya = xn + (size_t)BT * 1024;
  uint4* sG = (uint4*)((char*)p.R2 + (size_t)blockIdx.x * 65536 + t * 256);
  uint4* sH = sG + 8;
  TileIter ti(8);
  int mt, nt;
  while (ti.next(mt, nt)) {
    const int col0 = nt * 128 + wc * 64 + fr;
    f32x4 acc[4][4];
    zero_acc(acc);
    gemm_acc_db(acc, xn + (size_t)mt * 128 * 1024, 1024, p.WinT + (size_t)(6272 + nt * 128) * 1024, 1024, 1024, smem);
    {
      float gb[4];
#pragma unroll
      for (int n = 0; n < 4; n++) gb[n] = p.gbias[col0 + n * 16];
#pragma unroll
      for (int m = 0; m < 4; m++)
#pragma unroll
        for (int h = 0; h < 2; h++)
          sG[m * 2 + h] = make_uint4(pack2(sigmoidf_(acc[m][2 * h][0] + gb[2 * h]), sigmoidf_(acc[m][2 * h][1] + gb[2 * h])),
                                     pack2(sigmoidf_(acc[m][2 * h][2] + gb[2 * h]), sigmoidf_(acc[m][2 * h][3] + gb[2 * h])),
                                     pack2(sigmoidf_(acc[m][2 * h + 1][0] + gb[2 * h + 1]), sigmoidf_(acc[m][2 * h + 1][1] + gb[2 * h + 1])),
                                     pack2(sigmoidf_(acc[m][2 * h + 1][2] + gb[2 * h + 1]), sigmoidf_(acc[m][2 * h + 1][3] + gb[2 * h + 1])));
    }
    zero_acc(acc);
    gemm_acc_db(acc, ya + (size_t)mt * 128 * 1024, 1024, p.WaT + (size_t)nt * 128 * 1024, 1024, 1024, smem);
#pragma unroll
    for (int m = 0; m < 4; m++)
#pragma unroll
      for (int h = 0; h < 2; h++) {
        const uint4 g = sG[m * 2 + h];
        sG[m * 2 + h] = make_uint4(pack2(acc[m][2 * h][0] * blo(g.x), acc[m][2 * h][1] * bhi(g.x)),
                                   pack2(acc[m][2 * h][2] * blo(g.y), acc[m][2 * h][3] * bhi(g.y)),
                                   pack2(acc[m][2 * h + 1][0] * blo(g.z), acc[m][2 * h + 1][1] * bhi(g.z)),
                                   pack2(acc[m][2 * h + 1][2] * blo(g.w), acc[m][2 * h + 1][3] * bhi(g.w)));
      }
    zero_acc(acc);
    gemm_acc_db(acc, p.R6 + (size_t)mt * 128 * 1024, 1024, p.WbT + (size_t)nt * 128 * 1024, 1024, 1024, smem);
#pragma unroll
    for (int m = 0; m < 4; m++)
#pragma unroll
      for (int h = 0; h < 2; h++)
        sH[m * 2 + h] = make_uint4(pack2(acc[m][2 * h][0], acc[m][2 * h][1]), pack2(acc[m][2 * h][2], acc[m][2 * h][3]),
                                   pack2(acc[m][2 * h + 1][0], acc[m][2 * h + 1][1]), pack2(acc[m][2 * h + 1][2], acc[m][2 * h + 1][3]));
    zero_acc(acc);
    gemm_acc_db(acc, xn + (size_t)mt * 128 * 1024, 1024, p.WinT + (size_t)(6272 + 1024 + nt * 128) * 1024, 1024, 1024, smem);
    const int row0 = mt * 128 + wr * 64 + fq * 4;
    {
      float gb[4];
#pragma unroll
      for (int n = 0; n < 4; n++) gb[n] = p.gbias[1024 + col0 + n * 16];
#pragma unroll
      for (int m = 0; m < 4; m++)
#pragma unroll
        for (int h = 0; h < 2; h++) {
          const uint4 a = sG[m * 2 + h], b = sH[m * 2 + h];
          const u32 av[4] = {a.x, a.y, a.z, a.w}, bv[4] = {b.x, b.y, b.z, b.w};
#pragma unroll
          for (int nn = 0; nn < 2; nn++) {
            const int n = 2 * h + nn;
            float r0 = blo(av[nn * 2]) + blo(bv[nn * 2]) * sigmoidf_(acc[m][n][0] + gb[n]);
            float r1 = bhi(av[nn * 2]) + bhi(bv[nn * 2]) * sigmoidf_(acc[m][n][1] + gb[n]);
            float r2 = blo(av[nn * 2 + 1]) + blo(bv[nn * 2 + 1]) * sigmoidf_(acc[m][n][2] + gb[n]);
            float r3 = bhi(av[nn * 2 + 1]) + bhi(bv[nn * 2 + 1]) * sigmoidf_(acc[m][n][3] + gb[n]);
            u16* d = p.R1 + (size_t)(row0 + m * 16) * 1024 + col0 + n * 16;
            d[0] = f2b(r0); d[1024] = f2b(r1); d[2048] = f2b(r2); d[3072] = f2b(r3);
          }
        }
    }
  }
}

__device__ void phase7(const Params& p, char* smem) {
  u16* sA = (u16*)smem;
  u16* sB = sA + 128 * 64;
  const int t = threadIdx.x, lane = t & 63, w = t >> 6, wr = w >> 1, wc = w & 1, fr = lane & 15, fq = lane >> 4;
  float* x1 = (float*)p.R2;
  TileIter ti(8);
  int mt, nt;
  while (ti.next(mt, nt)) {
    f32x4 acc[4][4];
    zero_acc(acc);
    gemm_acc_db(acc, p.R1 + (size_t)mt * 128 * 1024, 1024, p.WoT + (size_t)nt * 128 * 1024, 1024, 1024, smem);
    const int row0 = mt * 128 + wr * 64 + fq * 4;
    const int col0 = nt * 128 + wc * 64 + fr;
#pragma unroll
    for (int m = 0; m < 4; m++)
#pragma unroll
      for (int n = 0; n < 4; n++)
#pragma unroll
        for (int j = 0; j < 4; j++) {
          size_t o = (size_t)(row0 + m * 16 + j) * 1024 + col0 + n * 16;
          x1[o] = p.x[o] + acc[m][n][j];
        }
  }
}

constexpr float U_SCALE = 256.f, V_SCALE = 64.f;
__device__ __forceinline__ u32 enc_fp8x4(float a, float b, float c, float d) {
  int w = __builtin_amdgcn_cvt_pk_fp8_f32(a, b, 0, false);
  w = __builtin_amdgcn_cvt_pk_fp8_f32(c, d, w, true);
  return (u32)w;
}
__device__ __forceinline__ void table_convert_job(const Params& p, int j, int t) {
  unsigned char* Tb = (unsigned char*)p.R5;
  const float* src = (j < 4096) ? p.pu : p.pv;
  const float sc = (j < 4096) ? U_SCALE : V_SCALE;
  size_t base = (size_t)(j & 4095) * 4096 + t * 16;
  unsigned char* slot = Tb + (base >> 10) * 2048 + ((j < 4096) ? 0 : 1024) + (base & 1023);
  float4 a = *(const float4*)(src + base), b = *(const float4*)(src + base + 4), c = *(const float4*)(src + base + 8),
         d = *(const float4*)(src + base + 12);
  *(uint4*)slot = make_uint4(enc_fp8x4(a.x * sc, a.y * sc, a.z * sc, a.w * sc), enc_fp8x4(b.x * sc, b.y * sc, b.z * sc, b.w * sc),
                                     enc_fp8x4(c.x * sc, c.y * sc, c.z * sc, c.w * sc), enc_fp8x4(d.x * sc, d.y * sc, d.z * sc, d.w * sc));
}
__device__ void phase8(const Params& p) {
  const int t = threadIdx.x, lane = t & 63, w = t >> 6;
  const float* x1 = (const float*)p.R2;
  for (int job = blockIdx.x; job < 4096; job += gridDim.x) {
    int row = job * 4 + w;
    rms_row(x1 + (size_t)row * 1024, p.norm2_g, p.R4 + (size_t)row * 1024, lane);
  }
}

__device__ void phase9(const Params& p, char* smem) {
  u16* sA = (u16*)smem;
  u16* sB = sA + 128 * 64;
  const int t = threadIdx.x, lane = t & 63, w = t >> 6, wr = w >> 1, wc = w & 1, fr = lane & 15, fq = lane >> 4;
  u16* q = (u16*)p.out;
  TileIter ti(16);
  int mt, nt;
  while (ti.next(mt, nt)) {
    f32x4 acc[4][4];
    zero_acc(acc);
    gemm_acc_db(acc, p.R4 + (size_t)mt * 128 * 1024, 1024, p.WqT + (size_t)nt * 128 * 1024, 1024, 1024, smem);
    const int row0 = mt * 128 + wr * 64 + fq * 4;
    const int col0 = nt * 128 + wc * 64 + fr;
#pragma unroll
    for (int m = 0; m < 4; m++)
#pragma unroll
      for (int n = 0; n < 4; n++)
#pragma unroll
        for (int j = 0; j < 4; j++) q[(size_t)(row0 + m * 16 + j) * 2048 + col0 + n * 16] = f2b(acc[m][n][j]);
#pragma unroll 1
    for (int r = 0; r < 4; r++) table_convert_job(p, (mt * 16 + nt) * 4 + r, t);
  }
}

__device__ __forceinline__ void select16q(u32* rowbase, int part, u32 (&tk)[16], unsigned char* idxp) {
  u32* myp = rowbase + part * 32;
#pragma unroll
  for (int it = 0; it < 16; it++) {
    u32 m = 0;
#pragma unroll
    for (int c = 0; c < 8; c++) {
      uint4 kk = *(const uint4*)(myp + c * 4);
      m = max(m, max(max(kk.x, kk.y), max(kk.z, kk.w)));
    }
    m = max(m, (u32)__shfl_xor((int)m, 1));
    m = max(m, (u32)__shfl_xor((int)m, 2));
    tk[it] = m;
    const int idx = 127 - (int)(m & 127u);
    if ((idx >> 5) == part) { rowbase[idx] = 0; idxp[it] = (unsigned char)idx; }
  }
}

__device__ void phase10(const Params& p, char* smem) {
  u16* sKeys = (u16*)smem;
  u32* sSc = (u32*)(smem + 128 * 136 * 2);
  unsigned char* sIdx = (unsigned char*)(smem + 128 * 136 * 2 + 64 * 132 * 4);
  const int t = threadIdx.x, lane = t & 63, w = t >> 6, fr = lane & 15, fq = lane >> 4;
  const int rl = lane >> 2, part = lane & 3, row = w * 16 + rl;
  const u16* q = (const u16*)p.out;
  int* experts = (int*)p.R7;
  float* gates = p.R7 + (size_t)BT * 128;
  for (int item = blockIdx.x; item < 256 * 8; item += gridDim.x) {
    const int tt = item >> 3, h = item & 7;
    u32 ta[16], tb[16];
#pragma unroll
    for (int pp = 0; pp < 2; pp++) {
      __syncthreads();
      const u16* ksrc = p.KeysB + (size_t)(h * 2 + pp) * 128 * 128;
#pragma unroll
      for (int i = 0; i < 8; i++) {
        int c = t + 256 * i, r = c >> 4, kc = (c & 15) * 8;
        *(uint4*)(sKeys + r * 136 + kc) = *(const uint4*)(ksrc + r * 128 + kc);
      }
      bf16x8 a[4];
      {
        const u16* qp = q + (size_t)(tt * 64 + w * 16 + fr) * 2048 + h * 256 + pp * 128 + fq * 8;
#pragma unroll
        for (int k = 0; k < 4; k++) a[k] = *(const bf16x8*)(qp + k * 32);
      }
      __syncthreads();
      f32x4 acc[8];
#pragma unroll
      for (int n = 0; n < 8; n++) acc[n] = f32x4{0.f, 0.f, 0.f, 0.f};
#pragma unroll
      for (int k = 0; k < 4; k++)
#pragma unroll
        for (int n = 0; n < 8; n++) {
          bf16x8 bv = *(const bf16x8*)(sKeys + (n * 16 + fr) * 136 + k * 32 + fq * 8);
          acc[n] = __builtin_amdgcn_mfma_f32_16x16x32_bf16(a[k], bv, acc[n], 0, 0, 0);
        }
#pragma unroll
      for (int n = 0; n < 8; n++)
#pragma unroll
        for (int j = 0; j < 4; j++) {
          int r = w * 16 + fq * 4 + j, col = n * 16 + fr;
          sSc[r * 132 + col] = (ordf(acc[n][j]) & ~127u) | (u32)(127 - col);
        }
      __syncthreads();
      if (pp == 0) select16q(sSc + row * 132, part, ta, sIdx + row * 32);
      else select16q(sSc + row * 132, part, tb, sIdx + row * 32 + 16);
    }
    __syncthreads();
    {
      float fa[4], fb[16];
#pragma unroll
      for (int r = 0; r < 4; r++) {
        const u32 s0 = ta[4 * r], s1 = ta[4 * r + 1], s2 = ta[4 * r + 2], s3 = ta[4 * r + 3];
        const u32 sel = part == 0 ? s0 : (part == 1 ? s1 : (part == 2 ? s2 : s3));
        fa[r] = unordf(sel & ~127u);
      }
#pragma unroll
      for (int j = 0; j < 16; j++) fb[j] = unordf(tb[j] & ~127u);
      constexpr int NJ[4] = {16, 3, 1, 1};
      u32 cand[4][16];
#pragma unroll
      for (int r = 0; r < 4; r++) {
        const int irow = part + 4 * r;
        const int jlim = 16 / (irow + 1);
#pragma unroll
        for (int j = 0; j < 16; j++)
          if (j < NJ[r]) cand[r][j] = (j < jlim) ? ((ordf(fa[r] + fb[j]) & ~255u) | (u32)(255 - (irow * 16 + j))) : 0u;
      }
      const int tok = tt * 64 + row;
      float sv[16];
      int ev[16];
#pragma unroll
      for (int it = 0; it < 16; it++) {
        u32 m = 0;
#pragma unroll
        for (int r = 0; r < 4; r++)
#pragma unroll
          for (int j = 0; j < 16; j++)
            if (j < NJ[r]) m = max(m, cand[r][j]);
        m = max(m, (u32)__shfl_xor((int)m, 1));
        m = max(m, (u32)__shfl_xor((int)m, 2));
#pragma unroll
        for (int r = 0; r < 4; r++)
#pragma unroll
          for (int j = 0; j < 16; j++)
            if (j < NJ[r]) cand[r][j] = (cand[r][j] == m) ? 0u : cand[r][j];
        const int c = 255 - (int)(m & 255u);
        const int i1 = sIdx[row * 32 + (c >> 4)], i2 = sIdx[row * 32 + 16 + (c & 15)];
        ev[it] = i1 * 128 + i2;
        sv[it] = unordf(m & ~255u);
      }
      const float mx = sv[0];
      float sum = 0.f;
#pragma unroll
      for (int it = 0; it < 16; it++) { sv[it] = __expf(sv[it] - mx); sum += sv[it]; }
      const float inv = 1.f / sum;
#pragma unroll
      for (int g = 0; g < 4; g++) {
        if (part == g) {
          *(int4*)(experts + (size_t)tok * 128 + h * 16 + g * 4) = make_int4(ev[g * 4], ev[g * 4 + 1], ev[g * 4 + 2], ev[g * 4 + 3]);
          *(float4*)(gates + (size_t)tok * 128 + h * 16 + g * 4) =
              make_float4(sv[g * 4] * inv, sv[g * 4 + 1] * inv, sv[g * 4 + 2] * inv, sv[g * 4 + 3] * inv);
        }
      }
    }
  }
}

typedef float f32x2 __attribute__((ext_vector_type(2)));
__device__ __forceinline__ void dec16(const uint4& q, float (&o)[16]) {
  const u32 ws_[4] = {q.x, q.y, q.z, q.w};
#pragma unroll
  for (int i = 0; i < 4; i++) {
    f32x2 lo = __builtin_amdgcn_cvt_pk_f32_fp8((int)ws_[i], false);
    f32x2 hi = __builtin_amdgcn_cvt_pk_f32_fp8((int)ws_[i], true);
    o[i * 4 + 0] = lo[0]; o[i * 4 + 1] = lo[1]; o[i * 4 + 2] = hi[0]; o[i * 4 + 3] = hi[1];
  }
}
__device__ __forceinline__ void peer_load8(uint4 (&U)[8], uint4 (&V)[8], const unsigned char* Ub, const unsigned char* Vb, int ev, int l0,
                                           int lane) {
#pragma unroll
  for (int u = 0; u < 8; u++) {
    const int e = __builtin_amdgcn_readlane(ev, l0 + u);
    U[u] = *(const uint4*)(Ub + (size_t)e * 2048 + lane * 16);
    V[u] = *(const uint4*)(Vb + (size_t)e * 2048 + lane * 16);
  }
}
__device__ __forceinline__ void peer_proc8(const uint4 (&U)[8], const uint4 (&V)[8], const f32x2 (&xp)[8], f32x2 (&accp)[8], float gate_lane,
                                           int lane) {
  float d[8];
#pragma unroll
  for (int u = 0; u < 8; u++) {
    const u32 ws_[4] = {U[u].x, U[u].y, U[u].z, U[u].w};
    f32x2 s = {0.f, 0.f};
#pragma unroll
    for (int q = 0; q < 4; q++) {
      s += xp[2 * q] * __builtin_amdgcn_cvt_pk_f32_fp8((int)ws_[q], false);
      s += xp[2 * q + 1] * __builtin_amdgcn_cvt_pk_f32_fp8((int)ws_[q], true);
    }
    d[u] = s[0] + s[1];
  }
  {
    const bool b4 = (lane & 4) != 0, b2 = (lane & 2) != 0, b1 = (lane & 1) != 0;
#pragma unroll
    for (int i = 0; i < 4; i++) {
      const float send = b4 ? d[i] : d[i + 4], keep = b4 ? d[i + 4] : d[i];
      d[i] = keep + __shfl_xor(send, 4);
    }
#pragma unroll
    for (int i = 0; i < 2; i++) {
      const float send = b2 ? d[i] : d[i + 2], keep = b2 ? d[i + 2] : d[i];
      d[i] = keep + __shfl_xor(send, 2);
    }
    {
      const float send = b1 ? d[0] : d[1], keep = b1 ? d[1] : d[0];
      d[0] = keep + __shfl_xor(send, 1);
    }
    d[0] += __shfl_xor(d[0], 8);
    d[0] += __shfl_xor(d[0], 16);
    d[0] += __shfl_xor(d[0], 32);
  }
  const float dd = d[0] * (1.f / U_SCALE);
  const float hd = 0.5f * dd * (1.f + erff(dd * 0.70710678118654752f));
  const int cl = __float_as_int(hd * gate_lane * (1.f / V_SCALE));
#pragma unroll
  for (int u = 0; u < 8; u++) {
    const float c = __int_as_float(__builtin_amdgcn_readlane(cl, u));
    const f32x2 c2 = {c, c};
    const u32 ws_[4] = {V[u].x, V[u].y, V[u].z, V[u].w};
#pragma unroll
    for (int q = 0; q < 4; q++) {
      accp[2 * q] += c2 * __builtin_amdgcn_cvt_pk_f32_fp8((int)ws_[q], false);
      accp[2 * q + 1] += c2 * __builtin_amdgcn_cvt_pk_f32_fp8((int)ws_[q], true);
    }
  }
}
__device__ __forceinline__ float dot16_fp8(const f32x2 (&xp)[8], const uint4& q) {
  const u32 ws_[4] = {q.x, q.y, q.z, q.w};
  f32x2 s = {0.f, 0.f};
#pragma unroll
  for (int i = 0; i < 4; i++) {
    s += xp[2 * i] * __builtin_amdgcn_cvt_pk_f32_fp8((int)ws_[i], false);
    s += xp[2 * i + 1] * __builtin_amdgcn_cvt_pk_f32_fp8((int)ws_[i], true);
  }
  return s[0] + s[1];
}
__device__ __forceinline__ void pe_load_tab(const unsigned char* Tb, unsigned loff, int e0, int e1, int g, uint4 (&U)[16]) {
#pragma unroll
  for (int kb = 0; kb < 16; kb++) {
    const int e = __shfl((kb < 8) ? e0 : e1, (kb & 7) * 8 + g);
    U[kb] = *(const uint4*)(Tb + ((unsigned)e * 2048u + loff));
  }
}
__device__ __forceinline__ void pe_load_x(const u16* xr, f32x2 (&xp)[8]) {
  uint4 a = *(const uint4*)(xr), b = *(const uint4*)(xr + 8);
  xp[0] = f32x2{blo(a.x), bhi(a.x)}; xp[1] = f32x2{blo(a.y), bhi(a.y)}; xp[2] = f32x2{blo(a.z), bhi(a.z)}; xp[3] = f32x2{blo(a.w), bhi(a.w)};
  xp[4] = f32x2{blo(b.x), bhi(b.x)}; xp[5] = f32x2{blo(b.y), bhi(b.y)}; xp[6] = f32x2{blo(b.z), bhi(b.z)}; xp[7] = f32x2{blo(b.w), bhi(b.w)};
}
__device__ __forceinline__ void pe_dot_store(const f32x2 (&xp)[8], const uint4 (&U)[16], float* pr, int lane, int r) {
  float d[16];
#pragma unroll
  for (int kb = 0; kb < 16; kb++) d[kb] = dot16_fp8(xp, U[kb]);
  const bool b4 = (lane & 4) != 0, b2 = (lane & 2) != 0, b1 = (lane & 1) != 0;
#pragma unroll
  for (int i = 0; i < 8; i++) { const float send = b4 ? d[i] : d[i + 8], keep = b4 ? d[i + 8] : d[i]; d[i] = keep + __shfl_xor(send, 4); }
#pragma unroll
  for (int i = 0; i < 4; i++) { const float send = b2 ? d[i] : d[i + 4], keep = b2 ? d[i + 4] : d[i]; d[i] = keep + __shfl_xor(send, 2); }
#pragma unroll
  for (int i = 0; i < 2; i++) { const float send = b1 ? d[i] : d[i + 2], keep = b1 ? d[i + 2] : d[i]; d[i] = keep + __shfl_xor(send, 1); }
  pr[(2 * r) * 8] = d[0];
  pr[(2 * r + 1) * 8] = d[1];
}
__device__ void phase11a(const Params& p) {
  const int t = threadIdx.x, lane = t & 63, w = t >> 6, g = lane >> 3, r = lane & 7;
  const int s = blockIdx.x & 7, jb = blockIdx.x >> 3, ns = (gridDim.x - s + 7) >> 3;
  const u16* xn2 = p.R4 + s * 128 + r * 16;
  const unsigned char* Tb = (const unsigned char*)p.R5 + s * 128;
  const unsigned loff = r * 16;
  const int* experts = (const int*)p.R7 + lane;
  float* part = p.out + (size_t)s * BT * 128 + g;
  const int first = jb * 4 + w, stride = ns * 4;
  if (first >= BT) return;
#define TOKC(T) (((T) < BT) ? (T) : first)
  int eA0, eA1, eB0, eB1;
  uint4 UA[16], UB[16];
  f32x2 xA[8], xB[8];
  eA0 = experts[(size_t)first * 128]; eA1 = experts[(size_t)first * 128 + 64];
  pe_load_tab(Tb, loff, eA0, eA1, g, UA);
  pe_load_x(xn2 + (size_t)first * 1024, xA);
  { const int t1 = TOKC(first + stride); eB0 = experts[(size_t)t1 * 128]; eB1 = experts[(size_t)t1 * 128 + 64]; }
#pragma unroll 1
  for (int tok = first; tok < BT; tok += 2 * stride) {
    const int t1 = tok + stride, t2 = tok + 2 * stride, t3 = tok + 3 * stride;
    pe_load_tab(Tb, loff, eB0, eB1, g, UB);
    pe_load_x(xn2 + (size_t)TOKC(t1) * 1024, xB);
    { const int tc = TOKC(t2); eA0 = experts[(size_t)tc * 128]; eA1 = experts[(size_t)tc * 128 + 64]; }
    pe_dot_store(xA, UA, part + (size_t)tok * 128, lane, r);
    pe_load_tab(Tb, loff, eA0, eA1, g, UA);
    pe_load_x(xn2 + (size_t)TOKC(t2) * 1024, xA);
    { const int tc = TOKC(t3); eB0 = experts[(size_t)tc * 128]; eB1 = experts[(size_t)tc * 128 + 64]; }
    if (t1 < BT) pe_dot_store(xB, UB, part + (size_t)t1 * 128, lane, r);
  }
}

__device__ void phase11r(const Params& p) {
  float* gates = p.R7 + (size_t)BT * 128;
  const float* part = p.out;
  for (int idx = blockIdx.x * 256 + threadIdx.x; idx < BT * 128 / 4; idx += gridDim.x * 256) {
    float4 h = *(const float4*)(part + (size_t)idx * 4);
#pragma unroll
    for (int ss = 1; ss < 8; ss++) {
      const float4 q = *(const float4*)(part + (size_t)ss * BT * 128 + (size_t)idx * 4);
      h.x += q.x; h.y += q.y; h.z += q.z; h.w += q.w;
    }
    float4 gt = *(const float4*)(gates + (size_t)idx * 4);
    const float hv[4] = {h.x * (1.f / U_SCALE), h.y * (1.f / U_SCALE), h.z * (1.f / U_SCALE), h.w * (1.f / U_SCALE)};
    const float gv[4] = {gt.x, gt.y, gt.z, gt.w};
    float c[4];
#pragma unroll
    for (int q = 0; q < 4; q++) c[q] = 0.5f * hv[q] * (1.f + erff(hv[q] * 0.70710678118654752f)) * gv[q] * (1.f / V_SCALE);
    *(float4*)(gates + (size_t)idx * 4) = make_float4(c[0], c[1], c[2], c[3]);
  }
}

struct PeTok { int e0, e1; float g0, g1; };
__device__ __forceinline__ PeTok pe_load_tok(const int* experts, const float* gates, int tok) {
  PeTok k;
  k.e0 = experts[(size_t)tok * 128]; k.e1 = experts[(size_t)tok * 128 + 64];
  k.g0 = gates[(size_t)tok * 128]; k.g1 = gates[(size_t)tok * 128 + 64];
  return k;
}
__device__ __forceinline__ void pe_value_store(const PeTok& k, const uint4 (&V)[16], float* x1row, float* ssqp, int lane, int g) {
  const float c0 = k.g0, c1 = k.g1;
  f32x2 accp[8];
#pragma unroll
  for (int i = 0; i < 8; i++) accp[i] = f32x2{0.f, 0.f};
#pragma unroll
  for (int kb = 0; kb < 16; kb++) {
    const float c = __shfl((kb < 8) ? c0 : c1, (kb & 7) * 8 + g);
    const f32x2 c2 = {c, c};
    const u32 ws_[4] = {V[kb].x, V[kb].y, V[kb].z, V[kb].w};
#pragma unroll
    for (int q = 0; q < 4; q++) {
      accp[2 * q] += c2 * __builtin_amdgcn_cvt_pk_f32_fp8((int)ws_[q], false);
      accp[2 * q + 1] += c2 * __builtin_amdgcn_cvt_pk_f32_fp8((int)ws_[q], true);
    }
  }
  float a[16];
#pragma unroll
  for (int i = 0; i < 8; i++) { a[2 * i] = accp[i][0]; a[2 * i + 1] = accp[i][1]; }
  const bool b32 = (lane & 32) != 0, b16 = (lane & 16) != 0, b8 = (lane & 8) != 0;
#pragma unroll
  for (int i = 0; i < 8; i++) { const float send = b32 ? a[i] : a[i + 8], keep = b32 ? a[i + 8] : a[i]; a[i] = keep + __shfl_xor(send, 32); }
#pragma unroll
  for (int i = 0; i < 4; i++) { const float send = b16 ? a[i] : a[i + 4], keep = b16 ? a[i + 4] : a[i]; a[i] = keep + __shfl_xor(send, 16); }
#pragma unroll
  for (int i = 0; i < 2; i++) { const float send = b8 ? a[i] : a[i + 2], keep = b8 ? a[i + 2] : a[i]; a[i] = keep + __shfl_xor(send, 8); }
  float2* xp = (float2*)x1row;
  float2 xv = *xp;
  xv.x += a[0]; xv.y += a[1];
  *xp = xv;
  const float sq = wave_sum(xv.x * xv.x + xv.y * xv.y);
  if (lane == 0) *ssqp = sq;
}
__device__ void phase11b(const Params& p) {
  const int t = threadIdx.x, lane = t & 63, w = t >> 6, g = lane >> 3, r = lane & 7;
  const int s = blockIdx.x & 7, jb = blockIdx.x >> 3, ns = (gridDim.x - s + 7) >> 3;
  const unsigned char* Tb = (const unsigned char*)p.R5 + 1024 + s * 128;
  const unsigned loff = r * 16;
  const int* experts = (const int*)p.R7 + lane;
  const float* gates = p.R7 + (size_t)BT * 128 + lane;
  float* ssq = p.R7 + (size_t)2 * BT * 128 + (size_t)s * BT;
  float* x1 = (float*)p.R2 + s * 128 + r * 16 + 2 * g;
  const int first = jb * 4 + w, stride = ns * 4;
  if (first >= BT) return;
  PeTok kA, kB;
  uint4 VA[16], VB[16];
  kA = pe_load_tok(experts, gates, first);
  pe_load_tab(Tb, loff, kA.e0, kA.e1, g, VA);
  kB = pe_load_tok(experts, gates, TOKC(first + stride));
#pragma unroll 1
  for (int tok = first; tok < BT; tok += 2 * stride) {
    const int t1 = tok + stride, t2 = tok + 2 * stride, t3 = tok + 3 * stride;
    pe_load_tab(Tb, loff, kB.e0, kB.e1, g, VB);
    const PeTok kC = pe_load_tok(experts, gates, TOKC(t2));
    pe_value_store(kA, VA, x1 + (size_t)tok * 1024, ssq + tok, lane, g);
    pe_load_tab(Tb, loff, kC.e0, kC.e1, g, VA);
    const PeTok kD = pe_load_tok(experts, gates, TOKC(t3));
    if (t1 < BT) pe_value_store(kB, VB, x1 + (size_t)t1 * 1024, ssq + t1, lane, g);
    kA = kC; kB = kD;
  }
#undef TOKC
}

__device__ void phase11c(const Params& p) {
  const int t = threadIdx.x, lane = t & 63, w = t >> 6;
  const float* x2 = (const float*)p.R2;
  const float* ssq = p.R7 + (size_t)2 * BT * 128;
  for (int tok = blockIdx.x * 4 + w; tok < BT; tok += gridDim.x * 4) {
    float ss = 0.f;
#pragma unroll
    for (int s = 0; s < 8; s++) ss += ssq[(size_t)s * BT + tok];
    const float rstd = rsqrtf(ss * (1.f / 1024.f) + 1e-6f);
    const float* xr = x2 + (size_t)tok * 1024 + lane * 16;
    float* orow = p.out + (size_t)tok * 1024 + lane * 16;
#pragma unroll
    for (int i = 0; i < 4; i++) {
      float4 v = *(const float4*)(xr + i * 4);
      float4 gg = *(const float4*)(p.fng + lane * 16 + i * 4);
      *(float4*)(orow + i * 4) = make_float4(v.x * rstd * gg.x, v.y * rstd * gg.y, v.z * rstd * gg.z, v.w * rstd * gg.w);
    }
  }
}

__global__ void __launch_bounds__(256, 2) fwd_mega(Params p, int ph_lo, int ph_hi) {
  extern __shared__ __attribute__((aligned(16))) char smem[];
  cg::grid_group grid = cg::this_grid();
  __shared__ uint4 xb_words;
  if (threadIdx.x == 0) xb_words = make_uint4(0u, 0u, 0u, 0u);
  __syncthreads();
  const XcdBarrier xb = xcd_barrier_post(p.bar, (volatile LAS unsigned*)&xb_words);
  if (ph_lo > ph_hi) grid.sync();
constexpr int REP0=1,REP1=1,REP2=1,REP3=1,REP4=1,REP5=1,REP6=1,REP7=1,REP8=1,REP9=1,REP10=1,REP11=1,REP12=1,REP13=1,REP14=1;
#define RUN_PHASE(k, call)                         \
  if (PH_ON(k) && ph_lo <= (k) && (k) < ph_hi) {   \
    for (int rep_ = 0; rep_ < REP##k; rep_++) { call; }  \
    if ((k) + 1 < ph_hi) xcd_barrier(xb);          \
  }
  RUN_PHASE(0, phase0(p, smem))
  RUN_PHASE(1, phase1(p, smem))
  RUN_PHASE(2, phase2(p, smem, xb))
  RUN_PHASE(3, phase3(p); weights_late(p, smem))
  RUN_PHASE(4, for (int item = blockIdx.x; item < 512; item += gridDim.x) gla_item(p, item, 2, smem))
  RUN_PHASE(5, phase5(p))
  RUN_PHASE(6, phase6(p, smem))
  RUN_PHASE(7, phase7(p, smem))
  RUN_PHASE(8, phase8(p))
  RUN_PHASE(9, phase9(p, smem))
  RUN_PHASE(10, phase10(p, smem))
  RUN_PHASE(11, phase11a(p))
  RUN_PHASE(12, phase11r(p))
  RUN_PHASE(13, phase11b(p))
  RUN_PHASE(14, phase11c(p))
}

extern "C" void kernel_launch(void* const* d_in, const int* in_sizes, int n_in, void* d_out, int out_size, void* d_ws,
                              size_t ws_size, hipStream_t stream) {
  (void)in_sizes; (void)n_in; (void)out_size; (void)ws_size;
  static int grid_blocks = 0;
  if (!grid_blocks) {
    int dev = 0, cus = 0, per_cu = 0;
    hipGetDevice(&dev);
    hipDeviceGetAttribute(&cus, hipDeviceAttributeMultiprocessorCount, dev);
    hipFuncSetAttribute((const void*)fwd_mega, hipFuncAttributeMaxDynamicSharedMemorySize, LDS_BYTES);
    hipOccupancyMaxActiveBlocksPerMultiprocessor(&per_cu, (const void*)fwd_mega, 256, LDS_BYTES);
    if (per_cu < 1) per_cu = 1;
    if (per_cu > 2) per_cu = 2;
    grid_blocks = cus * per_cu;
  }
  Params p{};
  const float* const* in = (const float* const*)d_in;
  p.x = in[0]; p.norm1_g = in[1]; p.w_in = in[2]; p.conv_w = in[3]; p.conv_b = in[4]; p.wa = in[5];
  p.dupf = in[6]; p.dbf = in[7]; p.dupb = in[8]; p.dbb = in[9]; p.gng = in[10]; p.wb = in[11];
  p.gbias = in[12]; p.wo = in[13]; p.norm2_g = in[14]; p.wq = in[15]; p.keys = in[16]; p.pu = in[17];
  p.pv = in[18]; p.fng = in[19];
  p.out = (float*)d_out;
  char* ws = (char*)d_ws;
  const size_t MiB = 1u << 20;
  p.WinT = (u16*)ws;
  p.WaT = (u16*)(ws + 17039360);
  p.WbT = (u16*)(ws + 17039360 + 2097152);
  p.WoT = (u16*)(ws + 17039360 + 2 * 2097152);
  p.WqT = (u16*)(ws + 17039360 + 3 * 2097152);
  p.KeysB = (u16*)(ws + 17039360 + 3 * 2097152 + 4194304);
  p.R1 = (u16*)(ws + 27 * MiB);
  p.R2 = (u16*)(ws + 59 * MiB);
  p.R3 = (u16*)(ws + 91 * MiB);
  p.R4 = (u16*)(ws + 123 * MiB);
  p.R5 = (u16*)(ws + 155 * MiB);
  p.R6 = (u16*)(ws + 187 * MiB);
  p.R7 = (float*)(ws + 219 * MiB);
  p.z = (float*)(ws + 251 * MiB);
  p.Dd = (float*)(ws + 253 * MiB);
  p.bar = (unsigned*)(ws + 254 * MiB);
  hipMemsetAsync(p.bar, 0, XCD_BAR_WORDS * sizeof(unsigned), stream);
#if MULTI_LAUNCH
  for (int ph = 0; ph < NPHASE; ph++) {
    hipLaunchKernelGGL(fwd_mega, dim3(grid_blocks), dim3(256), LDS_BYTES, stream, p, ph, ph + 1);
  }
#else
  int lo = 0, hi = NPHASE;
  void* args[] = {&p, &lo, &hi};
  hipError_t e = hipLaunchCooperativeKernel((const void*)fwd_mega, dim3(grid_blocks), dim3(256), args, LDS_BYTES, stream);
  if (e != hipSuccess) fprintf(stderr, "cooperative launch failed: %s (grid %d)\n", hipGetErrorString(e), grid_blocks);
#endif
}
```

```cpp
#include <hip/hip_runtime.h>
#include <hip/hip_cooperative_groups.h>
#include <cstdio>
namespace cg = cooperative_groups;

typedef unsigned short u16;
typedef unsigned int u32;
using bf16x8 = __attribute__((ext_vector_type(8))) short;
using f32x4 = __attribute__((ext_vector_type(4))) float;

#ifndef ONLY_PHASE
#define ONLY_PHASE -1
#endif
#define PH_ON(k) (ONLY_PHASE < 0 || ONLY_PHASE == (k))
#ifndef MULTI_LAUNCH
#define MULTI_LAUNCH 0
#endif

constexpr int BT = 16384, SEQ = 8192;
constexpr int LDS_BYTES = 80896;
constexpr int NPHASE = 15;

struct Params {
  const float *x, *norm1_g, *w_in, *conv_w, *conv_b, *wa, *dupf, *dbf, *dupb, *dbb, *gng, *wb, *gbias, *wo,
      *norm2_g, *wq, *keys, *pu, *pv, *fng;
  float* out;
  u16 *WinT, *WaT, *WbT, *WoT, *WqT, *KeysB;
  u16 *R1, *R2, *R3, *R4, *R5, *R6;
  float *R7, *z, *Dd;
  unsigned* bar;
};

__device__ __forceinline__ u16 f2b(float f) { u32 u = __float_as_uint(f); u += 0x7fffu + ((u >> 16) & 1u); return (u16)(u >> 16); }
__device__ __forceinline__ float b2f(u16 h) { return __uint_as_float(((u32)h) << 16); }
__device__ __forceinline__ u32 pack2(float a, float b) { return (u32)f2b(a) | ((u32)f2b(b) << 16); }
__device__ __forceinline__ float blo(u32 w) { return __uint_as_float(w << 16); }
__device__ __forceinline__ float bhi(u32 w) { return __uint_as_float(w & 0xffff0000u); }
__device__ __forceinline__ float wave_sum(float v) {
#pragma unroll
  for (int o = 32; o > 0; o >>= 1) v += __shfl_xor(v, o);
  return v;
}
__device__ __forceinline__ float sigmoidf_(float v) { return 1.f / (1.f + __expf(-v)); }
__device__ __forceinline__ u32 ordf(float v) { u32 u = __float_as_uint(v); return (u & 0x80000000u) ? ~u : (u | 0x80000000u); }
__device__ __forceinline__ float unordf(u32 k) { return __uint_as_float((k & 0x80000000u) ? (k ^ 0x80000000u) : ~k); }

template <int MT, int NT, int KT>
__device__ __forceinline__ void mma_nt(f32x4 (&acc)[MT][NT], const u16* A, int sa, const u16* B, int sb, int lane) {
  const int fr = lane & 15, fq = lane >> 4;
  const u16* pa = A + fr * sa + fq * 8;
  const u16* pb = B + fr * sb + fq * 8;
#pragma unroll
  for (int k = 0; k < KT; k++) {
    bf16x8 a[MT], b[NT];
#pragma unroll
    for (int m = 0; m < MT; m++) a[m] = *(const bf16x8*)(pa + m * 16 * sa + k * 32);
#pragma unroll
    for (int n = 0; n < NT; n++) b[n] = *(const bf16x8*)(pb + n * 16 * sb + k * 32);
#pragma unroll
    for (int m = 0; m < MT; m++)
#pragma unroll
      for (int n = 0; n < NT; n++) acc[m][n] = __builtin_amdgcn_mfma_f32_16x16x32_bf16(a[m], b[n], acc[m][n], 0, 0, 0);
  }
}

template <int MT, int NT>
__device__ __forceinline__ void mma_sw64(f32x4 (&acc)[MT][NT], const u16* A, const u16* B, int lane) {
  const int fr = lane & 15, fq = lane >> 4;
  const int cb = fq ^ ((fr >> 1) & 7);
  const u16* pa = A + fr * 64;
  const u16* pb = B + fr * 64;
#pragma unroll
  for (int k = 0; k < 2; k++) {
    const int co = (cb ^ (k * 4)) * 8;
    bf16x8 a[MT], b[NT];
#pragma unroll
    for (int m = 0; m < MT; m++) a[m] = *(const bf16x8*)(pa + m * 16 * 64 + co);
#pragma unroll
    for (int n = 0; n < NT; n++) b[n] = *(const bf16x8*)(pb + n * 16 * 64 + co);
#pragma unroll
    for (int m = 0; m < MT; m++)
#pragma unroll
      for (int n = 0; n < NT; n++) acc[m][n] = __builtin_amdgcn_mfma_f32_16x16x32_bf16(a[m], b[n], acc[m][n], 0, 0, 0);
  }
}

#define ST_DECL(S) uint4 S##a0, S##a1, S##a2, S##a3, S##b0, S##b1, S##b2, S##b3
#define ST_LOAD(S, PA, PB)                                                                                           \
  do {                                                                                                               \
    const char* pa_ = (const char*)(PA);                                                                             \
    const char* pb_ = (const char*)(PB);                                                                             \
    S##a0 = *(const uint4*)(pa_ + voffA); S##a1 = *(const uint4*)(pa_ + (size_t)64 * lda + voffA);                   \
    S##a2 = *(const uint4*)(pa_ + (size_t)128 * lda + voffA); S##a3 = *(const uint4*)(pa_ + (size_t)192 * lda + voffA); \
    S##b0 = *(const uint4*)(pb_ + voffB); S##b1 = *(const uint4*)(pb_ + (size_t)64 * ldb + voffB);                   \
    S##b2 = *(const uint4*)(pb_ + (size_t)128 * ldb + voffB); S##b3 = *(const uint4*)(pb_ + (size_t)192 * ldb + voffB); \
  } while (0)
#define ST_WRITE(S, WA, WB)                                                                                          \
  do {                                                                                                               \
    *(uint4*)(WA) = S##a0; *(uint4*)((WA) + 32 * 64) = S##a1; *(uint4*)((WA) + 64 * 64) = S##a2; *(uint4*)((WA) + 96 * 64) = S##a3; \
    *(uint4*)(WB) = S##b0; *(uint4*)((WB) + 32 * 64) = S##b1; *(uint4*)((WB) + 64 * 64) = S##b2; *(uint4*)((WB) + 96 * 64) = S##b3; \
  } while (0)

#define GLDS16(G, L) __builtin_amdgcn_global_load_lds((const void*)(G), (__attribute__((address_space(3))) void*)(L), 16, 0, 0)
__device__ __forceinline__ void gemm_acc_db(f32x4 (&acc)[4][4], const u16* __restrict__ A, int lda, const u16* __restrict__ B,
                                            int ldb, int K, char* smem) {
  const int t = threadIdx.x, lane = t & 63, w = t >> 6, wr = w >> 1, wc = w & 1;
  const int lr = t >> 3;
  const int gc = ((t & 7) ^ ((lr >> 1) & 7)) * 8;
  const u16* pa = A + (size_t)lr * lda + gc;
  const u16* pb = B + (size_t)lr * ldb + gc;
  char* l0 = smem + t * 16;
  u16* b0 = (u16*)smem;
  u16* b1 = b0 + 2 * 128 * 64;
#define ISSUE_TILE(KT, BUFOFF)                                                                     \
  do {                                                                                             \
    const u16* qa = pa + (KT) * 64;                                                                \
    const u16* qb = pb + (KT) * 64;                                                                \
    char* lb = l0 + (BUFOFF);                                                                      \
    GLDS16(qa, lb); GLDS16(qa + (size_t)32 * lda, lb + 4096);                                      \
    GLDS16(qa + (size_t)64 * lda, lb + 8192); GLDS16(qa + (size_t)96 * lda, lb + 12288);           \
    GLDS16(qb, lb + 16384); GLDS16(qb + (size_t)32 * ldb, lb + 16384 + 4096);                      \
    GLDS16(qb + (size_t)64 * ldb, lb + 16384 + 8192); GLDS16(qb + (size_t)96 * ldb, lb + 16384 + 12288); \
  } while (0)
  const int nk = K >> 6;
  __syncthreads();
  ISSUE_TILE(0, 0);
#define KSTEP(BUF, ISSUE_STMT)                                                 \
  do {                                                                         \
    asm volatile("s_waitcnt vmcnt(0)" ::: "memory");                          \
    __builtin_amdgcn_s_barrier();                                              \
    asm volatile("" ::: "memory");                                             \
    ISSUE_STMT;                                                                \
    mma_sw64<4, 4>(acc, BUF + wr * 64 * 64, BUF + 128 * 64 + wc * 64 * 64, lane); \
  } while (0)
  for (int kt = 0; kt + 2 < nk; kt += 2) {
    KSTEP(b0, ISSUE_TILE(kt + 1, 32768));
    KSTEP(b1, ISSUE_TILE(kt + 2, 0));
  }
  KSTEP(b0, ISSUE_TILE(nk - 1, 32768));
  KSTEP(b1, (void)0);
  asm volatile("s_waitcnt lgkmcnt(0)" ::: "memory");
#undef KSTEP
#undef ISSUE_TILE
}

struct TileIter {
  int i, step, lim, NT, xcd; bool swz;
  __device__ __forceinline__ TileIter(int nt_) {
    NT = nt_;
    swz = (gridDim.x & 7) == 0;
    if (swz) { xcd = blockIdx.x & 7; i = blockIdx.x >> 3; step = gridDim.x >> 3; lim = 16 * NT; }
    else { xcd = 0; i = blockIdx.x; step = gridDim.x; lim = 128 * NT; }
  }
  __device__ __forceinline__ bool next(int& mt, int& nt) {
    if (i >= lim) return false;
    if (swz) { int mg = i / (NT * 8), rem = i - mg * NT * 8; nt = rem >> 3; mt = xcd * 16 + mg * 8 + (rem & 7); }
    else { mt = i & 127; nt = i >> 7; }
    i += step;
    return true;
  }
};

__device__ __forceinline__ void zero_acc(f32x4 (&acc)[4][4]) {
#pragma unroll
  for (int m = 0; m < 4; m++)
#pragma unroll
    for (int n = 0; n < 4; n++) acc[m][n] = f32x4{0.f, 0.f, 0.f, 0.f};
}

__device__ __forceinline__ int winmap(int r) {
  if (r < 2048) { int tile = r >> 7, w = r & 127, grp = w >> 5; int ch = tile * 64 + (grp >> 1) * 32 + (w & 31); return ((grp & 1) ? 2048 : 0) + ch; }
  if (r < 3072) return r - 1024;
  if (r < 6176) return r;
  if (r < 6272) return -1;
  return r - 96;
}

__device__ __forceinline__ void tr_tile(const float* __restrict__ src, int ld, int col0, u16* __restrict__ dst, int r0, int k0, float* sT) {
  const int t = threadIdx.x;
  const int r = t >> 3, kc = t & 7;
  if (col0 < 0) {
    *(uint4*)(dst + (size_t)(r0 + r) * 1024 + k0 + kc * 8) = make_uint4(0, 0, 0, 0);
    return;
  }
  __syncthreads();
#pragma unroll
  for (int i = 0; i < 8; i++) {
    int k = (t >> 5) + i * 8, rr = t & 31;
    sT[k * 33 + rr] = src[(size_t)(k0 + k) * ld + col0 + rr];
  }
  __syncthreads();
  u32 wv[4];
#pragma unroll
  for (int j = 0; j < 4; j++) wv[j] = pack2(sT[(kc * 8 + 2 * j) * 33 + r], sT[(kc * 8 + 2 * j + 1) * 33 + r]);
  *(uint4*)(dst + (size_t)(r0 + r) * 1024 + k0 + kc * 8) = make_uint4(wv[0], wv[1], wv[2], wv[3]);
}

__device__ __forceinline__ void rms_row(const float* __restrict__ src, const float* __restrict__ g, u16* __restrict__ dst, int lane) {
  float4 v[4];
  float ss = 0.f;
#pragma unroll
  for (int i = 0; i < 4; i++) {
    v[i] = *(const float4*)(src + i * 256 + lane * 4);
    ss += v[i].x * v[i].x + v[i].y * v[i].y + v[i].z * v[i].z + v[i].w * v[i].w;
  }
  ss = wave_sum(ss);
  const float rstd = rsqrtf(ss * (1.f / 1024.f) + 1e-6f);
#pragma unroll
  for (int i = 0; i < 4; i++) {
    float4 gg = *(const float4*)(g + i * 256 + lane * 4);
    uint2 o;
    o.x = pack2(v[i].x * rstd * gg.x, v[i].y * rstd * gg.y);
    o.y = pack2(v[i].z * rstd * gg.z, v[i].w * rstd * gg.w);
    *(uint2*)(dst + i * 256 + lane * 4) = o;
  }
}

__device__ void phase0(const Params& p, char* smem) {
  float* sT = (float*)smem;
  const int t = threadIdx.x, lane = t & 63, w = t >> 6;
  u16* xn = (u16*)p.out;
  constexpr int J0 = 4160, J4 = J0 + 4096;
  for (int job = blockIdx.x; job < J4; job += gridDim.x) {
    if (job < J0) {
      int rb = job >> 4, kb = job & 15;
      tr_tile(p.w_in, 8224, winmap(rb * 32), p.WinT, rb * 32, kb * 64, sT);
    } else {
      int row = (job - J0) * 4 + w;
      rms_row(p.x + (size_t)row * 1024, p.norm1_g, xn + (size_t)row * 1024, lane);
    }
  }
}
__device__ void weights_late(const Params& p, char* smem) {
  float* sT = (float*)smem;
  const int t = threadIdx.x;
  constexpr int J1 = 1536, J2 = J1 + 1024, J3 = J2 + 128;
  for (int job = blockIdx.x; job < J3; job += gridDim.x) {
    if (job < J1) {
      int which = job >> 9, rb = (job & 511) >> 4, kb = job & 15;
      const float* src = which == 0 ? p.wa : (which == 1 ? p.wb : p.wo);
      u16* dst = which == 0 ? p.WaT : (which == 1 ? p.WbT : p.WoT);
      tr_tile(src, 1024, rb * 32, dst, rb * 32, kb * 64, sT);
    } else if (job < J2) {
      int j = job - J1, rb = j >> 4, kb = j & 15;
      tr_tile(p.wq, 2048, rb * 32, p.WqT, rb * 32, kb * 64, sT);
    } else {
      int j = job - J2;
      int base = (j * 256 + t) * 8;
      float4 a = *(const float4*)(p.keys + base), b = *(const float4*)(p.keys + base + 4);
      *(uint4*)(p.KeysB + base) = make_uint4(pack2(a.x, a.y), pack2(a.z, a.w), pack2(b.x, b.y), pack2(b.z, b.w));
    }
  }
}

__device__ void la_prep(const Params& p, char* smem) {
  float* sZ = (float*)smem;
  float* sPart = sZ + 1024;
  const int t = threadIdx.x, lane = t & 63, w = t >> 6, fr = lane & 15, fq = lane >> 4;
  const u16* xn = (const u16*)p.out;
  const u16* Wz = p.WinT + (size_t)6144 * 1024;
  u32* la16 = (u32*)p.R6;
  float uf0[16], uf1[16], ub0[16], ub1[16];
#pragma unroll
  for (int r = 0; r < 16; r++) {
    uf0[r] = p.dupf[r * 512 + 2 * t]; uf1[r] = p.dupf[r * 512 + 2 * t + 1];
    ub0[r] = p.dupb[r * 512 + 2 * t]; ub1[r] = p.dupb[r * 512 + 2 * t + 1];
  }
  const float bf0 = p.dbf[2 * t], bf1 = p.dbf[2 * t + 1], bb0 = p.dbb[2 * t], bb1 = p.dbb[2 * t + 1];
  for (int job = blockIdx.x; job < BT / 32; job += gridDim.x) {
    f32x4 az[2][2];
#pragma unroll
    for (int m = 0; m < 2; m++)
#pragma unroll
      for (int n = 0; n < 2; n++) az[m][n] = f32x4{0.f, 0.f, 0.f, 0.f};
    {
      const u16* ap = xn + (size_t)(job * 32 + fr) * 1024 + w * 256 + fq * 8;
      const u16* bp = Wz + (size_t)fr * 1024 + w * 256 + fq * 8;
#pragma unroll
      for (int ks = 0; ks < 8; ks++) {
        bf16x8 a0 = *(const bf16x8*)(ap + ks * 32), a1 = *(const bf16x8*)(ap + 16 * 1024 + ks * 32);
        bf16x8 b0 = *(const bf16x8*)(bp + ks * 32), b1 = *(const bf16x8*)(bp + 16 * 1024 + ks * 32);
        az[0][0] = __builtin_amdgcn_mfma_f32_16x16x32_bf16(a0, b0, az[0][0], 0, 0, 0);
        az[0][1] = __builtin_amdgcn_mfma_f32_16x16x32_bf16(a0, b1, az[0][1], 0, 0, 0);
        az[1][0] = __builtin_amdgcn_mfma_f32_16x16x32_bf16(a1, b0, az[1][0], 0, 0, 0);
        az[1][1] = __builtin_amdgcn_mfma_f32_16x16x32_bf16(a1, b1, az[1][1], 0, 0, 0);
      }
    }
    __syncthreads();
#pragma unroll
    for (int m = 0; m < 2; m++)
#pragma unroll
      for (int n = 0; n < 2; n++)
#pragma unroll
        for (int j = 0; j < 4; j++) sPart[w * 1024 + (m * 16 + fq * 4 + j) * 32 + n * 16 + fr] = az[m][n][j];
    __syncthreads();
    {
      const float4 q0 = *(const float4*)(sPart + t * 4), q1 = *(const float4*)(sPart + 1024 + t * 4), q2 = *(const float4*)(sPart + 2048 + t * 4),
                   q3 = *(const float4*)(sPart + 3072 + t * 4);
      *(float4*)(sZ + t * 4) = make_float4(q0.x + q1.x + q2.x + q3.x, q0.y + q1.y + q2.y + q3.y, q0.z + q1.z + q2.z + q3.z, q0.w + q1.w + q2.w + q3.w);
    }
    __syncthreads();
    for (int i = 0; i < 32; i++) {
      const float* zr = sZ + i * 32;
      float a0 = bf0, a1 = bf1, c0 = bb0, c1 = bb1;
#pragma unroll
      for (int r = 0; r < 16; r++) {
        const float zf = zr[r], zb = zr[16 + r];
        a0 += zf * uf0[r]; a1 += zf * uf1[r];
        c0 += zb * ub0[r]; c1 += zb * ub1[r];
      }
      const float l0 = (fminf(a0, 0.f) - __logf(1.f + __expf(-fabsf(a0)))) * 0.0625f;
      const float l1 = (fminf(a1, 0.f) - __logf(1.f + __expf(-fabsf(a1)))) * 0.0625f;
      const float m0 = (fminf(c0, 0.f) - __logf(1.f + __expf(-fabsf(c0)))) * 0.0625f;
      const float m1 = (fminf(c1, 0.f) - __logf(1.f + __expf(-fabsf(c1)))) * 0.0625f;
      const int tok = job * 32 + i;
      la16[(size_t)tok * 256 + t] = (u32)__builtin_bit_cast(unsigned short, (_Float16)l0) | ((u32)__builtin_bit_cast(unsigned short, (_Float16)l1) << 16);
      la16[(size_t)(BT + tok) * 256 + t] = (u32)__builtin_bit_cast(unsigned short, (_Float16)m0) | ((u32)__builtin_bit_cast(unsigned short, (_Float16)m1) << 16);
    }
  }
}

__device__ void phase1(const Params& p, char* smem) {
  u16* sA = (u16*)smem;
  u16* sB = sA + 128 * 64;
  const int t = threadIdx.x, lane = t & 63, w = t >> 6, wr = w >> 1, wc = w & 1, fr = lane & 15, fq = lane >> 4;
  const u16* xn = (const u16*)p.out;
  la_prep(p, smem);
  TileIter ti(48);
  int mt, nt;
  while (ti.next(mt, nt)) {
    f32x4 acc[4][4];
    zero_acc(acc);
    gemm_acc_db(acc, xn + (size_t)mt * 128 * 1024, 1024, p.WinT + (size_t)nt * 128 * 1024, 1024, 1024, smem);
    const int row0 = mt * 128 + wr * 64 + fq * 4;
    if (nt < 16) {
#pragma unroll
      for (int m = 0; m < 4; m++)
#pragma unroll
        for (int n = 0; n < 2; n++)
#pragma unroll
          for (int j = 0; j < 4; j++) {
            int ch = nt * 64 + wc * 32 + n * 16 + fr;
            p.R1[(size_t)(row0 + m * 16 + j) * 1024 + ch] = f2b(acc[m][n][j] * acc[m][n + 2][j]);
          }
    } else {
      const int g = (nt - 16) >> 3;
      u16* dst = g == 0 ? p.R2 : (g == 1 ? p.R3 : (g == 2 ? p.R4 : p.R5));
      const int cb = ((nt - 16) & 7) * 128 + wc * 64;
      const float sc = (g == 1 && cb < 512) ? 0.08838834764831845f : 1.f;
#pragma unroll
      for (int m = 0; m < 4; m++)
#pragma unroll
        for (int n = 0; n < 4; n++)
#pragma unroll
          for (int j = 0; j < 4; j++)
            dst[(size_t)(row0 + m * 16 + j) * 1024 + cb + n * 16 + fr] = f2b(acc[m][n][j] * sc);
    }
  }
}

#define XB_TMO      128
#define XB_XCNT(j)  (256  + 64 * (j))
#define XB_XSUB(j)  (1280 + 64 * (j))
#define XB_XGEN(j)  (2304 + 64 * (j))
#define XB_TOP      3328
#define XB_TOPGEN   3392
#define XCD_BAR_WORDS 3456
#define XB_SPIN_CAP (1u << 20)
#define LAS __attribute__((address_space(3)))
__device__ __forceinline__ unsigned xb_ld(unsigned* p) { return __hip_atomic_load(p, __ATOMIC_RELAXED, __HIP_MEMORY_SCOPE_AGENT); }
__device__ __forceinline__ unsigned xb_add(unsigned* p, unsigned v) { return __hip_atomic_fetch_add(p, v, __ATOMIC_RELAXED, __HIP_MEMORY_SCOPE_AGENT); }
__device__ __forceinline__ unsigned xb_xcc_id() { return (unsigned)__builtin_amdgcn_s_getreg((3 << 11) | 20) & 0xFu; }
#define XB_SPIN(cond, bar) do { unsigned _sp = 0; while (cond) { __builtin_amdgcn_s_sleep(1); \
    if ((++_sp & 255u) == 0u) { if (xb_ld(&(bar)[XB_TMO])) break; if (_sp > XB_SPIN_CAP) { atomicAdd(&(bar)[XB_TMO], 1u); break; } } } } while (0)
struct XcdBarrier { unsigned* bar; unsigned x; volatile LAS unsigned* st; };
__device__ __forceinline__ XcdBarrier xcd_barrier_post(unsigned* bar, volatile LAS unsigned* st) {
  XcdBarrier b; b.bar = bar; b.x = xb_xcc_id(); b.st = st;
  if (threadIdx.x == 0) (void)xb_add(&bar[XB_XCNT(b.x)], 1u);
  return b;
}
__device__ __forceinline__ void xcd_barrier_complete(unsigned* bar, unsigned x, unsigned& nloc, unsigned& nx) {
  const unsigned G = gridDim.x * gridDim.y * gridDim.z;
  unsigned sum, cnt, mine, sp = 0u;
  for (;;) {
    sum = 0u; cnt = 0u; mine = 0u;
#pragma unroll
    for (unsigned j = 0; j < 16; ++j) { const unsigned c = xb_ld(&bar[XB_XCNT(j)]); sum += c; cnt += (c > 0u) ? 1u : 0u; mine = (j == x) ? c : mine; }
    if (sum == G) break;
    __builtin_amdgcn_s_sleep(1);
    if ((++sp & 255u) == 0u) { if (xb_ld(&bar[XB_TMO])) break; if (sp > XB_SPIN_CAP) { atomicAdd(&bar[XB_TMO], 1u); break; } }
  }
  nloc = mine > 0u ? mine : 1u; nx = cnt > 0u ? cnt : 1u;
}
__device__ __forceinline__ void xcd_barrier(const XcdBarrier& b) {
  asm volatile("s_waitcnt vmcnt(0)" ::: "memory");
  __syncthreads();
  if (threadIdx.x == 0) {
    unsigned* bar = b.bar;
    __builtin_amdgcn_s_waitcnt(0);
    unsigned nloc = b.st[0], nx = b.st[1];
    if (nloc == 0u) { xcd_barrier_complete(bar, b.x, nloc, nx); b.st[0] = nloc; b.st[1] = nx; }
    const unsigned old = xb_add(&bar[XB_XSUB(b.x)], 1u);
    const unsigned gen = old / nloc;
    if (old + 1u == (gen + 1u) * nloc) {
      __builtin_amdgcn_fence(__ATOMIC_RELEASE, "agent");
      asm volatile("s_waitcnt vmcnt(0)" ::: "memory");
      const unsigned og = xb_add(&bar[XB_TOP], 1u);
      const unsigned tg = og / nx;
      if (og + 1u == (tg + 1u) * nx) xb_add(&bar[XB_TOPGEN], 1u);
      else XB_SPIN(xb_ld(&bar[XB_TOPGEN]) == tg, bar);
      __builtin_amdgcn_fence(__ATOMIC_ACQUIRE, "agent");
      xb_add(&bar[XB_XGEN(b.x)], 1u);
      asm volatile("s_waitcnt vmcnt(0)" ::: "memory");
    } else {
      XB_SPIN(xb_ld(&bar[XB_XGEN(b.x)]) == gen, bar);
      __builtin_amdgcn_fence(__ATOMIC_ACQUIRE, "agent");
      asm volatile("s_waitcnt vmcnt(0)" ::: "memory");
    }
  }
  __syncthreads();
}

__device__ void gla_item(const Params& p, int item, int pass, char* smem) {
  const int dvp = item & 1, seg = (item >> 1) & 15, dir = (item >> 5) & 1, h = (item >> 6) & 3, b = item >> 8;
  const int bhd = (b * 4 + h) * 2 + dir;
  u16* sQ = (u16*)smem;
  u16* sK = sQ + 64 * 136;
  u16* sKT = sK + 64 * 136;
  u16* sVT = sKT + 128 * 72;
  u16* sST = sVT + 64 * 72;
  float* sDec = (float*)(sST + 64 * 136);
  float* sTot = (float*)sVT;
  const int t = threadIdx.x, lane = t & 63, w = __builtin_amdgcn_readfirstlane(t >> 6), wr = w >> 1, wc = w & 1, fr = lane & 15, fq = lane >> 4;
  const int d0 = lane * 2;
  const u32* la16 = (const u32*)p.R6 + (size_t)dir * BT * 256 + h * 64 + lane;
  const u16* qk = p.R3;
  const u16* vv = p.R4;
  u16* obuf = dir ? p.R2 : p.R1;
  float* Lp = p.R7 + (size_t)(bhd * 16 + seg) * 32768 + (size_t)dvp * 128 * 128;

  f32x4 accS[2][2][4];
#pragma unroll
  for (int s = 0; s < 2; s++)
#pragma unroll
    for (int m = 0; m < 2; m++)
#pragma unroll
      for (int n = 0; n < 4; n++)
#pragma unroll
        for (int j = 0; j < 4; j++)
          accS[s][m][n][j] = (pass == 2) ? Lp[(s * 64 + wr * 32 + m * 16 + fq * 4 + j) * 128 + wc * 64 + n * 16 + fr] : 0.f;
  float dsum0 = 0.f, dsum1 = 0.f;

  for (int ci = 0; ci < 8; ci++) {
    const int c = seg * 8 + ci;
    __syncthreads();
    u32 qv[16], kv[16], lav[16], vreg[2][16];
#pragma unroll
    for (int ii = 0; ii < 16; ii++) {
      int f = c * 64 + w * 16 + ii;
      int pos = dir ? (SEQ - 1 - f) : f;
      size_t tokoff = (size_t)(b * SEQ + pos) * 1024;
      kv[ii] = *(const u32*)(qk + tokoff + 512 + h * 128 + d0);
      if (pass == 2) qv[ii] = *(const u32*)(qk + tokoff + h * 128 + d0);
      lav[ii] = la16[(size_t)(b * SEQ + pos) * 256];
      vreg[0][ii] = vv[tokoff + h * 256 + dvp * 128 + lane];
      vreg[1][ii] = vv[tokoff + h * 256 + dvp * 128 + 64 + lane];
    }
    float bl0[16], bl1[16];
    {
      float run0 = 0.f, run1 = 0.f;
#pragma unroll
      for (int ii = 0; ii < 16; ii++) {
        run0 += (float)__builtin_bit_cast(_Float16, (unsigned short)(lav[ii] & 0xffffu));
        run1 += (float)__builtin_bit_cast(_Float16, (unsigned short)(lav[ii] >> 16));
        bl0[ii] = run0; bl1[ii] = run1;
      }
      sTot[w * 128 + d0] = run0;
      sTot[w * 128 + d0 + 1] = run1;
    }
    __syncthreads();
    {
      float off0 = 0.f, off1 = 0.f, tot0 = 0.f, tot1 = 0.f;
#pragma unroll
      for (int ww = 0; ww < 4; ww++) {
        float a = sTot[ww * 128 + d0], bb = sTot[ww * 128 + d0 + 1];
        if (ww < w) { off0 += a; off1 += bb; }
        tot0 += a; tot1 += bb;
      }
      dsum0 += tot0; dsum1 += tot1;
      const float et0 = __expf(tot0), et1 = __expf(tot1);
      if (w == 0) { sDec[d0] = et0; sDec[d0 + 1] = et1; }
#pragma unroll
      for (int ii = 0; ii < 16; ii += 2) {
        float ke0[2], ke1[2];
#pragma unroll
        for (int s = 0; s < 2; s++) {
          const int i2 = ii + s;
          const float b0 = bl0[i2] + off0, b1 = bl1[i2] + off1;
          const float k0 = blo(kv[i2]), k1 = bhi(kv[i2]);
          const int i = w * 16 + i2;
          const float e0 = __expf(b0), e1 = __expf(b1);
          const float kt0 = k0 * __builtin_amdgcn_rcpf(e0), kt1 = k1 * __builtin_amdgcn_rcpf(e1);
          if (pass == 2) {
            *(u32*)(sQ + i * 136 + d0) = pack2(blo(qv[i2]) * e0, bhi(qv[i2]) * e1);
            *(u32*)(sK + i * 136 + d0) = pack2(kt0, kt1);
          }
          ke0[s] = kt0 * et0;
          ke1[s] = kt1 * et1;
        }
        *(u32*)(sKT + d0 * 72 + w * 16 + ii) = pack2(ke0[0], ke0[1]);
        *(u32*)(sKT + (d0 + 1) * 72 + w * 16 + ii) = pack2(ke1[0], ke1[1]);
      }
    }
    __syncthreads();
    u16* sP = sK;
    if (pass == 2) {
      f32x4 accP[2][2];
#pragma unroll
      for (int m = 0; m < 2; m++)
#pragma unroll
        for (int n = 0; n < 2; n++) accP[m][n] = f32x4{0.f, 0.f, 0.f, 0.f};
      mma_nt<2, 2, 4>(accP, sQ + wr * 32 * 136, 136, sK + wc * 32 * 136, 136, lane);
      __syncthreads();
#pragma unroll
      for (int m = 0; m < 2; m++)
#pragma unroll
        for (int n = 0; n < 2; n++)
#pragma unroll
          for (int j = 0; j < 4; j++) {
            int i = wr * 32 + m * 16 + fq * 4 + j, jj = wc * 32 + n * 16 + fr;
            sP[i * 72 + jj] = (i >= jj) ? f2b(accP[m][n][j]) : (u16)0;
          }
    }
#pragma unroll
    for (int s = 0; s < 2; s++) {
      if (pass == 2) {
#pragma unroll
        for (int m = 0; m < 2; m++)
#pragma unroll
          for (int n = 0; n < 4; n++)
#pragma unroll
            for (int j = 0; j < 4; j++) sST[(wr * 32 + m * 16 + fq * 4 + j) * 136 + wc * 64 + n * 16 + fr] = f2b(accS[s][m][n][j]);
      }
      {
        uint4 v0 = make_uint4(vreg[s][0] | (vreg[s][1] << 16), vreg[s][2] | (vreg[s][3] << 16), vreg[s][4] | (vreg[s][5] << 16),
                              vreg[s][6] | (vreg[s][7] << 16));
        uint4 v1 = make_uint4(vreg[s][8] | (vreg[s][9] << 16), vreg[s][10] | (vreg[s][11] << 16), vreg[s][12] | (vreg[s][13] << 16),
                              vreg[s][14] | (vreg[s][15] << 16));
        *(uint4*)(sVT + lane * 72 + w * 16) = v0;
        *(uint4*)(sVT + lane * 72 + w * 16 + 8) = v1;
      }
      __syncthreads();
      if (pass == 2) {
        f32x4 accO[2][2];
#pragma unroll
        for (int m = 0; m < 2; m++)
#pragma unroll
          for (int n = 0; n < 2; n++) accO[m][n] = f32x4{0.f, 0.f, 0.f, 0.f};
        mma_nt<2, 2, 4>(accO, sQ + wr * 32 * 136, 136, sST + wc * 32 * 136, 136, lane);
        mma_nt<2, 2, 2>(accO, sP + wr * 32 * 72, 72, sVT + wc * 32 * 72, 72, lane);
#pragma unroll
        for (int m = 0; m < 2; m++)
#pragma unroll
          for (int j = 0; j < 4; j++) {
            int i = wr * 32 + m * 16 + fq * 4 + j;
            int f = c * 64 + i;
            int pos = dir ? (SEQ - 1 - f) : f;
            size_t o = (size_t)(b * SEQ + pos) * 1024 + h * 256 + dvp * 128 + s * 64 + wc * 32 + fr;
#pragma unroll
            for (int n = 0; n < 2; n++) obuf[o + n * 16] = f2b(accO[m][n][j]);
          }
      }
#pragma unroll
      for (int n = 0; n < 4; n++) {
        float dc = sDec[wc * 64 + n * 16 + fr];
#pragma unroll
        for (int m = 0; m < 2; m++)
#pragma unroll
          for (int j = 0; j < 4; j++) accS[s][m][n][j] *= dc;
      }
      mma_nt<2, 4, 2>(accS[s], sVT + wr * 32 * 72, 72, sKT + wc * 64 * 72, 72, lane);
      if (s == 0) __syncthreads();
    }
  }
  if (pass == 1) {
#pragma unroll
    for (int s = 0; s < 2; s++)
#pragma unroll
      for (int m = 0; m < 2; m++)
#pragma unroll
        for (int n = 0; n < 4; n++)
#pragma unroll
          for (int j = 0; j < 4; j++) Lp[(s * 64 + wr * 32 + m * 16 + fq * 4 + j) * 128 + wc * 64 + n * 16 + fr] = accS[s][m][n][j];
    if (dvp == 0 && w == 0) {
      p.Dd[(bhd * 16 + seg) * 128 + d0] = __expf(dsum0);
      p.Dd[(bhd * 16 + seg) * 128 + d0 + 1] = __expf(dsum1);
    }
  }
}

__device__ void phase2(const Params& p, char* smem, const XcdBarrier& xb) {
  const int t = threadIdx.x;
  (void)xb;
  u16* ya = (u16*)p.out + (size_t)BT * 1024;
  for (int job = blockIdx.x; job < 512 + 2048; job += gridDim.x) {
    if (job < 512) {
      gla_item(p, job, 1, smem);
    } else {
      const int j = job - 512;
      const int ch = (t & 127) * 8;
      float w0[8], w1[8], w2[8], cb[8];
#pragma unroll
      for (int e = 0; e < 8; e++) { w0[e] = p.conv_w[ch + e]; w1[e] = p.conv_w[1024 + ch + e]; w2[e] = p.conv_w[2048 + ch + e]; cb[e] = p.conv_b[ch + e]; }
#pragma unroll
      for (int it = 0; it < 4; it++) {
        const int tok = j * 8 + it * 2 + (t >> 7);
        const int pos = tok & (SEQ - 1);
        const size_t o = (size_t)tok * 1024 + ch;
        uint4 pc = *(const uint4*)(p.R1 + o);
        uint4 pp = make_uint4(0, 0, 0, 0), pn = make_uint4(0, 0, 0, 0);
        if (pos > 0) pp = *(const uint4*)(p.R1 + o - 1024);
        if (pos < SEQ - 1) pn = *(const uint4*)(p.R1 + o + 1024);
        uint4 bb = *(const uint4*)(p.R2 + o);
        const u32 pcs[4] = {pc.x, pc.y, pc.z, pc.w}, pps[4] = {pp.x, pp.y, pp.z, pp.w}, pns[4] = {pn.x, pn.y, pn.z, pn.w},
                  bbs[4] = {bb.x, bb.y, bb.z, bb.w};
        u32 ov[4];
#pragma unroll
        for (int q = 0; q < 4; q++) {
          float y0 = cb[2 * q] + w0[2 * q] * blo(pps[q]) + w1[2 * q] * blo(pcs[q]) + w2[2 * q] * blo(pns[q]);
          float y1 = cb[2 * q + 1] + w0[2 * q + 1] * bhi(pps[q]) + w1[2 * q + 1] * bhi(pcs[q]) + w2[2 * q + 1] * bhi(pns[q]);
          ov[q] = pack2(blo(bbs[q]) * y0, bhi(bbs[q]) * y1);
        }
        *(uint4*)(ya + o) = make_uint4(ov[0], ov[1], ov[2], ov[3]);
      }
    }
  }
}

__device__ void phase3(const Params& p) {
  for (int gid = blockIdx.x * 256 + threadIdx.x; gid < 16 * 32768; gid += gridDim.x * 256) {
    const int bhd = gid >> 15, e = gid & 32767, dk = e & 127;
    float carry = 0.f;
    for (int s = 0; s < 16; s++) {
      float* lp = p.R7 + (size_t)(bhd * 16 + s) * 32768 + e;
      float tmp = *lp;
      *lp = carry;
      carry = p.Dd[(bhd * 16 + s) * 128 + dk] * carry + tmp;
    }
  }
}

__device__ void phase5(const Params& p) {
  const int t = threadIdx.x, lane = t & 63, w = t >> 6;
  for (int it = blockIdx.x * 4 + w; it < BT * 4; it += gridDim.x * 4) {
    const int tok = it >> 2, h = it & 3;
    const size_t o = (size_t)tok * 1024 + h * 256 + lane * 4;
    uint2 a = *(const uint2*)(p.R1 + o), b = *(const uint2*)(p.R2 + o), r = *(const uint2*)(p.R5 + o);
    float ov[4] = {blo(a.x) + blo(b.x), bhi(a.x) + bhi(b.x), blo(a.y) + blo(b.y), bhi(a.y) + bhi(b.y)};
    float rv[4] = {blo(r.x), bhi(r.x), blo(r.y), bhi(r.y)};
    float ss = ov[0] * ov[0] + ov[1] * ov[1] + ov[2] * ov[2] + ov[3] * ov[3];
    ss = wave_sum(ss);
    const float rstd = rsqrtf(ss * (1.f / 256.f) + 1e-6f);
    float4 g = *(const float4*)(p.gng + h * 256 + lane * 4);
    const float gv[4] = {g.x, g.y, g.z, g.w};
    float res[4];
#pragma unroll
    for (int e = 0; e < 4; e++) res[e] = ov[e] * rstd * gv[e] * (rv[e] * sigmoidf_(rv[e]));
    uint2 out;
    out.x = pack2(res[0], res[1]);
    out.y = pack2(res[2], res[3]);
    *(uint2*)(p.R6 + o) = out;
  }
}

__device__ void phase6(const Params& p, char* smem) {
  const int t = threadIdx.x, lane = t & 63, w = t >> 6, wr = w >> 1, wc = w & 1, fr = lane & 15, fq = lane >> 4;
  const u16* xn = (const u16*)p.out;
  const u16* ya = xn + (size_t)BT * 1024;
  uint4* sG = (uint4*)((char*)p.R2 + (size_t)blockIdx.x * 65536 + t * 256);
  uint4* sH = sG + 8;
  TileIter ti(8);
  int mt, nt;
  while (ti.next(mt, nt)) {
    const int col0 = nt * 128 + wc * 64 + fr;
    f32x4 acc[4][4];
    zero_acc(acc);
    gemm_acc_db(acc, xn + (size_t)mt * 128 * 1024, 1024, p.WinT + (size_t)(6272 + nt * 128) * 1024, 1024, 1024, smem);
    {
      float gb[4];
#pragma unroll
      for (int n = 0; n < 4; n++) gb[n] = p.gbias[col0 + n * 16];
#pragma unroll
      for (int m = 0; m < 4; m++)
#pragma unroll
        for (int h = 0; h < 2; h++)
          sG[m * 2 + h] = make_uint4(pack2(sigmoidf_(acc[m][2 * h][0] + gb[2 * h]), sigmoidf_(acc[m][2 * h][1] + gb[2 * h])),
                                     pack2(sigmoidf_(acc[m][2 * h][2] + gb[2 * h]), sigmoidf_(acc[m][2 * h][3] + gb[2 * h])),
                                     pack2(sigmoidf_(acc[m][2 * h + 1][0] + gb[2 * h + 1]), sigmoidf_(acc[m][2 * h + 1][1] + gb[2 * h + 1])),
                                     pack2(sigmoidf_(acc[m][2 * h + 1][2] + gb[2 * h + 1]), sigmoidf_(acc[m][2 * h + 1][3] + gb[2 * h + 1])));
    }
    zero_acc(acc);
    gemm_acc_db(acc, ya + (size_t)mt * 128 * 1024, 1024, p.WaT + (size_t)nt * 128 * 1024, 1024, 1024, smem);
#pragma unroll
    for (int m = 0; m < 4; m++)
#pragma unroll
      for (int h = 0; h < 2; h++) {
        const uint4 g = sG[m * 2 + h];
        sG[m * 2 + h] = make_uint4(pack2(acc[m][2 * h][0] * blo(g.x), acc[m][2 * h][1] * bhi(g.x)),
                                   pack2(acc[m][2 * h][2] * blo(g.y), acc[m][2 * h][3] * bhi(g.y)),
                                   pack2(acc[m][2 * h + 1][0] * blo(g.z), acc[m][2 * h + 1][1] * bhi(g.z)),
                                   pack2(acc[m][2 * h + 1][2] * blo(g.w), acc[m][2 * h + 1][3] * bhi(g.w)));
      }
    zero_acc(acc);
    gemm_acc_db(acc, p.R6 + (size_t)mt * 128 * 1024, 1024, p.WbT + (size_t)nt * 128 * 1024, 1024, 1024, smem);
#pragma unroll
    for (int m = 0; m < 4; m++)
#pragma unroll
      for (int h = 0; h < 2; h++)
        sH[m * 2 + h] = make_uint4(pack2(acc[m][2 * h][0], acc[m][2 * h][1]), pack2(acc[m][2 * h][2], acc[m][2 * h][3]),
                                   pack2(acc[m][2 * h + 1][0], acc[m][2 * h + 1][1]), pack2(acc[m][2 * h + 1][2], acc[m][2 * h + 1][3]));
    zero_acc(acc);
    gemm_acc_db(acc, xn + (size_t)mt * 128 * 1024, 1024, p.WinT + (size_t)(6272 + 1024 + nt * 128) * 1024, 1024, 1024, smem);
    const int row0 = mt * 128 + wr * 64 + fq * 4;
    {
      float gb[4];
#pragma unroll
      for (int n = 0; n < 4; n++) gb[n] = p.gbias[1024 + col0 + n * 16];
#pragma unroll
      for (int m = 0; m < 4; m++)
#pragma unroll
        for (int h = 0; h < 2; h++) {
          const uint4 a = sG[m * 2 + h], b = sH[m * 2 + h];
          const u32 av[4] = {a.x, a.y, a.z, a.w}, bv[4] = {b.x, b.y, b.z, b.w};
#pragma unroll
          for (int nn = 0; nn < 2; nn++) {
            const int n = 2 * h + nn;
            float r0 = blo(av[nn * 2]) + blo(bv[nn * 2]) * sigmoidf_(acc[m][n][0] + gb[n]);
            float r1 = bhi(av[nn * 2]) + bhi(bv[nn * 2]) * sigmoidf_(acc[m][n][1] + gb[n]);
            float r2 = blo(av[nn * 2 + 1]) + blo(bv[nn * 2 + 1]) * sigmoidf_(acc[m][n][2] + gb[n]);
            float r3 = bhi(av[nn * 2 + 1]) + bhi(bv[nn * 2 + 1]) * sigmoidf_(acc[m][n][3] + gb[n]);
            u16* d = p.R1 + (size_t)(row0 + m * 16) * 1024 + col0 + n * 16;
            d[0] = f2b(r0); d[1024] = f2b(r1); d[2048] = f2b(r2); d[3072] = f2b(r3);
          }
        }
    }
  }
}

__device__ void phase7(const Params& p, char* smem) {
  u16* sA = (u16*)smem;
  u16* sB = sA + 128 * 64;
  const int t = threadIdx.x, lane = t & 63, w = t >> 6, wr = w >> 1, wc = w & 1, fr = lane & 15, fq = lane >> 4;
  float* x1 = (float*)p.R2;
  TileIter ti(8);
  int mt, nt;
  while (ti.next(mt, nt)) {
    f32x4 acc[4][4];
    zero_acc(acc);
    gemm_acc_db(acc, p.R1 + (size_t)mt * 128 * 1024, 1024, p.WoT + (size_t)nt * 128 * 1024, 1024, 1024, smem);
    const int row0 = mt * 128 + wr * 64 + fq * 4;
    const int col0 = nt * 128 + wc * 64 + fr;
#pragma unroll
    for (int m = 0; m < 4; m++)
#pragma unroll
      for (int n = 0; n < 4; n++)
#pragma unroll
        for (int j = 0; j < 4; j++) {
          size_t o = (size_t)(row0 + m * 16 + j) * 1024 + col0 + n * 16;
          x1[o] = p.x[o] + acc[m][n][j];
        }
  }
}

constexpr float U_SCALE = 256.f, V_SCALE = 64.f;
__device__ __forceinline__ u32 enc_fp8x4(float a, float b, float c, float d) {
  int w = __builtin_amdgcn_cvt_pk_fp8_f32(a, b, 0, false);
  w = __builtin_amdgcn_cvt_pk_fp8_f32(c, d, w, true);
  return (u32)w;
}
__device__ __forceinline__ void table_convert_job(const Params& p, int j, int t) {
  unsigned char* Tb = (unsigned char*)p.R5;
  const float* src = (j < 4096) ? p.pu : p.pv;
  const float sc = (j < 4096) ? U_SCALE : V_SCALE;
  size_t base = (size_t)(j & 4095) * 4096 + t * 16;
  unsigned char* slot = Tb + (base >> 10) * 2048 + ((j < 4096) ? 0 : 1024) + (base & 1023);
  float4 a = *(const float4*)(src + base), b = *(const float4*)(src + base + 4), c = *(const float4*)(src + base + 8),
         d = *(const float4*)(src + base + 12);
  *(uint4*)slot = make_uint4(enc_fp8x4(a.x * sc, a.y * sc, a.z * sc, a.w * sc), enc_fp8x4(b.x * sc, b.y * sc, b.z * sc, b.w * sc),
                                     enc_fp8x4(c.x * sc, c.y * sc, c.z * sc, c.w * sc), enc_fp8x4(d.x * sc, d.y * sc, d.z * sc, d.w * sc));
}
__device__ void phase8(const Params& p) {
  const int t = threadIdx.x, lane = t & 63, w = t >> 6;
  const float* x1 = (const float*)p.R2;
  for (int job = blockIdx.x; job < 4096; job += gridDim.x) {
    int row = job * 4 + w;
    rms_row(x1 + (size_t)row * 1024, p.norm2_g, p.R4 + (size_t)row * 1024, lane);
  }
}

__device__ void phase9(const Params& p, char* smem) {
  u16* sA = (u16*)smem;
  u16* sB = sA + 128 * 64;
  const int t = threadIdx.x, lane = t & 63, w = t >> 6, wr = w >> 1, wc = w & 1, fr = lane & 15, fq = lane >> 4;
  u16* q = (u16*)p.out;
  TileIter ti(16);
  int mt, nt;
  while (ti.next(mt, nt)) {
    f32x4 acc[4][4];
    zero_acc(acc);
    gemm_acc_db(acc, p.R4 + (size_t)mt * 128 * 1024, 1024, p.WqT + (size_t)nt * 128 * 1024, 1024, 1024, smem);
    const int row0 = mt * 128 + wr * 64 + fq * 4;
    const int col0 = nt * 128 + wc * 64 + fr;
#pragma unroll
    for (int m = 0; m < 4; m++)
#pragma unroll
      for (int n = 0; n < 4; n++)
#pragma unroll
        for (int j = 0; j < 4; j++) q[(size_t)(row0 + m * 16 + j) * 2048 + col0 + n * 16] = f2b(acc[m][n][j]);
#pragma unroll 1
    for (int r = 0; r < 4; r++) table_convert_job(p, (mt * 16 + nt) * 4 + r, t);
  }
}

__device__ __forceinline__ void select16q(u32* rowbase, int part, u32 (&tk)[16], unsigned char* idxp) {
  u32* myp = rowbase + part * 32;
#pragma unroll
  for (int it = 0; it < 16; it++) {
    u32 m = 0;
#pragma unroll
    for (int c = 0; c < 8; c++) {
      uint4 kk = *(const uint4*)(myp + c * 4);
      m = max(m, max(max(kk.x, kk.y), max(kk.z, kk.w)));
    }
    m = max(m, (u32)__shfl_xor((int)m, 1));
    m = max(m, (u32)__shfl_xor((int)m, 2));
    tk[it] = m;
    const int idx = 127 - (int)(m & 127u);
    if ((idx >> 5) == part) { rowbase[idx] = 0; idxp[it] = (unsigned char)idx; }
  }
}

__device__ void phase10(const Params& p, char* smem) {
  u16* sKeys = (u16*)smem;
  u32* sSc = (u32*)(smem + 128 * 136 * 2);
  unsigned char* sIdx = (unsigned char*)(smem + 128 * 136 * 2 + 64 * 132 * 4);
  const int t = threadIdx.x, lane = t & 63, w = t >> 6, fr = lane & 15, fq = lane >> 4;
  const int rl = lane >> 2, part = lane & 3, row = w * 16 + rl;
  const u16* q = (const u16*)p.out;
  int* experts = (int*)p.R7;
  float* gates = p.R7 + (size_t)BT * 128;
  for (int item = blockIdx.x; item < 256 * 8; item += gridDim.x) {
    const int tt = item >> 3, h = item & 7;
    u32 ta[16], tb[16];
#pragma unroll
    for (int pp = 0; pp < 2; pp++) {
      __syncthreads();
      const u16* ksrc = p.KeysB + (size_t)(h * 2 + pp) * 128 * 128;
#pragma unroll
      for (int i = 0; i < 8; i++) {
        int c = t + 256 * i, r = c >> 4, kc = (c & 15) * 8;
        *(uint4*)(sKeys + r * 136 + kc) = *(const uint4*)(ksrc + r * 128 + kc);
      }
      bf16x8 a[4];
      {
        const u16* qp = q + (size_t)(tt * 64 + w * 16 + fr) * 2048 + h * 256 + pp * 128 + fq * 8;
#pragma unroll
        for (int k = 0; k < 4; k++) a[k] = *(const bf16x8*)(qp + k * 32);
      }
      __syncthreads();
      f32x4 acc[8];
#pragma unroll
      for (int n = 0; n < 8; n++) acc[n] = f32x4{0.f, 0.f, 0.f, 0.f};
#pragma unroll
      for (int k = 0; k < 4; k++)
#pragma unroll
        for (int n = 0; n < 8; n++) {
          bf16x8 bv = *(const bf16x8*)(sKeys + (n * 16 + fr) * 136 + k * 32 + fq * 8);
          acc[n] = __builtin_amdgcn_mfma_f32_16x16x32_bf16(a[k], bv, acc[n], 0, 0, 0);
        }
#pragma unroll
      for (int n = 0; n < 8; n++)
#pragma unroll
        for (int j = 0; j < 4; j++) {
          int r = w * 16 + fq * 4 + j, col = n * 16 + fr;
          sSc[r * 132 + col] = (ordf(acc[n][j]) & ~127u) | (u32)(127 - col);
        }
      __syncthreads();
      if (pp == 0) select16q(sSc + row * 132, part, ta, sIdx + row * 32);
      else select16q(sSc + row * 132, part, tb, sIdx + row * 32 + 16);
    }
    __syncthreads();
    {
      float fa[4], fb[16];
#pragma unroll
      for (int r = 0; r < 4; r++) {
        const u32 s0 = ta[4 * r], s1 = ta[4 * r + 1], s2 = ta[4 * r + 2], s3 = ta[4 * r + 3];
        const u32 sel = part == 0 ? s0 : (part == 1 ? s1 : (part == 2 ? s2 : s3));
        fa[r] = unordf(sel & ~127u);
      }
#pragma unroll
      for (int j = 0; j < 16; j++) fb[j] = unordf(tb[j] & ~127u);
      constexpr int NJ[4] = {16, 3, 1, 1};
      u32 cand[4][16];
#pragma unroll
      for (int r = 0; r < 4; r++) {
        const int irow = part + 4 * r;
        const int jlim = 16 / (irow + 1);
#pragma unroll
        for (int j = 0; j < 16; j++)
          if (j < NJ[r]) cand[r][j] = (j < jlim) ? ((ordf(fa[r] + fb[j]) & ~255u) | (u32)(255 - (irow * 16 + j))) : 0u;
      }
      const int tok = tt * 64 + row;
      float sv[16];
      int ev[16];
#pragma unroll
      for (int it = 0; it < 16; it++) {
        u32 m = 0;
#pragma unroll
        for (int r = 0; r < 4; r++)
#pragma unroll
          for (int j = 0; j < 16; j++)
            if (j < NJ[r]) m = max(m, cand[r][j]);
        m = max(m, (u32)__shfl_xor((int)m, 1));
        m = max(m, (u32)__shfl_xor((int)m, 2));
#pragma unroll
        for (int r = 0; r < 4; r++)
#pragma unroll
          for (int j = 0; j < 16; j++)
            if (j < NJ[r]) cand[r][j] = (cand[r][j] == m) ? 0u : cand[r][j];
        const int c = 255 - (int)(m & 255u);
        const int i1 = sIdx[row * 32 + (c >> 4)], i2 = sIdx[row * 32 + 16 + (c & 15)];
        ev[it] = i1 * 128 + i2;
        sv[it] = unordf(m & ~255u);
      }
      const float mx = sv[0];
      float sum = 0.f;
#pragma unroll
      for (int it = 0; it < 16; it++) { sv[it] = __expf(sv[it] - mx); sum += sv[it]; }
      const float inv = 1.f / sum;
#pragma unroll
      for (int g = 0; g < 4; g++) {
        if (part == g) {
          *(int4*)(experts + (size_t)tok * 128 + h * 16 + g * 4) = make_int4(ev[g * 4], ev[g * 4 + 1], ev[g * 4 + 2], ev[g * 4 + 3]);
          *(float4*)(gates + (size_t)tok * 128 + h * 16 + g * 4) =
              make_float4(sv[g * 4] * inv, sv[g * 4 + 1] * inv, sv[g * 4 + 2] * inv, sv[g * 4 + 3] * inv);
        }
      }
    }
  }
}

typedef float f32x2 __attribute__((ext_vector_type(2)));
__device__ __forceinline__ void dec16(const uint4& q, float (&o)[16]) {
  const u32 ws_[4] = {q.x, q.y, q.z, q.w};
#pragma unroll
  for (int i = 0; i < 4; i++) {
    f32x2 lo = __builtin_amdgcn_cvt_pk_f32_fp8((int)ws_[i], false);
    f32x2 hi = __builtin_amdgcn_cvt_pk_f32_fp8((int)ws_[i], true);
    o[i * 4 + 0] = lo[0]; o[i * 4 + 1] = lo[1]; o[i * 4 + 2] = hi[0]; o[i * 4 + 3] = hi[1];
  }
}
__device__ __forceinline__ void peer_load8(uint4 (&U)[8], uint4 (&V)[8], const unsigned char* Ub, const unsigned char* Vb, int ev, int l0,
                                           int lane) {
#pragma unroll
  for (int u = 0; u < 8; u++) {
    const int e = __builtin_amdgcn_readlane(ev, l0 + u);
    U[u] = *(const uint4*)(Ub + (size_t)e * 2048 + lane * 16);
    V[u] = *(const uint4*)(Vb + (size_t)e * 2048 + lane * 16);
  }
}
__device__ __forceinline__ void peer_proc8(const uint4 (&U)[8], const uint4 (&V)[8], const f32x2 (&xp)[8], f32x2 (&accp)[8], float gate_lane,
                                           int lane) {
  float d[8];
#pragma unroll
  for (int u = 0; u < 8; u++) {
    const u32 ws_[4] = {U[u].x, U[u].y, U[u].z, U[u].w};
    f32x2 s = {0.f, 0.f};
#pragma unroll
    for (int q = 0; q < 4; q++) {
      s += xp[2 * q] * __builtin_amdgcn_cvt_pk_f32_fp8((int)ws_[q], false);
      s += xp[2 * q + 1] * __builtin_amdgcn_cvt_pk_f32_fp8((int)ws_[q], true);
    }
    d[u] = s[0] + s[1];
  }
  {
    const bool b4 = (lane & 4) != 0, b2 = (lane & 2) != 0, b1 = (lane & 1) != 0;
#pragma unroll
    for (int i = 0; i < 4; i++) {
      const float send = b4 ? d[i] : d[i + 4], keep = b4 ? d[i + 4] : d[i];
      d[i] = keep + __shfl_xor(send, 4);
    }
#pragma unroll
    for (int i = 0; i < 2; i++) {
      const float send = b2 ? d[i] : d[i + 2], keep = b2 ? d[i + 2] : d[i];
      d[i] = keep + __shfl_xor(send, 2);
    }
    {
      const float send = b1 ? d[0] : d[1], keep = b1 ? d[1] : d[0];
      d[0] = keep + __shfl_xor(send, 1);
    }
    d[0] += __shfl_xor(d[0], 8);
    d[0] += __shfl_xor(d[0], 16);
    d[0] += __shfl_xor(d[0], 32);
  }
  const float dd = d[0] * (1.f / U_SCALE);
  const float hd = 0.5f * dd * (1.f + erff(dd * 0.70710678118654752f));
  const int cl = __float_as_int(hd * gate_lane * (1.f / V_SCALE));
#pragma unroll
  for (int u = 0; u < 8; u++) {
    const float c = __int_as_float(__builtin_amdgcn_readlane(cl, u));
    const f32x2 c2 = {c, c};
    const u32 ws_[4] = {V[u].x, V[u].y, V[u].z, V[u].w};
#pragma unroll
    for (int q = 0; q < 4; q++) {
      accp[2 * q] += c2 * __builtin_amdgcn_cvt_pk_f32_fp8((int)ws_[q], false);
      accp[2 * q + 1] += c2 * __builtin_amdgcn_cvt_pk_f32_fp8((int)ws_[q], true);
    }
  }
}
__device__ __forceinline__ float dot16_fp8(const f32x2 (&xp)[8], const uint4& q) {
  const u32 ws_[4] = {q.x, q.y, q.z, q.w};
  f32x2 s = {0.f, 0.f};
#pragma unroll
  for (int i = 0; i < 4; i++) {
    s += xp[2 * i] * __builtin_amdgcn_cvt_pk_f32_fp8((int)ws_[i], false);
    s += xp[2 * i + 1] * __builtin_amdgcn_cvt_pk_f32_fp8((int)ws_[i], true);
  }
  return s[0] + s[1];
}
__device__ __forceinline__ void pe_load_tab(const unsigned char* Tb, unsigned loff, int e0, int e1, int g, uint4 (&U)[16]) {
#pragma unroll
  for (int kb = 0; kb < 16; kb++) {
    const int e = __shfl((kb < 8) ? e0 : e1, (kb & 7) * 8 + g);
    U[kb] = *(const uint4*)(Tb + ((unsigned)e * 2048u + loff));
  }
}
__device__ __forceinline__ void pe_load_x(const u16* xr, f32x2 (&xp)[8]) {
  uint4 a = *(const uint4*)(xr), b = *(const uint4*)(xr + 8);
  xp[0] = f32x2{blo(a.x), bhi(a.x)}; xp[1] = f32x2{blo(a.y), bhi(a.y)}; xp[2] = f32x2{blo(a.z), bhi(a.z)}; xp[3] = f32x2{blo(a.w), bhi(a.w)};
  xp[4] = f32x2{blo(b.x), bhi(b.x)}; xp[5] = f32x2{blo(b.y), bhi(b.y)}; xp[6] = f32x2{blo(b.z), bhi(b.z)}; xp[7] = f32x2{blo(b.w), bhi(b.w)};
}
__device__ __forceinline__ void pe_dot_store(const f32x2 (&xp)[8], const uint4 (&U)[16], float* pr, int lane, int r) {
  float d[16];
#pragma unroll
  for (int kb = 0; kb < 16; kb++) d[kb] = dot16_fp8(xp, U[kb]);
  const bool b4 = (lane & 4) != 0, b2 = (lane & 2) != 0, b1 = (lane & 1) != 0;
#pragma unroll
  for (int i = 0; i < 8; i++) { const float send = b4 ? d[i] : d[i + 8], keep = b4 ? d[i + 8] : d[i]; d[i] = keep + __shfl_xor(send, 4); }
#pragma unroll
  for (int i = 0; i < 4; i++) { const float send = b2 ? d[i] : d[i + 4], keep = b2 ? d[i + 4] : d[i]; d[i] = keep + __shfl_xor(send, 2); }
#pragma unroll
  for (int i = 0; i < 2; i++) { const float send = b1 ? d[i] : d[i + 2], keep = b1 ? d[i + 2] : d[i]; d[i] = keep + __shfl_xor(send, 1); }
  pr[(2 * r) * 8] = d[0];
  pr[(2 * r + 1) * 8] = d[1];
}
__device__ void phase11a(const Params& p) {
  const int t = threadIdx.x, lane = t & 63, w = t >> 6, g = lane >> 3, r = lane & 7;
  const int s = blockIdx.x & 7, jb = blockIdx.x >> 3, ns = (gridDim.x - s + 7) >> 3;
  const u16* xn2 = p.R4 + s * 128 + r * 16;
  const unsigned char* Tb = (const unsigned char*)p.R5 + s * 128;
  const unsigned loff = r * 16;
  const int* experts = (const int*)p.R7 + lane;
  float* part = p.out + (size_t)s * BT * 128 + g;
  const int first = jb * 4 + w, stride = ns * 4;
  if (first >= BT) return;
#define TOKC(T) (((T) < BT) ? (T) : first)
  int eA0, eA1, eB0, eB1;
  uint4 UA[16], UB[16];
  f32x2 xA[8], xB[8];
  eA0 = experts[(size_t)first * 128]; eA1 = experts[(size_t)first * 128 + 64];
  pe_load_tab(Tb, loff, eA0, eA1, g, UA);
  pe_load_x(xn2 + (size_t)first * 1024, xA);
  { const int t1 = TOKC(first + stride); eB0 = experts[(size_t)t1 * 128]; eB1 = experts[(size_t)t1 * 128 + 64]; }
#pragma unroll 1
  for (int tok = first; tok < BT; tok += 2 * stride) {
    const int t1 = tok + stride, t2 = tok + 2 * stride, t3 = tok + 3 * stride;
    pe_load_tab(Tb, loff, eB0, eB1, g, UB);
    pe_load_x(xn2 + (size_t)TOKC(t1) * 1024, xB);
    { const int tc = TOKC(t2); eA0 = experts[(size_t)tc * 128]; eA1 = experts[(size_t)tc * 128 + 64]; }
    pe_dot_store(xA, UA, part + (size_t)tok * 128, lane, r);
    pe_load_tab(Tb, loff, eA0, eA1, g, UA);
    pe_load_x(xn2 + (size_t)TOKC(t2) * 1024, xA);
    { const int tc = TOKC(t3); eB0 = experts[(size_t)tc * 128]; eB1 = experts[(size_t)tc * 128 + 64]; }
    if (t1 < BT) pe_dot_store(xB, UB, part + (size_t)t1 * 128, lane, r);
  }
}

__device__ void phase11r(const Params& p) {
  float* gates = p.R7 + (size_t)BT * 128;
  const float* part = p.out;
  for (int idx = blockIdx.x * 256 + threadIdx.x; idx < BT * 128 / 4; idx += gridDim.x * 256) {
    float4 h = *(const float4*)(part + (size_t)idx * 4);
#pragma unroll
    for (int ss = 1; ss < 8; ss++) {
      const float4 q = *(const float4*)(part + (size_t)ss * BT * 128 + (size_t)idx * 4);
      h.x += q.x; h.y += q.y; h.z += q.z; h.w += q.w;
    }
    float4 gt = *(const float4*)(gates + (size_t)idx * 4);
    const float hv[4] = {h.x * (1.f / U_SCALE), h.y * (1.f / U_SCALE), h.z * (1.f / U_SCALE), h.w * (1.f / U_SCALE)};
    const float gv[4] = {gt.x, gt.y, gt.z, gt.w};
    float c[4];
#pragma unroll
    for (int q = 0; q < 4; q++) c[q] = 0.5f * hv[q] * (1.f + erff(hv[q] * 0.70710678118654752f)) * gv[q] * (1.f / V_SCALE);
    *(float4*)(gates + (size_t)idx * 4) = make_float4(c[0], c[1], c[2], c[3]);
  }
}

struct PeTok { int e0, e1; float g0, g1; };
__device__ __forceinline__ PeTok pe_load_tok(const int* experts, const float* gates, int tok) {
  PeTok k;
  k.e0 = experts[(size_t)tok * 128]; k.e1 = experts[(size_t)tok * 128 + 64];
  k.g0 = gates[(size_t)tok * 128]; k.g1 = gates[(size_t)tok * 128 + 64];
  return k;
}
__device__ __forceinline__ void pe_value_store(const PeTok& k, const uint4 (&V)[16], u16* drow, int lane, int g) {
  const float c0 = k.g0, c1 = k.g1;
  f32x2 accp[8];
#pragma unroll
  for (int i = 0; i < 8; i++) accp[i] = f32x2{0.f, 0.f};
#pragma unroll
  for (int kb = 0; kb < 16; kb++) {
    const float c = __shfl((kb < 8) ? c0 : c1, (kb & 7) * 8 + g);
    const f32x2 c2 = {c, c};
    const u32 ws_[4] = {V[kb].x, V[kb].y, V[kb].z, V[kb].w};
#pragma unroll
    for (int q = 0; q < 4; q++) {
      accp[2 * q] += c2 * __builtin_amdgcn_cvt_pk_f32_fp8((int)ws_[q], false);
      accp[2 * q + 1] += c2 * __builtin_amdgcn_cvt_pk_f32_fp8((int)ws_[q], true);
    }
  }
  float a[16];
#pragma unroll
  for (int i = 0; i < 8; i++) { a[2 * i] = accp[i][0]; a[2 * i + 1] = accp[i][1]; }
  const bool b32 = (lane & 32) != 0, b16 = (lane & 16) != 0, b8 = (lane & 8) != 0;
#pragma unroll
  for (int i = 0; i < 8; i++) { const float send = b32 ? a[i] : a[i + 8], keep = b32 ? a[i + 8] : a[i]; a[i] = keep + __shfl_xor(send, 32); }
#pragma unroll
  for (int i = 0; i < 4; i++) { const float send = b16 ? a[i] : a[i + 4], keep = b16 ? a[i + 4] : a[i]; a[i] = keep + __shfl_xor(send, 16); }
#pragma unroll
  for (int i = 0; i < 2; i++) { const float send = b8 ? a[i] : a[i + 2], keep = b8 ? a[i + 2] : a[i]; a[i] = keep + __shfl_xor(send, 8); }
  *(u32*)drow = pack2(a[0], a[1]);
}
__device__ void phase11b(const Params& p) {
  const int t = threadIdx.x, lane = t & 63, w = t >> 6, g = lane >> 3, r = lane & 7;
  const int s = blockIdx.x & 7, jb = blockIdx.x >> 3, ns = (gridDim.x - s + 7) >> 3;
  const unsigned char* Tb = (const unsigned char*)p.R5 + 1024 + s * 128;
  const unsigned loff = r * 16;
  const int* experts = (const int*)p.R7 + lane;
  const float* gates = p.R7 + (size_t)BT * 128 + lane;
  u16* x1 = p.R1 + s * 128 + r * 16 + 2 * g;
  const int first = jb * 4 + w, stride = ns * 4;
  if (first >= BT) return;
  PeTok kA, kB;
  uint4 VA[16], VB[16];
  kA = pe_load_tok(experts, gates, first);
  pe_load_tab(Tb, loff, kA.e0, kA.e1, g, VA);
  kB = pe_load_tok(experts, gates, TOKC(first + stride));
#pragma unroll 1
  for (int tok = first; tok < BT; tok += 2 * stride) {
    const int t1 = tok + stride, t2 = tok + 2 * stride, t3 = tok + 3 * stride;
    pe_load_tab(Tb, loff, kB.e0, kB.e1, g, VB);
    const PeTok kC = pe_load_tok(experts, gates, TOKC(t2));
    pe_value_store(kA, VA, x1 + (size_t)tok * 1024, lane, g);
    pe_load_tab(Tb, loff, kC.e0, kC.e1, g, VA);
    const PeTok kD = pe_load_tok(experts, gates, TOKC(t3));
    if (t1 < BT) pe_value_store(kB, VB, x1 + (size_t)t1 * 1024, lane, g);
    kA = kC; kB = kD;
  }
#undef TOKC
}

__device__ void phase11c(const Params& p) {
  const int t = threadIdx.x, lane = t & 63, w = t >> 6;
  const float* x1 = (const float*)p.R2;
  for (int tok = blockIdx.x * 4 + w; tok < BT; tok += gridDim.x * 4) {
    const float* xr = x1 + (size_t)tok * 1024 + lane * 16;
    const u16* dl = p.R1 + (size_t)tok * 1024 + lane * 16;
    float4 v[4];
    float ss = 0.f;
#pragma unroll
    for (int i = 0; i < 4; i++) {
      v[i] = *(const float4*)(xr + i * 4);
      const uint2 dd = *(const uint2*)(dl + i * 4);
      v[i].x += blo(dd.x); v[i].y += bhi(dd.x); v[i].z += blo(dd.y); v[i].w += bhi(dd.y);
      ss += v[i].x * v[i].x + v[i].y * v[i].y + v[i].z * v[i].z + v[i].w * v[i].w;
    }
    ss = wave_sum(ss);
    const float rstd = rsqrtf(ss * (1.f / 1024.f) + 1e-6f);
    float* orow = p.out + (size_t)tok * 1024 + lane * 16;
#pragma unroll
    for (int i = 0; i < 4; i++) {
      float4 gg = *(const float4*)(p.fng + lane * 16 + i * 4);
      *(float4*)(orow + i * 4) = make_float4(v[i].x * rstd * gg.x, v[i].y * rstd * gg.y, v[i].z * rstd * gg.z, v[i].w * rstd * gg.w);
    }
  }
}

__global__ void __launch_bounds__(256, 2) fwd_mega(Params p, int ph_lo, int ph_hi) {
  extern __shared__ __attribute__((aligned(16))) char smem[];
  cg::grid_group grid = cg::this_grid();
  __shared__ uint4 xb_words;
  if (threadIdx.x == 0) xb_words = make_uint4(0u, 0u, 0u, 0u);
  __syncthreads();
  const XcdBarrier xb = xcd_barrier_post(p.bar, (volatile LAS unsigned*)&xb_words);
  if (ph_lo > ph_hi) grid.sync();
constexpr int REP0=1,REP1=1,REP2=1,REP3=1,REP4=1,REP5=1,REP6=1,REP7=1,REP8=1,REP9=1,REP10=1,REP11=1,REP12=1,REP13=1,REP14=1;
#define RUN_PHASE(k, call)                         \
  if (PH_ON(k) && ph_lo <= (k) && (k) < ph_hi) {   \
    for (int rep_ = 0; rep_ < REP##k; rep_++) { call; }  \
    if ((k) + 1 < ph_hi) xcd_barrier(xb);          \
  }
  RUN_PHASE(0, phase0(p, smem))
  RUN_PHASE(1, phase1(p, smem))
  RUN_PHASE(2, phase2(p, smem, xb))
  RUN_PHASE(3, phase3(p); weights_late(p, smem))
  RUN_PHASE(4, for (int item = blockIdx.x; item < 512; item += gridDim.x) gla_item(p, item, 2, smem))
  RUN_PHASE(5, phase5(p))
  RUN_PHASE(6, phase6(p, smem))
  RUN_PHASE(7, phase7(p, smem))
  RUN_PHASE(8, phase8(p))
  RUN_PHASE(9, phase9(p, smem))
  RUN_PHASE(10, phase10(p, smem))
  RUN_PHASE(11, phase11a(p))
  RUN_PHASE(12, phase11r(p))
  RUN_PHASE(13, phase11b(p))
  RUN_PHASE(14, phase11c(p))
}

extern "C" void kernel_launch(void* const* d_in, const int* in_sizes, int n_in, void* d_out, int out_size, void* d_ws,
                              size_t ws_size, hipStream_t stream) {
  (void)in_sizes; (void)n_in; (void)out_size; (void)ws_size;
  static int grid_blocks = 0;
  if (!grid_blocks) {
    int dev = 0, cus = 0, per_cu = 0;
    hipGetDevice(&dev);
    hipDeviceGetAttribute(&cus, hipDeviceAttributeMultiprocessorCount, dev);
    hipFuncSetAttribute((const void*)fwd_mega, hipFuncAttributeMaxDynamicSharedMemorySize, LDS_BYTES);
    hipOccupancyMaxActiveBlocksPerMultiprocessor(&per_cu, (const void*)fwd_mega, 256, LDS_BYTES);
    if (per_cu < 1) per_cu = 1;
    if (per_cu > 2) per_cu = 2;
    grid_blocks = cus * per_cu;
  }
  Params p{};
  const float* const* in = (const float* const*)d_in;
  p.x = in[0]; p.norm1_g = in[1]; p.w_in = in[2]; p.conv_w = in[3]; p.conv_b = in[4]; p.wa = in[5];
  p.dupf = in[6]; p.dbf = in[7]; p.dupb = in[8]; p.dbb = in[9]; p.gng = in[10]; p.wb = in[11];
  p.gbias = in[12]; p.wo = in[13]; p.norm2_g = in[14]; p.wq = in[15]; p.keys = in[16]; p.pu = in[17];
  p.pv = in[18]; p.fng = in[19];
  p.out = (float*)d_out;
  char* ws = (char*)d_ws;
  const size_t MiB = 1u << 20;
  p.WinT = (u16*)ws;
  p.WaT = (u16*)(ws + 17039360);
  p.WbT = (u16*)(ws + 17039360 + 2097152);
  p.WoT = (u16*)(ws + 17039360 + 2 * 2097152);
  p.WqT = (u16*)(ws + 17039360 + 3 * 2097152);
  p.KeysB = (u16*)(ws + 17039360 + 3 * 2097152 + 4194304);
  p.R1 = (u16*)(ws + 27 * MiB);
  p.R2 = (u16*)(ws + 59 * MiB);
  p.R3 = (u16*)(ws + 91 * MiB);
  p.R4 = (u16*)(ws + 123 * MiB);
  p.R5 = (u16*)(ws + 155 * MiB);
  p.R6 = (u16*)(ws + 187 * MiB);
  p.R7 = (float*)(ws + 219 * MiB);
  p.z = (float*)(ws + 251 * MiB);
  p.Dd = (float*)(ws + 253 * MiB);
  p.bar = (unsigned*)(ws + 254 * MiB);
  hipMemsetAsync(p.bar, 0, XCD_BAR_WORDS * sizeof(unsigned), stream);
#if MULTI_LAUNCH
  for (int ph = 0; ph < NPHASE; ph++) {
    hipLaunchKernelGGL(fwd_mega, dim3(grid_blocks), dim3(256), LDS_BYTES, stream, p, ph, ph + 1);
  }
#else
  int lo = 0, hi = NPHASE;
  void* args[] = {&p, &lo, &hi};
  hipError_t e = hipLaunchCooperativeKernel((const void*)fwd_mega, dim3(grid_blocks), dim3(256), args, LDS_BYTES, stream);
  if (e != hipSuccess) fprintf(stderr, "cooperative launch failed: %s (grid %d)\n", hipGetErrorString(e), grid_blocks);
#endif
}
```

```cpp
#include <hip/hip_runtime.h>
#include <hip/hip_cooperative_groups.h>
#include <cstdio>
namespace cg = cooperative_groups;

typedef unsigned short u16;
typedef unsigned int u32;
using bf16x8 = __attribute__((ext_vector_type(8))) short;
using f32x4 = __attribute__((ext_vector_type(4))) float;

#ifndef ONLY_PHASE
#define ONLY_PHASE -1
#endif
#define PH_ON(k) (ONLY_PHASE < 0 || ONLY_PHASE == (k))
#ifndef MULTI_LAUNCH
#define MULTI_LAUNCH 0
#endif

constexpr int BT = 16384, SEQ = 8192;
constexpr int LDS_BYTES = 80896;
constexpr int NPHASE = 15;

struct Params {
  const float *x, *norm1_g, *w_in, *conv_w, *conv_b, *wa, *dupf, *dbf, *dupb, *dbb, *gng, *wb, *gbias, *wo,
      *norm2_g, *wq, *keys, *pu, *pv, *fng;
  float* out;
  u16 *WinT, *WaT, *WbT, *WoT, *WqT, *KeysB;
  u16 *R1, *R2, *R3, *R4, *R5, *R6;
  float *R7, *z, *Dd;
  unsigned* bar;
};

__device__ __forceinline__ u16 f2b(float f) { u32 u = __float_as_uint(f); u += 0x7fffu + ((u >> 16) & 1u); return (u16)(u >> 16); }
__device__ __forceinline__ float b2f(u16 h) { return __uint_as_float(((u32)h) << 16); }
__device__ __forceinline__ u32 pack2(float a, float b) { return (u32)f2b(a) | ((u32)f2b(b) << 16); }
__device__ __forceinline__ float blo(u32 w) { return __uint_as_float(w << 16); }
__device__ __forceinline__ float bhi(u32 w) { return __uint_as_float(w & 0xffff0000u); }
__device__ __forceinline__ float wave_sum(float v) {
#pragma unroll
  for (int o = 32; o > 0; o >>= 1) v += __shfl_xor(v, o);
  return v;
}
__device__ __forceinline__ float sigmoidf_(float v) { return 1.f / (1.f + __expf(-v)); }
__device__ __forceinline__ u32 ordf(float v) { u32 u = __float_as_uint(v); return (u & 0x80000000u) ? ~u : (u | 0x80000000u); }
__device__ __forceinline__ float unordf(u32 k) { return __uint_as_float((k & 0x80000000u) ? (k ^ 0x80000000u) : ~k); }

template <int MT, int NT, int KT>
__device__ __forceinline__ void mma_nt(f32x4 (&acc)[MT][NT], const u16* A, int sa, const u16* B, int sb, int lane) {
  const int fr = lane & 15, fq = lane >> 4;
  const u16* pa = A + fr * sa + fq * 8;
  const u16* pb = B + fr * sb + fq * 8;
#pragma unroll
  for (int k = 0; k < KT; k++) {
    bf16x8 a[MT], b[NT];
#pragma unroll
    for (int m = 0; m < MT; m++) a[m] = *(const bf16x8*)(pa + m * 16 * sa + k * 32);
#pragma unroll
    for (int n = 0; n < NT; n++) b[n] = *(const bf16x8*)(pb + n * 16 * sb + k * 32);
#pragma unroll
    for (int m = 0; m < MT; m++)
#pragma unroll
      for (int n = 0; n < NT; n++) acc[m][n] = __builtin_amdgcn_mfma_f32_16x16x32_bf16(a[m], b[n], acc[m][n], 0, 0, 0);
  }
}

template <int MT, int NT>
__device__ __forceinline__ void mma_sw64(f32x4 (&acc)[MT][NT], const u16* A, const u16* B, int lane) {
  const int fr = lane & 15, fq = lane >> 4;
  const int cb = fq ^ ((fr >> 1) & 7);
  const u16* pa = A + fr * 64;
  const u16* pb = B + fr * 64;
#pragma unroll
  for (int k = 0; k < 2; k++) {
    const int co = (cb ^ (k * 4)) * 8;
    bf16x8 a[MT], b[NT];
#pragma unroll
    for (int m = 0; m < MT; m++) a[m] = *(const bf16x8*)(pa + m * 16 * 64 + co);
#pragma unroll
    for (int n = 0; n < NT; n++) b[n] = *(const bf16x8*)(pb + n * 16 * 64 + co);
#pragma unroll
    for (int m = 0; m < MT; m++)
#pragma unroll
      for (int n = 0; n < NT; n++) acc[m][n] = __builtin_amdgcn_mfma_f32_16x16x32_bf16(b[n], a[m], acc[m][n], 0, 0, 0);
  }
}

#define ST_DECL(S) uint4 S##a0, S##a1, S##a2, S##a3, S##b0, S##b1, S##b2, S##b3
#define ST_LOAD(S, PA, PB)                                                                                           \
  do {                                                                                                               \
    const char* pa_ = (const char*)(PA);                                                                             \
    const char* pb_ = (const char*)(PB);                                                                             \
    S##a0 = *(const uint4*)(pa_ + voffA); S##a1 = *(const uint4*)(pa_ + (size_t)64 * lda + voffA);                   \
    S##a2 = *(const uint4*)(pa_ + (size_t)128 * lda + voffA); S##a3 = *(const uint4*)(pa_ + (size_t)192 * lda + voffA); \
    S##b0 = *(const uint4*)(pb_ + voffB); S##b1 = *(const uint4*)(pb_ + (size_t)64 * ldb + voffB);                   \
    S##b2 = *(const uint4*)(pb_ + (size_t)128 * ldb + voffB); S##b3 = *(const uint4*)(pb_ + (size_t)192 * ldb + voffB); \
  } while (0)
#define ST_WRITE(S, WA, WB)                                                                                          \
  do {                                                                                                               \
    *(uint4*)(WA) = S##a0; *(uint4*)((WA) + 32 * 64) = S##a1; *(uint4*)((WA) + 64 * 64) = S##a2; *(uint4*)((WA) + 96 * 64) = S##a3; \
    *(uint4*)(WB) = S##b0; *(uint4*)((WB) + 32 * 64) = S##b1; *(uint4*)((WB) + 64 * 64) = S##b2; *(uint4*)((WB) + 96 * 64) = S##b3; \
  } while (0)

#define GLDS16(G, L) __builtin_amdgcn_global_load_lds((const void*)(G), (__attribute__((address_space(3))) void*)(L), 16, 0, 0)
__device__ __forceinline__ void gemm_acc_db(f32x4 (&acc)[4][4], const u16* __restrict__ A, int lda, const u16* __restrict__ B,
                                            int ldb, int K, char* smem) {
  const int t = threadIdx.x, lane = t & 63, w = t >> 6, wr = w >> 1, wc = w & 1;
  const int lr = t >> 3;
  const int gc = ((t & 7) ^ ((lr >> 1) & 7)) * 8;
  const u16* pa = A + (size_t)lr * lda + gc;
  const u16* pb = B + (size_t)lr * ldb + gc;
  char* l0 = smem + t * 16;
  u16* b0 = (u16*)smem;
  u16* b1 = b0 + 2 * 128 * 64;
#define ISSUE_TILE(KT, BUFOFF)                                                                     \
  do {                                                                                             \
    const u16* qa = pa + (KT) * 64;                                                                \
    const u16* qb = pb + (KT) * 64;                                                                \
    char* lb = l0 + (BUFOFF);                                                                      \
    GLDS16(qa, lb); GLDS16(qa + (size_t)32 * lda, lb + 4096);                                      \
    GLDS16(qa + (size_t)64 * lda, lb + 8192); GLDS16(qa + (size_t)96 * lda, lb + 12288);           \
    GLDS16(qb, lb + 16384); GLDS16(qb + (size_t)32 * ldb, lb + 16384 + 4096);                      \
    GLDS16(qb + (size_t)64 * ldb, lb + 16384 + 8192); GLDS16(qb + (size_t)96 * ldb, lb + 16384 + 12288); \
  } while (0)
  const int nk = K >> 6;
  __syncthreads();
  ISSUE_TILE(0, 0);
#define KSTEP(BUF, ISSUE_STMT)                                                 \
  do {                                                                         \
    asm volatile("s_waitcnt vmcnt(0)" ::: "memory");                          \
    __builtin_amdgcn_s_barrier();                                              \
    asm volatile("" ::: "memory");                                             \
    ISSUE_STMT;                                                                \
    mma_sw64<4, 4>(acc, BUF + wr * 64 * 64, BUF + 128 * 64 + wc * 64 * 64, lane); \
  } while (0)
  for (int kt = 0; kt + 2 < nk; kt += 2) {
    KSTEP(b0, ISSUE_TILE(kt + 1, 32768));
    KSTEP(b1, ISSUE_TILE(kt + 2, 0));
  }
  KSTEP(b0, ISSUE_TILE(nk - 1, 32768));
  KSTEP(b1, (void)0);
  asm volatile("s_waitcnt lgkmcnt(0)" ::: "memory");
#undef KSTEP
#undef ISSUE_TILE
}

struct TileIter {
  int i, step, lim, NT, xcd; bool swz;
  __device__ __forceinline__ TileIter(int nt_) {
    NT = nt_;
    swz = (gridDim.x & 7) == 0;
    if (swz) { xcd = blockIdx.x & 7; i = blockIdx.x >> 3; step = gridDim.x >> 3; lim = 16 * NT; }
    else { xcd = 0; i = blockIdx.x; step = gridDim.x; lim = 128 * NT; }
  }
  __device__ __forceinline__ bool next(int& mt, int& nt) {
    if (i >= lim) return false;
    if (swz) { int mg = i / (NT * 8), rem = i - mg * NT * 8; nt = rem >> 3; mt = xcd * 16 + mg * 8 + (rem & 7); }
    else { mt = i & 127; nt = i >> 7; }
    i += step;
    return true;
  }
};

__device__ __forceinline__ void zero_acc(f32x4 (&acc)[4][4]) {
#pragma unroll
  for (int m = 0; m < 4; m++)
#pragma unroll
    for (int n = 0; n < 4; n++) acc[m][n] = f32x4{0.f, 0.f, 0.f, 0.f};
}

__device__ __forceinline__ int winmap(int r) {
  if (r < 2048) { int tile = r >> 7, w = r & 127, grp = w >> 5; int ch = tile * 64 + (grp >> 1) * 32 + (w & 31); return ((grp & 1) ? 2048 : 0) + ch; }
  if (r < 3072) return r - 1024;
  if (r < 6176) return r;
  if (r < 6272) return -1;
  return r - 96;
}

__device__ __forceinline__ void tr_tile(const float* __restrict__ src, int ld, int col0, u16* __restrict__ dst, int r0, int k0, float* sT) {
  const int t = threadIdx.x;
  const int r = t >> 3, kc = t & 7;
  if (col0 < 0) {
    *(uint4*)(dst + (size_t)(r0 + r) * 1024 + k0 + kc * 8) = make_uint4(0, 0, 0, 0);
    return;
  }
  __syncthreads();
#pragma unroll
  for (int i = 0; i < 8; i++) {
    int k = (t >> 5) + i * 8, rr = t & 31;
    sT[k * 33 + rr] = src[(size_t)(k0 + k) * ld + col0 + rr];
  }
  __syncthreads();
  u32 wv[4];
#pragma unroll
  for (int j = 0; j < 4; j++) wv[j] = pack2(sT[(kc * 8 + 2 * j) * 33 + r], sT[(kc * 8 + 2 * j + 1) * 33 + r]);
  *(uint4*)(dst + (size_t)(r0 + r) * 1024 + k0 + kc * 8) = make_uint4(wv[0], wv[1], wv[2], wv[3]);
}

__device__ __forceinline__ void rms_row(const float* __restrict__ src, const float* __restrict__ g, u16* __restrict__ dst, int lane) {
  float4 v[4];
  float ss = 0.f;
#pragma unroll
  for (int i = 0; i < 4; i++) {
    v[i] = *(const float4*)(src + i * 256 + lane * 4);
    ss += v[i].x * v[i].x + v[i].y * v[i].y + v[i].z * v[i].z + v[i].w * v[i].w;
  }
  ss = wave_sum(ss);
  const float rstd = rsqrtf(ss * (1.f / 1024.f) + 1e-6f);
#pragma unroll
  for (int i = 0; i < 4; i++) {
    float4 gg = *(const float4*)(g + i * 256 + lane * 4);
    uint2 o;
    o.x = pack2(v[i].x * rstd * gg.x, v[i].y * rstd * gg.y);
    o.y = pack2(v[i].z * rstd * gg.z, v[i].w * rstd * gg.w);
    *(uint2*)(dst + i * 256 + lane * 4) = o;
  }
}

__device__ void phase0(const Params& p, char* smem) {
  float* sT = (float*)smem;
  const int t = threadIdx.x, lane = t & 63, w = t >> 6;
  u16* xn = (u16*)p.out;
  constexpr int J0 = 4160, J4 = J0 + 4096;
  for (int job = blockIdx.x; job < J4; job += gridDim.x) {
    if (job < J0) {
      int rb = job >> 4, kb = job & 15;
      tr_tile(p.w_in, 8224, winmap(rb * 32), p.WinT, rb * 32, kb * 64, sT);
    } else {
      int row = (job - J0) * 4 + w;
      rms_row(p.x + (size_t)row * 1024, p.norm1_g, xn + (size_t)row * 1024, lane);
    }
  }
}
__device__ void weights_late(const Params& p, char* smem) {
  float* sT = (float*)smem;
  const int t = threadIdx.x;
  constexpr int J1 = 1536, J2 = J1 + 1024, J3 = J2 + 128;
  for (int job = blockIdx.x; job < J3; job += gridDim.x) {
    if (job < J1) {
      int which = job >> 9, rb = (job & 511) >> 4, kb = job & 15;
      const float* src = which == 0 ? p.wa : (which == 1 ? p.wb : p.wo);
      u16* dst = which == 0 ? p.WaT : (which == 1 ? p.WbT : p.WoT);
      tr_tile(src, 1024, rb * 32, dst, rb * 32, kb * 64, sT);
    } else if (job < J2) {
      int j = job - J1, rb = j >> 4, kb = j & 15;
      tr_tile(p.wq, 2048, rb * 32, p.WqT, rb * 32, kb * 64, sT);
    } else {
      int j = job - J2;
      int base = (j * 256 + t) * 8;
      float4 a = *(const float4*)(p.keys + base), b = *(const float4*)(p.keys + base + 4);
      *(uint4*)(p.KeysB + base) = make_uint4(pack2(a.x, a.y), pack2(a.z, a.w), pack2(b.x, b.y), pack2(b.z, b.w));
    }
  }
}

__device__ void la_prep(const Params& p, char* smem) {
  float* sZ = (float*)smem;
  float* sPart = sZ + 1024;
  const int t = threadIdx.x, lane = t & 63, w = t >> 6, fr = lane & 15, fq = lane >> 4;
  const u16* xn = (const u16*)p.out;
  const u16* Wz = p.WinT + (size_t)6144 * 1024;
  u32* la16 = (u32*)p.R6;
  float uf0[16], uf1[16], ub0[16], ub1[16];
#pragma unroll
  for (int r = 0; r < 16; r++) {
    uf0[r] = p.dupf[r * 512 + 2 * t]; uf1[r] = p.dupf[r * 512 + 2 * t + 1];
    ub0[r] = p.dupb[r * 512 + 2 * t]; ub1[r] = p.dupb[r * 512 + 2 * t + 1];
  }
  const float bf0 = p.dbf[2 * t], bf1 = p.dbf[2 * t + 1], bb0 = p.dbb[2 * t], bb1 = p.dbb[2 * t + 1];
  for (int job = blockIdx.x; job < BT / 32; job += gridDim.x) {
    f32x4 az[2][2];
#pragma unroll
    for (int m = 0; m < 2; m++)
#pragma unroll
      for (int n = 0; n < 2; n++) az[m][n] = f32x4{0.f, 0.f, 0.f, 0.f};
    {
      const u16* ap = xn + (size_t)(job * 32 + fr) * 1024 + w * 256 + fq * 8;
      const u16* bp = Wz + (size_t)fr * 1024 + w * 256 + fq * 8;
#pragma unroll
      for (int ks = 0; ks < 8; ks++) {
        bf16x8 a0 = *(const bf16x8*)(ap + ks * 32), a1 = *(const bf16x8*)(ap + 16 * 1024 + ks * 32);
        bf16x8 b0 = *(const bf16x8*)(bp + ks * 32), b1 = *(const bf16x8*)(bp + 16 * 1024 + ks * 32);
        az[0][0] = __builtin_amdgcn_mfma_f32_16x16x32_bf16(a0, b0, az[0][0], 0, 0, 0);
        az[0][1] = __builtin_amdgcn_mfma_f32_16x16x32_bf16(a0, b1, az[0][1], 0, 0, 0);
        az[1][0] = __builtin_amdgcn_mfma_f32_16x16x32_bf16(a1, b0, az[1][0], 0, 0, 0);
        az[1][1] = __builtin_amdgcn_mfma_f32_16x16x32_bf16(a1, b1, az[1][1], 0, 0, 0);
      }
    }
    __syncthreads();
#pragma unroll
    for (int m = 0; m < 2; m++)
#pragma unroll
      for (int n = 0; n < 2; n++)
#pragma unroll
        for (int j = 0; j < 4; j++) sPart[w * 1024 + (m * 16 + fq * 4 + j) * 32 + n * 16 + fr] = az[m][n][j];
    __syncthreads();
    {
      const float4 q0 = *(const float4*)(sPart + t * 4), q1 = *(const float4*)(sPart + 1024 + t * 4), q2 = *(const float4*)(sPart + 2048 + t * 4),
                   q3 = *(const float4*)(sPart + 3072 + t * 4);
      *(float4*)(sZ + t * 4) = make_float4(q0.x + q1.x + q2.x + q3.x, q0.y + q1.y + q2.y + q3.y, q0.z + q1.z + q2.z + q3.z, q0.w + q1.w + q2.w + q3.w);
    }
    __syncthreads();
    for (int i = 0; i < 32; i++) {
      const float* zr = sZ + i * 32;
      float a0 = bf0, a1 = bf1, c0 = bb0, c1 = bb1;
#pragma unroll
      for (int r = 0; r < 16; r++) {
        const float zf = zr[r], zb = zr[16 + r];
        a0 += zf * uf0[r]; a1 += zf * uf1[r];
        c0 += zb * ub0[r]; c1 += zb * ub1[r];
      }
      const float l0 = (fminf(a0, 0.f) - __logf(1.f + __expf(-fabsf(a0)))) * 0.0625f;
      const float l1 = (fminf(a1, 0.f) - __logf(1.f + __expf(-fabsf(a1)))) * 0.0625f;
      const float m0 = (fminf(c0, 0.f) - __logf(1.f + __expf(-fabsf(c0)))) * 0.0625f;
      const float m1 = (fminf(c1, 0.f) - __logf(1.f + __expf(-fabsf(c1)))) * 0.0625f;
      const int tok = job * 32 + i;
      la16[(size_t)tok * 256 + t] = (u32)__builtin_bit_cast(unsigned short, (_Float16)l0) | ((u32)__builtin_bit_cast(unsigned short, (_Float16)l1) << 16);
      la16[(size_t)(BT + tok) * 256 + t] = (u32)__builtin_bit_cast(unsigned short, (_Float16)m0) | ((u32)__builtin_bit_cast(unsigned short, (_Float16)m1) << 16);
    }
  }
}

__device__ void phase1(const Params& p, char* smem) {
  u16* sA = (u16*)smem;
  u16* sB = sA + 128 * 64;
  const int t = threadIdx.x, lane = t & 63, w = t >> 6, wr = w >> 1, wc = w & 1, fr = lane & 15, fq = lane >> 4;
  const u16* xn = (const u16*)p.out;
  la_prep(p, smem);
  TileIter ti(48);
  int mt, nt;
  while (ti.next(mt, nt)) {
    f32x4 acc[4][4];
    zero_acc(acc);
    gemm_acc_db(acc, xn + (size_t)mt * 128 * 1024, 1024, p.WinT + (size_t)nt * 128 * 1024, 1024, 1024, smem);
    const int rowb = mt * 128 + wr * 64 + fr;
    if (nt < 16) {
#pragma unroll
      for (int m = 0; m < 4; m++)
#pragma unroll
        for (int n = 0; n < 2; n++) {
          const int ch = nt * 64 + wc * 32 + n * 16 + fq * 4;
          *(uint2*)(p.R1 + (size_t)(rowb + m * 16) * 1024 + ch) =
              make_uint2(pack2(acc[m][n][0] * acc[m][n + 2][0], acc[m][n][1] * acc[m][n + 2][1]),
                         pack2(acc[m][n][2] * acc[m][n + 2][2], acc[m][n][3] * acc[m][n + 2][3]));
        }
    } else {
      const int g = (nt - 16) >> 3;
      u16* dst = g == 0 ? p.R2 : (g == 1 ? p.R3 : (g == 2 ? p.R4 : p.R5));
      const int cb = ((nt - 16) & 7) * 128 + wc * 64;
      const float sc = (g == 1 && cb < 512) ? 0.08838834764831845f : 1.f;
#pragma unroll
      for (int m = 0; m < 4; m++)
#pragma unroll
        for (int n = 0; n < 4; n++)
          *(uint2*)(dst + (size_t)(rowb + m * 16) * 1024 + cb + n * 16 + fq * 4) =
              make_uint2(pack2(acc[m][n][0] * sc, acc[m][n][1] * sc), pack2(acc[m][n][2] * sc, acc[m][n][3] * sc));
    }
  }
}

#define XB_TMO      128
#define XB_XCNT(j)  (256  + 64 * (j))
#define XB_XSUB(j)  (1280 + 64 * (j))
#define XB_XGEN(j)  (2304 + 64 * (j))
#define XB_TOP      3328
#define XB_TOPGEN   3392
#define XCD_BAR_WORDS 3456
#define XB_SPIN_CAP (1u << 20)
#define LAS __attribute__((address_space(3)))
__device__ __forceinline__ unsigned xb_ld(unsigned* p) { return __hip_atomic_load(p, __ATOMIC_RELAXED, __HIP_MEMORY_SCOPE_AGENT); }
__device__ __forceinline__ unsigned xb_add(unsigned* p, unsigned v) { return __hip_atomic_fetch_add(p, v, __ATOMIC_RELAXED, __HIP_MEMORY_SCOPE_AGENT); }
__device__ __forceinline__ unsigned xb_xcc_id() { return (unsigned)__builtin_amdgcn_s_getreg((3 << 11) | 20) & 0xFu; }
#define XB_SPIN(cond, bar) do { unsigned _sp = 0; while (cond) { __builtin_amdgcn_s_sleep(1); \
    if ((++_sp & 255u) == 0u) { if (xb_ld(&(bar)[XB_TMO])) break; if (_sp > XB_SPIN_CAP) { atomicAdd(&(bar)[XB_TMO], 1u); break; } } } } while (0)
struct XcdBarrier { unsigned* bar; unsigned x; volatile LAS unsigned* st; };
__device__ __forceinline__ XcdBarrier xcd_barrier_post(unsigned* bar, volatile LAS unsigned* st) {
  XcdBarrier b; b.bar = bar; b.x = xb_xcc_id(); b.st = st;
  if (threadIdx.x == 0) (void)xb_add(&bar[XB_XCNT(b.x)], 1u);
  return b;
}
__device__ __forceinline__ void xcd_barrier_complete(unsigned* bar, unsigned x, unsigned& nloc, unsigned& nx) {
  const unsigned G = gridDim.x * gridDim.y * gridDim.z;
  unsigned sum, cnt, mine, sp = 0u;
  for (;;) {
    sum = 0u; cnt = 0u; mine = 0u;
#pragma unroll
    for (unsigned j = 0; j < 16; ++j) { const unsigned c = xb_ld(&bar[XB_XCNT(j)]); sum += c; cnt += (c > 0u) ? 1u : 0u; mine = (j == x) ? c : mine; }
    if (sum == G) break;
    __builtin_amdgcn_s_sleep(1);
    if ((++sp & 255u) == 0u) { if (xb_ld(&bar[XB_TMO])) break; if (sp > XB_SPIN_CAP) { atomicAdd(&bar[XB_TMO], 1u); break; } }
  }
  nloc = mine > 0u ? mine : 1u; nx = cnt > 0u ? cnt : 1u;
}
__device__ __forceinline__ void xcd_barrier(const XcdBarrier& b) {
  asm volatile("s_waitcnt vmcnt(0)" ::: "memory");
  __syncthreads();
  if (threadIdx.x == 0) {
    unsigned* bar = b.bar;
    __builtin_amdgcn_s_waitcnt(0);
    unsigned nloc = b.st[0], nx = b.st[1];
    if (nloc == 0u) { xcd_barrier_complete(bar, b.x, nloc, nx); b.st[0] = nloc; b.st[1] = nx; }
    const unsigned old = xb_add(&bar[XB_XSUB(b.x)], 1u);
    const unsigned gen = old / nloc;
    if (old + 1u == (gen + 1u) * nloc) {
      __builtin_amdgcn_fence(__ATOMIC_RELEASE, "agent");
      asm volatile("s_waitcnt vmcnt(0)" ::: "memory");
      const unsigned og = xb_add(&bar[XB_TOP], 1u);
      const unsigned tg = og / nx;
      if (og + 1u == (tg + 1u) * nx) xb_add(&bar[XB_TOPGEN], 1u);
      else XB_SPIN(xb_ld(&bar[XB_TOPGEN]) == tg, bar);
      __builtin_amdgcn_fence(__ATOMIC_ACQUIRE, "agent");
      xb_add(&bar[XB_XGEN(b.x)], 1u);
      asm volatile("s_waitcnt vmcnt(0)" ::: "memory");
    } else {
      XB_SPIN(xb_ld(&bar[XB_XGEN(b.x)]) == gen, bar);
      __builtin_amdgcn_fence(__ATOMIC_ACQUIRE, "agent");
      asm volatile("s_waitcnt vmcnt(0)" ::: "memory");
    }
  }
  __syncthreads();
}

__device__ void gla_item(const Params& p, int item, int pass, char* smem) {
  const int dvp = item & 1, seg = (item >> 1) & 15, dir = (item >> 5) & 1, h = (item >> 6) & 3, b = item >> 8;
  const int bhd = (b * 4 + h) * 2 + dir;
  u16* sQ = (u16*)smem;
  u16* sK = sQ + 64 * 136;
  u16* sKT = sK + 64 * 136;
  u16* sVT = sKT + 128 * 72;
  u16* sST = sVT + 64 * 72;
  float* sDec = (float*)(sST + 64 * 136);
  float* sTot = (float*)sVT;
  const int t = threadIdx.x, lane = t & 63, w = __builtin_amdgcn_readfirstlane(t >> 6), wr = w >> 1, wc = w & 1, fr = lane & 15, fq = lane >> 4;
  const int d0 = lane * 2;
  const u32* la16 = (const u32*)p.R6 + (size_t)dir * BT * 256 + h * 64 + lane;
  const u16* qk = p.R3;
  const u16* vv = p.R4;
  u16* obuf = dir ? p.R2 : p.R1;
  float* Lp = p.R7 + (size_t)(bhd * 16 + seg) * 32768 + (size_t)dvp * 128 * 128;

  f32x4 accS[2][2][4];
#pragma unroll
  for (int s = 0; s < 2; s++)
#pragma unroll
    for (int m = 0; m < 2; m++)
#pragma unroll
      for (int n = 0; n < 4; n++)
#pragma unroll
        for (int j = 0; j < 4; j++)
          accS[s][m][n][j] = (pass == 2) ? Lp[(s * 64 + wr * 32 + m * 16 + fq * 4 + j) * 128 + wc * 64 + n * 16 + fr] : 0.f;
  float dsum0 = 0.f, dsum1 = 0.f;

  for (int ci = 0; ci < 8; ci++) {
    const int c = seg * 8 + ci;
    __syncthreads();
    u32 qv[16], kv[16], lav[16], vreg[2][16];
#pragma unroll
    for (int ii = 0; ii < 16; ii++) {
      int f = c * 64 + w * 16 + ii;
      int pos = dir ? (SEQ - 1 - f) : f;
      size_t tokoff = (size_t)(b * SEQ + pos) * 1024;
      kv[ii] = *(const u32*)(qk + tokoff + 512 + h * 128 + d0);
      if (pass == 2) qv[ii] = *(const u32*)(qk + tokoff + h * 128 + d0);
      lav[ii] = la16[(size_t)(b * SEQ + pos) * 256];
      vreg[0][ii] = vv[tokoff + h * 256 + dvp * 128 + lane];
      vreg[1][ii] = vv[tokoff + h * 256 + dvp * 128 + 64 + lane];
    }
    float bl0[16], bl1[16];
    {
      float run0 = 0.f, run1 = 0.f;
#pragma unroll
      for (int ii = 0; ii < 16; ii++) {
        run0 += (float)__builtin_bit_cast(_Float16, (unsigned short)(lav[ii] & 0xffffu));
        run1 += (float)__builtin_bit_cast(_Float16, (unsigned short)(lav[ii] >> 16));
        bl0[ii] = run0; bl1[ii] = run1;
      }
      sTot[w * 128 + d0] = run0;
      sTot[w * 128 + d0 + 1] = run1;
    }
    __syncthreads();
    {
      float off0 = 0.f, off1 = 0.f, tot0 = 0.f, tot1 = 0.f;
#pragma unroll
      for (int ww = 0; ww < 4; ww++) {
        float a = sTot[ww * 128 + d0], bb = sTot[ww * 128 + d0 + 1];
        if (ww < w) { off0 += a; off1 += bb; }
        tot0 += a; tot1 += bb;
      }
      dsum0 += tot0; dsum1 += tot1;
      const float et0 = __expf(tot0), et1 = __expf(tot1);
      if (w == 0) { sDec[d0] = et0; sDec[d0 + 1] = et1; }
#pragma unroll
      for (int ii = 0; ii < 16; ii += 2) {
        float ke0[2], ke1[2];
#pragma unroll
        for (int s = 0; s < 2; s++) {
          const int i2 = ii + s;
          const float b0 = bl0[i2] + off0, b1 = bl1[i2] + off1;
          const float k0 = blo(kv[i2]), k1 = bhi(kv[i2]);
          const int i = w * 16 + i2;
          const float e0 = __expf(b0), e1 = __expf(b1);
          const float kt0 = k0 * __builtin_amdgcn_rcpf(e0), kt1 = k1 * __builtin_amdgcn_rcpf(e1);
          if (pass == 2) {
            *(u32*)(sQ + i * 136 + d0) = pack2(blo(qv[i2]) * e0, bhi(qv[i2]) * e1);
            *(u32*)(sK + i * 136 + d0) = pack2(kt0, kt1);
          }
          ke0[s] = kt0 * et0;
          ke1[s] = kt1 * et1;
        }
        *(u32*)(sKT + d0 * 72 + w * 16 + ii) = pack2(ke0[0], ke0[1]);
        *(u32*)(sKT + (d0 + 1) * 72 + w * 16 + ii) = pack2(ke1[0], ke1[1]);
      }
    }
    __syncthreads();
    u16* sP = sK;
    if (pass == 2) {
      f32x4 accP[2][2];
#pragma unroll
      for (int m = 0; m < 2; m++)
#pragma unroll
        for (int n = 0; n < 2; n++) accP[m][n] = f32x4{0.f, 0.f, 0.f, 0.f};
      mma_nt<2, 2, 4>(accP, sQ + wr * 32 * 136, 136, sK + wc * 32 * 136, 136, lane);
      __syncthreads();
#pragma unroll
      for (int m = 0; m < 2; m++)
#pragma unroll
        for (int n = 0; n < 2; n++)
#pragma unroll
          for (int j = 0; j < 4; j++) {
            int i = wr * 32 + m * 16 + fq * 4 + j, jj = wc * 32 + n * 16 + fr;
            sP[i * 72 + jj] = (i >= jj) ? f2b(accP[m][n][j]) : (u16)0;
          }
    }
#pragma unroll
    for (int s = 0; s < 2; s++) {
      if (pass == 2) {
#pragma unroll
        for (int m = 0; m < 2; m++)
#pragma unroll
          for (int n = 0; n < 4; n++)
#pragma unroll
            for (int j = 0; j < 4; j++) sST[(wr * 32 + m * 16 + fq * 4 + j) * 136 + wc * 64 + n * 16 + fr] = f2b(accS[s][m][n][j]);
      }
      {
        uint4 v0 = make_uint4(vreg[s][0] | (vreg[s][1] << 16), vreg[s][2] | (vreg[s][3] << 16), vreg[s][4] | (vreg[s][5] << 16),
                              vreg[s][6] | (vreg[s][7] << 16));
        uint4 v1 = make_uint4(vreg[s][8] | (vreg[s][9] << 16), vreg[s][10] | (vreg[s][11] << 16), vreg[s][12] | (vreg[s][13] << 16),
                              vreg[s][14] | (vreg[s][15] << 16));
        *(uint4*)(sVT + lane * 72 + w * 16) = v0;
        *(uint4*)(sVT + lane * 72 + w * 16 + 8) = v1;
      }
      __syncthreads();
      if (pass == 2) {
        f32x4 accO[2][2];
#pragma unroll
        for (int m = 0; m < 2; m++)
#pragma unroll
          for (int n = 0; n < 2; n++) accO[m][n] = f32x4{0.f, 0.f, 0.f, 0.f};
        mma_nt<2, 2, 4>(accO, sQ + wr * 32 * 136, 136, sST + wc * 32 * 136, 136, lane);
        mma_nt<2, 2, 2>(accO, sP + wr * 32 * 72, 72, sVT + wc * 32 * 72, 72, lane);
#pragma unroll
        for (int m = 0; m < 2; m++)
#pragma unroll
          for (int j = 0; j < 4; j++) {
            int i = wr * 32 + m * 16 + fq * 4 + j;
            int f = c * 64 + i;
            int pos = dir ? (SEQ - 1 - f) : f;
            size_t o = (size_t)(b * SEQ + pos) * 1024 + h * 256 + dvp * 128 + s * 64 + wc * 32 + fr;
#pragma unroll
            for (int n = 0; n < 2; n++) obuf[o + n * 16] = f2b(accO[m][n][j]);
          }
      }
#pragma unroll
      for (int n = 0; n < 4; n++) {
        float dc = sDec[wc * 64 + n * 16 + fr];
#pragma unroll
        for (int m = 0; m < 2; m++)
#pragma unroll
          for (int j = 0; j < 4; j++) accS[s][m][n][j] *= dc;
      }
      mma_nt<2, 4, 2>(accS[s], sVT + wr * 32 * 72, 72, sKT + wc * 64 * 72, 72, lane);
      if (s == 0) __syncthreads();
    }
  }
  if (pass == 1) {
#pragma unroll
    for (int s = 0; s < 2; s++)
#pragma unroll
      for (int m = 0; m < 2; m++)
#pragma unroll
        for (int n = 0; n < 4; n++)
#pragma unroll
          for (int j = 0; j < 4; j++) Lp[(s * 64 + wr * 32 + m * 16 + fq * 4 + j) * 128 + wc * 64 + n * 16 + fr] = accS[s][m][n][j];
    if (dvp == 0 && w == 0) {
      p.Dd[(bhd * 16 + seg) * 128 + d0] = __expf(dsum0);
      p.Dd[(bhd * 16 + seg) * 128 + d0 + 1] = __expf(dsum1);
    }
  }
}

__device__ void phase2(const Params& p, char* smem, const XcdBarrier& xb) {
  const int t = threadIdx.x;
  (void)xb;
  u16* ya = (u16*)p.out + (size_t)BT * 1024;
  for (int job = blockIdx.x; job < 512 + 2048; job += gridDim.x) {
    if (job < 512) {
      gla_item(p, job, 1, smem);
    } else {
      const int j = job - 512;
      const int ch = (t & 127) * 8;
      float w0[8], w1[8], w2[8], cb[8];
#pragma unroll
      for (int e = 0; e < 8; e++) { w0[e] = p.conv_w[ch + e]; w1[e] = p.conv_w[1024 + ch + e]; w2[e] = p.conv_w[2048 + ch + e]; cb[e] = p.conv_b[ch + e]; }
#pragma unroll
      for (int it = 0; it < 4; it++) {
        const int tok = j * 8 + it * 2 + (t >> 7);
        const int pos = tok & (SEQ - 1);
        const size_t o = (size_t)tok * 1024 + ch;
        uint4 pc = *(const uint4*)(p.R1 + o);
        uint4 pp = make_uint4(0, 0, 0, 0), pn = make_uint4(0, 0, 0, 0);
        if (pos > 0) pp = *(const uint4*)(p.R1 + o - 1024);
        if (pos < SEQ - 1) pn = *(const uint4*)(p.R1 + o + 1024);
        uint4 bb = *(const uint4*)(p.R2 + o);
        const u32 pcs[4] = {pc.x, pc.y, pc.z, pc.w}, pps[4] = {pp.x, pp.y, pp.z, pp.w}, pns[4] = {pn.x, pn.y, pn.z, pn.w},
                  bbs[4] = {bb.x, bb.y, bb.z, bb.w};
        u32 ov[4];
#pragma unroll
        for (int q = 0; q < 4; q++) {
          float y0 = cb[2 * q] + w0[2 * q] * blo(pps[q]) + w1[2 * q] * blo(pcs[q]) + w2[2 * q] * blo(pns[q]);
          float y1 = cb[2 * q + 1] + w0[2 * q + 1] * bhi(pps[q]) + w1[2 * q + 1] * bhi(pcs[q]) + w2[2 * q + 1] * bhi(pns[q]);
          ov[q] = pack2(blo(bbs[q]) * y0, bhi(bbs[q]) * y1);
        }
        *(uint4*)(ya + o) = make_uint4(ov[0], ov[1], ov[2], ov[3]);
      }
    }
  }
}

__device__ void phase3(const Params& p) {
  for (int gid = blockIdx.x * 256 + threadIdx.x; gid < 16 * 32768; gid += gridDim.x * 256) {
    const int bhd = gid >> 15, e = gid & 32767, dk = e & 127;
    float carry = 0.f;
    for (int s = 0; s < 16; s++) {
      float* lp = p.R7 + (size_t)(bhd * 16 + s) * 32768 + e;
      float tmp = *lp;
      *lp = carry;
      carry = p.Dd[(bhd * 16 + s) * 128 + dk] * carry + tmp;
    }
  }
}

__device__ void phase5(const Params& p) {
  const int t = threadIdx.x, lane = t & 63, w = t >> 6;
  for (int it = blockIdx.x * 4 + w; it < BT * 4; it += gridDim.x * 4) {
    const int tok = it >> 2, h = it & 3;
    const size_t o = (size_t)tok * 1024 + h * 256 + lane * 4;
    uint2 a = *(const uint2*)(p.R1 + o), b = *(const uint2*)(p.R2 + o), r = *(const uint2*)(p.R5 + o);
    float ov[4] = {blo(a.x) + blo(b.x), bhi(a.x) + bhi(b.x), blo(a.y) + blo(b.y), bhi(a.y) + bhi(b.y)};
    float rv[4] = {blo(r.x), bhi(r.x), blo(r.y), bhi(r.y)};
    float ss = ov[0] * ov[0] + ov[1] * ov[1] + ov[2] * ov[2] + ov[3] * ov[3];
    ss = wave_sum(ss);
    const float rstd = rsqrtf(ss * (1.f / 256.f) + 1e-6f);
    float4 g = *(const float4*)(p.gng + h * 256 + lane * 4);
    const float gv[4] = {g.x, g.y, g.z, g.w};
    float res[4];
#pragma unroll
    for (int e = 0; e < 4; e++) res[e] = ov[e] * rstd * gv[e] * (rv[e] * sigmoidf_(rv[e]));
    uint2 out;
    out.x = pack2(res[0], res[1]);
    out.y = pack2(res[2], res[3]);
    *(uint2*)(p.R6 + o) = out;
  }
}

__device__ void phase6(const Params& p, char* smem) {
  const int t = threadIdx.x, lane = t & 63, w = t >> 6, wr = w >> 1, wc = w & 1, fr = lane & 15, fq = lane >> 4;
  const u16* xn = (const u16*)p.out;
  const u16* ya = xn + (size_t)BT * 1024;
  uint4* sG = (uint4*)((char*)p.R2 + (size_t)blockIdx.x * 65536 + t * 256);
  uint4* sH = sG + 8;
  TileIter ti(8);
  int mt, nt;
  while (ti.next(mt, nt)) {
    const int colb = nt * 128 + wc * 64 + fq * 4;
    f32x4 acc[4][4];
    zero_acc(acc);
    gemm_acc_db(acc, xn + (size_t)mt * 128 * 1024, 1024, p.WinT + (size_t)(6272 + nt * 128) * 1024, 1024, 1024, smem);
    {
      float4 gb[4];
#pragma unroll
      for (int n = 0; n < 4; n++) gb[n] = *(const float4*)(p.gbias + colb + n * 16);
#pragma unroll
      for (int m = 0; m < 4; m++)
#pragma unroll
        for (int h = 0; h < 2; h++)
          sG[m * 2 + h] = make_uint4(pack2(sigmoidf_(acc[m][2 * h][0] + gb[2 * h].x), sigmoidf_(acc[m][2 * h][1] + gb[2 * h].y)),
                                     pack2(sigmoidf_(acc[m][2 * h][2] + gb[2 * h].z), sigmoidf_(acc[m][2 * h][3] + gb[2 * h].w)),
                                     pack2(sigmoidf_(acc[m][2 * h + 1][0] + gb[2 * h + 1].x), sigmoidf_(acc[m][2 * h + 1][1] + gb[2 * h + 1].y)),
                                     pack2(sigmoidf_(acc[m][2 * h + 1][2] + gb[2 * h + 1].z), sigmoidf_(acc[m][2 * h + 1][3] + gb[2 * h + 1].w)));
    }
    zero_acc(acc);
    gemm_acc_db(acc, ya + (size_t)mt * 128 * 1024, 1024, p.WaT + (size_t)nt * 128 * 1024, 1024, 1024, smem);
#pragma unroll
    for (int m = 0; m < 4; m++)
#pragma unroll
      for (int h = 0; h < 2; h++) {
        const uint4 g = sG[m * 2 + h];
        sG[m * 2 + h] = make_uint4(pack2(acc[m][2 * h][0] * blo(g.x), acc[m][2 * h][1] * bhi(g.x)),
                                   pack2(acc[m][2 * h][2] * blo(g.y), acc[m][2 * h][3] * bhi(g.y)),
                                   pack2(acc[m][2 * h + 1][0] * blo(g.z), acc[m][2 * h + 1][1] * bhi(g.z)),
                                   pack2(acc[m][2 * h + 1][2] * blo(g.w), acc[m][2 * h + 1][3] * bhi(g.w)));
      }
    zero_acc(acc);
    gemm_acc_db(acc, p.R6 + (size_t)mt * 128 * 1024, 1024, p.WbT + (size_t)nt * 128 * 1024, 1024, 1024, smem);
#pragma unroll
    for (int m = 0; m < 4; m++)
#pragma unroll
      for (int h = 0; h < 2; h++)
        sH[m * 2 + h] = make_uint4(pack2(acc[m][2 * h][0], acc[m][2 * h][1]), pack2(acc[m][2 * h][2], acc[m][2 * h][3]),
                                   pack2(acc[m][2 * h + 1][0], acc[m][2 * h + 1][1]), pack2(acc[m][2 * h + 1][2], acc[m][2 * h + 1][3]));
    zero_acc(acc);
    gemm_acc_db(acc, xn + (size_t)mt * 128 * 1024, 1024, p.WinT + (size_t)(6272 + 1024 + nt * 128) * 1024, 1024, 1024, smem);
    const int rowb = mt * 128 + wr * 64 + fr;
    {
      float4 gb[4];
#pragma unroll
      for (int n = 0; n < 4; n++) gb[n] = *(const float4*)(p.gbias + 1024 + colb + n * 16);
#pragma unroll
      for (int m = 0; m < 4; m++)
#pragma unroll
        for (int h = 0; h < 2; h++) {
          const uint4 a = sG[m * 2 + h], b = sH[m * 2 + h];
          const u32 av[4] = {a.x, a.y, a.z, a.w}, bv[4] = {b.x, b.y, b.z, b.w};
#pragma unroll
          for (int nn = 0; nn < 2; nn++) {
            const int n = 2 * h + nn;
            float r0 = blo(av[nn * 2]) + blo(bv[nn * 2]) * sigmoidf_(acc[m][n][0] + gb[n].x);
            float r1 = bhi(av[nn * 2]) + bhi(bv[nn * 2]) * sigmoidf_(acc[m][n][1] + gb[n].y);
            float r2 = blo(av[nn * 2 + 1]) + blo(bv[nn * 2 + 1]) * sigmoidf_(acc[m][n][2] + gb[n].z);
            float r3 = bhi(av[nn * 2 + 1]) + bhi(bv[nn * 2 + 1]) * sigmoidf_(acc[m][n][3] + gb[n].w);
            *(uint2*)(p.R1 + (size_t)(rowb + m * 16) * 1024 + colb + n * 16) = make_uint2(pack2(r0, r1), pack2(r2, r3));
          }
        }
    }
  }
}

__device__ void phase7(const Params& p, char* smem) {
  u16* sA = (u16*)smem;
  u16* sB = sA + 128 * 64;
  const int t = threadIdx.x, lane = t & 63, w = t >> 6, wr = w >> 1, wc = w & 1, fr = lane & 15, fq = lane >> 4;
  float* x1 = (float*)p.R2;
  TileIter ti(8);
  int mt, nt;
  while (ti.next(mt, nt)) {
    f32x4 acc[4][4];
    zero_acc(acc);
    gemm_acc_db(acc, p.R1 + (size_t)mt * 128 * 1024, 1024, p.WoT + (size_t)nt * 128 * 1024, 1024, 1024, smem);
    const int rowb = mt * 128 + wr * 64 + fr;
    const int colb = nt * 128 + wc * 64 + fq * 4;
#pragma unroll
    for (int m = 0; m < 4; m++)
#pragma unroll
      for (int n = 0; n < 4; n++) {
        const size_t o = (size_t)(rowb + m * 16) * 1024 + colb + n * 16;
        const float4 xv = *(const float4*)(p.x + o);
        *(float4*)(x1 + o) = make_float4(xv.x + acc[m][n][0], xv.y + acc[m][n][1], xv.z + acc[m][n][2], xv.w + acc[m][n][3]);
      }
  }
}

constexpr float U_SCALE = 256.f, V_SCALE = 64.f;
__device__ __forceinline__ u32 enc_fp8x4(float a, float b, float c, float d) {
  int w = __builtin_amdgcn_cvt_pk_fp8_f32(a, b, 0, false);
  w = __builtin_amdgcn_cvt_pk_fp8_f32(c, d, w, true);
  return (u32)w;
}
__device__ __forceinline__ void table_convert_job(const Params& p, int j, int t) {
  unsigned char* Tb = (unsigned char*)p.R5;
  const float* src = (j < 4096) ? p.pu : p.pv;
  const float sc = (j < 4096) ? U_SCALE : V_SCALE;
  size_t base = (size_t)(j & 4095) * 4096 + t * 16;
  unsigned char* slot = Tb + (base >> 10) * 2048 + ((j < 4096) ? 0 : 1024) + (base & 1023);
  float4 a = *(const float4*)(src + base), b = *(const float4*)(src + base + 4), c = *(const float4*)(src + base + 8),
         d = *(const float4*)(src + base + 12);
  *(uint4*)slot = make_uint4(enc_fp8x4(a.x * sc, a.y * sc, a.z * sc, a.w * sc), enc_fp8x4(b.x * sc, b.y * sc, b.z * sc, b.w * sc),
                                     enc_fp8x4(c.x * sc, c.y * sc, c.z * sc, c.w * sc), enc_fp8x4(d.x * sc, d.y * sc, d.z * sc, d.w * sc));
}
__device__ void phase8(const Params& p) {
  const int t = threadIdx.x, lane = t & 63, w = t >> 6;
  const float* x1 = (const float*)p.R2;
  for (int job = blockIdx.x; job < 4096; job += gridDim.x) {
    int row = job * 4 + w;
    rms_row(x1 + (size_t)row * 1024, p.norm2_g, p.R4 + (size_t)row * 1024, lane);
  }
}

__device__ void phase9(const Params& p, char* smem) {
  u16* sA = (u16*)smem;
  u16* sB = sA + 128 * 64;
  const int t = threadIdx.x, lane = t & 63, w = t >> 6, wr = w >> 1, wc = w & 1, fr = lane & 15, fq = lane >> 4;
  u16* q = (u16*)p.out;
  TileIter ti(16);
  int mt, nt;
  while (ti.next(mt, nt)) {
    f32x4 acc[4][4];
    zero_acc(acc);
    gemm_acc_db(acc, p.R4 + (size_t)mt * 128 * 1024, 1024, p.WqT + (size_t)nt * 128 * 1024, 1024, 1024, smem);
    const int rowb = mt * 128 + wr * 64 + fr;
    const int colb = nt * 128 + wc * 64 + fq * 4;
#pragma unroll
    for (int m = 0; m < 4; m++)
#pragma unroll
      for (int n = 0; n < 4; n++)
        *(uint2*)(q + (size_t)(rowb + m * 16) * 2048 + colb + n * 16) = make_uint2(pack2(acc[m][n][0], acc[m][n][1]), pack2(acc[m][n][2], acc[m][n][3]));
#pragma unroll 1
    for (int r = 0; r < 4; r++) table_convert_job(p, (mt * 16 + nt) * 4 + r, t);
  }
}

__device__ __forceinline__ void select16q(u32* rowbase, int part, u32 (&tk)[16], unsigned char* idxp) {
  u32* myp = rowbase + part * 32;
#pragma unroll
  for (int it = 0; it < 16; it++) {
    u32 m = 0;
#pragma unroll
    for (int c = 0; c < 8; c++) {
      uint4 kk = *(const uint4*)(myp + c * 4);
      m = max(m, max(max(kk.x, kk.y), max(kk.z, kk.w)));
    }
    m = max(m, (u32)__shfl_xor((int)m, 1));
    m = max(m, (u32)__shfl_xor((int)m, 2));
    tk[it] = m;
    const int idx = 127 - (int)(m & 127u);
    if ((idx >> 5) == part) { rowbase[idx] = 0; idxp[it] = (unsigned char)idx; }
  }
}

__device__ void phase10(const Params& p, char* smem) {
  u16* sKeys = (u16*)smem;
  u32* sSc = (u32*)(smem + 128 * 136 * 2);
  unsigned char* sIdx = (unsigned char*)(smem + 128 * 136 * 2 + 64 * 132 * 4);
  const int t = threadIdx.x, lane = t & 63, w = t >> 6, fr = lane & 15, fq = lane >> 4;
  const int rl = lane >> 2, part = lane & 3, row = w * 16 + rl;
  const u16* q = (const u16*)p.out;
  int* experts = (int*)p.R7;
  float* gates = p.R7 + (size_t)BT * 128;
  for (int item = blockIdx.x; item < 256 * 8; item += gridDim.x) {
    const int tt = item >> 3, h = item & 7;
    u32 ta[16], tb[16];
#pragma unroll
    for (int pp = 0; pp < 2; pp++) {
      __syncthreads();
      const u16* ksrc = p.KeysB + (size_t)(h * 2 + pp) * 128 * 128;
#pragma unroll
      for (int i = 0; i < 8; i++) {
        int c = t + 256 * i, r = c >> 4, kc = (c & 15) * 8;
        *(uint4*)(sKeys + r * 136 + kc) = *(const uint4*)(ksrc + r * 128 + kc);
      }
      bf16x8 a[4];
      {
        const u16* qp = q + (size_t)(tt * 64 + w * 16 + fr) * 2048 + h * 256 + pp * 128 + fq * 8;
#pragma unroll
        for (int k = 0; k < 4; k++) a[k] = *(const bf16x8*)(qp + k * 32);
      }
      __syncthreads();
      f32x4 acc[8];
#pragma unroll
      for (int n = 0; n < 8; n++) acc[n] = f32x4{0.f, 0.f, 0.f, 0.f};
#pragma unroll
      for (int k = 0; k < 4; k++)
#pragma unroll
        for (int n = 0; n < 8; n++) {
          bf16x8 bv = *(const bf16x8*)(sKeys + (n * 16 + fr) * 136 + k * 32 + fq * 8);
          acc[n] = __builtin_amdgcn_mfma_f32_16x16x32_bf16(a[k], bv, acc[n], 0, 0, 0);
        }
#pragma unroll
      for (int n = 0; n < 8; n++)
#pragma unroll
        for (int j = 0; j < 4; j++) {
          int r = w * 16 + fq * 4 + j, col = n * 16 + fr;
          sSc[r * 132 + col] = (ordf(acc[n][j]) & ~127u) | (u32)(127 - col);
        }
      __syncthreads();
      if (pp == 0) select16q(sSc + row * 132, part, ta, sIdx + row * 32);
      else select16q(sSc + row * 132, part, tb, sIdx + row * 32 + 16);
    }
    __syncthreads();
    {
      float fa[4], fb[16];
#pragma unroll
      for (int r = 0; r < 4; r++) {
        const u32 s0 = ta[4 * r], s1 = ta[4 * r + 1], s2 = ta[4 * r + 2], s3 = ta[4 * r + 3];
        const u32 sel = part == 0 ? s0 : (part == 1 ? s1 : (part == 2 ? s2 : s3));
        fa[r] = unordf(sel & ~127u);
      }
#pragma unroll
      for (int j = 0; j < 16; j++) fb[j] = unordf(tb[j] & ~127u);
      constexpr int NJ[4] = {16, 3, 1, 1};
      u32 cand[4][16];
#pragma unroll
      for (int r = 0; r < 4; r++) {
        const int irow = part + 4 * r;
        const int jlim = 16 / (irow + 1);
#pragma unroll
        for (int j = 0; j < 16; j++)
          if (j < NJ[r]) cand[r][j] = (j < jlim) ? ((ordf(fa[r] + fb[j]) & ~255u) | (u32)(255 - (irow * 16 + j))) : 0u;
      }
      const int tok = tt * 64 + row;
      float sv[16];
      int ev[16];
#pragma unroll
      for (int it = 0; it < 16; it++) {
        u32 m = 0;
#pragma unroll
        for (int r = 0; r < 4; r++)
#pragma unroll
          for (int j = 0; j < 16; j++)
            if (j < NJ[r]) m = max(m, cand[r][j]);
        m = max(m, (u32)__shfl_xor((int)m, 1));
        m = max(m, (u32)__shfl_xor((int)m, 2));
#pragma unroll
        for (int r = 0; r < 4; r++)
#pragma unroll
          for (int j = 0; j < 16; j++)
            if (j < NJ[r]) cand[r][j] = (cand[r][j] == m) ? 0u : cand[r][j];
        const int c = 255 - (int)(m & 255u);
        const int i1 = sIdx[row * 32 + (c >> 4)], i2 = sIdx[row * 32 + 16 + (c & 15)];
        ev[it] = i1 * 128 + i2;
        sv[it] = unordf(m & ~255u);
      }
      const float mx = sv[0];
      float sum = 0.f;
#pragma unroll
      for (int it = 0; it < 16; it++) { sv[it] = __expf(sv[it] - mx); sum += sv[it]; }
      const float inv = 1.f / sum;
#pragma unroll
      for (int g = 0; g < 4; g++) {
        if (part == g) {
          *(int4*)(experts + (size_t)tok * 128 + h * 16 + g * 4) = make_int4(ev[g * 4], ev[g * 4 + 1], ev[g * 4 + 2], ev[g * 4 + 3]);
          *(float4*)(gates + (size_t)tok * 128 + h * 16 + g * 4) =
              make_float4(sv[g * 4] * inv, sv[g * 4 + 1] * inv, sv[g * 4 + 2] * inv, sv[g * 4 + 3] * inv);
        }
      }
    }
  }
}

typedef float f32x2 __attribute__((ext_vector_type(2)));
__device__ __forceinline__ void dec16(const uint4& q, float (&o)[16]) {
  const u32 ws_[4] = {q.x, q.y, q.z, q.w};
#pragma unroll
  for (int i = 0; i < 4; i++) {
    f32x2 lo = __builtin_amdgcn_cvt_pk_f32_fp8((int)ws_[i], false);
    f32x2 hi = __builtin_amdgcn_cvt_pk_f32_fp8((int)ws_[i], true);
    o[i * 4 + 0] = lo[0]; o[i * 4 + 1] = lo[1]; o[i * 4 + 2] = hi[0]; o[i * 4 + 3] = hi[1];
  }
}
__device__ __forceinline__ void peer_load8(uint4 (&U)[8], uint4 (&V)[8], const unsigned char* Ub, const unsigned char* Vb, int ev, int l0,
                                           int lane) {
#pragma unroll
  for (int u = 0; u < 8; u++) {
    const int e = __builtin_amdgcn_readlane(ev, l0 + u);
    U[u] = *(const uint4*)(Ub + (size_t)e * 2048 + lane * 16);
    V[u] = *(const uint4*)(Vb + (size_t)e * 2048 + lane * 16);
  }
}
__device__ __forceinline__ void peer_proc8(const uint4 (&U)[8], const uint4 (&V)[8], const f32x2 (&xp)[8], f32x2 (&accp)[8], float gate_lane,
                                           int lane) {
  float d[8];
#pragma unroll
  for (int u = 0; u < 8; u++) {
    const u32 ws_[4] = {U[u].x, U[u].y, U[u].z, U[u].w};
    f32x2 s = {0.f, 0.f};
#pragma unroll
    for (int q = 0; q < 4; q++) {
      s += xp[2 * q] * __builtin_amdgcn_cvt_pk_f32_fp8((int)ws_[q], false);
      s += xp[2 * q + 1] * __builtin_amdgcn_cvt_pk_f32_fp8((int)ws_[q], true);
    }
    d[u] = s[0] + s[1];
  }
  {
    const bool b4 = (lane & 4) != 0, b2 = (lane & 2) != 0, b1 = (lane & 1) != 0;
#pragma unroll
    for (int i = 0; i < 4; i++) {
      const float send = b4 ? d[i] : d[i + 4], keep = b4 ? d[i + 4] : d[i];
      d[i] = keep + __shfl_xor(send, 4);
    }
#pragma unroll
    for (int i = 0; i < 2; i++) {
      const float send = b2 ? d[i] : d[i + 2], keep = b2 ? d[i + 2] : d[i];
      d[i] = keep + __shfl_xor(send, 2);
    }
    {
      const float send = b1 ? d[0] : d[1], keep = b1 ? d[1] : d[0];
      d[0] = keep + __shfl_xor(send, 1);
    }
    d[0] += __shfl_xor(d[0], 8);
    d[0] += __shfl_xor(d[0], 16);
    d[0] += __shfl_xor(d[0], 32);
  }
  const float dd = d[0] * (1.f / U_SCALE);
  const float hd = 0.5f * dd * (1.f + erff(dd * 0.70710678118654752f));
  const int cl = __float_as_int(hd * gate_lane * (1.f / V_SCALE));
#pragma unroll
  for (int u = 0; u < 8; u++) {
    const float c = __int_as_float(__builtin_amdgcn_readlane(cl, u));
    const f32x2 c2 = {c, c};
    const u32 ws_[4] = {V[u].x, V[u].y, V[u].z, V[u].w};
#pragma unroll
    for (int q = 0; q < 4; q++) {
      accp[2 * q] += c2 * __builtin_amdgcn_cvt_pk_f32_fp8((int)ws_[q], false);
      accp[2 * q + 1] += c2 * __builtin_amdgcn_cvt_pk_f32_fp8((int)ws_[q], true);
    }
  }
}
__device__ __forceinline__ float dot16_fp8(const f32x2 (&xp)[8], const uint4& q) {
  const u32 ws_[4] = {q.x, q.y, q.z, q.w};
  f32x2 s = {0.f, 0.f};
#pragma unroll
  for (int i = 0; i < 4; i++) {
    s += xp[2 * i] * __builtin_amdgcn_cvt_pk_f32_fp8((int)ws_[i], false);
    s += xp[2 * i + 1] * __builtin_amdgcn_cvt_pk_f32_fp8((int)ws_[i], true);
  }
  return s[0] + s[1];
}
__device__ __forceinline__ void pe_load_tab(const unsigned char* Tb, unsigned loff, int e0, int e1, int g, uint4 (&U)[16]) {
#pragma unroll
  for (int kb = 0; kb < 16; kb++) {
    const int e = __shfl((kb < 8) ? e0 : e1, (kb & 7) * 8 + g);
    U[kb] = *(const uint4*)(Tb + ((unsigned)e * 2048u + loff));
  }
}
__device__ __forceinline__ void pe_load_x(const u16* xr, f32x2 (&xp)[8]) {
  uint4 a = *(const uint4*)(xr), b = *(const uint4*)(xr + 8);
  xp[0] = f32x2{blo(a.x), bhi(a.x)}; xp[1] = f32x2{blo(a.y), bhi(a.y)}; xp[2] = f32x2{blo(a.z), bhi(a.z)}; xp[3] = f32x2{blo(a.w), bhi(a.w)};
  xp[4] = f32x2{blo(b.x), bhi(b.x)}; xp[5] = f32x2{blo(b.y), bhi(b.y)}; xp[6] = f32x2{blo(b.z), bhi(b.z)}; xp[7] = f32x2{blo(b.w), bhi(b.w)};
}
__device__ __forceinline__ void pe_dot_store(const f32x2 (&xp)[8], const uint4 (&U)[16], float* pr, int lane, int r) {
  float d[16];
#pragma unroll
  for (int kb = 0; kb < 16; kb++) d[kb] = dot16_fp8(xp, U[kb]);
  const bool b4 = (lane & 4) != 0, b2 = (lane & 2) != 0, b1 = (lane & 1) != 0;
#pragma unroll
  for (int i = 0; i < 8; i++) { const float send = b4 ? d[i] : d[i + 8], keep = b4 ? d[i + 8] : d[i]; d[i] = keep + __shfl_xor(send, 4); }
#pragma unroll
  for (int i = 0; i < 4; i++) { const float send = b2 ? d[i] : d[i + 4], keep = b2 ? d[i + 4] : d[i]; d[i] = keep + __shfl_xor(send, 2); }
#pragma unroll
  for (int i = 0; i < 2; i++) { const float send = b1 ? d[i] : d[i + 2], keep = b1 ? d[i + 2] : d[i]; d[i] = keep + __shfl_xor(send, 1); }
  pr[(2 * r) * 8] = d[0];
  pr[(2 * r + 1) * 8] = d[1];
}
__device__ void phase11a(const Params& p) {
  const int t = threadIdx.x, lane = t & 63, w = t >> 6, g = lane >> 3, r = lane & 7;
  const int s = blockIdx.x & 7, jb = blockIdx.x >> 3, ns = (gridDim.x - s + 7) >> 3;
  const u16* xn2 = p.R4 + s * 128 + r * 16;
  const unsigned char* Tb = (const unsigned char*)p.R5 + s * 128;
  const unsigned loff = r * 16;
  const int* experts = (const int*)p.R7 + lane;
  float* part = p.out + (size_t)s * BT * 128 + g;
  const int first = jb * 4 + w, stride = ns * 4;
  if (first >= BT) return;
#define TOKC(T) (((T) < BT) ? (T) : first)
  int eA0, eA1, eB0, eB1;
  uint4 UA[16], UB[16];
  f32x2 xA[8], xB[8];
  eA0 = experts[(size_t)first * 128]; eA1 = experts[(size_t)first * 128 + 64];
  pe_load_tab(Tb, loff, eA0, eA1, g, UA);
  pe_load_x(xn2 + (size_t)first * 1024, xA);
  { const int t1 = TOKC(first + stride); eB0 = experts[(size_t)t1 * 128]; eB1 = experts[(size_t)t1 * 128 + 64]; }
#pragma unroll 1
  for (int tok = first; tok < BT; tok += 2 * stride) {
    const int t1 = tok + stride, t2 = tok + 2 * stride, t3 = tok + 3 * stride;
    pe_load_tab(Tb, loff, eB0, eB1, g, UB);
    pe_load_x(xn2 + (size_t)TOKC(t1) * 1024, xB);
    { const int tc = TOKC(t2); eA0 = experts[(size_t)tc * 128]; eA1 = experts[(size_t)tc * 128 + 64]; }
    pe_dot_store(xA, UA, part + (size_t)tok * 128, lane, r);
    pe_load_tab(Tb, loff, eA0, eA1, g, UA);
    pe_load_x(xn2 + (size_t)TOKC(t2) * 1024, xA);
    { const int tc = TOKC(t3); eB0 = experts[(size_t)tc * 128]; eB1 = experts[(size_t)tc * 128 + 64]; }
    if (t1 < BT) pe_dot_store(xB, UB, part + (size_t)t1 * 128, lane, r);
  }
}

__device__ void phase11r(const Params& p) {
  float* gates = p.R7 + (size_t)BT * 128;
  const float* part = p.out;
  for (int idx = blockIdx.x * 256 + threadIdx.x; idx < BT * 128 / 4; idx += gridDim.x * 256) {
    float4 h = *(const float4*)(part + (size_t)idx * 4);
#pragma unroll
    for (int ss = 1; ss < 8; ss++) {
      const float4 q = *(const float4*)(part + (size_t)ss * BT * 128 + (size_t)idx * 4);
      h.x += q.x; h.y += q.y; h.z += q.z; h.w += q.w;
    }
    float4 gt = *(const float4*)(gates + (size_t)idx * 4);
    const float hv[4] = {h.x * (1.f / U_SCALE), h.y * (1.f / U_SCALE), h.z * (1.f / U_SCALE), h.w * (1.f / U_SCALE)};
    const float gv[4] = {gt.x, gt.y, gt.z, gt.w};
    float c[4];
#pragma unroll
    for (int q = 0; q < 4; q++) c[q] = 0.5f * hv[q] * (1.f + erff(hv[q] * 0.70710678118654752f)) * gv[q] * (1.f / V_SCALE);
    *(float4*)(gates + (size_t)idx * 4) = make_float4(c[0], c[1], c[2], c[3]);
  }
}

struct PeTok { int e0, e1; float g0, g1; };
__device__ __forceinline__ PeTok pe_load_tok(const int* experts, const float* gates, int tok) {
  PeTok k;
  k.e0 = experts[(size_t)tok * 128]; k.e1 = experts[(size_t)tok * 128 + 64];
  k.g0 = gates[(size_t)tok * 128]; k.g1 = gates[(size_t)tok * 128 + 64];
  return k;
}
__device__ __forceinline__ void pe_value_store(const PeTok& k, const uint4 (&V)[16], u16* drow, int lane, int g) {
  const float c0 = k.g0, c1 = k.g1;
  f32x2 accp[8];
#pragma unroll
  for (int i = 0; i < 8; i++) accp[i] = f32x2{0.f, 0.f};
#pragma unroll
  for (int kb = 0; kb < 16; kb++) {
    const float c = __shfl((kb < 8) ? c0 : c1, (kb & 7) * 8 + g);
    const f32x2 c2 = {c, c};
    const u32 ws_[4] = {V[kb].x, V[kb].y, V[kb].z, V[kb].w};
#pragma unroll
    for (int q = 0; q < 4; q++) {
      accp[2 * q] += c2 * __builtin_amdgcn_cvt_pk_f32_fp8((int)ws_[q], false);
      accp[2 * q + 1] += c2 * __builtin_amdgcn_cvt_pk_f32_fp8((int)ws_[q], true);
    }
  }
  float a[16];
#pragma unroll
  for (int i = 0; i < 8; i++) { a[2 * i] = accp[i][0]; a[2 * i + 1] = accp[i][1]; }
  const bool b32 = (lane & 32) != 0, b16 = (lane & 16) != 0, b8 = (lane & 8) != 0;
#pragma unroll
  for (int i = 0; i < 8; i++) { const float send = b32 ? a[i] : a[i + 8], keep = b32 ? a[i + 8] : a[i]; a[i] = keep + __shfl_xor(send, 32); }
#pragma unroll
  for (int i = 0; i < 4; i++) { const float send = b16 ? a[i] : a[i + 4], keep = b16 ? a[i + 4] : a[i]; a[i] = keep + __shfl_xor(send, 16); }
#pragma unroll
  for (int i = 0; i < 2; i++) { const float send = b8 ? a[i] : a[i + 2], keep = b8 ? a[i + 2] : a[i]; a[i] = keep + __shfl_xor(send, 8); }
  *(u32*)drow = pack2(a[0], a[1]);
}
__device__ void phase11b(const Params& p) {
  const int t = threadIdx.x, lane = t & 63, w = t >> 6, g = lane >> 3, r = lane & 7;
  const int s = blockIdx.x & 7, jb = blockIdx.x >> 3, ns = (gridDim.x - s + 7) >> 3;
  const unsigned char* Tb = (const unsigned char*)p.R5 + 1024 + s * 128;
  const unsigned loff = r * 16;
  const int* experts = (const int*)p.R7 + lane;
  const float* gates = p.R7 + (size_t)BT * 128 + lane;
  u16* x1 = p.R1 + s * 128 + r * 16 + 2 * g;
  const int first = jb * 4 + w, stride = ns * 4;
  if (first >= BT) return;
  PeTok kA, kB;
  uint4 VA[16], VB[16];
  kA = pe_load_tok(experts, gates, first);
  pe_load_tab(Tb, loff, kA.e0, kA.e1, g, VA);
  kB = pe_load_tok(experts, gates, TOKC(first + stride));
#pragma unroll 1
  for (int tok = first; tok < BT; tok += 2 * stride) {
    const int t1 = tok + stride, t2 = tok + 2 * stride, t3 = tok + 3 * stride;
    pe_load_tab(Tb, loff, kB.e0, kB.e1, g, VB);
    const PeTok kC = pe_load_tok(experts, gates, TOKC(t2));
    pe_value_store(kA, VA, x1 + (size_t)tok * 1024, lane, g);
    pe_load_tab(Tb, loff, kC.e0, kC.e1, g, VA);
    const PeTok kD = pe_load_tok(experts, gates, TOKC(t3));
    if (t1 < BT) pe_value_store(kB, VB, x1 + (size_t)t1 * 1024, lane, g);
    kA = kC; kB = kD;
  }
#undef TOKC
}

__device__ void phase11c(const Params& p) {
  const int t = threadIdx.x, lane = t & 63, w = t >> 6;
  const float* x1 = (const float*)p.R2;
  for (int tok = blockIdx.x * 4 + w; tok < BT; tok += gridDim.x * 4) {
    const float* xr = x1 + (size_t)tok * 1024 + lane * 16;
    const u16* dl = p.R1 + (size_t)tok * 1024 + lane * 16;
    float4 v[4];
    float ss = 0.f;
#pragma unroll
    for (int i = 0; i < 4; i++) {
      v[i] = *(const float4*)(xr + i * 4);
      const uint2 dd = *(const uint2*)(dl + i * 4);
      v[i].x += blo(dd.x); v[i].y += bhi(dd.x); v[i].z += blo(dd.y); v[i].w += bhi(dd.y);
      ss += v[i].x * v[i].x + v[i].y * v[i].y + v[i].z * v[i].z + v[i].w * v[i].w;
    }
    ss = wave_sum(ss);
    const float rstd = rsqrtf(ss * (1.f / 1024.f) + 1e-6f);
    float* orow = p.out + (size_t)tok * 1024 + lane * 16;
#pragma unroll
    for (int i = 0; i < 4; i++) {
      float4 gg = *(const float4*)(p.fng + lane * 16 + i * 4);
      *(float4*)(orow + i * 4) = make_float4(v[i].x * rstd * gg.x, v[i].y * rstd * gg.y, v[i].z * rstd * gg.z, v[i].w * rstd * gg.w);
    }
  }
}

__global__ void __launch_bounds__(256, 2) fwd_mega(Params p, int ph_lo, int ph_hi) {
  extern __shared__ __attribute__((aligned(16))) char smem[];
  cg::grid_group grid = cg::this_grid();
  __shared__ uint4 xb_words;
  if (threadIdx.x == 0) xb_words = make_uint4(0u, 0u, 0u, 0u);
  __syncthreads();
  const XcdBarrier xb = xcd_barrier_post(p.bar, (volatile LAS unsigned*)&xb_words);
  if (ph_lo > ph_hi) grid.sync();
constexpr int REP0=1,REP1=1,REP2=1,REP3=1,REP4=1,REP5=1,REP6=1,REP7=1,REP8=1,REP9=1,REP10=1,REP11=1,REP12=1,REP13=1,REP14=1;
#define RUN_PHASE(k, call)                         \
  if (PH_ON(k) && ph_lo <= (k) && (k) < ph_hi) {   \
    for (int rep_ = 0; rep_ < REP##k; rep_++) { call; }  \
    if ((k) + 1 < ph_hi) xcd_barrier(xb);          \
  }
  RUN_PHASE(0, phase0(p, smem))
  RUN_PHASE(1, phase1(p, smem))
  RUN_PHASE(2, phase2(p, smem, xb))
  RUN_PHASE(3, phase3(p); weights_late(p, smem))
  RUN_PHASE(4, for (int item = blockIdx.x; item < 512; item += gridDim.x) gla_item(p, item, 2, smem))
  RUN_PHASE(5, phase5(p))
  RUN_PHASE(6, phase6(p, smem))
  RUN_PHASE(7, phase7(p, smem))
  RUN_PHASE(8, phase8(p))
  RUN_PHASE(9, phase9(p, smem))
  RUN_PHASE(10, phase10(p, smem))
  RUN_PHASE(11, phase11a(p))
  RUN_PHASE(12, phase11r(p))
  RUN_PHASE(13, phase11b(p))
  RUN_PHASE(14, phase11c(p))
}

extern "C" void kernel_launch(void* const* d_in, const int* in_sizes, int n_in, void* d_out, int out_size, void* d_ws,
                              size_t ws_size, hipStream_t stream) {
  (void)in_sizes; (void)n_in; (void)out_size; (void)ws_size;
  static int grid_blocks = 0;
  if (!grid_blocks) {
    int dev = 0, cus = 0, per_cu = 0;
    hipGetDevice(&dev);
    hipDeviceGetAttribute(&cus, hipDeviceAttributeMultiprocessorCount, dev);
    hipFuncSetAttribute((const void*)fwd_mega, hipFuncAttributeMaxDynamicSharedMemorySize, LDS_BYTES);
    hipOccupancyMaxActiveBlocksPerMultiprocessor(&per_cu, (const void*)fwd_mega, 256, LDS_BYTES);
    if (per_cu < 1) per_cu = 1;
    if (per_cu > 2) per_cu = 2;
    grid_blocks = cus * per_cu;
  }
  Params p{};
  const float* const* in = (const float* const*)d_in;
  p.x = in[0]; p.norm1_g = in[1]; p.w_in = in[2]; p.conv_w = in[3]; p.conv_b = in[4]; p.wa = in[5];
  p.dupf = in[6]; p.dbf = in[7]; p.dupb = in[8]; p.dbb = in[9]; p.gng = in[10]; p.wb = in[11];
  p.gbias = in[12]; p.wo = in[13]; p.norm2_g = in[14]; p.wq = in[15]; p.keys = in[16]; p.pu = in[17];
  p.pv = in[18]; p.fng = in[19];
  p.out = (float*)d_out;
  char* ws = (char*)d_ws;
  const size_t MiB = 1u << 20;
  p.WinT = (u16*)ws;
  p.WaT = (u16*)(ws + 17039360);
  p.WbT = (u16*)(ws + 17039360 + 2097152);
  p.WoT = (u16*)(ws + 17039360 + 2 * 2097152);
  p.WqT = (u16*)(ws + 17039360 + 3 * 2097152);
  p.KeysB = (u16*)(ws + 17039360 + 3 * 2097152 + 4194304);
  p.R1 = (u16*)(ws + 27 * MiB);
  p.R2 = (u16*)(ws + 59 * MiB);
  p.R3 = (u16*)(ws + 91 * MiB);
  p.R4 = (u16*)(ws + 123 * MiB);
  p.R5 = (u16*)(ws + 155 * MiB);
  p.R6 = (u16*)(ws + 187 * MiB);
  p.R7 = (float*)(ws + 219 * MiB);
  p.z = (float*)(ws + 251 * MiB);
  p.Dd = (float*)(ws + 253 * MiB);
  p.bar = (unsigned*)(ws + 254 * MiB);
  hipMemsetAsync(p.bar, 0, XCD_BAR_WORDS * sizeof(unsigned), stream);
#if MULTI_LAUNCH
  for (int ph = 0; ph < NPHASE; ph++) {
    hipLaunchKernelGGL(fwd_mega, dim3(grid_blocks), dim3(256), LDS_BYTES, stream, p, ph, ph + 1);
  }
#else
  int lo = 0, hi = NPHASE;
  void* args[] = {&p, &lo, &hi};
  hipError_t e = hipLaunchCooperativeKernel((const void*)fwd_mega, dim3(grid_blocks), dim3(256), args, LDS_BYTES, stream);
  if (e != hipSuccess) fprintf(stderr, "cooperative launch failed: %s (grid %d)\n", hipGetErrorString(e), grid_blocks);
#endif
}
```

```cpp
#include <hip/hip_runtime.h>
#include <hip/hip_cooperative_groups.h>
#include <cstdio>
namespace cg = cooperative_groups;

typedef unsigned short u16;
typedef unsigned int u32;
using bf16x8 = __attribute__((ext_vector_type(8))) short;
using f32x4 = __attribute__((ext_vector_type(4))) float;

#ifndef ONLY_PHASE
#define ONLY_PHASE -1
#endif
#define PH_ON(k) (ONLY_PHASE < 0 || ONLY_PHASE == (k))
#ifndef MULTI_LAUNCH
#define MULTI_LAUNCH 0
#endif

constexpr int BT = 16384, SEQ = 8192;
constexpr int LDS_BYTES = 80896;
constexpr int NPHASE = 15;

struct Params {
  const float *x, *norm1_g, *w_in, *conv_w, *conv_b, *wa, *dupf, *dbf, *dupb, *dbb, *gng, *wb, *gbias, *wo,
      *norm2_g, *wq, *keys, *pu, *pv, *fng;
  float* out;
  u16 *WinT, *WaT, *WbT, *WoT, *WqT, *KeysB;
  u16 *R1, *R2, *R3, *R4, *R5, *R6;
  float *R7, *z, *Dd;
  unsigned* bar;
};

__device__ __forceinline__ u16 f2b(float f) { u32 u = __float_as_uint(f); u += 0x7fffu + ((u >> 16) & 1u); return (u16)(u >> 16); }
__device__ __forceinline__ float b2f(u16 h) { return __uint_as_float(((u32)h) << 16); }
__device__ __forceinline__ u32 pack2(float a, float b) { return (u32)f2b(a) | ((u32)f2b(b) << 16); }
__device__ __forceinline__ float blo(u32 w) { return __uint_as_float(w << 16); }
__device__ __forceinline__ float bhi(u32 w) { return __uint_as_float(w & 0xffff0000u); }
__device__ __forceinline__ float wave_sum(float v) {
#pragma unroll
  for (int o = 32; o > 0; o >>= 1) v += __shfl_xor(v, o);
  return v;
}
__device__ __forceinline__ float sigmoidf_(float v) { return 1.f / (1.f + __expf(-v)); }
__device__ __forceinline__ u32 ordf(float v) { u32 u = __float_as_uint(v); return (u & 0x80000000u) ? ~u : (u | 0x80000000u); }
__device__ __forceinline__ float unordf(u32 k) { return __uint_as_float((k & 0x80000000u) ? (k ^ 0x80000000u) : ~k); }

template <int MT, int NT, int KT>
__device__ __forceinline__ void mma_nt(f32x4 (&acc)[MT][NT], const u16* A, int sa, const u16* B, int sb, int lane) {
  const int fr = lane & 15, fq = lane >> 4;
  const u16* pa = A + fr * sa + fq * 8;
  const u16* pb = B + fr * sb + fq * 8;
#pragma unroll
  for (int k = 0; k < KT; k++) {
    bf16x8 a[MT], b[NT];
#pragma unroll
    for (int m = 0; m < MT; m++) a[m] = *(const bf16x8*)(pa + m * 16 * sa + k * 32);
#pragma unroll
    for (int n = 0; n < NT; n++) b[n] = *(const bf16x8*)(pb + n * 16 * sb + k * 32);
#pragma unroll
    for (int m = 0; m < MT; m++)
#pragma unroll
      for (int n = 0; n < NT; n++) acc[m][n] = __builtin_amdgcn_mfma_f32_16x16x32_bf16(a[m], b[n], acc[m][n], 0, 0, 0);
  }
}

template <int MT, int NT>
__device__ __forceinline__ void mma_sw64(f32x4 (&acc)[MT][NT], const u16* A, const u16* B, int lane) {
  const int fr = lane & 15, fq = lane >> 4;
  const int cb = fq ^ ((fr >> 1) & 7);
  const u16* pa = A + fr * 64;
  const u16* pb = B + fr * 64;
#pragma unroll
  for (int k = 0; k < 2; k++) {
    const int co = (cb ^ (k * 4)) * 8;
    bf16x8 a[MT], b[NT];
#pragma unroll
    for (int m = 0; m < MT; m++) a[m] = *(const bf16x8*)(pa + m * 16 * 64 + co);
#pragma unroll
    for (int n = 0; n < NT; n++) b[n] = *(const bf16x8*)(pb + n * 16 * 64 + co);
#pragma unroll
    for (int m = 0; m < MT; m++)
#pragma unroll
      for (int n = 0; n < NT; n++) acc[m][n] = __builtin_amdgcn_mfma_f32_16x16x32_bf16(b[n], a[m], acc[m][n], 0, 0, 0);
  }
}

#define ST_DECL(S) uint4 S##a0, S##a1, S##a2, S##a3, S##b0, S##b1, S##b2, S##b3
#define ST_LOAD(S, PA, PB)                                                                                           \
  do {                                                                                                               \
    const char* pa_ = (const char*)(PA);                                                                             \
    const char* pb_ = (const char*)(PB);                                                                             \
    S##a0 = *(const uint4*)(pa_ + voffA); S##a1 = *(const uint4*)(pa_ + (size_t)64 * lda + voffA);                   \
    S##a2 = *(const uint4*)(pa_ + (size_t)128 * lda + voffA); S##a3 = *(const uint4*)(pa_ + (size_t)192 * lda + voffA); \
    S##b0 = *(const uint4*)(pb_ + voffB); S##b1 = *(const uint4*)(pb_ + (size_t)64 * ldb + voffB);                   \
    S##b2 = *(const uint4*)(pb_ + (size_t)128 * ldb + voffB); S##b3 = *(const uint4*)(pb_ + (size_t)192 * ldb + voffB); \
  } while (0)
#define ST_WRITE(S, WA, WB)                                                                                          \
  do {                                                                                                               \
    *(uint4*)(WA) = S##a0; *(uint4*)((WA) + 32 * 64) = S##a1; *(uint4*)((WA) + 64 * 64) = S##a2; *(uint4*)((WA) + 96 * 64) = S##a3; \
    *(uint4*)(WB) = S##b0; *(uint4*)((WB) + 32 * 64) = S##b1; *(uint4*)((WB) + 64 * 64) = S##b2; *(uint4*)((WB) + 96 * 64) = S##b3; \
  } while (0)

#define GLDS16(G, L) __builtin_amdgcn_global_load_lds((const void*)(G), (__attribute__((address_space(3))) void*)(L), 16, 0, 0)
__device__ __forceinline__ void gemm_acc_db(f32x4 (&acc)[4][4], const u16* __restrict__ A, int lda, const u16* __restrict__ B,
                                            int ldb, int K, char* smem) {
  const int t = threadIdx.x, lane = t & 63, w = t >> 6, wr = w >> 1, wc = w & 1;
  const int lr = t >> 3;
  const int gc = ((t & 7) ^ ((lr >> 1) & 7)) * 8;
  const u16* pa = A + (size_t)lr * lda + gc;
  const u16* pb = B + (size_t)lr * ldb + gc;
  char* l0 = smem + t * 16;
  u16* b0 = (u16*)smem;
  u16* b1 = b0 + 2 * 128 * 64;
#define ISSUE_TILE(KT, BUFOFF)                                                                     \
  do {                                                                                             \
    const u16* qa = pa + (KT) * 64;                                                                \
    const u16* qb = pb + (KT) * 64;                                                                \
    char* lb = l0 + (BUFOFF);                                                                      \
    GLDS16(qa, lb); GLDS16(qa + (size_t)32 * lda, lb + 4096);                                      \
    GLDS16(qa + (size_t)64 * lda, lb + 8192); GLDS16(qa + (size_t)96 * lda, lb + 12288);           \
    GLDS16(qb, lb + 16384); GLDS16(qb + (size_t)32 * ldb, lb + 16384 + 4096);                      \
    GLDS16(qb + (size_t)64 * ldb, lb + 16384 + 8192); GLDS16(qb + (size_t)96 * ldb, lb + 16384 + 12288); \
  } while (0)
  const int nk = K >> 6;
  __syncthreads();
  ISSUE_TILE(0, 0);
#define KSTEP(BUF, ISSUE_STMT)                                                 \
  do {                                                                         \
    asm volatile("s_waitcnt vmcnt(0)" ::: "memory");                          \
    __builtin_amdgcn_s_barrier();                                              \
    asm volatile("" ::: "memory");                                             \
    ISSUE_STMT;                                                                \
    mma_sw64<4, 4>(acc, BUF + wr * 64 * 64, BUF + 128 * 64 + wc * 64 * 64, lane); \
  } while (0)
  for (int kt = 0; kt + 2 < nk; kt += 2) {
    KSTEP(b0, ISSUE_TILE(kt + 1, 32768));
    KSTEP(b1, ISSUE_TILE(kt + 2, 0));
  }
  KSTEP(b0, ISSUE_TILE(nk - 1, 32768));
  KSTEP(b1, (void)0);
  asm volatile("s_waitcnt lgkmcnt(0)" ::: "memory");
#undef KSTEP
#undef ISSUE_TILE
}

struct TileIter {
  int i, step, lim, NT, xcd; bool swz;
  __device__ __forceinline__ TileIter(int nt_) {
    NT = nt_;
    swz = (gridDim.x & 7) == 0;
    if (swz) { xcd = blockIdx.x & 7; i = blockIdx.x >> 3; step = gridDim.x >> 3; lim = 16 * NT; }
    else { xcd = 0; i = blockIdx.x; step = gridDim.x; lim = 128 * NT; }
  }
  __device__ __forceinline__ bool next(int& mt, int& nt) {
    if (i >= lim) return false;
    if (swz) { int mg = i / (NT * 8), rem = i - mg * NT * 8; nt = rem >> 3; mt = xcd * 16 + mg * 8 + (rem & 7); }
    else { mt = i & 127; nt = i >> 7; }
    i += step;
    return true;
  }
};

__device__ __forceinline__ void zero_acc(f32x4 (&acc)[4][4]) {
#pragma unroll
  for (int m = 0; m < 4; m++)
#pragma unroll
    for (int n = 0; n < 4; n++) acc[m][n] = f32x4{0.f, 0.f, 0.f, 0.f};
}

__device__ __forceinline__ int winmap(int r) {
  if (r < 2048) { int tile = r >> 7, w = r & 127, grp = w >> 5; int ch = tile * 64 + (grp >> 1) * 32 + (w & 31); return ((grp & 1) ? 2048 : 0) + ch; }
  if (r < 3072) return r - 1024;
  if (r < 6176) return r;
  if (r < 6272) return -1;
  return r - 96;
}

__device__ __forceinline__ void tr_tile(const float* __restrict__ src, int ld, int col0, u16* __restrict__ dst, int r0, int k0, float* sT) {
  const int t = threadIdx.x;
  const int r = t >> 3, kc = t & 7;
  if (col0 < 0) {
    *(uint4*)(dst + (size_t)(r0 + r) * 1024 + k0 + kc * 8) = make_uint4(0, 0, 0, 0);
    return;
  }
  __syncthreads();
#pragma unroll
  for (int i = 0; i < 8; i++) {
    int k = (t >> 5) + i * 8, rr = t & 31;
    sT[k * 33 + rr] = src[(size_t)(k0 + k) * ld + col0 + rr];
  }
  __syncthreads();
  u32 wv[4];
#pragma unroll
  for (int j = 0; j < 4; j++) wv[j] = pack2(sT[(kc * 8 + 2 * j) * 33 + r], sT[(kc * 8 + 2 * j + 1) * 33 + r]);
  *(uint4*)(dst + (size_t)(r0 + r) * 1024 + k0 + kc * 8) = make_uint4(wv[0], wv[1], wv[2], wv[3]);
}

__device__ __forceinline__ void rms_row(const float* __restrict__ src, const float* __restrict__ g, u16* __restrict__ dst, int lane) {
  float4 v[4];
  float ss = 0.f;
#pragma unroll
  for (int i = 0; i < 4; i++) {
    v[i] = *(const float4*)(src + i * 256 + lane * 4);
    ss += v[i].x * v[i].x + v[i].y * v[i].y + v[i].z * v[i].z + v[i].w * v[i].w;
  }
  ss = wave_sum(ss);
  const float rstd = rsqrtf(ss * (1.f / 1024.f) + 1e-6f);
#pragma unroll
  for (int i = 0; i < 4; i++) {
    float4 gg = *(const float4*)(g + i * 256 + lane * 4);
    uint2 o;
    o.x = pack2(v[i].x * rstd * gg.x, v[i].y * rstd * gg.y);
    o.y = pack2(v[i].z * rstd * gg.z, v[i].w * rstd * gg.w);
    *(uint2*)(dst + i * 256 + lane * 4) = o;
  }
}

__device__ void phase0(const Params& p, char* smem) {
  float* sT = (float*)smem;
  const int t = threadIdx.x, lane = t & 63, w = t >> 6;
  u16* xn = (u16*)p.out;
  constexpr int J0 = 4160, J4 = J0 + 4096;
  for (int job = blockIdx.x; job < J4; job += gridDim.x) {
    if (job < J0) {
      int rb = job >> 4, kb = job & 15;
      tr_tile(p.w_in, 8224, winmap(rb * 32), p.WinT, rb * 32, kb * 64, sT);
    } else {
      int row = (job - J0) * 4 + w;
      rms_row(p.x + (size_t)row * 1024, p.norm1_g, xn + (size_t)row * 1024, lane);
    }
  }
}
__device__ void weights_late(const Params& p, char* smem) {
  float* sT = (float*)smem;
  const int t = threadIdx.x;
  constexpr int J1 = 1536, J2 = J1 + 1024, J3 = J2 + 128;
  for (int job = blockIdx.x; job < J3; job += gridDim.x) {
    if (job < J1) {
      int which = job >> 9, rb = (job & 511) >> 4, kb = job & 15;
      const float* src = which == 0 ? p.wa : (which == 1 ? p.wb : p.wo);
      u16* dst = which == 0 ? p.WaT : (which == 1 ? p.WbT : p.WoT);
      tr_tile(src, 1024, rb * 32, dst, rb * 32, kb * 64, sT);
    } else if (job < J2) {
      int j = job - J1, rb = j >> 4, kb = j & 15;
      tr_tile(p.wq, 2048, rb * 32, p.WqT, rb * 32, kb * 64, sT);
    } else {
      int j = job - J2;
      int base = (j * 256 + t) * 8;
      float4 a = *(const float4*)(p.keys + base), b = *(const float4*)(p.keys + base + 4);
      *(uint4*)(p.KeysB + base) = make_uint4(pack2(a.x, a.y), pack2(a.z, a.w), pack2(b.x, b.y), pack2(b.z, b.w));
    }
  }
}

__device__ void la_prep(const Params& p, char* smem) {
  float* sZ = (float*)smem;
  float* sPart = sZ + 1024;
  const int t = threadIdx.x, lane = t & 63, w = t >> 6, fr = lane & 15, fq = lane >> 4;
  const u16* xn = (const u16*)p.out;
  const u16* Wz = p.WinT + (size_t)6144 * 1024;
  u32* la16 = (u32*)p.R6;
  float uf0[16], uf1[16], ub0[16], ub1[16];
#pragma unroll
  for (int r = 0; r < 16; r++) {
    uf0[r] = p.dupf[r * 512 + 2 * t]; uf1[r] = p.dupf[r * 512 + 2 * t + 1];
    ub0[r] = p.dupb[r * 512 + 2 * t]; ub1[r] = p.dupb[r * 512 + 2 * t + 1];
  }
  const float bf0 = p.dbf[2 * t], bf1 = p.dbf[2 * t + 1], bb0 = p.dbb[2 * t], bb1 = p.dbb[2 * t + 1];
  for (int job = blockIdx.x; job < BT / 32; job += gridDim.x) {
    f32x4 az[2][2];
#pragma unroll
    for (int m = 0; m < 2; m++)
#pragma unroll
      for (int n = 0; n < 2; n++) az[m][n] = f32x4{0.f, 0.f, 0.f, 0.f};
    {
      const u16* ap = xn + (size_t)(job * 32 + fr) * 1024 + w * 256 + fq * 8;
      const u16* bp = Wz + (size_t)fr * 1024 + w * 256 + fq * 8;
#pragma unroll
      for (int ks = 0; ks < 8; ks++) {
        bf16x8 a0 = *(const bf16x8*)(ap + ks * 32), a1 = *(const bf16x8*)(ap + 16 * 1024 + ks * 32);
        bf16x8 b0 = *(const bf16x8*)(bp + ks * 32), b1 = *(const bf16x8*)(bp + 16 * 1024 + ks * 32);
        az[0][0] = __builtin_amdgcn_mfma_f32_16x16x32_bf16(a0, b0, az[0][0], 0, 0, 0);
        az[0][1] = __builtin_amdgcn_mfma_f32_16x16x32_bf16(a0, b1, az[0][1], 0, 0, 0);
        az[1][0] = __builtin_amdgcn_mfma_f32_16x16x32_bf16(a1, b0, az[1][0], 0, 0, 0);
        az[1][1] = __builtin_amdgcn_mfma_f32_16x16x32_bf16(a1, b1, az[1][1], 0, 0, 0);
      }
    }
    __syncthreads();
#pragma unroll
    for (int m = 0; m < 2; m++)
#pragma unroll
      for (int n = 0; n < 2; n++)
#pragma unroll
        for (int j = 0; j < 4; j++) sPart[w * 1024 + (m * 16 + fq * 4 + j) * 32 + n * 16 + fr] = az[m][n][j];
    __syncthreads();
    {
      const float4 q0 = *(const float4*)(sPart + t * 4), q1 = *(const float4*)(sPart + 1024 + t * 4), q2 = *(const float4*)(sPart + 2048 + t * 4),
                   q3 = *(const float4*)(sPart + 3072 + t * 4);
      *(float4*)(sZ + t * 4) = make_float4(q0.x + q1.x + q2.x + q3.x, q0.y + q1.y + q2.y + q3.y, q0.z + q1.z + q2.z + q3.z, q0.w + q1.w + q2.w + q3.w);
    }
    __syncthreads();
    for (int i = 0; i < 32; i++) {
      const float* zr = sZ + i * 32;
      float a0 = bf0, a1 = bf1, c0 = bb0, c1 = bb1;
#pragma unroll
      for (int r = 0; r < 16; r++) {
        const float zf = zr[r], zb = zr[16 + r];
        a0 += zf * uf0[r]; a1 += zf * uf1[r];
        c0 += zb * ub0[r]; c1 += zb * ub1[r];
      }
      const float l0 = (fminf(a0, 0.f) - __logf(1.f + __expf(-fabsf(a0)))) * 0.0625f;
      const float l1 = (fminf(a1, 0.f) - __logf(1.f + __expf(-fabsf(a1)))) * 0.0625f;
      const float m0 = (fminf(c0, 0.f) - __logf(1.f + __expf(-fabsf(c0)))) * 0.0625f;
      const float m1 = (fminf(c1, 0.f) - __logf(1.f + __expf(-fabsf(c1)))) * 0.0625f;
      const int tok = job * 32 + i;
      la16[(size_t)tok * 256 + t] = (u32)__builtin_bit_cast(unsigned short, (_Float16)l0) | ((u32)__builtin_bit_cast(unsigned short, (_Float16)l1) << 16);
      la16[(size_t)(BT + tok) * 256 + t] = (u32)__builtin_bit_cast(unsigned short, (_Float16)m0) | ((u32)__builtin_bit_cast(unsigned short, (_Float16)m1) << 16);
    }
  }
}

__device__ void phase1(const Params& p, char* smem) {
  u16* sA = (u16*)smem;
  u16* sB = sA + 128 * 64;
  const int t = threadIdx.x, lane = t & 63, w = t >> 6, wr = w >> 1, wc = w & 1, fr = lane & 15, fq = lane >> 4;
  const u16* xn = (const u16*)p.out;
  la_prep(p, smem);
  TileIter ti(48);
  int mt, nt;
  while (ti.next(mt, nt)) {
    f32x4 acc[4][4];
    zero_acc(acc);
    gemm_acc_db(acc, xn + (size_t)mt * 128 * 1024, 1024, p.WinT + (size_t)nt * 128 * 1024, 1024, 1024, smem);
    const int rowb = mt * 128 + wr * 64 + fr;
    if (nt < 16) {
#pragma unroll
      for (int m = 0; m < 4; m++)
#pragma unroll
        for (int n = 0; n < 2; n++) {
          const int ch = nt * 64 + wc * 32 + n * 16 + fq * 4;
          *(uint2*)(p.R1 + (size_t)(rowb + m * 16) * 1024 + ch) =
              make_uint2(pack2(acc[m][n][0] * acc[m][n + 2][0], acc[m][n][1] * acc[m][n + 2][1]),
                         pack2(acc[m][n][2] * acc[m][n + 2][2], acc[m][n][3] * acc[m][n + 2][3]));
        }
    } else {
      const int g = (nt - 16) >> 3;
      u16* dst = g == 0 ? p.R2 : (g == 1 ? p.R3 : (g == 2 ? p.R4 : p.R5));
      const int cb = ((nt - 16) & 7) * 128 + wc * 64;
      const float sc = (g == 1 && cb < 512) ? 0.08838834764831845f : 1.f;
#pragma unroll
      for (int m = 0; m < 4; m++)
#pragma unroll
        for (int n = 0; n < 4; n++)
          *(uint2*)(dst + (size_t)(rowb + m * 16) * 1024 + cb + n * 16 + fq * 4) =
              make_uint2(pack2(acc[m][n][0] * sc, acc[m][n][1] * sc), pack2(acc[m][n][2] * sc, acc[m][n][3] * sc));
    }
  }
}

#define XB_TMO      128
#define XB_XCNT(j)  (256  + 64 * (j))
#define XB_XSUB(j)  (1280 + 64 * (j))
#define XB_XGEN(j)  (2304 + 64 * (j))
#define XB_TOP      3328
#define XB_TOPGEN   3392
#define XCD_BAR_WORDS 3456
#define XB_SPIN_CAP (1u << 20)
#define LAS __attribute__((address_space(3)))
__device__ __forceinline__ unsigned xb_ld(unsigned* p) { return __hip_atomic_load(p, __ATOMIC_RELAXED, __HIP_MEMORY_SCOPE_AGENT); }
__device__ __forceinline__ unsigned xb_add(unsigned* p, unsigned v) { return __hip_atomic_fetch_add(p, v, __ATOMIC_RELAXED, __HIP_MEMORY_SCOPE_AGENT); }
__device__ __forceinline__ unsigned xb_xcc_id() { return (unsigned)__builtin_amdgcn_s_getreg((3 << 11) | 20) & 0xFu; }
#define XB_SPIN(cond, bar) do { unsigned _sp = 0; while (cond) { __builtin_amdgcn_s_sleep(1); \
    if ((++_sp & 255u) == 0u) { if (xb_ld(&(bar)[XB_TMO])) break; if (_sp > XB_SPIN_CAP) { atomicAdd(&(bar)[XB_TMO], 1u); break; } } } } while (0)
struct XcdBarrier { unsigned* bar; unsigned x; volatile LAS unsigned* st; };
__device__ __forceinline__ XcdBarrier xcd_barrier_post(unsigned* bar, volatile LAS unsigned* st) {
  XcdBarrier b; b.bar = bar; b.x = xb_xcc_id(); b.st = st;
  if (threadIdx.x == 0) (void)xb_add(&bar[XB_XCNT(b.x)], 1u);
  return b;
}
__device__ __forceinline__ void xcd_barrier_complete(unsigned* bar, unsigned x, unsigned& nloc, unsigned& nx) {
  const unsigned G = gridDim.x * gridDim.y * gridDim.z;
  unsigned sum, cnt, mine, sp = 0u;
  for (;;) {
    sum = 0u; cnt = 0u; mine = 0u;
#pragma unroll
    for (unsigned j = 0; j < 16; ++j) { const unsigned c = xb_ld(&bar[XB_XCNT(j)]); sum += c; cnt += (c > 0u) ? 1u : 0u; mine = (j == x) ? c : mine; }
    if (sum == G) break;
    __builtin_amdgcn_s_sleep(1);
    if ((++sp & 255u) == 0u) { if (xb_ld(&bar[XB_TMO])) break; if (sp > XB_SPIN_CAP) { atomicAdd(&bar[XB_TMO], 1u); break; } }
  }
  nloc = mine > 0u ? mine : 1u; nx = cnt > 0u ? cnt : 1u;
}
__device__ __forceinline__ void xcd_barrier(const XcdBarrier& b) {
  asm volatile("s_waitcnt vmcnt(0)" ::: "memory");
  __syncthreads();
  if (threadIdx.x == 0) {
    unsigned* bar = b.bar;
    __builtin_amdgcn_s_waitcnt(0);
    unsigned nloc = b.st[0], nx = b.st[1];
    if (nloc == 0u) { xcd_barrier_complete(bar, b.x, nloc, nx); b.st[0] = nloc; b.st[1] = nx; }
    const unsigned old = xb_add(&bar[XB_XSUB(b.x)], 1u);
    const unsigned gen = old / nloc;
    if (old + 1u == (gen + 1u) * nloc) {
      __builtin_amdgcn_fence(__ATOMIC_RELEASE, "agent");
      asm volatile("s_waitcnt vmcnt(0)" ::: "memory");
      const unsigned og = xb_add(&bar[XB_TOP], 1u);
      const unsigned tg = og / nx;
      if (og + 1u == (tg + 1u) * nx) xb_add(&bar[XB_TOPGEN], 1u);
      else XB_SPIN(xb_ld(&bar[XB_TOPGEN]) == tg, bar);
      __builtin_amdgcn_fence(__ATOMIC_ACQUIRE, "agent");
      xb_add(&bar[XB_XGEN(b.x)], 1u);
      asm volatile("s_waitcnt vmcnt(0)" ::: "memory");
    } else {
      XB_SPIN(xb_ld(&bar[XB_XGEN(b.x)]) == gen, bar);
      __builtin_amdgcn_fence(__ATOMIC_ACQUIRE, "agent");
      asm volatile("s_waitcnt vmcnt(0)" ::: "memory");
    }
  }
  __syncthreads();
}

__device__ void gla_item(const Params& p, int item, int pass, char* smem) {
  const int dvp = item & 1, seg = (item >> 1) & 15, dir = (item >> 5) & 1, h = (item >> 6) & 3, b = item >> 8;
  const int bhd = (b * 4 + h) * 2 + dir;
  u16* sQ = (u16*)smem;
  u16* sK = sQ + 64 * 136;
  u16* sKT = sK + 64 * 136;
  u16* sVT = sKT + 128 * 72;
  u16* sST = sVT + 64 * 72;
  float* sDec = (float*)(sST + 64 * 136);
  float* sTot = (float*)sVT;
  const int t = threadIdx.x, lane = t & 63, w = __builtin_amdgcn_readfirstlane(t >> 6), wr = w >> 1, wc = w & 1, fr = lane & 15, fq = lane >> 4;
  const int d0 = lane * 2;
  const u32* la16 = (const u32*)p.R6 + (size_t)dir * BT * 256 + h * 64 + lane;
  const u16* qk = p.R3;
  const u16* vv = p.R4;
  u16* obuf = dir ? p.R2 : p.R1;
  float* Lp = p.R7 + (size_t)(bhd * 16 + seg) * 32768 + (size_t)dvp * 128 * 128;

  f32x4 accS[2][2][4];
#pragma unroll
  for (int s = 0; s < 2; s++)
#pragma unroll
    for (int m = 0; m < 2; m++)
#pragma unroll
      for (int n = 0; n < 4; n++)
#pragma unroll
        for (int j = 0; j < 4; j++)
          accS[s][m][n][j] = (pass == 2) ? Lp[(s * 64 + wr * 32 + m * 16 + fq * 4 + j) * 128 + wc * 64 + n * 16 + fr] : 0.f;
  float dsum0 = 0.f, dsum1 = 0.f;

  for (int ci = 0; ci < 8; ci++) {
    const int c = seg * 8 + ci;
    __syncthreads();
    u32 qv[16], kv[16], lav[16], vreg[2][16];
#pragma unroll
    for (int ii = 0; ii < 16; ii++) {
      int f = c * 64 + w * 16 + ii;
      int pos = dir ? (SEQ - 1 - f) : f;
      size_t tokoff = (size_t)(b * SEQ + pos) * 1024;
      kv[ii] = *(const u32*)(qk + tokoff + 512 + h * 128 + d0);
      if (pass == 2) qv[ii] = *(const u32*)(qk + tokoff + h * 128 + d0);
      lav[ii] = la16[(size_t)(b * SEQ + pos) * 256];
      vreg[0][ii] = vv[tokoff + h * 256 + dvp * 128 + lane];
      vreg[1][ii] = vv[tokoff + h * 256 + dvp * 128 + 64 + lane];
    }
    float bl0[16], bl1[16];
    {
      float run0 = 0.f, run1 = 0.f;
#pragma unroll
      for (int ii = 0; ii < 16; ii++) {
        run0 += (float)__builtin_bit_cast(_Float16, (unsigned short)(lav[ii] & 0xffffu));
        run1 += (float)__builtin_bit_cast(_Float16, (unsigned short)(lav[ii] >> 16));
        bl0[ii] = run0; bl1[ii] = run1;
      }
      sTot[w * 128 + d0] = run0;
      sTot[w * 128 + d0 + 1] = run1;
    }
    __syncthreads();
    {
      float off0 = 0.f, off1 = 0.f, tot0 = 0.f, tot1 = 0.f;
#pragma unroll
      for (int ww = 0; ww < 4; ww++) {
        float a = sTot[ww * 128 + d0], bb = sTot[ww * 128 + d0 + 1];
        if (ww < w) { off0 += a; off1 += bb; }
        tot0 += a; tot1 += bb;
      }
      dsum0 += tot0; dsum1 += tot1;
      const float et0 = __expf(tot0), et1 = __expf(tot1);
      if (w == 0) { sDec[d0] = et0; sDec[d0 + 1] = et1; }
#pragma unroll
      for (int ii = 0; ii < 16; ii += 2) {
        float ke0[2], ke1[2];
#pragma unroll
        for (int s = 0; s < 2; s++) {
          const int i2 = ii + s;
          const float b0 = bl0[i2] + off0, b1 = bl1[i2] + off1;
          const float k0 = blo(kv[i2]), k1 = bhi(kv[i2]);
          const int i = w * 16 + i2;
          const float e0 = __expf(b0), e1 = __expf(b1);
          const float kt0 = k0 * __builtin_amdgcn_rcpf(e0), kt1 = k1 * __builtin_amdgcn_rcpf(e1);
          if (pass == 2) {
            *(u32*)(sQ + i * 136 + d0) = pack2(blo(qv[i2]) * e0, bhi(qv[i2]) * e1);
            *(u32*)(sK + i * 136 + d0) = pack2(kt0, kt1);
          }
          ke0[s] = kt0 * et0;
          ke1[s] = kt1 * et1;
        }
        *(u32*)(sKT + d0 * 72 + w * 16 + ii) = pack2(ke0[0], ke0[1]);
        *(u32*)(sKT + (d0 + 1) * 72 + w * 16 + ii) = pack2(ke1[0], ke1[1]);
      }
    }
    __syncthreads();
    u16* sP = sK;
    if (pass == 2) {
      f32x4 accP[2][2];
#pragma unroll
      for (int m = 0; m < 2; m++)
#pragma unroll
        for (int n = 0; n < 2; n++) accP[m][n] = f32x4{0.f, 0.f, 0.f, 0.f};
      mma_nt<2, 2, 4>(accP, sQ + wr * 32 * 136, 136, sK + wc * 32 * 136, 136, lane);
      __syncthreads();
#pragma unroll
      for (int m = 0; m < 2; m++)
#pragma unroll
        for (int n = 0; n < 2; n++)
#pragma unroll
          for (int j = 0; j < 4; j++) {
            int i = wr * 32 + m * 16 + fq * 4 + j, jj = wc * 32 + n * 16 + fr;
            sP[i * 72 + jj] = (i >= jj) ? f2b(accP[m][n][j]) : (u16)0;
          }
    }
#pragma unroll
    for (int s = 0; s < 2; s++) {
      if (pass == 2) {
#pragma unroll
        for (int m = 0; m < 2; m++)
#pragma unroll
          for (int n = 0; n < 4; n++)
#pragma unroll
            for (int j = 0; j < 4; j++) sST[(wr * 32 + m * 16 + fq * 4 + j) * 136 + wc * 64 + n * 16 + fr] = f2b(accS[s][m][n][j]);
      }
      {
        uint4 v0 = make_uint4(vreg[s][0] | (vreg[s][1] << 16), vreg[s][2] | (vreg[s][3] << 16), vreg[s][4] | (vreg[s][5] << 16),
                              vreg[s][6] | (vreg[s][7] << 16));
        uint4 v1 = make_uint4(vreg[s][8] | (vreg[s][9] << 16), vreg[s][10] | (vreg[s][11] << 16), vreg[s][12] | (vreg[s][13] << 16),
                              vreg[s][14] | (vreg[s][15] << 16));
        *(uint4*)(sVT + lane * 72 + w * 16) = v0;
        *(uint4*)(sVT + lane * 72 + w * 16 + 8) = v1;
      }
      __syncthreads();
      if (pass == 2) {
        f32x4 accO[2][2];
#pragma unroll
        for (int m = 0; m < 2; m++)
#pragma unroll
          for (int n = 0; n < 2; n++) accO[m][n] = f32x4{0.f, 0.f, 0.f, 0.f};
        mma_nt<2, 2, 4>(accO, sQ + wr * 32 * 136, 136, sST + wc * 32 * 136, 136, lane);
        mma_nt<2, 2, 2>(accO, sP + wr * 32 * 72, 72, sVT + wc * 32 * 72, 72, lane);
#pragma unroll
        for (int m = 0; m < 2; m++)
#pragma unroll
          for (int j = 0; j < 4; j++) {
            int i = wr * 32 + m * 16 + fq * 4 + j;
            int f = c * 64 + i;
            int pos = dir ? (SEQ - 1 - f) : f;
            size_t o = (size_t)(b * SEQ + pos) * 1024 + h * 256 + dvp * 128 + s * 64 + wc * 32 + fr;
#pragma unroll
            for (int n = 0; n < 2; n++) obuf[o + n * 16] = f2b(accO[m][n][j]);
          }
      }
#pragma unroll
      for (int n = 0; n < 4; n++) {
        float dc = sDec[wc * 64 + n * 16 + fr];
#pragma unroll
        for (int m = 0; m < 2; m++)
#pragma unroll
          for (int j = 0; j < 4; j++) accS[s][m][n][j] *= dc;
      }
      mma_nt<2, 4, 2>(accS[s], sVT + wr * 32 * 72, 72, sKT + wc * 64 * 72, 72, lane);
      if (s == 0) __syncthreads();
    }
  }
  if (pass == 1) {
#pragma unroll
    for (int s = 0; s < 2; s++)
#pragma unroll
      for (int m = 0; m < 2; m++)
#pragma unroll
        for (int n = 0; n < 4; n++)
#pragma unroll
          for (int j = 0; j < 4; j++) Lp[(s * 64 + wr * 32 + m * 16 + fq * 4 + j) * 128 + wc * 64 + n * 16 + fr] = accS[s][m][n][j];
    if (dvp == 0 && w == 0) {
      p.Dd[(bhd * 16 + seg) * 128 + d0] = __expf(dsum0);
      p.Dd[(bhd * 16 + seg) * 128 + d0 + 1] = __expf(dsum1);
    }
  }
}

__device__ void phase2(const Params& p, char* smem, const XcdBarrier& xb) {
  const int t = threadIdx.x;
  (void)xb;
  u16* ya = (u16*)p.out + (size_t)BT * 1024;
  for (int job = blockIdx.x; job < 512 + 2048; job += gridDim.x) {
    if (job < 512) {
      gla_item(p, job, 1, smem);
    } else {
      const int j = job - 512;
      const int ch = (t & 127) * 8;
      float w0[8], w1[8], w2[8], cb[8];
#pragma unroll
      for (int e = 0; e < 8; e++) { w0[e] = p.conv_w[ch + e]; w1[e] = p.conv_w[1024 + ch + e]; w2[e] = p.conv_w[2048 + ch + e]; cb[e] = p.conv_b[ch + e]; }
#pragma unroll
      for (int it = 0; it < 4; it++) {
        const int tok = j * 8 + it * 2 + (t >> 7);
        const int pos = tok & (SEQ - 1);
        const size_t o = (size_t)tok * 1024 + ch;
        uint4 pc = *(const uint4*)(p.R1 + o);
        uint4 pp = make_uint4(0, 0, 0, 0), pn = make_uint4(0, 0, 0, 0);
        if (pos > 0) pp = *(const uint4*)(p.R1 + o - 1024);
        if (pos < SEQ - 1) pn = *(const uint4*)(p.R1 + o + 1024);
        uint4 bb = *(const uint4*)(p.R2 + o);
        const u32 pcs[4] = {pc.x, pc.y, pc.z, pc.w}, pps[4] = {pp.x, pp.y, pp.z, pp.w}, pns[4] = {pn.x, pn.y, pn.z, pn.w},
                  bbs[4] = {bb.x, bb.y, bb.z, bb.w};
        u32 ov[4];
#pragma unroll
        for (int q = 0; q < 4; q++) {
          float y0 = cb[2 * q] + w0[2 * q] * blo(pps[q]) + w1[2 * q] * blo(pcs[q]) + w2[2 * q] * blo(pns[q]);
          float y1 = cb[2 * q + 1] + w0[2 * q + 1] * bhi(pps[q]) + w1[2 * q + 1] * bhi(pcs[q]) + w2[2 * q + 1] * bhi(pns[q]);
          ov[q] = pack2(blo(bbs[q]) * y0, bhi(bbs[q]) * y1);
        }
        *(uint4*)(ya + o) = make_uint4(ov[0], ov[1], ov[2], ov[3]);
      }
    }
  }
}

__device__ void phase3(const Params& p) {
  for (int gid = blockIdx.x * 256 + threadIdx.x; gid < 16 * 32768; gid += gridDim.x * 256) {
    const int bhd = gid >> 15, e = gid & 32767, dk = e & 127;
    float carry = 0.f;
    for (int s = 0; s < 16; s++) {
      float* lp = p.R7 + (size_t)(bhd * 16 + s) * 32768 + e;
      float tmp = *lp;
      *lp = carry;
      carry = p.Dd[(bhd * 16 + s) * 128 + dk] * carry + tmp;
    }
  }
}

__device__ void phase5(const Params& p) {
  const int t = threadIdx.x, lane = t & 63, w = t >> 6;
  for (int it = blockIdx.x * 4 + w; it < BT * 4; it += gridDim.x * 4) {
    const int tok = it >> 2, h = it & 3;
    const size_t o = (size_t)tok * 1024 + h * 256 + lane * 4;
    uint2 a = *(const uint2*)(p.R1 + o), b = *(const uint2*)(p.R2 + o), r = *(const uint2*)(p.R5 + o);
    float ov[4] = {blo(a.x) + blo(b.x), bhi(a.x) + bhi(b.x), blo(a.y) + blo(b.y), bhi(a.y) + bhi(b.y)};
    float rv[4] = {blo(r.x), bhi(r.x), blo(r.y), bhi(r.y)};
    float ss = ov[0] * ov[0] + ov[1] * ov[1] + ov[2] * ov[2] + ov[3] * ov[3];
    ss = wave_sum(ss);
    const float rstd = rsqrtf(ss * (1.f / 256.f) + 1e-6f);
    float4 g = *(const float4*)(p.gng + h * 256 + lane * 4);
    const float gv[4] = {g.x, g.y, g.z, g.w};
    float res[4];
#pragma unroll
    for (int e = 0; e < 4; e++) res[e] = ov[e] * rstd * gv[e] * (rv[e] * sigmoidf_(rv[e]));
    uint2 out;
    out.x = pack2(res[0], res[1]);
    out.y = pack2(res[2], res[3]);
    *(uint2*)(p.R6 + o) = out;
  }
}

__device__ void phase6(const Params& p, char* smem) {
  const int t = threadIdx.x, lane = t & 63, w = t >> 6, wr = w >> 1, wc = w & 1, fr = lane & 15, fq = lane >> 4;
  const u16* xn = (const u16*)p.out;
  const u16* ya = xn + (size_t)BT * 1024;
  uint4* sG = (uint4*)((char*)p.R2 + (size_t)blockIdx.x * 65536 + t * 256);
  uint4* sH = sG + 8;
  TileIter ti(8);
  int mt, nt;
  while (ti.next(mt, nt)) {
    const int colb = nt * 128 + wc * 64 + fq * 4;
    f32x4 acc[4][4];
    zero_acc(acc);
    gemm_acc_db(acc, xn + (size_t)mt * 128 * 1024, 1024, p.WinT + (size_t)(6272 + nt * 128) * 1024, 1024, 1024, smem);
    {
      float4 gb[4];
#pragma unroll
      for (int n = 0; n < 4; n++) gb[n] = *(const float4*)(p.gbias + colb + n * 16);
#pragma unroll
      for (int m = 0; m < 4; m++)
#pragma unroll
        for (int h = 0; h < 2; h++)
          sG[m * 2 + h] = make_uint4(pack2(sigmoidf_(acc[m][2 * h][0] + gb[2 * h].x), sigmoidf_(acc[m][2 * h][1] + gb[2 * h].y)),
                                     pack2(sigmoidf_(acc[m][2 * h][2] + gb[2 * h].z), sigmoidf_(acc[m][2 * h][3] + gb[2 * h].w)),
                                     pack2(sigmoidf_(acc[m][2 * h + 1][0] + gb[2 * h + 1].x), sigmoidf_(acc[m][2 * h + 1][1] + gb[2 * h + 1].y)),
                                     pack2(sigmoidf_(acc[m][2 * h + 1][2] + gb[2 * h + 1].z), sigmoidf_(acc[m][2 * h + 1][3] + gb[2 * h + 1].w)));
    }
    zero_acc(acc);
    gemm_acc_db(acc, ya + (size_t)mt * 128 * 1024, 1024, p.WaT + (size_t)nt * 128 * 1024, 1024, 1024, smem);
#pragma unroll
    for (int m = 0; m < 4; m++)
#pragma unroll
      for (int h = 0; h < 2; h++) {
        const uint4 g = sG[m * 2 + h];
        sG[m * 2 + h] = make_uint4(pack2(acc[m][2 * h][0] * blo(g.x), acc[m][2 * h][1] * bhi(g.x)),
                                   pack2(acc[m][2 * h][2] * blo(g.y), acc[m][2 * h][3] * bhi(g.y)),
                                   pack2(acc[m][2 * h + 1][0] * blo(g.z), acc[m][2 * h + 1][1] * bhi(g.z)),
                                   pack2(acc[m][2 * h + 1][2] * blo(g.w), acc[m][2 * h + 1][3] * bhi(g.w)));
      }
    zero_acc(acc);
    gemm_acc_db(acc, p.R6 + (size_t)mt * 128 * 1024, 1024, p.WbT + (size_t)nt * 128 * 1024, 1024, 1024, smem);
#pragma unroll
    for (int m = 0; m < 4; m++)
#pragma unroll
      for (int h = 0; h < 2; h++)
        sH[m * 2 + h] = make_uint4(pack2(acc[m][2 * h][0], acc[m][2 * h][1]), pack2(acc[m][2 * h][2], acc[m][2 * h][3]),
                                   pack2(acc[m][2 * h + 1][0], acc[m][2 * h + 1][1]), pack2(acc[m][2 * h + 1][2], acc[m][2 * h + 1][3]));
    zero_acc(acc);
    gemm_acc_db(acc, xn + (size_t)mt * 128 * 1024, 1024, p.WinT + (size_t)(6272 + 1024 + nt * 128) * 1024, 1024, 1024, smem);
    const int rowb = mt * 128 + wr * 64 + fr;
    {
      float4 gb[4];
#pragma unroll
      for (int n = 0; n < 4; n++) gb[n] = *(const float4*)(p.gbias + 1024 + colb + n * 16);
#pragma unroll
      for (int m = 0; m < 4; m++)
#pragma unroll
        for (int h = 0; h < 2; h++) {
          const uint4 a = sG[m * 2 + h], b = sH[m * 2 + h];
          const u32 av[4] = {a.x, a.y, a.z, a.w}, bv[4] = {b.x, b.y, b.z, b.w};
#pragma unroll
          for (int nn = 0; nn < 2; nn++) {
            const int n = 2 * h + nn;
            float r0 = blo(av[nn * 2]) + blo(bv[nn * 2]) * sigmoidf_(acc[m][n][0] + gb[n].x);
            float r1 = bhi(av[nn * 2]) + bhi(bv[nn * 2]) * sigmoidf_(acc[m][n][1] + gb[n].y);
            float r2 = blo(av[nn * 2 + 1]) + blo(bv[nn * 2 + 1]) * sigmoidf_(acc[m][n][2] + gb[n].z);
            float r3 = bhi(av[nn * 2 + 1]) + bhi(bv[nn * 2 + 1]) * sigmoidf_(acc[m][n][3] + gb[n].w);
            *(uint2*)(p.R1 + (size_t)(rowb + m * 16) * 1024 + colb + n * 16) = make_uint2(pack2(r0, r1), pack2(r2, r3));
          }
        }
    }
  }
}

__device__ void phase7(const Params& p, char* smem) {
  u16* sA = (u16*)smem;
  u16* sB = sA + 128 * 64;
  const int t = threadIdx.x, lane = t & 63, w = t >> 6, wr = w >> 1, wc = w & 1, fr = lane & 15, fq = lane >> 4;
  float* x1 = (float*)p.R2;
  TileIter ti(8);
  int mt, nt;
  while (ti.next(mt, nt)) {
    f32x4 acc[4][4];
    zero_acc(acc);
    gemm_acc_db(acc, p.R1 + (size_t)mt * 128 * 1024, 1024, p.WoT + (size_t)nt * 128 * 1024, 1024, 1024, smem);
    const int rowb = mt * 128 + wr * 64 + fr;
    const int colb = nt * 128 + wc * 64 + fq * 4;
#pragma unroll
    for (int m = 0; m < 4; m++)
#pragma unroll
      for (int n = 0; n < 4; n++) {
        const size_t o = (size_t)(rowb + m * 16) * 1024 + colb + n * 16;
        const float4 xv = *(const float4*)(p.x + o);
        *(float4*)(x1 + o) = make_float4(xv.x + acc[m][n][0], xv.y + acc[m][n][1], xv.z + acc[m][n][2], xv.w + acc[m][n][3]);
      }
  }
}

constexpr float U_SCALE = 256.f, V_SCALE = 64.f;
__device__ __forceinline__ u32 enc_fp8x4(float a, float b, float c, float d) {
  int w = __builtin_amdgcn_cvt_pk_fp8_f32(a, b, 0, false);
  w = __builtin_amdgcn_cvt_pk_fp8_f32(c, d, w, true);
  return (u32)w;
}
__device__ __forceinline__ void table_convert_job(const Params& p, int j, int t) {
  unsigned char* Tb = (unsigned char*)p.R5;
  const float* src = (j < 4096) ? p.pu : p.pv;
  const float sc = (j < 4096) ? U_SCALE : V_SCALE;
  size_t base = (size_t)(j & 4095) * 4096 + t * 16;
  unsigned char* slot = Tb + (base >> 10) * 2048 + ((j < 4096) ? 0 : 1024) + (base & 1023);
  float4 a = *(const float4*)(src + base), b = *(const float4*)(src + base + 4), c = *(const float4*)(src + base + 8),
         d = *(const float4*)(src + base + 12);
  *(uint4*)slot = make_uint4(enc_fp8x4(a.x * sc, a.y * sc, a.z * sc, a.w * sc), enc_fp8x4(b.x * sc, b.y * sc, b.z * sc, b.w * sc),
                                     enc_fp8x4(c.x * sc, c.y * sc, c.z * sc, c.w * sc), enc_fp8x4(d.x * sc, d.y * sc, d.z * sc, d.w * sc));
}
__device__ void phase8(const Params& p) {
  const int t = threadIdx.x, lane = t & 63, w = t >> 6;
  const float* x1 = (const float*)p.R2;
  for (int job = blockIdx.x; job < 4096; job += gridDim.x) {
    int row = job * 4 + w;
    rms_row(x1 + (size_t)row * 1024, p.norm2_g, p.R4 + (size_t)row * 1024, lane);
  }
}

__device__ void phase9(const Params& p, char* smem) {
  u16* sA = (u16*)smem;
  u16* sB = sA + 128 * 64;
  const int t = threadIdx.x, lane = t & 63, w = t >> 6, wr = w >> 1, wc = w & 1, fr = lane & 15, fq = lane >> 4;
  u16* q = (u16*)p.out;
  TileIter ti(16);
  int mt, nt;
  while (ti.next(mt, nt)) {
    f32x4 acc[4][4];
    zero_acc(acc);
    gemm_acc_db(acc, p.R4 + (size_t)mt * 128 * 1024, 1024, p.WqT + (size_t)nt * 128 * 1024, 1024, 1024, smem);
    const int rowb = mt * 128 + wr * 64 + fr;
    const int colb = nt * 128 + wc * 64 + fq * 4;
#pragma unroll
    for (int m = 0; m < 4; m++)
#pragma unroll
      for (int n = 0; n < 4; n++)
        *(uint2*)(q + (size_t)(rowb + m * 16) * 2048 + colb + n * 16) = make_uint2(pack2(acc[m][n][0], acc[m][n][1]), pack2(acc[m][n][2], acc[m][n][3]));
#pragma unroll 1
    for (int r = 0; r < 4; r++) table_convert_job(p, (mt * 16 + nt) * 4 + r, t);
  }
}

__device__ __forceinline__ void select16q(u32* rowbase, int part, u32 (&tk)[16], unsigned char* idxp) {
  u32* myp = rowbase + part * 32;
#pragma unroll
  for (int it = 0; it < 16; it++) {
    u32 m = 0;
#pragma unroll
    for (int c = 0; c < 8; c++) {
      uint4 kk = *(const uint4*)(myp + c * 4);
      m = max(m, max(max(kk.x, kk.y), max(kk.z, kk.w)));
    }
    m = max(m, (u32)__shfl_xor((int)m, 1));
    m = max(m, (u32)__shfl_xor((int)m, 2));
    tk[it] = m;
    const int idx = 127 - (int)(m & 127u);
    if ((idx >> 5) == part) { rowbase[idx] = 0; idxp[it] = (unsigned char)idx; }
  }
}

__device__ void phase10(const Params& p, char* smem) {
  u16* sKeys = (u16*)smem;
  u32* sSc = (u32*)(smem + 128 * 136 * 2);
  unsigned char* sIdx = (unsigned char*)(smem + 128 * 136 * 2 + 64 * 132 * 4);
  const int t = threadIdx.x, lane = t & 63, w = t >> 6, fr = lane & 15, fq = lane >> 4;
  const int rl = lane >> 2, part = lane & 3, row = w * 16 + rl;
  const u16* q = (const u16*)p.out;
  int* experts = (int*)p.R7;
  float* gates = p.R7 + (size_t)BT * 128;
#define P10_DECL(S) uint4 S##k0, S##k1, S##k2, S##k3, S##k4, S##k5, S##k6, S##k7; bf16x8 S##q0, S##q1, S##q2, S##q3
#define P10_LOAD(S, ITEM, PP)                                                                               \
  do {                                                                                                      \
    const int it_ = ((ITEM) < 256 * 8) ? (ITEM) : (int)blockIdx.x;                                          \
    const int tt_ = it_ >> 3, h_ = it_ & 7;                                                                 \
    const u16* ks_ = p.KeysB + (size_t)(h_ * 2 + (PP)) * 128 * 128 + (t >> 4) * 128 + (t & 15) * 8;         \
    S##k0 = *(const uint4*)(ks_); S##k1 = *(const uint4*)(ks_ + 16 * 128); S##k2 = *(const uint4*)(ks_ + 32 * 128);   \
    S##k3 = *(const uint4*)(ks_ + 48 * 128); S##k4 = *(const uint4*)(ks_ + 64 * 128); S##k5 = *(const uint4*)(ks_ + 80 * 128); \
    S##k6 = *(const uint4*)(ks_ + 96 * 128); S##k7 = *(const uint4*)(ks_ + 112 * 128);                      \
    const u16* qp_ = q + (size_t)(tt_ * 64 + w * 16 + fr) * 2048 + h_ * 256 + (PP) * 128 + fq * 8;          \
    S##q0 = *(const bf16x8*)(qp_); S##q1 = *(const bf16x8*)(qp_ + 32); S##q2 = *(const bf16x8*)(qp_ + 64);  \
    S##q3 = *(const bf16x8*)(qp_ + 96);                                                                     \
  } while (0)
#define P10_MFMA_K(QK, KI)                                                                                  \
  _Pragma("unroll") for (int n_ = 0; n_ < 8; n_++) {                                                        \
    bf16x8 bv_ = *(const bf16x8*)(sKeys + (n_ * 16 + fr) * 136 + (KI) * 32 + fq * 8);                       \
    acc_[n_] = __builtin_amdgcn_mfma_f32_16x16x32_bf16(QK, bv_, acc_[n_], 0, 0, 0);                         \
  }
#define P10_SCORE(S)                                                                                        \
  do {                                                                                                      \
    __syncthreads();                                                                                        \
    u16* kd_ = sKeys + (t >> 4) * 136 + (t & 15) * 8;                                                       \
    *(uint4*)(kd_) = S##k0; *(uint4*)(kd_ + 16 * 136) = S##k1; *(uint4*)(kd_ + 32 * 136) = S##k2;           \
    *(uint4*)(kd_ + 48 * 136) = S##k3; *(uint4*)(kd_ + 64 * 136) = S##k4; *(uint4*)(kd_ + 80 * 136) = S##k5; \
    *(uint4*)(kd_ + 96 * 136) = S##k6; *(uint4*)(kd_ + 112 * 136) = S##k7;                                  \
    __syncthreads();                                                                                        \
    f32x4 acc_[8];                                                                                          \
    _Pragma("unroll") for (int n_ = 0; n_ < 8; n_++) acc_[n_] = f32x4{0.f, 0.f, 0.f, 0.f};                  \
    P10_MFMA_K(S##q0, 0) P10_MFMA_K(S##q1, 1) P10_MFMA_K(S##q2, 2) P10_MFMA_K(S##q3, 3)                     \
    _Pragma("unroll") for (int n_ = 0; n_ < 8; n_++)                                                        \
      _Pragma("unroll") for (int j_ = 0; j_ < 4; j_++) {                                                    \
        int r_ = w * 16 + fq * 4 + j_, col_ = n_ * 16 + fr;                                                 \
        sSc[r_ * 132 + col_] = (ordf(acc_[n_][j_]) & ~127u) | (u32)(127 - col_);                            \
      }                                                                                                     \
    __syncthreads();                                                                                        \
  } while (0)
  P10_DECL(sa);
  P10_DECL(sb);
  P10_LOAD(sa, (int)blockIdx.x, 0);
  for (int item = blockIdx.x; item < 256 * 8; item += gridDim.x) {
    const int tt = item >> 3, h = item & 7;
    u32 ta[16], tb[16];
    P10_SCORE(sa);
    P10_LOAD(sb, item, 1);
    select16q(sSc + row * 132, part, ta, sIdx + row * 32);
    P10_SCORE(sb);
    P10_LOAD(sa, item + (int)gridDim.x, 0);
    select16q(sSc + row * 132, part, tb, sIdx + row * 32 + 16);
    __syncthreads();
    {
      float fa[4], fb[16];
#pragma unroll
      for (int r = 0; r < 4; r++) {
        const u32 s0 = ta[4 * r], s1 = ta[4 * r + 1], s2 = ta[4 * r + 2], s3 = ta[4 * r + 3];
        const u32 sel = part == 0 ? s0 : (part == 1 ? s1 : (part == 2 ? s2 : s3));
        fa[r] = unordf(sel & ~127u);
      }
#pragma unroll
      for (int j = 0; j < 16; j++) fb[j] = unordf(tb[j] & ~127u);
      constexpr int NJ[4] = {16, 3, 1, 1};
      u32 cand[4][16];
#pragma unroll
      for (int r = 0; r < 4; r++) {
        const int irow = part + 4 * r;
        const int jlim = 16 / (irow + 1);
#pragma unroll
        for (int j = 0; j < 16; j++)
          if (j < NJ[r]) cand[r][j] = (j < jlim) ? ((ordf(fa[r] + fb[j]) & ~255u) | (u32)(255 - (irow * 16 + j))) : 0u;
      }
      const int tok = tt * 64 + row;
      float sv[16];
      int ev[16];
#pragma unroll
      for (int it = 0; it < 16; it++) {
        u32 m = 0;
#pragma unroll
        for (int r = 0; r < 4; r++)
#pragma unroll
          for (int j = 0; j < 16; j++)
            if (j < NJ[r]) m = max(m, cand[r][j]);
        m = max(m, (u32)__shfl_xor((int)m, 1));
        m = max(m, (u32)__shfl_xor((int)m, 2));
#pragma unroll
        for (int r = 0; r < 4; r++)
#pragma unroll
          for (int j = 0; j < 16; j++)
            if (j < NJ[r]) cand[r][j] = (cand[r][j] == m) ? 0u : cand[r][j];
        const int c = 255 - (int)(m & 255u);
        const int i1 = sIdx[row * 32 + (c >> 4)], i2 = sIdx[row * 32 + 16 + (c & 15)];
        ev[it] = i1 * 128 + i2;
        sv[it] = unordf(m & ~255u);
      }
      const float mx = sv[0];
      float sum = 0.f;
#pragma unroll
      for (int it = 0; it < 16; it++) { sv[it] = __expf(sv[it] - mx); sum += sv[it]; }
      const float inv = 1.f / sum;
#pragma unroll
      for (int g = 0; g < 4; g++) {
        if (part == g) {
          *(int4*)(experts + (size_t)tok * 128 + h * 16 + g * 4) = make_int4(ev[g * 4], ev[g * 4 + 1], ev[g * 4 + 2], ev[g * 4 + 3]);
          *(float4*)(gates + (size_t)tok * 128 + h * 16 + g * 4) =
              make_float4(sv[g * 4] * inv, sv[g * 4 + 1] * inv, sv[g * 4 + 2] * inv, sv[g * 4 + 3] * inv);
        }
      }
    }
  }
}

#undef P10_LOAD
#undef P10_SCORE
#undef P10_MFMA_K
#undef P10_DECL
typedef float f32x2 __attribute__((ext_vector_type(2)));
__device__ __forceinline__ void dec16(const uint4& q, float (&o)[16]) {
  const u32 ws_[4] = {q.x, q.y, q.z, q.w};
#pragma unroll
  for (int i = 0; i < 4; i++) {
    f32x2 lo = __builtin_amdgcn_cvt_pk_f32_fp8((int)ws_[i], false);
    f32x2 hi = __builtin_amdgcn_cvt_pk_f32_fp8((int)ws_[i], true);
    o[i * 4 + 0] = lo[0]; o[i * 4 + 1] = lo[1]; o[i * 4 + 2] = hi[0]; o[i * 4 + 3] = hi[1];
  }
}
__device__ __forceinline__ void peer_load8(uint4 (&U)[8], uint4 (&V)[8], const unsigned char* Ub, const unsigned char* Vb, int ev, int l0,
                                           int lane) {
#pragma unroll
  for (int u = 0; u < 8; u++) {
    const int e = __builtin_amdgcn_readlane(ev, l0 + u);
    U[u] = *(const uint4*)(Ub + (size_t)e * 2048 + lane * 16);
    V[u] = *(const uint4*)(Vb + (size_t)e * 2048 + lane * 16);
  }
}
__device__ __forceinline__ void peer_proc8(const uint4 (&U)[8], const uint4 (&V)[8], const f32x2 (&xp)[8], f32x2 (&accp)[8], float gate_lane,
                                           int lane) {
  float d[8];
#pragma unroll
  for (int u = 0; u < 8; u++) {
    const u32 ws_[4] = {U[u].x, U[u].y, U[u].z, U[u].w};
    f32x2 s = {0.f, 0.f};
#pragma unroll
    for (int q = 0; q < 4; q++) {
      s += xp[2 * q] * __builtin_amdgcn_cvt_pk_f32_fp8((int)ws_[q], false);
      s += xp[2 * q + 1] * __builtin_amdgcn_cvt_pk_f32_fp8((int)ws_[q], true);
    }
    d[u] = s[0] + s[1];
  }
  {
    const bool b4 = (lane & 4) != 0, b2 = (lane & 2) != 0, b1 = (lane & 1) != 0;
#pragma unroll
    for (int i = 0; i < 4; i++) {
      const float send = b4 ? d[i] : d[i + 4], keep = b4 ? d[i + 4] : d[i];
      d[i] = keep + __shfl_xor(send, 4);
    }
#pragma unroll
    for (int i = 0; i < 2; i++) {
      const float send = b2 ? d[i] : d[i + 2], keep = b2 ? d[i + 2] : d[i];
      d[i] = keep + __shfl_xor(send, 2);
    }
    {
      const float send = b1 ? d[0] : d[1], keep = b1 ? d[1] : d[0];
      d[0] = keep + __shfl_xor(send, 1);
    }
    d[0] += __shfl_xor(d[0], 8);
    d[0] += __shfl_xor(d[0], 16);
    d[0] += __shfl_xor(d[0], 32);
  }
  const float dd = d[0] * (1.f / U_SCALE);
  const float hd = 0.5f * dd * (1.f + erff(dd * 0.70710678118654752f));
  const int cl = __float_as_int(hd * gate_lane * (1.f / V_SCALE));
#pragma unroll
  for (int u = 0; u < 8; u++) {
    const float c = __int_as_float(__builtin_amdgcn_readlane(cl, u));
    const f32x2 c2 = {c, c};
    const u32 ws_[4] = {V[u].x, V[u].y, V[u].z, V[u].w};
#pragma unroll
    for (int q = 0; q < 4; q++) {
      accp[2 * q] += c2 * __builtin_amdgcn_cvt_pk_f32_fp8((int)ws_[q], false);
      accp[2 * q + 1] += c2 * __builtin_amdgcn_cvt_pk_f32_fp8((int)ws_[q], true);
    }
  }
}
__device__ __forceinline__ float dot16_fp8(const f32x2 (&xp)[8], const uint4& q) {
  const u32 ws_[4] = {q.x, q.y, q.z, q.w};
  f32x2 s = {0.f, 0.f};
#pragma unroll
  for (int i = 0; i < 4; i++) {
    s += xp[2 * i] * __builtin_amdgcn_cvt_pk_f32_fp8((int)ws_[i], false);
    s += xp[2 * i + 1] * __builtin_amdgcn_cvt_pk_f32_fp8((int)ws_[i], true);
  }
  return s[0] + s[1];
}
__device__ __forceinline__ void pe_load_tab(const unsigned char* Tb, unsigned loff, int e0, int e1, int g, uint4 (&U)[16]) {
#pragma unroll
  for (int kb = 0; kb < 16; kb++) {
    const int e = __shfl((kb < 8) ? e0 : e1, (kb & 7) * 8 + g);
    U[kb] = *(const uint4*)(Tb + ((unsigned)e * 2048u + loff));
  }
}
__device__ __forceinline__ void pe_load_x(const u16* xr, f32x2 (&xp)[8]) {
  uint4 a = *(const uint4*)(xr), b = *(const uint4*)(xr + 8);
  xp[0] = f32x2{blo(a.x), bhi(a.x)}; xp[1] = f32x2{blo(a.y), bhi(a.y)}; xp[2] = f32x2{blo(a.z), bhi(a.z)}; xp[3] = f32x2{blo(a.w), bhi(a.w)};
  xp[4] = f32x2{blo(b.x), bhi(b.x)}; xp[5] = f32x2{blo(b.y), bhi(b.y)}; xp[6] = f32x2{blo(b.z), bhi(b.z)}; xp[7] = f32x2{blo(b.w), bhi(b.w)};
}
__device__ __forceinline__ void pe_dot_store(const f32x2 (&xp)[8], const uint4 (&U)[16], float* pr, int lane, int r) {
  float d[16];
#pragma unroll
  for (int kb = 0; kb < 16; kb++) d[kb] = dot16_fp8(xp, U[kb]);
  const bool b4 = (lane & 4) != 0, b2 = (lane & 2) != 0, b1 = (lane & 1) != 0;
#pragma unroll
  for (int i = 0; i < 8; i++) { const float send = b4 ? d[i] : d[i + 8], keep = b4 ? d[i + 8] : d[i]; d[i] = keep + __shfl_xor(send, 4); }
#pragma unroll
  for (int i = 0; i < 4; i++) { const float send = b2 ? d[i] : d[i + 4], keep = b2 ? d[i + 4] : d[i]; d[i] = keep + __shfl_xor(send, 2); }
#pragma unroll
  for (int i = 0; i < 2; i++) { const float send = b1 ? d[i] : d[i + 2], keep = b1 ? d[i + 2] : d[i]; d[i] = keep + __shfl_xor(send, 1); }
  pr[(2 * r) * 8] = d[0];
  pr[(2 * r + 1) * 8] = d[1];
}
__device__ void phase11a(const Params& p) {
  const int t = threadIdx.x, lane = t & 63, w = t >> 6, g = lane >> 3, r = lane & 7;
  const int s = blockIdx.x & 7, jb = blockIdx.x >> 3, ns = (gridDim.x - s + 7) >> 3;
  const u16* xn2 = p.R4 + s * 128 + r * 16;
  const unsigned char* Tb = (const unsigned char*)p.R5 + s * 128;
  const unsigned loff = r * 16;
  const int* experts = (const int*)p.R7 + lane;
  float* part = p.out + (size_t)s * BT * 128 + g;
  const int first = jb * 4 + w, stride = ns * 4;
  if (first >= BT) return;
#define TOKC(T) (((T) < BT) ? (T) : first)
  int eA0, eA1, eB0, eB1;
  uint4 UA[16], UB[16];
  f32x2 xA[8], xB[8];
  eA0 = experts[(size_t)first * 128]; eA1 = experts[(size_t)first * 128 + 64];
  pe_load_tab(Tb, loff, eA0, eA1, g, UA);
  pe_load_x(xn2 + (size_t)first * 1024, xA);
  { const int t1 = TOKC(first + stride); eB0 = experts[(size_t)t1 * 128]; eB1 = experts[(size_t)t1 * 128 + 64]; }
#pragma unroll 1
  for (int tok = first; tok < BT; tok += 2 * stride) {
    const int t1 = tok + stride, t2 = tok + 2 * stride, t3 = tok + 3 * stride;
    pe_load_tab(Tb, loff, eB0, eB1, g, UB);
    pe_load_x(xn2 + (size_t)TOKC(t1) * 1024, xB);
    { const int tc = TOKC(t2); eA0 = experts[(size_t)tc * 128]; eA1 = experts[(size_t)tc * 128 + 64]; }
    pe_dot_store(xA, UA, part + (size_t)tok * 128, lane, r);
    pe_load_tab(Tb, loff, eA0, eA1, g, UA);
    pe_load_x(xn2 + (size_t)TOKC(t2) * 1024, xA);
    { const int tc = TOKC(t3); eB0 = experts[(size_t)tc * 128]; eB1 = experts[(size_t)tc * 128 + 64]; }
    if (t1 < BT) pe_dot_store(xB, UB, part + (size_t)t1 * 128, lane, r);
  }
}

__device__ void phase11r(const Params& p) {
  float* gates = p.R7 + (size_t)BT * 128;
  const float* part = p.out;
  for (int idx = blockIdx.x * 256 + threadIdx.x; idx < BT * 128 / 4; idx += gridDim.x * 256) {
    float4 h = *(const float4*)(part + (size_t)idx * 4);
#pragma unroll
    for (int ss = 1; ss < 8; ss++) {
      const float4 q = *(const float4*)(part + (size_t)ss * BT * 128 + (size_t)idx * 4);
      h.x += q.x; h.y += q.y; h.z += q.z; h.w += q.w;
    }
    float4 gt = *(const float4*)(gates + (size_t)idx * 4);
    const float hv[4] = {h.x * (1.f / U_SCALE), h.y * (1.f / U_SCALE), h.z * (1.f / U_SCALE), h.w * (1.f / U_SCALE)};
    const float gv[4] = {gt.x, gt.y, gt.z, gt.w};
    float c[4];
#pragma unroll
    for (int q = 0; q < 4; q++) c[q] = 0.5f * hv[q] * (1.f + erff(hv[q] * 0.70710678118654752f)) * gv[q] * (1.f / V_SCALE);
    *(float4*)(gates + (size_t)idx * 4) = make_float4(c[0], c[1], c[2], c[3]);
  }
}

struct PeTok { int e0, e1; float g0, g1; };
__device__ __forceinline__ PeTok pe_load_tok(const int* experts, const float* gates, int tok) {
  PeTok k;
  k.e0 = experts[(size_t)tok * 128]; k.e1 = experts[(size_t)tok * 128 + 64];
  k.g0 = gates[(size_t)tok * 128]; k.g1 = gates[(size_t)tok * 128 + 64];
  return k;
}
__device__ __forceinline__ void pe_value_store(const PeTok& k, const uint4 (&V)[16], u16* drow, int lane, int g) {
  const float c0 = k.g0, c1 = k.g1;
  f32x2 accp[8];
#pragma unroll
  for (int i = 0; i < 8; i++) accp[i] = f32x2{0.f, 0.f};
#pragma unroll
  for (int kb = 0; kb < 16; kb++) {
    const float c = __shfl((kb < 8) ? c0 : c1, (kb & 7) * 8 + g);
    const f32x2 c2 = {c, c};
    const u32 ws_[4] = {V[kb].x, V[kb].y, V[kb].z, V[kb].w};
#pragma unroll
    for (int q = 0; q < 4; q++) {
      accp[2 * q] += c2 * __builtin_amdgcn_cvt_pk_f32_fp8((int)ws_[q], false);
      accp[2 * q + 1] += c2 * __builtin_amdgcn_cvt_pk_f32_fp8((int)ws_[q], true);
    }
  }
  float a[16];
#pragma unroll
  for (int i = 0; i < 8; i++) { a[2 * i] = accp[i][0]; a[2 * i + 1] = accp[i][1]; }
  const bool b32 = (lane & 32) != 0, b16 = (lane & 16) != 0, b8 = (lane & 8) != 0;
#pragma unroll
  for (int i = 0; i < 8; i++) { const float send = b32 ? a[i] : a[i + 8], keep = b32 ? a[i + 8] : a[i]; a[i] = keep + __shfl_xor(send, 32); }
#pragma unroll
  for (int i = 0; i < 4; i++) { const float send = b16 ? a[i] : a[i + 4], keep = b16 ? a[i + 4] : a[i]; a[i] = keep + __shfl_xor(send, 16); }
#pragma unroll
  for (int i = 0; i < 2; i++) { const float send = b8 ? a[i] : a[i + 2], keep = b8 ? a[i + 2] : a[i]; a[i] = keep + __shfl_xor(send, 8); }
  *(u32*)drow = pack2(a[0], a[1]);
}
__device__ void phase11b(const Params& p) {
  const int t = threadIdx.x, lane = t & 63, w = t >> 6, g = lane >> 3, r = lane & 7;
  const int s = blockIdx.x & 7, jb = blockIdx.x >> 3, ns = (gridDim.x - s + 7) >> 3;
  const unsigned char* Tb = (const unsigned char*)p.R5 + 1024 + s * 128;
  const unsigned loff = r * 16;
  const int* experts = (const int*)p.R7 + lane;
  const float* gates = p.R7 + (size_t)BT * 128 + lane;
  u16* x1 = p.R1 + s * 128 + r * 16 + 2 * g;
  const int first = jb * 4 + w, stride = ns * 4;
  if (first >= BT) return;
  PeTok kA, kB;
  uint4 VA[16], VB[16];
  kA = pe_load_tok(experts, gates, first);
  pe_load_tab(Tb, loff, kA.e0, kA.e1, g, VA);
  kB = pe_load_tok(experts, gates, TOKC(first + stride));
#pragma unroll 1
  for (int tok = first; tok < BT; tok += 2 * stride) {
    const int t1 = tok + stride, t2 = tok + 2 * stride, t3 = tok + 3 * stride;
    pe_load_tab(Tb, loff, kB.e0, kB.e1, g, VB);
    const PeTok kC = pe_load_tok(experts, gates, TOKC(t2));
    pe_value_store(kA, VA, x1 + (size_t)tok * 1024, lane, g);
    pe_load_tab(Tb, loff, kC.e0, kC.e1, g, VA);
    const PeTok kD = pe_load_tok(experts, gates, TOKC(t3));
    if (t1 < BT) pe_value_store(kB, VB, x1 + (size_t)t1 * 1024, lane, g);
    kA = kC; kB = kD;
  }
#undef TOKC
}

__device__ void phase11c(const Params& p) {
  const int t = threadIdx.x, lane = t & 63, w = t >> 6;
  const float* x1 = (const float*)p.R2;
  for (int tok = blockIdx.x * 4 + w; tok < BT; tok += gridDim.x * 4) {
    const float* xr = x1 + (size_t)tok * 1024 + lane * 16;
    const u16* dl = p.R1 + (size_t)tok * 1024 + lane * 16;
    float4 v[4];
    float ss = 0.f;
#pragma unroll
    for (int i = 0; i < 4; i++) {
      v[i] = *(const float4*)(xr + i * 4);
      const uint2 dd = *(const uint2*)(dl + i * 4);
      v[i].x += blo(dd.x); v[i].y += bhi(dd.x); v[i].z += blo(dd.y); v[i].w += bhi(dd.y);
      ss += v[i].x * v[i].x + v[i].y * v[i].y + v[i].z * v[i].z + v[i].w * v[i].w;
    }
    ss = wave_sum(ss);
    const float rstd = rsqrtf(ss * (1.f / 1024.f) + 1e-6f);
    float* orow = p.out + (size_t)tok * 1024 + lane * 16;
#pragma unroll
    for (int i = 0; i < 4; i++) {
      float4 gg = *(const float4*)(p.fng + lane * 16 + i * 4);
      *(float4*)(orow + i * 4) = make_float4(v[i].x * rstd * gg.x, v[i].y * rstd * gg.y, v[i].z * rstd * gg.z, v[i].w * rstd * gg.w);
    }
  }
}

__global__ void __launch_bounds__(256, 2) fwd_mega(Params p, int ph_lo, int ph_hi) {
  extern __shared__ __attribute__((aligned(16))) char smem[];
  cg::grid_group grid = cg::this_grid();
  __shared__ uint4 xb_words;
  if (threadIdx.x == 0) xb_words = make_uint4(0u, 0u, 0u, 0u);
  __syncthreads();
  const XcdBarrier xb = xcd_barrier_post(p.bar, (volatile LAS unsigned*)&xb_words);
  if (ph_lo > ph_hi) grid.sync();
constexpr int REP0=1,REP1=1,REP2=1,REP3=1,REP4=1,REP5=1,REP6=1,REP7=1,REP8=1,REP9=1,REP10=1,REP11=1,REP12=1,REP13=1,REP14=1;
#define RUN_PHASE(k, call)                         \
  if (PH_ON(k) && ph_lo <= (k) && (k) < ph_hi) {   \
    for (int rep_ = 0; rep_ < REP##k; rep_++) { call; }  \
    if ((k) + 1 < ph_hi) xcd_barrier(xb);          \
  }
  RUN_PHASE(0, phase0(p, smem))
  RUN_PHASE(1, phase1(p, smem))
  RUN_PHASE(2, phase2(p, smem, xb))
  RUN_PHASE(3, phase3(p); weights_late(p, smem))
  RUN_PHASE(4, for (int item = blockIdx.x; item < 512; item += gridDim.x) gla_item(p, item, 2, smem))
  RUN_PHASE(5, phase5(p))
  RUN_PHASE(6, phase6(p, smem))
  RUN_PHASE(7, phase7(p, smem))
  RUN_PHASE(8, phase8(p))
  RUN_PHASE(9, phase9(p, smem))
  RUN_PHASE(10, phase10(p, smem))
  RUN_PHASE(11, phase11a(p))
  RUN_PHASE(12, phase11r(p))
  RUN_PHASE(13, phase11b(p))
  RUN_PHASE(14, phase11c(p))
}

extern "C" void kernel_launch(void* const* d_in, const int* in_sizes, int n_in, void* d_out, int out_size, void* d_ws,
                              size_t ws_size, hipStream_t stream) {
  (void)in_sizes; (void)n_in; (void)out_size; (void)ws_size;
  static int grid_blocks = 0;
  if (!grid_blocks) {
    int dev = 0, cus = 0, per_cu = 0;
    hipGetDevice(&dev);
    hipDeviceGetAttribute(&cus, hipDeviceAttributeMultiprocessorCount, dev);
    hipFuncSetAttribute((const void*)fwd_mega, hipFuncAttributeMaxDynamicSharedMemorySize, LDS_BYTES);
    hipOccupancyMaxActiveBlocksPerMultiprocessor(&per_cu, (const void*)fwd_mega, 256, LDS_BYTES);
    if (per_cu < 1) per_cu = 1;
    if (per_cu > 2) per_cu = 2;
    grid_blocks = cus * per_cu;
  }
  Params p{};
  const float* const* in = (const float* const*)d_in;
  p.x = in[0]; p.norm1_g = in[1]; p.w_in = in[2]; p.conv_w = in[3]; p.conv_b = in[4]; p.wa = in[5];
  p.dupf = in[6]; p.dbf = in[7]; p.dupb = in[8]; p.dbb = in[9]; p.gng = in[10]; p.wb = in[11];
  p.gbias = in[12]; p.wo = in[13]; p.norm2_g = in[14]; p.wq = in[15]; p.keys = in[16]; p.pu = in[17];
  p.pv = in[18]; p.fng = in[19];
  p.out = (float*)d_out;
  char* ws = (char*)d_ws;
  const size_t MiB = 1u << 20;
  p.WinT = (u16*)ws;
  p.WaT = (u16*)(ws + 17039360);
  p.WbT = (u16*)(ws + 17039360 + 2097152);
  p.WoT = (u16*)(ws + 17039360 + 2 * 2097152);
  p.WqT = (u16*)(ws + 17039360 + 3 * 2097152);
  p.KeysB = (u16*)(ws + 17039360 + 3 * 2097152 + 4194304);
  p.R1 = (u16*)(ws + 27 * MiB);
  p.R2 = (u16*)(ws + 59 * MiB);
  p.R3 = (u16*)(ws + 91 * MiB);
  p.R4 = (u16*)(ws + 123 * MiB);
  p.R5 = (u16*)(ws + 155 * MiB);
  p.R6 = (u16*)(ws + 187 * MiB);
  p.R7 = (float*)(ws + 219 * MiB);
  p.z = (float*)(ws + 251 * MiB);
  p.Dd = (float*)(ws + 253 * MiB);
  p.bar = (unsigned*)(ws + 254 * MiB);
  hipMemsetAsync(p.bar, 0, XCD_BAR_WORDS * sizeof(unsigned), stream);
#if MULTI_LAUNCH
  for (int ph = 0; ph < NPHASE; ph++) {
    hipLaunchKernelGGL(fwd_mega, dim3(grid_blocks), dim3(256), LDS_BYTES, stream, p, ph, ph + 1);
  }
#else
  int lo = 0, hi = NPHASE;
  void* args[] = {&p, &lo, &hi};
  hipError_t e = hipLaunchCooperativeKernel((const void*)fwd_mega, dim3(grid_blocks), dim3(256), args, LDS_BYTES, stream);
  if (e != hipSuccess) fprintf(stderr, "cooperative launch failed: %s (grid %d)\n", hipGetErrorString(e), grid_blocks);
#endif
}
```

```cpp
#include <hip/hip_runtime.h>
#include <hip/hip_cooperative_groups.h>
#include <cstdio>
namespace cg = cooperative_groups;

typedef unsigned short u16;
typedef unsigned int u32;
using bf16x8 = __attribute__((ext_vector_type(8))) short;
using f32x4 = __attribute__((ext_vector_type(4))) float;

#ifndef ONLY_PHASE
#define ONLY_PHASE -1
#endif
#define PH_ON(k) (ONLY_PHASE < 0 || ONLY_PHASE == (k))
#ifndef MULTI_LAUNCH
#define MULTI_LAUNCH 0
#endif

constexpr int BT = 16384, SEQ = 8192;
constexpr int LDS_BYTES = 80896;
constexpr int NPHASE = 15;

struct Params {
  const float *x, *norm1_g, *w_in, *conv_w, *conv_b, *wa, *dupf, *dbf, *dupb, *dbb, *gng, *wb, *gbias, *wo,
      *norm2_g, *wq, *keys, *pu, *pv, *fng;
  float* out;
  u16 *WinT, *WaT, *WbT, *WoT, *WqT, *KeysB;
  u16 *R1, *R2, *R3, *R4, *R5, *R6;
  float *R7, *z, *Dd;
  unsigned* bar;
};

__device__ __forceinline__ u16 f2b(float f) { u32 u = __float_as_uint(f); u += 0x7fffu + ((u >> 16) & 1u); return (u16)(u >> 16); }
__device__ __forceinline__ float b2f(u16 h) { return __uint_as_float(((u32)h) << 16); }
__device__ __forceinline__ u32 pack2(float a, float b) { return (u32)f2b(a) | ((u32)f2b(b) << 16); }
__device__ __forceinline__ float blo(u32 w) { return __uint_as_float(w << 16); }
__device__ __forceinline__ float bhi(u32 w) { return __uint_as_float(w & 0xffff0000u); }
__device__ __forceinline__ float wave_sum(float v) {
#pragma unroll
  for (int o = 32; o > 0; o >>= 1) v += __shfl_xor(v, o);
  return v;
}
__device__ __forceinline__ float sigmoidf_(float v) { return 1.f / (1.f + __expf(-v)); }
__device__ __forceinline__ u32 ordf(float v) { u32 u = __float_as_uint(v); return (u & 0x80000000u) ? ~u : (u | 0x80000000u); }
__device__ __forceinline__ float unordf(u32 k) { return __uint_as_float((k & 0x80000000u) ? (k ^ 0x80000000u) : ~k); }

template <int MT, int NT, int KT>
__device__ __forceinline__ void mma_nt(f32x4 (&acc)[MT][NT], const u16* A, int sa, const u16* B, int sb, int lane) {
  const int fr = lane & 15, fq = lane >> 4;
  const u16* pa = A + fr * sa + fq * 8;
  const u16* pb = B + fr * sb + fq * 8;
#pragma unroll
  for (int k = 0; k < KT; k++) {
    bf16x8 a[MT], b[NT];
#pragma unroll
    for (int m = 0; m < MT; m++) a[m] = *(const bf16x8*)(pa + m * 16 * sa + k * 32);
#pragma unroll
    for (int n = 0; n < NT; n++) b[n] = *(const bf16x8*)(pb + n * 16 * sb + k * 32);
#pragma unroll
    for (int m = 0; m < MT; m++)
#pragma unroll
      for (int n = 0; n < NT; n++) acc[m][n] = __builtin_amdgcn_mfma_f32_16x16x32_bf16(a[m], b[n], acc[m][n], 0, 0, 0);
  }
}

template <int MT, int NT>
__device__ __forceinline__ void mma_sw64(f32x4 (&acc)[MT][NT], const u16* A, const u16* B, int lane) {
  const int fr = lane & 15, fq = lane >> 4;
  const int cb = fq ^ ((fr >> 1) & 7);
  const u16* pa = A + fr * 64;
  const u16* pb = B + fr * 64;
#pragma unroll
  for (int k = 0; k < 2; k++) {
    const int co = (cb ^ (k * 4)) * 8;
    bf16x8 a[MT], b[NT];
#pragma unroll
    for (int m = 0; m < MT; m++) a[m] = *(const bf16x8*)(pa + m * 16 * 64 + co);
#pragma unroll
    for (int n = 0; n < NT; n++) b[n] = *(const bf16x8*)(pb + n * 16 * 64 + co);
#pragma unroll
    for (int m = 0; m < MT; m++)
#pragma unroll
      for (int n = 0; n < NT; n++) acc[m][n] = __builtin_amdgcn_mfma_f32_16x16x32_bf16(b[n], a[m], acc[m][n], 0, 0, 0);
  }
}

#define ST_DECL(S) uint4 S##a0, S##a1, S##a2, S##a3, S##b0, S##b1, S##b2, S##b3
#define ST_LOAD(S, PA, PB)                                                                                           \
  do {                                                                                                               \
    const char* pa_ = (const char*)(PA);                                                                             \
    const char* pb_ = (const char*)(PB);                                                                             \
    S##a0 = *(const uint4*)(pa_ + voffA); S##a1 = *(const uint4*)(pa_ + (size_t)64 * lda + voffA);                   \
    S##a2 = *(const uint4*)(pa_ + (size_t)128 * lda + voffA); S##a3 = *(const uint4*)(pa_ + (size_t)192 * lda + voffA); \
    S##b0 = *(const uint4*)(pb_ + voffB); S##b1 = *(const uint4*)(pb_ + (size_t)64 * ldb + voffB);                   \
    S##b2 = *(const uint4*)(pb_ + (size_t)128 * ldb + voffB); S##b3 = *(const uint4*)(pb_ + (size_t)192 * ldb + voffB); \
  } while (0)
#define ST_WRITE(S, WA, WB)                                                                                          \
  do {                                                                                                               \
    *(uint4*)(WA) = S##a0; *(uint4*)((WA) + 32 * 64) = S##a1; *(uint4*)((WA) + 64 * 64) = S##a2; *(uint4*)((WA) + 96 * 64) = S##a3; \
    *(uint4*)(WB) = S##b0; *(uint4*)((WB) + 32 * 64) = S##b1; *(uint4*)((WB) + 64 * 64) = S##b2; *(uint4*)((WB) + 96 * 64) = S##b3; \
  } while (0)

#define GLDS16(G, L) __builtin_amdgcn_global_load_lds((const void*)(G), (__attribute__((address_space(3))) void*)(L), 16, 0, 0)
__device__ __forceinline__ void gemm_acc_db(f32x4 (&acc)[4][4], const u16* __restrict__ A, int lda, const u16* __restrict__ B,
                                            int ldb, int K, char* smem) {
  const int t = threadIdx.x, lane = t & 63, w = t >> 6, wr = w >> 1, wc = w & 1;
  const int lr = t >> 3;
  const int gc = ((t & 7) ^ ((lr >> 1) & 7)) * 8;
  const u16* pa = A + (size_t)lr * lda + gc;
  const u16* pb = B + (size_t)lr * ldb + gc;
  char* l0 = smem + t * 16;
  u16* b0 = (u16*)smem;
  u16* b1 = b0 + 2 * 128 * 64;
#define ISSUE_TILE(KT, BUFOFF)                                                                     \
  do {                                                                                             \
    const u16* qa = pa + (KT) * 64;                                                                \
    const u16* qb = pb + (KT) * 64;                                                                \
    char* lb = l0 + (BUFOFF);                                                                      \
    GLDS16(qa, lb); GLDS16(qa + (size_t)32 * lda, lb + 4096);                                      \
    GLDS16(qa + (size_t)64 * lda, lb + 8192); GLDS16(qa + (size_t)96 * lda, lb + 12288);           \
    GLDS16(qb, lb + 16384); GLDS16(qb + (size_t)32 * ldb, lb + 16384 + 4096);                      \
    GLDS16(qb + (size_t)64 * ldb, lb + 16384 + 8192); GLDS16(qb + (size_t)96 * ldb, lb + 16384 + 12288); \
  } while (0)
  const int nk = K >> 6;
  __syncthreads();
  ISSUE_TILE(0, 0);
  if (blockIdx.x >= (gridDim.x >> 1)) __builtin_amdgcn_s_sleep(8);
#define KSTEP(BUF, ISSUE_STMT)                                                 \
  do {                                                                         \
    asm volatile("s_waitcnt vmcnt(0)" ::: "memory");                          \
    __builtin_amdgcn_s_barrier();                                              \
    asm volatile("" ::: "memory");                                             \
    ISSUE_STMT;                                                                \
    mma_sw64<4, 4>(acc, BUF + wr * 64 * 64, BUF + 128 * 64 + wc * 64 * 64, lane); \
  } while (0)
  for (int kt = 0; kt + 2 < nk; kt += 2) {
    KSTEP(b0, ISSUE_TILE(kt + 1, 32768));
    KSTEP(b1, ISSUE_TILE(kt + 2, 0));
  }
  KSTEP(b0, ISSUE_TILE(nk - 1, 32768));
  KSTEP(b1, (void)0);
  asm volatile("s_waitcnt lgkmcnt(0)" ::: "memory");
#undef KSTEP
#undef ISSUE_TILE
}

struct TileIter {
  int i, step, lim, NT, xcd; bool swz;
  __device__ __forceinline__ TileIter(int nt_) {
    NT = nt_;
    swz = (gridDim.x & 7) == 0;
    if (swz) { xcd = blockIdx.x & 7; i = blockIdx.x >> 3; step = gridDim.x >> 3; lim = 16 * NT; }
    else { xcd = 0; i = blockIdx.x; step = gridDim.x; lim = 128 * NT; }
  }
  __device__ __forceinline__ bool next(int& mt, int& nt) {
    if (i >= lim) return false;
    if (swz) { int mg = i / (NT * 8), rem = i - mg * NT * 8; nt = rem >> 3; mt = xcd * 16 + mg * 8 + (rem & 7); }
    else { mt = i & 127; nt = i >> 7; }
    i += step;
    return true;
  }
};

__device__ __forceinline__ void zero_acc(f32x4 (&acc)[4][4]) {
#pragma unroll
  for (int m = 0; m < 4; m++)
#pragma unroll
    for (int n = 0; n < 4; n++) acc[m][n] = f32x4{0.f, 0.f, 0.f, 0.f};
}

__device__ __forceinline__ int winmap(int r) {
  if (r < 2048) { int tile = r >> 7, w = r & 127, grp = w >> 5; int ch = tile * 64 + (grp >> 1) * 32 + (w & 31); return ((grp & 1) ? 2048 : 0) + ch; }
  if (r < 3072) return r - 1024;
  if (r < 6176) return r;
  if (r < 6272) return -1;
  return r - 96;
}

__device__ __forceinline__ void tr_tile(const float* __restrict__ src, int ld, int col0, u16* __restrict__ dst, int r0, int k0, float* sT) {
  const int t = threadIdx.x;
  const int r = t >> 3, kc = t & 7;
  if (col0 < 0) {
    *(uint4*)(dst + (size_t)(r0 + r) * 1024 + k0 + kc * 8) = make_uint4(0, 0, 0, 0);
    return;
  }
  __syncthreads();
#pragma unroll
  for (int i = 0; i < 8; i++) {
    int k = (t >> 5) + i * 8, rr = t & 31;
    sT[k * 33 + rr] = src[(size_t)(k0 + k) * ld + col0 + rr];
  }
  __syncthreads();
  u32 wv[4];
#pragma unroll
  for (int j = 0; j < 4; j++) wv[j] = pack2(sT[(kc * 8 + 2 * j) * 33 + r], sT[(kc * 8 + 2 * j + 1) * 33 + r]);
  *(uint4*)(dst + (size_t)(r0 + r) * 1024 + k0 + kc * 8) = make_uint4(wv[0], wv[1], wv[2], wv[3]);
}

__device__ __forceinline__ void rms_row(const float* __restrict__ src, const float* __restrict__ g, u16* __restrict__ dst, int lane) {
  float4 v[4];
  float ss = 0.f;
#pragma unroll
  for (int i = 0; i < 4; i++) {
    v[i] = *(const float4*)(src + i * 256 + lane * 4);
    ss += v[i].x * v[i].x + v[i].y * v[i].y + v[i].z * v[i].z + v[i].w * v[i].w;
  }
  ss = wave_sum(ss);
  const float rstd = rsqrtf(ss * (1.f / 1024.f) + 1e-6f);
#pragma unroll
  for (int i = 0; i < 4; i++) {
    float4 gg = *(const float4*)(g + i * 256 + lane * 4);
    uint2 o;
    o.x = pack2(v[i].x * rstd * gg.x, v[i].y * rstd * gg.y);
    o.y = pack2(v[i].z * rstd * gg.z, v[i].w * rstd * gg.w);
    *(uint2*)(dst + i * 256 + lane * 4) = o;
  }
}

__device__ void phase0(const Params& p, char* smem) {
  float* sT = (float*)smem;
  const int t = threadIdx.x, lane = t & 63, w = t >> 6;
  u16* xn = (u16*)p.out;
  constexpr int J0 = 4160, J4 = J0 + 4096;
  for (int job = blockIdx.x; job < J4; job += gridDim.x) {
    if (job < J0) {
      int rb = job >> 4, kb = job & 15;
      tr_tile(p.w_in, 8224, winmap(rb * 32), p.WinT, rb * 32, kb * 64, sT);
    } else {
      int row = (job - J0) * 4 + w;
      rms_row(p.x + (size_t)row * 1024, p.norm1_g, xn + (size_t)row * 1024, lane);
    }
  }
}
__device__ void weights_late(const Params& p, char* smem) {
  float* sT = (float*)smem;
  const int t = threadIdx.x;
  constexpr int J1 = 1536, J2 = J1 + 1024, J3 = J2 + 128;
  for (int job = blockIdx.x; job < J3; job += gridDim.x) {
    if (job < J1) {
      int which = job >> 9, rb = (job & 511) >> 4, kb = job & 15;
      const float* src = which == 0 ? p.wa : (which == 1 ? p.wb : p.wo);
      u16* dst = which == 0 ? p.WaT : (which == 1 ? p.WbT : p.WoT);
      tr_tile(src, 1024, rb * 32, dst, rb * 32, kb * 64, sT);
    } else if (job < J2) {
      int j = job - J1, rb = j >> 4, kb = j & 15;
      tr_tile(p.wq, 2048, rb * 32, p.WqT, rb * 32, kb * 64, sT);
    } else {
      int j = job - J2;
      int base = (j * 256 + t) * 8;
      float4 a = *(const float4*)(p.keys + base), b = *(const float4*)(p.keys + base + 4);
      *(uint4*)(p.KeysB + base) = make_uint4(pack2(a.x, a.y), pack2(a.z, a.w), pack2(b.x, b.y), pack2(b.z, b.w));
    }
  }
}

__device__ void la_prep(const Params& p, char* smem) {
  float* sZ = (float*)smem;
  float* sPart = sZ + 1024;
  const int t = threadIdx.x, lane = t & 63, w = t >> 6, fr = lane & 15, fq = lane >> 4;
  const u16* xn = (const u16*)p.out;
  const u16* Wz = p.WinT + (size_t)6144 * 1024;
  u32* la16 = (u32*)p.R6;
  float uf0[16], uf1[16], ub0[16], ub1[16];
#pragma unroll
  for (int r = 0; r < 16; r++) {
    uf0[r] = p.dupf[r * 512 + 2 * t]; uf1[r] = p.dupf[r * 512 + 2 * t + 1];
    ub0[r] = p.dupb[r * 512 + 2 * t]; ub1[r] = p.dupb[r * 512 + 2 * t + 1];
  }
  const float bf0 = p.dbf[2 * t], bf1 = p.dbf[2 * t + 1], bb0 = p.dbb[2 * t], bb1 = p.dbb[2 * t + 1];
  for (int job = blockIdx.x; job < BT / 32; job += gridDim.x) {
    f32x4 az[2][2];
#pragma unroll
    for (int m = 0; m < 2; m++)
#pragma unroll
      for (int n = 0; n < 2; n++) az[m][n] = f32x4{0.f, 0.f, 0.f, 0.f};
    {
      const u16* ap = xn + (size_t)(job * 32 + fr) * 1024 + w * 256 + fq * 8;
      const u16* bp = Wz + (size_t)fr * 1024 + w * 256 + fq * 8;
#pragma unroll
      for (int ks = 0; ks < 8; ks++) {
        bf16x8 a0 = *(const bf16x8*)(ap + ks * 32), a1 = *(const bf16x8*)(ap + 16 * 1024 + ks * 32);
        bf16x8 b0 = *(const bf16x8*)(bp + ks * 32), b1 = *(const bf16x8*)(bp + 16 * 1024 + ks * 32);
        az[0][0] = __builtin_amdgcn_mfma_f32_16x16x32_bf16(a0, b0, az[0][0], 0, 0, 0);
        az[0][1] = __builtin_amdgcn_mfma_f32_16x16x32_bf16(a0, b1, az[0][1], 0, 0, 0);
        az[1][0] = __builtin_amdgcn_mfma_f32_16x16x32_bf16(a1, b0, az[1][0], 0, 0, 0);
        az[1][1] = __builtin_amdgcn_mfma_f32_16x16x32_bf16(a1, b1, az[1][1], 0, 0, 0);
      }
    }
    __syncthreads();
#pragma unroll
    for (int m = 0; m < 2; m++)
#pragma unroll
      for (int n = 0; n < 2; n++)
#pragma unroll
        for (int j = 0; j < 4; j++) sPart[w * 1024 + (m * 16 + fq * 4 + j) * 32 + n * 16 + fr] = az[m][n][j];
    __syncthreads();
    {
      const float4 q0 = *(const float4*)(sPart + t * 4), q1 = *(const float4*)(sPart + 1024 + t * 4), q2 = *(const float4*)(sPart + 2048 + t * 4),
                   q3 = *(const float4*)(sPart + 3072 + t * 4);
      *(float4*)(sZ + t * 4) = make_float4(q0.x + q1.x + q2.x + q3.x, q0.y + q1.y + q2.y + q3.y, q0.z + q1.z + q2.z + q3.z, q0.w + q1.w + q2.w + q3.w);
    }
    __syncthreads();
    for (int i = 0; i < 32; i++) {
      const float* zr = sZ + i * 32;
      float a0 = bf0, a1 = bf1, c0 = bb0, c1 = bb1;
#pragma unroll
      for (int r = 0; r < 16; r++) {
        const float zf = zr[r], zb = zr[16 + r];
        a0 += zf * uf0[r]; a1 += zf * uf1[r];
        c0 += zb * ub0[r]; c1 += zb * ub1[r];
      }
      const float l0 = (fminf(a0, 0.f) - __logf(1.f + __expf(-fabsf(a0)))) * 0.0625f;
      const float l1 = (fminf(a1, 0.f) - __logf(1.f + __expf(-fabsf(a1)))) * 0.0625f;
      const float m0 = (fminf(c0, 0.f) - __logf(1.f + __expf(-fabsf(c0)))) * 0.0625f;
      const float m1 = (fminf(c1, 0.f) - __logf(1.f + __expf(-fabsf(c1)))) * 0.0625f;
      const int tok = job * 32 + i;
      la16[(size_t)tok * 256 + t] = (u32)__builtin_bit_cast(unsigned short, (_Float16)l0) | ((u32)__builtin_bit_cast(unsigned short, (_Float16)l1) << 16);
      la16[(size_t)(BT + tok) * 256 + t] = (u32)__builtin_bit_cast(unsigned short, (_Float16)m0) | ((u32)__builtin_bit_cast(unsigned short, (_Float16)m1) << 16);
    }
  }
}

__device__ void phase1(const Params& p, char* smem) {
  u16* sA = (u16*)smem;
  u16* sB = sA + 128 * 64;
  const int t = threadIdx.x, lane = t & 63, w = t >> 6, wr = w >> 1, wc = w & 1, fr = lane & 15, fq = lane >> 4;
  const u16* xn = (const u16*)p.out;
  la_prep(p, smem);
  TileIter ti(48);
  int mt, nt;
  while (ti.next(mt, nt)) {
    f32x4 acc[4][4];
    zero_acc(acc);
    gemm_acc_db(acc, xn + (size_t)mt * 128 * 1024, 1024, p.WinT + (size_t)nt * 128 * 1024, 1024, 1024, smem);
    const int rowb = mt * 128 + wr * 64 + fr;
    if (nt < 16) {
#pragma unroll
      for (int m = 0; m < 4; m++)
#pragma unroll
        for (int n = 0; n < 2; n++) {
          const int ch = nt * 64 + wc * 32 + n * 16 + fq * 4;
          *(uint2*)(p.R1 + (size_t)(rowb + m * 16) * 1024 + ch) =
              make_uint2(pack2(acc[m][n][0] * acc[m][n + 2][0], acc[m][n][1] * acc[m][n + 2][1]),
                         pack2(acc[m][n][2] * acc[m][n + 2][2], acc[m][n][3] * acc[m][n + 2][3]));
        }
    } else {
      const int g = (nt - 16) >> 3;
      u16* dst = g == 0 ? p.R2 : (g == 1 ? p.R3 : (g == 2 ? p.R4 : p.R5));
      const int cb = ((nt - 16) & 7) * 128 + wc * 64;
      const float sc = (g == 1 && cb < 512) ? 0.08838834764831845f : 1.f;
#pragma unroll
      for (int m = 0; m < 4; m++)
#pragma unroll
        for (int n = 0; n < 4; n++)
          *(uint2*)(dst + (size_t)(rowb + m * 16) * 1024 + cb + n * 16 + fq * 4) =
              make_uint2(pack2(acc[m][n][0] * sc, acc[m][n][1] * sc), pack2(acc[m][n][2] * sc, acc[m][n][3] * sc));
    }
  }
}

#define XB_TMO      128
#define XB_XCNT(j)  (256  + 64 * (j))
#define XB_XSUB(j)  (1280 + 64 * (j))
#define XB_XGEN(j)  (2304 + 64 * (j))
#define XB_TOP      3328
#define XB_TOPGEN   3392
#define XCD_BAR_WORDS 3456
#define XB_SPIN_CAP (1u << 20)
#define LAS __attribute__((address_space(3)))
__device__ __forceinline__ unsigned xb_ld(unsigned* p) { return __hip_atomic_load(p, __ATOMIC_RELAXED, __HIP_MEMORY_SCOPE_AGENT); }
__device__ __forceinline__ unsigned xb_add(unsigned* p, unsigned v) { return __hip_atomic_fetch_add(p, v, __ATOMIC_RELAXED, __HIP_MEMORY_SCOPE_AGENT); }
__device__ __forceinline__ unsigned xb_xcc_id() { return (unsigned)__builtin_amdgcn_s_getreg((3 << 11) | 20) & 0xFu; }
#define XB_SPIN(cond, bar) do { unsigned _sp = 0; while (cond) { __builtin_amdgcn_s_sleep(1); \
    if ((++_sp & 255u) == 0u) { if (xb_ld(&(bar)[XB_TMO])) break; if (_sp > XB_SPIN_CAP) { atomicAdd(&(bar)[XB_TMO], 1u); break; } } } } while (0)
struct XcdBarrier { unsigned* bar; unsigned x; volatile LAS unsigned* st; };
__device__ __forceinline__ XcdBarrier xcd_barrier_post(unsigned* bar, volatile LAS unsigned* st) {
  XcdBarrier b; b.bar = bar; b.x = xb_xcc_id(); b.st = st;
  if (threadIdx.x == 0) (void)xb_add(&bar[XB_XCNT(b.x)], 1u);
  return b;
}
__device__ __forceinline__ void xcd_barrier_complete(unsigned* bar, unsigned x, unsigned& nloc, unsigned& nx) {
  const unsigned G = gridDim.x * gridDim.y * gridDim.z;
  unsigned sum, cnt, mine, sp = 0u;
  for (;;) {
    sum = 0u; cnt = 0u; mine = 0u;
#pragma unroll
    for (unsigned j = 0; j < 16; ++j) { const unsigned c = xb_ld(&bar[XB_XCNT(j)]); sum += c; cnt += (c > 0u) ? 1u : 0u; mine = (j == x) ? c : mine; }
    if (sum == G) break;
    __builtin_amdgcn_s_sleep(1);
    if ((++sp & 255u) == 0u) { if (xb_ld(&bar[XB_TMO])) break; if (sp > XB_SPIN_CAP) { atomicAdd(&bar[XB_TMO], 1u); break; } }
  }
  nloc = mine > 0u ? mine : 1u; nx = cnt > 0u ? cnt : 1u;
}
__device__ __forceinline__ void xcd_barrier(const XcdBarrier& b) {
  asm volatile("s_waitcnt vmcnt(0)" ::: "memory");
  __syncthreads();
  if (threadIdx.x == 0) {
    unsigned* bar = b.bar;
    __builtin_amdgcn_s_waitcnt(0);
    unsigned nloc = b.st[0], nx = b.st[1];
    if (nloc == 0u) { xcd_barrier_complete(bar, b.x, nloc, nx); b.st[0] = nloc; b.st[1] = nx; }
    const unsigned old = xb_add(&bar[XB_XSUB(b.x)], 1u);
    const unsigned gen = old / nloc;
    if (old + 1u == (gen + 1u) * nloc) {
      __builtin_amdgcn_fence(__ATOMIC_RELEASE, "agent");
      asm volatile("s_waitcnt vmcnt(0)" ::: "memory");
      const unsigned og = xb_add(&bar[XB_TOP], 1u);
      const unsigned tg = og / nx;
      if (og + 1u == (tg + 1u) * nx) xb_add(&bar[XB_TOPGEN], 1u);
      else XB_SPIN(xb_ld(&bar[XB_TOPGEN]) == tg, bar);
      __builtin_amdgcn_fence(__ATOMIC_ACQUIRE, "agent");
      xb_add(&bar[XB_XGEN(b.x)], 1u);
      asm volatile("s_waitcnt vmcnt(0)" ::: "memory");
    } else {
      XB_SPIN(xb_ld(&bar[XB_XGEN(b.x)]) == gen, bar);
      __builtin_amdgcn_fence(__ATOMIC_ACQUIRE, "agent");
      asm volatile("s_waitcnt vmcnt(0)" ::: "memory");
    }
  }
  __syncthreads();
}

__device__ void gla_item(const Params& p, int item, int pass, char* smem) {
  const int dvp = item & 1, seg = (item >> 1) & 15, dir = (item >> 5) & 1, h = (item >> 6) & 3, b = item >> 8;
  const int bhd = (b * 4 + h) * 2 + dir;
  u16* sQ = (u16*)smem;
  u16* sK = sQ + 64 * 136;
  u16* sKT = sK + 64 * 136;
  u16* sVT = sKT + 128 * 72;
  u16* sST = sVT + 64 * 72;
  float* sDec = (float*)(sST + 64 * 136);
  float* sTot = (float*)sVT;
  const int t = threadIdx.x, lane = t & 63, w = __builtin_amdgcn_readfirstlane(t >> 6), wr = w >> 1, wc = w & 1, fr = lane & 15, fq = lane >> 4;
  const int d0 = lane * 2;
  const u32* la16 = (const u32*)p.R6 + (size_t)dir * BT * 256 + h * 64 + lane;
  const u16* qk = p.R3;
  const u16* vv = p.R4;
  u16* obuf = dir ? p.R2 : p.R1;
  float* Lp = p.R7 + (size_t)(bhd * 16 + seg) * 32768 + (size_t)dvp * 128 * 128;

  f32x4 accS[2][2][4];
#pragma unroll
  for (int s = 0; s < 2; s++)
#pragma unroll
    for (int m = 0; m < 2; m++)
#pragma unroll
      for (int n = 0; n < 4; n++)
#pragma unroll
        for (int j = 0; j < 4; j++)
          accS[s][m][n][j] = (pass == 2) ? Lp[(s * 64 + wr * 32 + m * 16 + fq * 4 + j) * 128 + wc * 64 + n * 16 + fr] : 0.f;
  float dsum0 = 0.f, dsum1 = 0.f;

  for (int ci = 0; ci < 8; ci++) {
    const int c = seg * 8 + ci;
    __syncthreads();
    u32 qv[16], kv[16], lav[16], vreg[2][16];
#pragma unroll
    for (int ii = 0; ii < 16; ii++) {
      int f = c * 64 + w * 16 + ii;
      int pos = dir ? (SEQ - 1 - f) : f;
      size_t tokoff = (size_t)(b * SEQ + pos) * 1024;
      kv[ii] = *(const u32*)(qk + tokoff + 512 + h * 128 + d0);
      if (pass == 2) qv[ii] = *(const u32*)(qk + tokoff + h * 128 + d0);
      lav[ii] = la16[(size_t)(b * SEQ + pos) * 256];
      vreg[0][ii] = vv[tokoff + h * 256 + dvp * 128 + lane];
      vreg[1][ii] = vv[tokoff + h * 256 + dvp * 128 + 64 + lane];
    }
    float bl0[16], bl1[16];
    {
      float run0 = 0.f, run1 = 0.f;
#pragma unroll
      for (int ii = 0; ii < 16; ii++) {
        run0 += (float)__builtin_bit_cast(_Float16, (unsigned short)(lav[ii] & 0xffffu));
        run1 += (float)__builtin_bit_cast(_Float16, (unsigned short)(lav[ii] >> 16));
        bl0[ii] = run0; bl1[ii] = run1;
      }
      sTot[w * 128 + d0] = run0;
      sTot[w * 128 + d0 + 1] = run1;
    }
    __syncthreads();
    {
      float off0 = 0.f, off1 = 0.f, tot0 = 0.f, tot1 = 0.f;
#pragma unroll
      for (int ww = 0; ww < 4; ww++) {
        float a = sTot[ww * 128 + d0], bb = sTot[ww * 128 + d0 + 1];
        if (ww < w) { off0 += a; off1 += bb; }
        tot0 += a; tot1 += bb;
      }
      dsum0 += tot0; dsum1 += tot1;
      const float et0 = __expf(tot0), et1 = __expf(tot1);
      if (w == 0) { sDec[d0] = et0; sDec[d0 + 1] = et1; }
#pragma unroll
      for (int ii = 0; ii < 16; ii += 2) {
        float ke0[2], ke1[2];
#pragma unroll
        for (int s = 0; s < 2; s++) {
          const int i2 = ii + s;
          const float b0 = bl0[i2] + off0, b1 = bl1[i2] + off1;
          const float k0 = blo(kv[i2]), k1 = bhi(kv[i2]);
          const int i = w * 16 + i2;
          const float e0 = __expf(b0), e1 = __expf(b1);
          const float kt0 = k0 * __builtin_amdgcn_rcpf(e0), kt1 = k1 * __builtin_amdgcn_rcpf(e1);
          if (pass == 2) {
            *(u32*)(sQ + i * 136 + d0) = pack2(blo(qv[i2]) * e0, bhi(qv[i2]) * e1);
            *(u32*)(sK + i * 136 + d0) = pack2(kt0, kt1);
          }
          ke0[s] = kt0 * et0;
          ke1[s] = kt1 * et1;
        }
        *(u32*)(sKT + d0 * 72 + w * 16 + ii) = pack2(ke0[0], ke0[1]);
        *(u32*)(sKT + (d0 + 1) * 72 + w * 16 + ii) = pack2(ke1[0], ke1[1]);
      }
    }
    __syncthreads();
    u16* sP = sK;
    if (pass == 2) {
      f32x4 accP[2][2];
#pragma unroll
      for (int m = 0; m < 2; m++)
#pragma unroll
        for (int n = 0; n < 2; n++) accP[m][n] = f32x4{0.f, 0.f, 0.f, 0.f};
      mma_nt<2, 2, 4>(accP, sQ + wr * 32 * 136, 136, sK + wc * 32 * 136, 136, lane);
      __syncthreads();
#pragma unroll
      for (int m = 0; m < 2; m++)
#pragma unroll
        for (int n = 0; n < 2; n++)
#pragma unroll
          for (int j = 0; j < 4; j++) {
            int i = wr * 32 + m * 16 + fq * 4 + j, jj = wc * 32 + n * 16 + fr;
            sP[i * 72 + jj] = (i >= jj) ? f2b(accP[m][n][j]) : (u16)0;
          }
    }
#pragma unroll
    for (int s = 0; s < 2; s++) {
      if (pass == 2) {
#pragma unroll
        for (int m = 0; m < 2; m++)
#pragma unroll
          for (int n = 0; n < 4; n++)
#pragma unroll
            for (int j = 0; j < 4; j++) sST[(wr * 32 + m * 16 + fq * 4 + j) * 136 + wc * 64 + n * 16 + fr] = f2b(accS[s][m][n][j]);
      }
      {
        uint4 v0 = make_uint4(vreg[s][0] | (vreg[s][1] << 16), vreg[s][2] | (vreg[s][3] << 16), vreg[s][4] | (vreg[s][5] << 16),
                              vreg[s][6] | (vreg[s][7] << 16));
        uint4 v1 = make_uint4(vreg[s][8] | (vreg[s][9] << 16), vreg[s][10] | (vreg[s][11] << 16), vreg[s][12] | (vreg[s][13] << 16),
                              vreg[s][14] | (vreg[s][15] << 16));
        *(uint4*)(sVT + lane * 72 + w * 16) = v0;
        *(uint4*)(sVT + lane * 72 + w * 16 + 8) = v1;
      }
      __syncthreads();
      if (pass == 2) {
        f32x4 accO[2][2];
#pragma unroll
        for (int m = 0; m < 2; m++)
#pragma unroll
          for (int n = 0; n < 2; n++) accO[m][n] = f32x4{0.f, 0.f, 0.f, 0.f};
        mma_nt<2, 2, 4>(accO, sQ + wr * 32 * 136, 136, sST + wc * 32 * 136, 136, lane);
        mma_nt<2, 2, 2>(accO, sP + wr * 32 * 72, 72, sVT + wc * 32 * 72, 72, lane);
#pragma unroll
        for (int m = 0; m < 2; m++)
#pragma unroll
          for (int j = 0; j < 4; j++) {
            int i = wr * 32 + m * 16 + fq * 4 + j;
            int f = c * 64 + i;
            int pos = dir ? (SEQ - 1 - f) : f;
            size_t o = (size_t)(b * SEQ + pos) * 1024 + h * 256 + dvp * 128 + s * 64 + wc * 32 + fr;
#pragma unroll
            for (int n = 0; n < 2; n++) obuf[o + n * 16] = f2b(accO[m][n][j]);
          }
      }
#pragma unroll
      for (int n = 0; n < 4; n++) {
        float dc = sDec[wc * 64 + n * 16 + fr];
#pragma unroll
        for (int m = 0; m < 2; m++)
#pragma unroll
          for (int j = 0; j < 4; j++) accS[s][m][n][j] *= dc;
      }
      mma_nt<2, 4, 2>(accS[s], sVT + wr * 32 * 72, 72, sKT + wc * 64 * 72, 72, lane);
      if (s == 0) __syncthreads();
    }
  }
  if (pass == 1) {
#pragma unroll
    for (int s = 0; s < 2; s++)
#pragma unroll
      for (int m = 0; m < 2; m++)
#pragma unroll
        for (int n = 0; n < 4; n++)
#pragma unroll
          for (int j = 0; j < 4; j++) Lp[(s * 64 + wr * 32 + m * 16 + fq * 4 + j) * 128 + wc * 64 + n * 16 + fr] = accS[s][m][n][j];
    if (dvp == 0 && w == 0) {
      p.Dd[(bhd * 16 + seg) * 128 + d0] = __expf(dsum0);
      p.Dd[(bhd * 16 + seg) * 128 + d0 + 1] = __expf(dsum1);
    }
  }
}

__device__ void phase2(const Params& p, char* smem, const XcdBarrier& xb) {
  const int t = threadIdx.x;
  (void)xb;
  u16* ya = (u16*)p.out + (size_t)BT * 1024;
  for (int job = blockIdx.x; job < 512 + 2048; job += gridDim.x) {
    if (job < 512) {
      gla_item(p, job, 1, smem);
    } else {
      const int j = job - 512;
      const int ch = (t & 127) * 8;
      float w0[8], w1[8], w2[8], cb[8];
#pragma unroll
      for (int e = 0; e < 8; e++) { w0[e] = p.conv_w[ch + e]; w1[e] = p.conv_w[1024 + ch + e]; w2[e] = p.conv_w[2048 + ch + e]; cb[e] = p.conv_b[ch + e]; }
#pragma unroll
      for (int it = 0; it < 4; it++) {
        const int tok = j * 8 + it * 2 + (t >> 7);
        const int pos = tok & (SEQ - 1);
        const size_t o = (size_t)tok * 1024 + ch;
        uint4 pc = *(const uint4*)(p.R1 + o);
        uint4 pp = make_uint4(0, 0, 0, 0), pn = make_uint4(0, 0, 0, 0);
        if (pos > 0) pp = *(const uint4*)(p.R1 + o - 1024);
        if (pos < SEQ - 1) pn = *(const uint4*)(p.R1 + o + 1024);
        uint4 bb = *(const uint4*)(p.R2 + o);
        const u32 pcs[4] = {pc.x, pc.y, pc.z, pc.w}, pps[4] = {pp.x, pp.y, pp.z, pp.w}, pns[4] = {pn.x, pn.y, pn.z, pn.w},
                  bbs[4] = {bb.x, bb.y, bb.z, bb.w};
        u32 ov[4];
#pragma unroll
        for (int q = 0; q < 4; q++) {
          float y0 = cb[2 * q] + w0[2 * q] * blo(pps[q]) + w1[2 * q] * blo(pcs[q]) + w2[2 * q] * blo(pns[q]);
          float y1 = cb[2 * q + 1] + w0[2 * q + 1] * bhi(pps[q]) + w1[2 * q + 1] * bhi(pcs[q]) + w2[2 * q + 1] * bhi(pns[q]);
          ov[q] = pack2(blo(bbs[q]) * y0, bhi(bbs[q]) * y1);
        }
        *(uint4*)(ya + o) = make_uint4(ov[0], ov[1], ov[2], ov[3]);
      }
    }
  }
}

__device__ void phase3(const Params& p) {
  for (int gid = blockIdx.x * 256 + threadIdx.x; gid < 16 * 32768; gid += gridDim.x * 256) {
    const int bhd = gid >> 15, e = gid & 32767, dk = e & 127;
    float carry = 0.f;
    for (int s = 0; s < 16; s++) {
      float* lp = p.R7 + (size_t)(bhd * 16 + s) * 32768 + e;
      float tmp = *lp;
      *lp = carry;
      carry = p.Dd[(bhd * 16 + s) * 128 + dk] * carry + tmp;
    }
  }
}

__device__ void phase5(const Params& p) {
  const int t = threadIdx.x, lane = t & 63, w = t >> 6;
  for (int it = blockIdx.x * 4 + w; it < BT * 4; it += gridDim.x * 4) {
    const int tok = it >> 2, h = it & 3;
    const size_t o = (size_t)tok * 1024 + h * 256 + lane * 4;
    uint2 a = *(const uint2*)(p.R1 + o), b = *(const uint2*)(p.R2 + o), r = *(const uint2*)(p.R5 + o);
    float ov[4] = {blo(a.x) + blo(b.x), bhi(a.x) + bhi(b.x), blo(a.y) + blo(b.y), bhi(a.y) + bhi(b.y)};
    float rv[4] = {blo(r.x), bhi(r.x), blo(r.y), bhi(r.y)};
    float ss = ov[0] * ov[0] + ov[1] * ov[1] + ov[2] * ov[2] + ov[3] * ov[3];
    ss = wave_sum(ss);
    const float rstd = rsqrtf(ss * (1.f / 256.f) + 1e-6f);
    float4 g = *(const float4*)(p.gng + h * 256 + lane * 4);
    const float gv[4] = {g.x, g.y, g.z, g.w};
    float res[4];
#pragma unroll
    for (int e = 0; e < 4; e++) res[e] = ov[e] * rstd * gv[e] * (rv[e] * sigmoidf_(rv[e]));
    uint2 out;
    out.x = pack2(res[0], res[1]);
    out.y = pack2(res[2], res[3]);
    *(uint2*)(p.R6 + o) = out;
  }
}

__device__ void phase6(const Params& p, char* smem) {
  const int t = threadIdx.x, lane = t & 63, w = t >> 6, wr = w >> 1, wc = w & 1, fr = lane & 15, fq = lane >> 4;
  const u16* xn = (const u16*)p.out;
  const u16* ya = xn + (size_t)BT * 1024;
  uint4* sG = (uint4*)((char*)p.R2 + (size_t)blockIdx.x * 65536 + t * 256);
  uint4* sH = sG + 8;
  TileIter ti(8);
  int mt, nt;
  while (ti.next(mt, nt)) {
    const int colb = nt * 128 + wc * 64 + fq * 4;
    f32x4 acc[4][4];
    zero_acc(acc);
    gemm_acc_db(acc, xn + (size_t)mt * 128 * 1024, 1024, p.WinT + (size_t)(6272 + nt * 128) * 1024, 1024, 1024, smem);
    {
      float4 gb[4];
#pragma unroll
      for (int n = 0; n < 4; n++) gb[n] = *(const float4*)(p.gbias + colb + n * 16);
#pragma unroll
      for (int m = 0; m < 4; m++)
#pragma unroll
        for (int h = 0; h < 2; h++)
          sG[m * 2 + h] = make_uint4(pack2(sigmoidf_(acc[m][2 * h][0] + gb[2 * h].x), sigmoidf_(acc[m][2 * h][1] + gb[2 * h].y)),
                                     pack2(sigmoidf_(acc[m][2 * h][2] + gb[2 * h].z), sigmoidf_(acc[m][2 * h][3] + gb[2 * h].w)),
                                     pack2(sigmoidf_(acc[m][2 * h + 1][0] + gb[2 * h + 1].x), sigmoidf_(acc[m][2 * h + 1][1] + gb[2 * h + 1].y)),
                                     pack2(sigmoidf_(acc[m][2 * h + 1][2] + gb[2 * h + 1].z), sigmoidf_(acc[m][2 * h + 1][3] + gb[2 * h + 1].w)));
    }
    zero_acc(acc);
    gemm_acc_db(acc, ya + (size_t)mt * 128 * 1024, 1024, p.WaT + (size_t)nt * 128 * 1024, 1024, 1024, smem);
#pragma unroll
    for (int m = 0; m < 4; m++)
#pragma unroll
      for (int h = 0; h < 2; h++) {
        const uint4 g = sG[m * 2 + h];
        sG[m * 2 + h] = make_uint4(pack2(acc[m][2 * h][0] * blo(g.x), acc[m][2 * h][1] * bhi(g.x)),
                                   pack2(acc[m][2 * h][2] * blo(g.y), acc[m][2 * h][3] * bhi(g.y)),
                                   pack2(acc[m][2 * h + 1][0] * blo(g.z), acc[m][2 * h + 1][1] * bhi(g.z)),
                                   pack2(acc[m][2 * h + 1][2] * blo(g.w), acc[m][2 * h + 1][3] * bhi(g.w)));
      }
    zero_acc(acc);
    gemm_acc_db(acc, p.R6 + (size_t)mt * 128 * 1024, 1024, p.WbT + (size_t)nt * 128 * 1024, 1024, 1024, smem);
#pragma unroll
    for (int m = 0; m < 4; m++)
#pragma unroll
      for (int h = 0; h < 2; h++)
        sH[m * 2 + h] = make_uint4(pack2(acc[m][2 * h][0], acc[m][2 * h][1]), pack2(acc[m][2 * h][2], acc[m][2 * h][3]),
                                   pack2(acc[m][2 * h + 1][0], acc[m][2 * h + 1][1]), pack2(acc[m][2 * h + 1][2], acc[m][2 * h + 1][3]));
    zero_acc(acc);
    gemm_acc_db(acc, xn + (size_t)mt * 128 * 1024, 1024, p.WinT + (size_t)(6272 + 1024 + nt * 128) * 1024, 1024, 1024, smem);
    const int rowb = mt * 128 + wr * 64 + fr;
    {
      float4 gb[4];
#pragma unroll
      for (int n = 0; n < 4; n++) gb[n] = *(const float4*)(p.gbias + 1024 + colb + n * 16);
#pragma unroll
      for (int m = 0; m < 4; m++)
#pragma unroll
        for (int h = 0; h < 2; h++) {
          const uint4 a = sG[m * 2 + h], b = sH[m * 2 + h];
          const u32 av[4] = {a.x, a.y, a.z, a.w}, bv[4] = {b.x, b.y, b.z, b.w};
#pragma unroll
          for (int nn = 0; nn < 2; nn++) {
            const int n = 2 * h + nn;
            float r0 = blo(av[nn * 2]) + blo(bv[nn * 2]) * sigmoidf_(acc[m][n][0] + gb[n].x);
            float r1 = bhi(av[nn * 2]) + bhi(bv[nn * 2]) * sigmoidf_(acc[m][n][1] + gb[n].y);
            float r2 = blo(av[nn * 2 + 1]) + blo(bv[nn * 2 + 1]) * sigmoidf_(acc[m][n][2] + gb[n].z);
            float r3 = bhi(av[nn * 2 + 1]) + bhi(bv[nn * 2 + 1]) * sigmoidf_(acc[m][n][3] + gb[n].w);
            *(uint2*)(p.R1 + (size_t)(rowb + m * 16) * 1024 + colb + n * 16) = make_uint2(pack2(r0, r1), pack2(r2, r3));
          }
        }
    }
  }
}

__device__ void phase7(const Params& p, char* smem) {
  u16* sA = (u16*)smem;
  u16* sB = sA + 128 * 64;
  const int t = threadIdx.x, lane = t & 63, w = t >> 6, wr = w >> 1, wc = w & 1, fr = lane & 15, fq = lane >> 4;
  float* x1 = (float*)p.R2;
  TileIter ti(8);
  int mt, nt;
  while (ti.next(mt, nt)) {
    f32x4 acc[4][4];
    zero_acc(acc);
    gemm_acc_db(acc, p.R1 + (size_t)mt * 128 * 1024, 1024, p.WoT + (size_t)nt * 128 * 1024, 1024, 1024, smem);
    const int rowb = mt * 128 + wr * 64 + fr;
    const int colb = nt * 128 + wc * 64 + fq * 4;
#pragma unroll
    for (int m = 0; m < 4; m++)
#pragma unroll
      for (int n = 0; n < 4; n++) {
        const size_t o = (size_t)(rowb + m * 16) * 1024 + colb + n * 16;
        const float4 xv = *(const float4*)(p.x + o);
        *(float4*)(x1 + o) = make_float4(xv.x + acc[m][n][0], xv.y + acc[m][n][1], xv.z + acc[m][n][2], xv.w + acc[m][n][3]);
      }
  }
}

constexpr float U_SCALE = 256.f, V_SCALE = 64.f;
__device__ __forceinline__ u32 enc_fp8x4(float a, float b, float c, float d) {
  int w = __builtin_amdgcn_cvt_pk_fp8_f32(a, b, 0, false);
  w = __builtin_amdgcn_cvt_pk_fp8_f32(c, d, w, true);
  return (u32)w;
}
__device__ __forceinline__ void table_convert_job(const Params& p, int j, int t) {
  unsigned char* Tb = (unsigned char*)p.R5;
  const float* src = (j < 4096) ? p.pu : p.pv;
  const float sc = (j < 4096) ? U_SCALE : V_SCALE;
  size_t base = (size_t)(j & 4095) * 4096 + t * 16;
  unsigned char* slot = Tb + (base >> 10) * 2048 + ((j < 4096) ? 0 : 1024) + (base & 1023);
  float4 a = *(const float4*)(src + base), b = *(const float4*)(src + base + 4), c = *(const float4*)(src + base + 8),
         d = *(const float4*)(src + base + 12);
  *(uint4*)slot = make_uint4(enc_fp8x4(a.x * sc, a.y * sc, a.z * sc, a.w * sc), enc_fp8x4(b.x * sc, b.y * sc, b.z * sc, b.w * sc),
                                     enc_fp8x4(c.x * sc, c.y * sc, c.z * sc, c.w * sc), enc_fp8x4(d.x * sc, d.y * sc, d.z * sc, d.w * sc));
}
__device__ void phase8(const Params& p) {
  const int t = threadIdx.x, lane = t & 63, w = t >> 6;
  const float* x1 = (const float*)p.R2;
  for (int job = blockIdx.x; job < 4096; job += gridDim.x) {
    int row = job * 4 + w;
    rms_row(x1 + (size_t)row * 1024, p.norm2_g, p.R4 + (size_t)row * 1024, lane);
  }
}

__device__ void phase9(const Params& p, char* smem) {
  u16* sA = (u16*)smem;
  u16* sB = sA + 128 * 64;
  const int t = threadIdx.x, lane = t & 63, w = t >> 6, wr = w >> 1, wc = w & 1, fr = lane & 15, fq = lane >> 4;
  u16* q = (u16*)p.out;
  TileIter ti(16);
  int mt, nt;
  while (ti.next(mt, nt)) {
    f32x4 acc[4][4];
    zero_acc(acc);
    gemm_acc_db(acc, p.R4 + (size_t)mt * 128 * 1024, 1024, p.WqT + (size_t)nt * 128 * 1024, 1024, 1024, smem);
    const int rowb = mt * 128 + wr * 64 + fr;
    const int colb = nt * 128 + wc * 64 + fq * 4;
#pragma unroll
    for (int m = 0; m < 4; m++)
#pragma unroll
      for (int n = 0; n < 4; n++)
        *(uint2*)(q + (size_t)(rowb + m * 16) * 2048 + colb + n * 16) = make_uint2(pack2(acc[m][n][0], acc[m][n][1]), pack2(acc[m][n][2], acc[m][n][3]));
#pragma unroll 1
    for (int r = 0; r < 4; r++) table_convert_job(p, (mt * 16 + nt) * 4 + r, t);
  }
}

__device__ __forceinline__ void select16q(u32* rowbase, int part, u32 (&tk)[16], unsigned char* idxp) {
  u32* myp = rowbase + part * 32;
#pragma unroll
  for (int it = 0; it < 16; it++) {
    u32 m = 0;
#pragma unroll
    for (int c = 0; c < 8; c++) {
      uint4 kk = *(const uint4*)(myp + c * 4);
      m = max(m, max(max(kk.x, kk.y), max(kk.z, kk.w)));
    }
    m = max(m, (u32)__shfl_xor((int)m, 1));
    m = max(m, (u32)__shfl_xor((int)m, 2));
    tk[it] = m;
    const int idx = 127 - (int)(m & 127u);
    if ((idx >> 5) == part) { rowbase[idx] = 0; idxp[it] = (unsigned char)idx; }
  }
}

__device__ void phase10(const Params& p, char* smem) {
  u16* sKeys = (u16*)smem;
  u32* sSc = (u32*)(smem + 128 * 136 * 2);
  unsigned char* sIdx = (unsigned char*)(smem + 128 * 136 * 2 + 64 * 132 * 4);
  const int t = threadIdx.x, lane = t & 63, w = t >> 6, fr = lane & 15, fq = lane >> 4;
  const int rl = lane >> 2, part = lane & 3, row = w * 16 + rl;
  const u16* q = (const u16*)p.out;
  int* experts = (int*)p.R7;
  float* gates = p.R7 + (size_t)BT * 128;
#define P10_DECL(S) uint4 S##k0, S##k1, S##k2, S##k3, S##k4, S##k5, S##k6, S##k7; bf16x8 S##q0, S##q1, S##q2, S##q3
#define P10_LOAD(S, ITEM, PP)                                                                               \
  do {                                                                                                      \
    const int it_ = ((ITEM) < 256 * 8) ? (ITEM) : (int)blockIdx.x;                                          \
    const int tt_ = it_ >> 3, h_ = it_ & 7;                                                                 \
    const u16* ks_ = p.KeysB + (size_t)(h_ * 2 + (PP)) * 128 * 128 + (t >> 4) * 128 + (t & 15) * 8;         \
    S##k0 = *(const uint4*)(ks_); S##k1 = *(const uint4*)(ks_ + 16 * 128); S##k2 = *(const uint4*)(ks_ + 32 * 128);   \
    S##k3 = *(const uint4*)(ks_ + 48 * 128); S##k4 = *(const uint4*)(ks_ + 64 * 128); S##k5 = *(const uint4*)(ks_ + 80 * 128); \
    S##k6 = *(const uint4*)(ks_ + 96 * 128); S##k7 = *(const uint4*)(ks_ + 112 * 128);                      \
    const u16* qp_ = q + (size_t)(tt_ * 64 + w * 16 + fr) * 2048 + h_ * 256 + (PP) * 128 + fq * 8;          \
    S##q0 = *(const bf16x8*)(qp_); S##q1 = *(const bf16x8*)(qp_ + 32); S##q2 = *(const bf16x8*)(qp_ + 64);  \
    S##q3 = *(const bf16x8*)(qp_ + 96);                                                                     \
  } while (0)
#define P10_MFMA_K(QK, KI)                                                                                  \
  _Pragma("unroll") for (int n_ = 0; n_ < 8; n_++) {                                                        \
    bf16x8 bv_ = *(const bf16x8*)(sKeys + (n_ * 16 + fr) * 136 + (KI) * 32 + fq * 8);                       \
    acc_[n_] = __builtin_amdgcn_mfma_f32_16x16x32_bf16(QK, bv_, acc_[n_], 0, 0, 0);                         \
  }
#define P10_SCORE(S)                                                                                        \
  do {                                                                                                      \
    __syncthreads();                                                                                        \
    u16* kd_ = sKeys + (t >> 4) * 136 + (t & 15) * 8;                                                       \
    *(uint4*)(kd_) = S##k0; *(uint4*)(kd_ + 16 * 136) = S##k1; *(uint4*)(kd_ + 32 * 136) = S##k2;           \
    *(uint4*)(kd_ + 48 * 136) = S##k3; *(uint4*)(kd_ + 64 * 136) = S##k4; *(uint4*)(kd_ + 80 * 136) = S##k5; \
    *(uint4*)(kd_ + 96 * 136) = S##k6; *(uint4*)(kd_ + 112 * 136) = S##k7;                                  \
    __syncthreads();                                                                                        \
    f32x4 acc_[8];                                                                                          \
    _Pragma("unroll") for (int n_ = 0; n_ < 8; n_++) acc_[n_] = f32x4{0.f, 0.f, 0.f, 0.f};                  \
    P10_MFMA_K(S##q0, 0) P10_MFMA_K(S##q1, 1) P10_MFMA_K(S##q2, 2) P10_MFMA_K(S##q3, 3)                     \
    _Pragma("unroll") for (int n_ = 0; n_ < 8; n_++)                                                        \
      _Pragma("unroll") for (int j_ = 0; j_ < 4; j_++) {                                                    \
        int r_ = w * 16 + fq * 4 + j_, col_ = n_ * 16 + fr;                                                 \
        sSc[r_ * 132 + col_] = (ordf(acc_[n_][j_]) & ~127u) | (u32)(127 - col_);                            \
      }                                                                                                     \
    __syncthreads();                                                                                        \
  } while (0)
  P10_DECL(sa);
  P10_DECL(sb);
  P10_LOAD(sa, (int)blockIdx.x, 0);
  for (int item = blockIdx.x; item < 256 * 8; item += gridDim.x) {
    const int tt = item >> 3, h = item & 7;
    u32 ta[16], tb[16];
    P10_SCORE(sa);
    P10_LOAD(sb, item, 1);
    select16q(sSc + row * 132, part, ta, sIdx + row * 32);
    P10_SCORE(sb);
    P10_LOAD(sa, item + (int)gridDim.x, 0);
    select16q(sSc + row * 132, part, tb, sIdx + row * 32 + 16);
    __syncthreads();
    {
      float fa[4], fb[16];
#pragma unroll
      for (int r = 0; r < 4; r++) {
        const u32 s0 = ta[4 * r], s1 = ta[4 * r + 1], s2 = ta[4 * r + 2], s3 = ta[4 * r + 3];
        const u32 sel = part == 0 ? s0 : (part == 1 ? s1 : (part == 2 ? s2 : s3));
        fa[r] = unordf(sel & ~127u);
      }
#pragma unroll
      for (int j = 0; j < 16; j++) fb[j] = unordf(tb[j] & ~127u);
      constexpr int NJ[4] = {16, 3, 1, 1};
      u32 cand[4][16];
#pragma unroll
      for (int r = 0; r < 4; r++) {
        const int irow = part + 4 * r;
        const int jlim = 16 / (irow + 1);
#pragma unroll
        for (int j = 0; j < 16; j++)
          if (j < NJ[r]) cand[r][j] = (j < jlim) ? ((ordf(fa[r] + fb[j]) & ~255u) | (u32)(255 - (irow * 16 + j))) : 0u;
      }
      const int tok = tt * 64 + row;
      float sv[16];
      int ev[16];
#pragma unroll
      for (int it = 0; it < 16; it++) {
        u32 m = 0;
#pragma unroll
        for (int r = 0; r < 4; r++)
#pragma unroll
          for (int j = 0; j < 16; j++)
            if (j < NJ[r]) m = max(m, cand[r][j]);
        m = max(m, (u32)__shfl_xor((int)m, 1));
        m = max(m, (u32)__shfl_xor((int)m, 2));
#pragma unroll
        for (int r = 0; r < 4; r++)
#pragma unroll
          for (int j = 0; j < 16; j++)
            if (j < NJ[r]) cand[r][j] = (cand[r][j] == m) ? 0u : cand[r][j];
        const int c = 255 - (int)(m & 255u);
        const int i1 = sIdx[row * 32 + (c >> 4)], i2 = sIdx[row * 32 + 16 + (c & 15)];
        ev[it] = i1 * 128 + i2;
        sv[it] = unordf(m & ~255u);
      }
      const float mx = sv[0];
      float sum = 0.f;
#pragma unroll
      for (int it = 0; it < 16; it++) { sv[it] = __expf(sv[it] - mx); sum += sv[it]; }
      const float inv = 1.f / sum;
#pragma unroll
      for (int g = 0; g < 4; g++) {
        if (part == g) {
          *(int4*)(experts + (size_t)tok * 128 + h * 16 + g * 4) = make_int4(ev[g * 4], ev[g * 4 + 1], ev[g * 4 + 2], ev[g * 4 + 3]);
          *(float4*)(gates + (size_t)tok * 128 + h * 16 + g * 4) =
              make_float4(sv[g * 4] * inv, sv[g * 4 + 1] * inv, sv[g * 4 + 2] * inv, sv[g * 4 + 3] * inv);
        }
      }
    }
  }
}

#undef P10_LOAD
#undef P10_SCORE
#undef P10_MFMA_K
#undef P10_DECL
typedef float f32x2 __attribute__((ext_vector_type(2)));
__device__ __forceinline__ void dec16(const uint4& q, float (&o)[16]) {
  const u32 ws_[4] = {q.x, q.y, q.z, q.w};
#pragma unroll
  for (int i = 0; i < 4; i++) {
    f32x2 lo = __builtin_amdgcn_cvt_pk_f32_fp8((int)ws_[i], false);
    f32x2 hi = __builtin_amdgcn_cvt_pk_f32_fp8((int)ws_[i], true);
    o[i * 4 + 0] = lo[0]; o[i * 4 + 1] = lo[1]; o[i * 4 + 2] = hi[0]; o[i * 4 + 3] = hi[1];
  }
}
__device__ __forceinline__ void peer_load8(uint4 (&U)[8], uint4 (&V)[8], const unsigned char* Ub, const unsigned char* Vb, int ev, int l0,
                                           int lane) {
#pragma unroll
  for (int u = 0; u < 8; u++) {
    const int e = __builtin_amdgcn_readlane(ev, l0 + u);
    U[u] = *(const uint4*)(Ub + (size_t)e * 2048 + lane * 16);
    V[u] = *(const uint4*)(Vb + (size_t)e * 2048 + lane * 16);
  }
}
__device__ __forceinline__ void peer_proc8(const uint4 (&U)[8], const uint4 (&V)[8], const f32x2 (&xp)[8], f32x2 (&accp)[8], float gate_lane,
                                           int lane) {
  float d[8];
#pragma unroll
  for (int u = 0; u < 8; u++) {
    const u32 ws_[4] = {U[u].x, U[u].y, U[u].z, U[u].w};
    f32x2 s = {0.f, 0.f};
#pragma unroll
    for (int q = 0; q < 4; q++) {
      s += xp[2 * q] * __builtin_amdgcn_cvt_pk_f32_fp8((int)ws_[q], false);
      s += xp[2 * q + 1] * __builtin_amdgcn_cvt_pk_f32_fp8((int)ws_[q], true);
    }
    d[u] = s[0] + s[1];
  }
  {
    const bool b4 = (lane & 4) != 0, b2 = (lane & 2) != 0, b1 = (lane & 1) != 0;
#pragma unroll
    for (int i = 0; i < 4; i++) {
      const float send = b4 ? d[i] : d[i + 4], keep = b4 ? d[i + 4] : d[i];
      d[i] = keep + __shfl_xor(send, 4);
    }
#pragma unroll
    for (int i = 0; i < 2; i++) {
      const float send = b2 ? d[i] : d[i + 2], keep = b2 ? d[i + 2] : d[i];
      d[i] = keep + __shfl_xor(send, 2);
    }
    {
      const float send = b1 ? d[0] : d[1], keep = b1 ? d[1] : d[0];
      d[0] = keep + __shfl_xor(send, 1);
    }
    d[0] += __shfl_xor(d[0], 8);
    d[0] += __shfl_xor(d[0], 16);
    d[0] += __shfl_xor(d[0], 32);
  }
  const float dd = d[0] * (1.f / U_SCALE);
  const float hd = 0.5f * dd * (1.f + erff(dd * 0.70710678118654752f));
  const int cl = __float_as_int(hd * gate_lane * (1.f / V_SCALE));
#pragma unroll
  for (int u = 0; u < 8; u++) {
    const float c = __int_as_float(__builtin_amdgcn_readlane(cl, u));
    const f32x2 c2 = {c, c};
    const u32 ws_[4] = {V[u].x, V[u].y, V[u].z, V[u].w};
#pragma unroll
    for (int q = 0; q < 4; q++) {
      accp[2 * q] += c2 * __builtin_amdgcn_cvt_pk_f32_fp8((int)ws_[q], false);
      accp[2 * q + 1] += c2 * __builtin_amdgcn_cvt_pk_f32_fp8((int)ws_[q], true);
    }
  }
}
__device__ __forceinline__ float dot16_fp8(const f32x2 (&xp)[8], const uint4& q) {
  const u32 ws_[4] = {q.x, q.y, q.z, q.w};
  f32x2 s = {0.f, 0.f};
#pragma unroll
  for (int i = 0; i < 4; i++) {
    s += xp[2 * i] * __builtin_amdgcn_cvt_pk_f32_fp8((int)ws_[i], false);
    s += xp[2 * i + 1] * __builtin_amdgcn_cvt_pk_f32_fp8((int)ws_[i], true);
  }
  return s[0] + s[1];
}
__device__ __forceinline__ void pe_load_tab(const unsigned char* Tb, unsigned loff, int e0, int e1, int g, uint4 (&U)[16]) {
#pragma unroll
  for (int kb = 0; kb < 16; kb++) {
    const int e = __shfl((kb < 8) ? e0 : e1, (kb & 7) * 8 + g);
    U[kb] = *(const uint4*)(Tb + ((unsigned)e * 2048u + loff));
  }
}
__device__ __forceinline__ void pe_load_x(const u16* xr, f32x2 (&xp)[8]) {
  uint4 a = *(const uint4*)(xr), b = *(const uint4*)(xr + 8);
  xp[0] = f32x2{blo(a.x), bhi(a.x)}; xp[1] = f32x2{blo(a.y), bhi(a.y)}; xp[2] = f32x2{blo(a.z), bhi(a.z)}; xp[3] = f32x2{blo(a.w), bhi(a.w)};
  xp[4] = f32x2{blo(b.x), bhi(b.x)}; xp[5] = f32x2{blo(b.y), bhi(b.y)}; xp[6] = f32x2{blo(b.z), bhi(b.z)}; xp[7] = f32x2{blo(b.w), bhi(b.w)};
}
__device__ __forceinline__ void pe_dot_store(const f32x2 (&xp)[8], const uint4 (&U)[16], float* pr, int lane, int r) {
  float d[16];
#pragma unroll
  for (int kb = 0; kb < 16; kb++) d[kb] = dot16_fp8(xp, U[kb]);
  const bool b4 = (lane & 4) != 0, b2 = (lane & 2) != 0, b1 = (lane & 1) != 0;
#pragma unroll
  for (int i = 0; i < 8; i++) { const float send = b4 ? d[i] : d[i + 8], keep = b4 ? d[i + 8] : d[i]; d[i] = keep + __shfl_xor(send, 4); }
#pragma unroll
  for (int i = 0; i < 4; i++) { const float send = b2 ? d[i] : d[i + 4], keep = b2 ? d[i + 4] : d[i]; d[i] = keep + __shfl_xor(send, 2); }
#pragma unroll
  for (int i = 0; i < 2; i++) { const float send = b1 ? d[i] : d[i + 2], keep = b1 ? d[i + 2] : d[i]; d[i] = keep + __shfl_xor(send, 1); }
  pr[(2 * r) * 8] = d[0];
  pr[(2 * r + 1) * 8] = d[1];
}
__device__ void phase11a(const Params& p) {
  const int t = threadIdx.x, lane = t & 63, w = t >> 6, g = lane >> 3, r = lane & 7;
  const int s = blockIdx.x & 7, jb = blockIdx.x >> 3, ns = (gridDim.x - s + 7) >> 3;
  const u16* xn2 = p.R4 + s * 128 + r * 16;
  const unsigned char* Tb = (const unsigned char*)p.R5 + s * 128;
  const unsigned loff = r * 16;
  const int* experts = (const int*)p.R7 + lane;
  float* part = p.out + (size_t)s * BT * 128 + g;
  const int first = jb * 4 + w, stride = ns * 4;
  if (first >= BT) return;
#define TOKC(T) (((T) < BT) ? (T) : first)
  int eA0, eA1, eB0, eB1;
  uint4 UA[16], UB[16];
  f32x2 xA[8], xB[8];
  eA0 = experts[(size_t)first * 128]; eA1 = experts[(size_t)first * 128 + 64];
  pe_load_tab(Tb, loff, eA0, eA1, g, UA);
  pe_load_x(xn2 + (size_t)first * 1024, xA);
  { const int t1 = TOKC(first + stride); eB0 = experts[(size_t)t1 * 128]; eB1 = experts[(size_t)t1 * 128 + 64]; }
#pragma unroll 1
  for (int tok = first; tok < BT; tok += 2 * stride) {
    const int t1 = tok + stride, t2 = tok + 2 * stride, t3 = tok + 3 * stride;
    pe_load_tab(Tb, loff, eB0, eB1, g, UB);
    pe_load_x(xn2 + (size_t)TOKC(t1) * 1024, xB);
    { const int tc = TOKC(t2); eA0 = experts[(size_t)tc * 128]; eA1 = experts[(size_t)tc * 128 + 64]; }
    pe_dot_store(xA, UA, part + (size_t)tok * 128, lane, r);
    pe_load_tab(Tb, loff, eA0, eA1, g, UA);
    pe_load_x(xn2 + (size_t)TOKC(t2) * 1024, xA);
    { const int tc = TOKC(t3); eB0 = experts[(size_t)tc * 128]; eB1 = experts[(size_t)tc * 128 + 64]; }
    if (t1 < BT) pe_dot_store(xB, UB, part + (size_t)t1 * 128, lane, r);
  }
}

__device__ void phase11r(const Params& p) {
  float* gates = p.R7 + (size_t)BT * 128;
  const float* part = p.out;
  for (int idx = blockIdx.x * 256 + threadIdx.x; idx < BT * 128 / 4; idx += gridDim.x * 256) {
    float4 h = *(const float4*)(part + (size_t)idx * 4);
#pragma unroll
    for (int ss = 1; ss < 8; ss++) {
      const float4 q = *(const float4*)(part + (size_t)ss * BT * 128 + (size_t)idx * 4);
      h.x += q.x; h.y += q.y; h.z += q.z; h.w += q.w;
    }
    float4 gt = *(const float4*)(gates + (size_t)idx * 4);
    const float hv[4] = {h.x * (1.f / U_SCALE), h.y * (1.f / U_SCALE), h.z * (1.f / U_SCALE), h.w * (1.f / U_SCALE)};
    const float gv[4] = {gt.x, gt.y, gt.z, gt.w};
    float c[4];
#pragma unroll
    for (int q = 0; q < 4; q++) c[q] = 0.5f * hv[q] * (1.f + erff(hv[q] * 0.70710678118654752f)) * gv[q] * (1.f / V_SCALE);
    *(float4*)(gates + (size_t)idx * 4) = make_float4(c[0], c[1], c[2], c[3]);
  }
}

struct PeTok { int e0, e1; float g0, g1; };
__device__ __forceinline__ PeTok pe_load_tok(const int* experts, const float* gates, int tok) {
  PeTok k;
  k.e0 = experts[(size_t)tok * 128]; k.e1 = experts[(size_t)tok * 128 + 64];
  k.g0 = gates[(size_t)tok * 128]; k.g1 = gates[(size_t)tok * 128 + 64];
  return k;
}
__device__ __forceinline__ void pe_value_store(const PeTok& k, const uint4 (&V)[16], u16* drow, int lane, int g) {
  const float c0 = k.g0, c1 = k.g1;
  f32x2 accp[8];
#pragma unroll
  for (int i = 0; i < 8; i++) accp[i] = f32x2{0.f, 0.f};
#pragma unroll
  for (int kb = 0; kb < 16; kb++) {
    const float c = __shfl((kb < 8) ? c0 : c1, (kb & 7) * 8 + g);
    const f32x2 c2 = {c, c};
    const u32 ws_[4] = {V[kb].x, V[kb].y, V[kb].z, V[kb].w};
#pragma unroll
    for (int q = 0; q < 4; q++) {
      accp[2 * q] += c2 * __builtin_amdgcn_cvt_pk_f32_fp8((int)ws_[q], false);
      accp[2 * q + 1] += c2 * __builtin_amdgcn_cvt_pk_f32_fp8((int)ws_[q], true);
    }
  }
  float a[16];
#pragma unroll
  for (int i = 0; i < 8; i++) { a[2 * i] = accp[i][0]; a[2 * i + 1] = accp[i][1]; }
  const bool b32 = (lane & 32) != 0, b16 = (lane & 16) != 0, b8 = (lane & 8) != 0;
#pragma unroll
  for (int i = 0; i < 8; i++) { const float send = b32 ? a[i] : a[i + 8], keep = b32 ? a[i + 8] : a[i]; a[i] = keep + __shfl_xor(send, 32); }
#pragma unroll
  for (int i = 0; i < 4; i++) { const float send = b16 ? a[i] : a[i + 4], keep = b16 ? a[i + 4] : a[i]; a[i] = keep + __shfl_xor(send, 16); }
#pragma unroll
  for (int i = 0; i < 2; i++) { const float send = b8 ? a[i] : a[i + 2], keep = b8 ? a[i + 2] : a[i]; a[i] = keep + __shfl_xor(send, 8); }
  *(u32*)drow = pack2(a[0], a[1]);
}
__device__ void phase11b(const Params& p) {
  const int t = threadIdx.x, lane = t & 63, w = t >> 6, g = lane >> 3, r = lane & 7;
  const int s = blockIdx.x & 7, jb = blockIdx.x >> 3, ns = (gridDim.x - s + 7) >> 3;
  const unsigned char* Tb = (const unsigned char*)p.R5 + 1024 + s * 128;
  const unsigned loff = r * 16;
  const int* experts = (const int*)p.R7 + lane;
  const float* gates = p.R7 + (size_t)BT * 128 + lane;
  u16* x1 = p.R1 + s * 128 + r * 16 + 2 * g;
  const int first = jb * 4 + w, stride = ns * 4;
  if (first >= BT) return;
  PeTok kA, kB;
  uint4 VA[16], VB[16];
  kA = pe_load_tok(experts, gates, first);
  pe_load_tab(Tb, loff, kA.e0, kA.e1, g, VA);
  kB = pe_load_tok(experts, gates, TOKC(first + stride));
#pragma unroll 1
  for (int tok = first; tok < BT; tok += 2 * stride) {
    const int t1 = tok + stride, t2 = tok + 2 * stride, t3 = tok + 3 * stride;
    pe_load_tab(Tb, loff, kB.e0, kB.e1, g, VB);
    const PeTok kC = pe_load_tok(experts, gates, TOKC(t2));
    pe_value_store(kA, VA, x1 + (size_t)tok * 1024, lane, g);
    pe_load_tab(Tb, loff, kC.e0, kC.e1, g, VA);
    const PeTok kD = pe_load_tok(experts, gates, TOKC(t3));
    if (t1 < BT) pe_value_store(kB, VB, x1 + (size_t)t1 * 1024, lane, g);
    kA = kC; kB = kD;
  }
#undef TOKC
}

__device__ void phase11c(const Params& p) {
  const int t = threadIdx.x, lane = t & 63, w = t >> 6;
  const float* x1 = (const float*)p.R2;
  for (int tok = blockIdx.x * 4 + w; tok < BT; tok += gridDim.x * 4) {
    const float* xr = x1 + (size_t)tok * 1024 + lane * 16;
    const u16* dl = p.R1 + (size_t)tok * 1024 + lane * 16;
    float4 v[4];
    float ss = 0.f;
#pragma unroll
    for (int i = 0; i < 4; i++) {
      v[i] = *(const float4*)(xr + i * 4);
      const uint2 dd = *(const uint2*)(dl + i * 4);
      v[i].x += blo(dd.x); v[i].y += bhi(dd.x); v[i].z += blo(dd.y); v[i].w += bhi(dd.y);
      ss += v[i].x * v[i].x + v[i].y * v[i].y + v[i].z * v[i].z + v[i].w * v[i].w;
    }
    ss = wave_sum(ss);
    const float rstd = rsqrtf(ss * (1.f / 1024.f) + 1e-6f);
    float* orow = p.out + (size_t)tok * 1024 + lane * 16;
#pragma unroll
    for (int i = 0; i < 4; i++) {
      float4 gg = *(const float4*)(p.fng + lane * 16 + i * 4);
      *(float4*)(orow + i * 4) = make_float4(v[i].x * rstd * gg.x, v[i].y * rstd * gg.y, v[i].z * rstd * gg.z, v[i].w * rstd * gg.w);
    }
  }
}

__global__ void __launch_bounds__(256, 2) fwd_mega(Params p, int ph_lo, int ph_hi) {
  extern __shared__ __attribute__((aligned(16))) char smem[];
  cg::grid_group grid = cg::this_grid();
  __shared__ uint4 xb_words;
  if (threadIdx.x == 0) xb_words = make_uint4(0u, 0u, 0u, 0u);
  __syncthreads();
  const XcdBarrier xb = xcd_barrier_post(p.bar, (volatile LAS unsigned*)&xb_words);
  if (ph_lo > ph_hi) grid.sync();
constexpr int REP0=1,REP1=1,REP2=1,REP3=1,REP4=1,REP5=1,REP6=1,REP7=1,REP8=1,REP9=1,REP10=1,REP11=1,REP12=1,REP13=1,REP14=1;
#define RUN_PHASE(k, call)                         \
  if (PH_ON(k) && ph_lo <= (k) && (k) < ph_hi) {   \
    for (int rep_ = 0; rep_ < REP##k; rep_++) { call; }  \
    if ((k) + 1 < ph_hi) xcd_barrier(xb);          \
  }
  RUN_PHASE(0, phase0(p, smem))
  RUN_PHASE(1, phase1(p, smem))
  RUN_PHASE(2, phase2(p, smem, xb))
  RUN_PHASE(3, phase3(p); weights_late(p, smem))
  RUN_PHASE(4, for (int item = blockIdx.x; item < 512; item += gridDim.x) gla_item(p, item, 2, smem))
  RUN_PHASE(5, phase5(p))
  RUN_PHASE(6, phase6(p, smem))
  RUN_PHASE(7, phase7(p, smem))
  RUN_PHASE(8, phase8(p))
  RUN_PHASE(9, phase9(p, smem))
  RUN_PHASE(10, phase10(p, smem))
  RUN_PHASE(11, phase11a(p))
  RUN_PHASE(12, phase11r(p))
  RUN_PHASE(13, phase11b(p))
  RUN_PHASE(14, phase11c(p))
}

extern "C" void kernel_launch(void* const* d_in, const int* in_sizes, int n_in, void* d_out, int out_size, void* d_ws,
                              size_t ws_size, hipStream_t stream) {
  (void)in_sizes; (void)n_in; (void)out_size; (void)ws_size;
  static int grid_blocks = 0;
  if (!grid_blocks) {
    int dev = 0, cus = 0, per_cu = 0;
    hipGetDevice(&dev);
    hipDeviceGetAttribute(&cus, hipDeviceAttributeMultiprocessorCount, dev);
    hipFuncSetAttribute((const void*)fwd_mega, hipFuncAttributeMaxDynamicSharedMemorySize, LDS_BYTES);
    hipOccupancyMaxActiveBlocksPerMultiprocessor(&per_cu, (const void*)fwd_mega, 256, LDS_BYTES);
    if (per_cu < 1) per_cu = 1;
    if (per_cu > 2) per_cu = 2;
    grid_blocks = cus * per_cu;
  }
  Params p{};
  const float* const* in = (const float* const*)d_in;
  p.x = in[0]; p.norm1_g = in[1]; p.w_in = in[2]; p.conv_w = in[3]; p.conv_b = in[4]; p.wa = in[5];
  p.dupf = in[6]; p.dbf = in[7]; p.dupb = in[8]; p.dbb = in[9]; p.gng = in[10]; p.wb = in[11];
  p.gbias = in[12]; p.wo = in[13]; p.norm2_g = in[14]; p.wq = in[15]; p.keys = in[16]; p.pu = in[17];
  p.pv = in[18]; p.fng = in[19];
  p.out = (float*)d_out;
  char* ws = (char*)d_ws;
  const size_t MiB = 1u << 20;
  p.WinT = (u16*)ws;
  p.WaT = (u16*)(ws + 17039360);
  p.WbT = (u16*)(ws + 17039360 + 2097152);
  p.WoT = (u16*)(ws + 17039360 + 2 * 2097152);
  p.WqT = (u16*)(ws + 17039360 + 3 * 2097152);
  p.KeysB = (u16*)(ws + 17039360 + 3 * 2097152 + 4194304);
  p.R1 = (u16*)(ws + 27 * MiB);
  p.R2 = (u16*)(ws + 59 * MiB);
  p.R3 = (u16*)(ws + 91 * MiB);
  p.R4 = (u16*)(ws + 123 * MiB);
  p.R5 = (u16*)(ws + 155 * MiB);
  p.R6 = (u16*)(ws + 187 * MiB);
  p.R7 = (float*)(ws + 219 * MiB);
  p.z = (float*)(ws + 251 * MiB);
  p.Dd = (float*)(ws + 253 * MiB);
  p.bar = (unsigned*)(ws + 254 * MiB);
  hipMemsetAsync(p.bar, 0, XCD_BAR_WORDS * sizeof(unsigned), stream);
#if MULTI_LAUNCH
  for (int ph = 0; ph < NPHASE; ph++) {
    hipLaunchKernelGGL(fwd_mega, dim3(grid_blocks), dim3(256), LDS_BYTES, stream, p, ph, ph + 1);
  }
#else
  int lo = 0, hi = NPHASE;
  void* args[] = {&p, &lo, &hi};
  hipError_t e = hipLaunchCooperativeKernel((const void*)fwd_mega, dim3(grid_blocks), dim3(256), args, LDS_BYTES, stream);
  if (e != hipSuccess) fprintf(stderr, "cooperative launch failed: %s (grid %d)\n", hipGetErrorString(e), grid_blocks);
#endif
}
```

```cpp
#include <hip/hip_runtime.h>
#include <hip/hip_cooperative_groups.h>
#include <cstdio>
namespace cg = cooperative_groups;

typedef unsigned short u16;
typedef unsigned int u32;
using bf16x8 = __attribute__((ext_vector_type(8))) short;
using f32x4 = __attribute__((ext_vector_type(4))) float;

#ifndef ONLY_PHASE
#define ONLY_PHASE -1
#endif
#define PH_ON(k) (ONLY_PHASE < 0 || ONLY_PHASE == (k))
#ifndef MULTI_LAUNCH
#define MULTI_LAUNCH 0
#endif

constexpr int BT = 16384, SEQ = 8192;
constexpr int LDS_BYTES = 80896;
constexpr int NPHASE = 15;

struct Params {
  const float *x, *norm1_g, *w_in, *conv_w, *conv_b, *wa, *dupf, *dbf, *dupb, *dbb, *gng, *wb, *gbias, *wo,
      *norm2_g, *wq, *keys, *pu, *pv, *fng;
  float* out;
  u16 *WinT, *WaT, *WbT, *WoT, *WqT, *KeysB;
  u16 *R1, *R2, *R3, *R4, *R5, *R6;
  float *R7, *z, *Dd;
  unsigned* bar;
};

__device__ __forceinline__ u16 f2b(float f) { u32 u = __float_as_uint(f); u += 0x7fffu + ((u >> 16) & 1u); return (u16)(u >> 16); }
__device__ __forceinline__ float b2f(u16 h) { return __uint_as_float(((u32)h) << 16); }
__device__ __forceinline__ u32 pack2(float a, float b) { return (u32)f2b(a) | ((u32)f2b(b) << 16); }
__device__ __forceinline__ float blo(u32 w) { return __uint_as_float(w << 16); }
__device__ __forceinline__ float bhi(u32 w) { return __uint_as_float(w & 0xffff0000u); }
__device__ __forceinline__ float wave_sum(float v) {
#pragma unroll
  for (int o = 32; o > 0; o >>= 1) v += __shfl_xor(v, o);
  return v;
}
__device__ __forceinline__ float sigmoidf_(float v) { return 1.f / (1.f + __expf(-v)); }
__device__ __forceinline__ u32 ordf(float v) { u32 u = __float_as_uint(v); return (u & 0x80000000u) ? ~u : (u | 0x80000000u); }
__device__ __forceinline__ float unordf(u32 k) { return __uint_as_float((k & 0x80000000u) ? (k ^ 0x80000000u) : ~k); }

template <int MT, int NT, int KT>
__device__ __forceinline__ void mma_nt(f32x4 (&acc)[MT][NT], const u16* A, int sa, const u16* B, int sb, int lane) {
  const int fr = lane & 15, fq = lane >> 4;
  const u16* pa = A + fr * sa + fq * 8;
  const u16* pb = B + fr * sb + fq * 8;
#pragma unroll
  for (int k = 0; k < KT; k++) {
    bf16x8 a[MT], b[NT];
#pragma unroll
    for (int m = 0; m < MT; m++) a[m] = *(const bf16x8*)(pa + m * 16 * sa + k * 32);
#pragma unroll
    for (int n = 0; n < NT; n++) b[n] = *(const bf16x8*)(pb + n * 16 * sb + k * 32);
#pragma unroll
    for (int m = 0; m < MT; m++)
#pragma unroll
      for (int n = 0; n < NT; n++) acc[m][n] = __builtin_amdgcn_mfma_f32_16x16x32_bf16(a[m], b[n], acc[m][n], 0, 0, 0);
  }
}

template <int MT, int NT>
__device__ __forceinline__ void mma_sw64(f32x4 (&acc)[MT][NT], const u16* A, const u16* B, int lane) {
  const int fr = lane & 15, fq = lane >> 4;
  const int cb = fq ^ ((fr >> 1) & 7);
  const u16* pa = A + fr * 64;
  const u16* pb = B + fr * 64;
#pragma unroll
  for (int k = 0; k < 2; k++) {
    const int co = (cb ^ (k * 4)) * 8;
    bf16x8 a[MT], b[NT];
#pragma unroll
    for (int m = 0; m < MT; m++) a[m] = *(const bf16x8*)(pa + m * 16 * 64 + co);
#pragma unroll
    for (int n = 0; n < NT; n++) b[n] = *(const bf16x8*)(pb + n * 16 * 64 + co);
#pragma unroll
    for (int m = 0; m < MT; m++)
#pragma unroll
      for (int n = 0; n < NT; n++) acc[m][n] = __builtin_amdgcn_mfma_f32_16x16x32_bf16(b[n], a[m], acc[m][n], 0, 0, 0);
  }
}

#define ST_DECL(S) uint4 S##a0, S##a1, S##a2, S##a3, S##b0, S##b1, S##b2, S##b3
#define ST_LOAD(S, PA, PB)                                                                                           \
  do {                                                                                                               \
    const char* pa_ = (const char*)(PA);                                                                             \
    const char* pb_ = (const char*)(PB);                                                                             \
    S##a0 = *(const uint4*)(pa_ + voffA); S##a1 = *(const uint4*)(pa_ + (size_t)64 * lda + voffA);                   \
    S##a2 = *(const uint4*)(pa_ + (size_t)128 * lda + voffA); S##a3 = *(const uint4*)(pa_ + (size_t)192 * lda + voffA); \
    S##b0 = *(const uint4*)(pb_ + voffB); S##b1 = *(const uint4*)(pb_ + (size_t)64 * ldb + voffB);                   \
    S##b2 = *(const uint4*)(pb_ + (size_t)128 * ldb + voffB); S##b3 = *(const uint4*)(pb_ + (size_t)192 * ldb + voffB); \
  } while (0)
#define ST_WRITE(S, WA, WB)                                                                                          \
  do {                                                                                                               \
    *(uint4*)(WA) = S##a0; *(uint4*)((WA) + 32 * 64) = S##a1; *(uint4*)((WA) + 64 * 64) = S##a2; *(uint4*)((WA) + 96 * 64) = S##a3; \
    *(uint4*)(WB) = S##b0; *(uint4*)((WB) + 32 * 64) = S##b1; *(uint4*)((WB) + 64 * 64) = S##b2; *(uint4*)((WB) + 96 * 64) = S##b3; \
  } while (0)

#define GLDS16(G, L) __builtin_amdgcn_global_load_lds((const void*)(G), (__attribute__((address_space(3))) void*)(L), 16, 0, 0)
__device__ __forceinline__ void gemm_acc_db(f32x4 (&acc)[4][4], const u16* __restrict__ A, int lda, const u16* __restrict__ B,
                                            int ldb, int K, char* smem) {
  const int t = threadIdx.x, lane = t & 63, w = t >> 6, wr = w >> 1, wc = w & 1;
  const int lr = t >> 3;
  const int gc = ((t & 7) ^ ((lr >> 1) & 7)) * 8;
  const u16* pa = A + (size_t)lr * lda + gc;
  const u16* pb = B + (size_t)lr * ldb + gc;
  char* l0 = smem + t * 16;
  u16* b0 = (u16*)smem;
  u16* b1 = b0 + 2 * 128 * 64;
#define ISSUE_TILE(KT, BUFOFF)                                                                     \
  do {                                                                                             \
    const u16* qa = pa + (KT) * 64;                                                                \
    const u16* qb = pb + (KT) * 64;                                                                \
    char* lb = l0 + (BUFOFF);                                                                      \
    GLDS16(qa, lb); GLDS16(qa + (size_t)32 * lda, lb + 4096);                                      \
    GLDS16(qa + (size_t)64 * lda, lb + 8192); GLDS16(qa + (size_t)96 * lda, lb + 12288);           \
    GLDS16(qb, lb + 16384); GLDS16(qb + (size_t)32 * ldb, lb + 16384 + 4096);                      \
    GLDS16(qb + (size_t)64 * ldb, lb + 16384 + 8192); GLDS16(qb + (size_t)96 * ldb, lb + 16384 + 12288); \
  } while (0)
  const int nk = K >> 6;
  __syncthreads();
  ISSUE_TILE(0, 0);
  if (blockIdx.x >= (gridDim.x >> 1)) __builtin_amdgcn_s_sleep(8);
#define KSTEP(BUF, ISSUE_STMT)                                                 \
  do {                                                                         \
    asm volatile("s_waitcnt vmcnt(0) lgkmcnt(0)" ::: "memory");    \
    __builtin_amdgcn_s_barrier();                                              \
    asm volatile("" ::: "memory");                                             \
    ISSUE_STMT;                                                                \
    mma_sw64<4, 4>(acc, BUF + wr * 64 * 64, BUF + 128 * 64 + wc * 64 * 64, lane); \
  } while (0)
  for (int kt = 0; kt + 2 < nk; kt += 2) {
    KSTEP(b0, ISSUE_TILE(kt + 1, 32768));
    KSTEP(b1, ISSUE_TILE(kt + 2, 0));
  }
  KSTEP(b0, ISSUE_TILE(nk - 1, 32768));
  KSTEP(b1, (void)0);
  asm volatile("s_waitcnt lgkmcnt(0)" ::: "memory");
#undef KSTEP
#undef ISSUE_TILE
}

struct TileIter {
  int i, step, lim, NT, xcd; bool swz;
  __device__ __forceinline__ TileIter(int nt_) {
    NT = nt_;
    swz = (gridDim.x & 7) == 0;
    if (swz) { xcd = blockIdx.x & 7; i = blockIdx.x >> 3; step = gridDim.x >> 3; lim = 16 * NT; }
    else { xcd = 0; i = blockIdx.x; step = gridDim.x; lim = 128 * NT; }
  }
  __device__ __forceinline__ bool next(int& mt, int& nt) {
    if (i >= lim) return false;
    if (swz) { int mg = i / (NT * 8), rem = i - mg * NT * 8; nt = rem >> 3; mt = xcd * 16 + mg * 8 + (rem & 7); }
    else { mt = i & 127; nt = i >> 7; }
    i += step;
    return true;
  }
};

__device__ __forceinline__ void zero_acc(f32x4 (&acc)[4][4]) {
#pragma unroll
  for (int m = 0; m < 4; m++)
#pragma unroll
    for (int n = 0; n < 4; n++) acc[m][n] = f32x4{0.f, 0.f, 0.f, 0.f};
}

__device__ __forceinline__ int winmap(int r) {
  if (r < 2048) { int tile = r >> 7, w = r & 127, grp = w >> 5; int ch = tile * 64 + (grp >> 1) * 32 + (w & 31); return ((grp & 1) ? 2048 : 0) + ch; }
  if (r < 3072) return r - 1024;
  if (r < 6176) return r;
  if (r < 6272) return -1;
  return r - 96;
}

__device__ __forceinline__ void tr_tile(const float* __restrict__ src, int ld, int col0, u16* __restrict__ dst, int r0, int k0, float* sT) {
  const int t = threadIdx.x;
  const int r = t >> 3, kc = t & 7;
  if (col0 < 0) {
    *(uint4*)(dst + (size_t)(r0 + r) * 1024 + k0 + kc * 8) = make_uint4(0, 0, 0, 0);
    return;
  }
  __syncthreads();
#pragma unroll
  for (int i = 0; i < 8; i++) {
    int k = (t >> 5) + i * 8, rr = t & 31;
    sT[k * 33 + rr] = src[(size_t)(k0 + k) * ld + col0 + rr];
  }
  __syncthreads();
  u32 wv[4];
#pragma unroll
  for (int j = 0; j < 4; j++) wv[j] = pack2(sT[(kc * 8 + 2 * j) * 33 + r], sT[(kc * 8 + 2 * j + 1) * 33 + r]);
  *(uint4*)(dst + (size_t)(r0 + r) * 1024 + k0 + kc * 8) = make_uint4(wv[0], wv[1], wv[2], wv[3]);
}

__device__ __forceinline__ void rms_row(const float* __restrict__ src, const float* __restrict__ g, u16* __restrict__ dst, int lane) {
  float4 v[4];
  float ss = 0.f;
#pragma unroll
  for (int i = 0; i < 4; i++) {
    v[i] = *(const float4*)(src + i * 256 + lane * 4);
    ss += v[i].x * v[i].x + v[i].y * v[i].y + v[i].z * v[i].z + v[i].w * v[i].w;
  }
  ss = wave_sum(ss);
  const float rstd = rsqrtf(ss * (1.f / 1024.f) + 1e-6f);
#pragma unroll
  for (int i = 0; i < 4; i++) {
    float4 gg = *(const float4*)(g + i * 256 + lane * 4);
    uint2 o;
    o.x = pack2(v[i].x * rstd * gg.x, v[i].y * rstd * gg.y);
    o.y = pack2(v[i].z * rstd * gg.z, v[i].w * rstd * gg.w);
    *(uint2*)(dst + i * 256 + lane * 4) = o;
  }
}

__device__ void phase0(const Params& p, char* smem) {
  float* sT = (float*)smem;
  const int t = threadIdx.x, lane = t & 63, w = t >> 6;
  u16* xn = (u16*)p.out;
  constexpr int J0 = 4160, J4 = J0 + 4096;
  for (int job = blockIdx.x; job < J4; job += gridDim.x) {
    if (job < J0) {
      int rb = job >> 4, kb = job & 15;
      tr_tile(p.w_in, 8224, winmap(rb * 32), p.WinT, rb * 32, kb * 64, sT);
    } else {
      int row = (job - J0) * 4 + w;
      rms_row(p.x + (size_t)row * 1024, p.norm1_g, xn + (size_t)row * 1024, lane);
    }
  }
}
__device__ void weights_late(const Params& p, char* smem) {
  float* sT = (float*)smem;
  const int t = threadIdx.x;
  constexpr int J1 = 1536, J2 = J1 + 1024, J3 = J2 + 128;
  for (int job = blockIdx.x; job < J3; job += gridDim.x) {
    if (job < J1) {
      int which = job >> 9, rb = (job & 511) >> 4, kb = job & 15;
      const float* src = which == 0 ? p.wa : (which == 1 ? p.wb : p.wo);
      u16* dst = which == 0 ? p.WaT : (which == 1 ? p.WbT : p.WoT);
      tr_tile(src, 1024, rb * 32, dst, rb * 32, kb * 64, sT);
    } else if (job < J2) {
      int j = job - J1, rb = j >> 4, kb = j & 15;
      tr_tile(p.wq, 2048, rb * 32, p.WqT, rb * 32, kb * 64, sT);
    } else {
      int j = job - J2;
      int base = (j * 256 + t) * 8;
      float4 a = *(const float4*)(p.keys + base), b = *(const float4*)(p.keys + base + 4);
      *(uint4*)(p.KeysB + base) = make_uint4(pack2(a.x, a.y), pack2(a.z, a.w), pack2(b.x, b.y), pack2(b.z, b.w));
    }
  }
}

__device__ void la_prep(const Params& p, char* smem) {
  float* sZ = (float*)smem;
  float* sPart = sZ + 1024;
  const int t = threadIdx.x, lane = t & 63, w = t >> 6, fr = lane & 15, fq = lane >> 4;
  const u16* xn = (const u16*)p.out;
  const u16* Wz = p.WinT + (size_t)6144 * 1024;
  u32* la16 = (u32*)p.R6;
  float uf0[16], uf1[16], ub0[16], ub1[16];
#pragma unroll
  for (int r = 0; r < 16; r++) {
    uf0[r] = p.dupf[r * 512 + 2 * t]; uf1[r] = p.dupf[r * 512 + 2 * t + 1];
    ub0[r] = p.dupb[r * 512 + 2 * t]; ub1[r] = p.dupb[r * 512 + 2 * t + 1];
  }
  const float bf0 = p.dbf[2 * t], bf1 = p.dbf[2 * t + 1], bb0 = p.dbb[2 * t], bb1 = p.dbb[2 * t + 1];
  for (int job = blockIdx.x; job < BT / 32; job += gridDim.x) {
    f32x4 az[2][2];
#pragma unroll
    for (int m = 0; m < 2; m++)
#pragma unroll
      for (int n = 0; n < 2; n++) az[m][n] = f32x4{0.f, 0.f, 0.f, 0.f};
    {
      const u16* ap = xn + (size_t)(job * 32 + fr) * 1024 + w * 256 + fq * 8;
      const u16* bp = Wz + (size_t)fr * 1024 + w * 256 + fq * 8;
#pragma unroll
      for (int ks = 0; ks < 8; ks++) {
        bf16x8 a0 = *(const bf16x8*)(ap + ks * 32), a1 = *(const bf16x8*)(ap + 16 * 1024 + ks * 32);
        bf16x8 b0 = *(const bf16x8*)(bp + ks * 32), b1 = *(const bf16x8*)(bp + 16 * 1024 + ks * 32);
        az[0][0] = __builtin_amdgcn_mfma_f32_16x16x32_bf16(a0, b0, az[0][0], 0, 0, 0);
        az[0][1] = __builtin_amdgcn_mfma_f32_16x16x32_bf16(a0, b1, az[0][1], 0, 0, 0);
        az[1][0] = __builtin_amdgcn_mfma_f32_16x16x32_bf16(a1, b0, az[1][0], 0, 0, 0);
        az[1][1] = __builtin_amdgcn_mfma_f32_16x16x32_bf16(a1, b1, az[1][1], 0, 0, 0);
      }
    }
    __syncthreads();
#pragma unroll
    for (int m = 0; m < 2; m++)
#pragma unroll
      for (int n = 0; n < 2; n++)
#pragma unroll
        for (int j = 0; j < 4; j++) sPart[w * 1024 + (m * 16 + fq * 4 + j) * 32 + n * 16 + fr] = az[m][n][j];
    __syncthreads();
    {
      const float4 q0 = *(const float4*)(sPart + t * 4), q1 = *(const float4*)(sPart + 1024 + t * 4), q2 = *(const float4*)(sPart + 2048 + t * 4),
                   q3 = *(const float4*)(sPart + 3072 + t * 4);
      *(float4*)(sZ + t * 4) = make_float4(q0.x + q1.x + q2.x + q3.x, q0.y + q1.y + q2.y + q3.y, q0.z + q1.z + q2.z + q3.z, q0.w + q1.w + q2.w + q3.w);
    }
    __syncthreads();
    for (int i = 0; i < 32; i++) {
      const float* zr = sZ + i * 32;
      float a0 = bf0, a1 = bf1, c0 = bb0, c1 = bb1;
#pragma unroll
      for (int r = 0; r < 16; r++) {
        const float zf = zr[r], zb = zr[16 + r];
        a0 += zf * uf0[r]; a1 += zf * uf1[r];
        c0 += zb * ub0[r]; c1 += zb * ub1[r];
      }
      const float l0 = (fminf(a0, 0.f) - __logf(1.f + __expf(-fabsf(a0)))) * 0.0625f;
      const float l1 = (fminf(a1, 0.f) - __logf(1.f + __expf(-fabsf(a1)))) * 0.0625f;
      const float m0 = (fminf(c0, 0.f) - __logf(1.f + __expf(-fabsf(c0)))) * 0.0625f;
      const float m1 = (fminf(c1, 0.f) - __logf(1.f + __expf(-fabsf(c1)))) * 0.0625f;
      const int tok = job * 32 + i;
      la16[(size_t)tok * 256 + t] = (u32)__builtin_bit_cast(unsigned short, (_Float16)l0) | ((u32)__builtin_bit_cast(unsigned short, (_Float16)l1) << 16);
      la16[(size_t)(BT + tok) * 256 + t] = (u32)__builtin_bit_cast(unsigned short, (_Float16)m0) | ((u32)__builtin_bit_cast(unsigned short, (_Float16)m1) << 16);
    }
  }
}

__device__ void phase1(const Params& p, char* smem) {
  u16* sA = (u16*)smem;
  u16* sB = sA + 128 * 64;
  const int t = threadIdx.x, lane = t & 63, w = t >> 6, wr = w >> 1, wc = w & 1, fr = lane & 15, fq = lane >> 4;
  const u16* xn = (const u16*)p.out;
  la_prep(p, smem);
  TileIter ti(48);
  int mt, nt;
  while (ti.next(mt, nt)) {
    f32x4 acc[4][4];
    zero_acc(acc);
    gemm_acc_db(acc, xn + (size_t)mt * 128 * 1024, 1024, p.WinT + (size_t)nt * 128 * 1024, 1024, 1024, smem);
    const int rowb = mt * 128 + wr * 64 + fr;
    if (nt < 16) {
#pragma unroll
      for (int m = 0; m < 4; m++)
#pragma unroll
        for (int n = 0; n < 2; n++) {
          const int ch = nt * 64 + wc * 32 + n * 16 + fq * 4;
          *(uint2*)(p.R1 + (size_t)(rowb + m * 16) * 1024 + ch) =
              make_uint2(pack2(acc[m][n][0] * acc[m][n + 2][0], acc[m][n][1] * acc[m][n + 2][1]),
                         pack2(acc[m][n][2] * acc[m][n + 2][2], acc[m][n][3] * acc[m][n + 2][3]));
        }
    } else {
      const int g = (nt - 16) >> 3;
      u16* dst = g == 0 ? p.R2 : (g == 1 ? p.R3 : (g == 2 ? p.R4 : p.R5));
      const int cb = ((nt - 16) & 7) * 128 + wc * 64;
      const float sc = (g == 1 && cb < 512) ? 0.08838834764831845f : 1.f;
#pragma unroll
      for (int m = 0; m < 4; m++)
#pragma unroll
        for (int n = 0; n < 4; n++)
          *(uint2*)(dst + (size_t)(rowb + m * 16) * 1024 + cb + n * 16 + fq * 4) =
              make_uint2(pack2(acc[m][n][0] * sc, acc[m][n][1] * sc), pack2(acc[m][n][2] * sc, acc[m][n][3] * sc));
    }
  }
}

#define XB_TMO      128
#define XB_XCNT(j)  (256  + 64 * (j))
#define XB_XSUB(j)  (1280 + 64 * (j))
#define XB_XGEN(j)  (2304 + 64 * (j))
#define XB_TOP      3328
#define XB_TOPGEN   3392
#define XCD_BAR_WORDS 3456
#define XB_SPIN_CAP (1u << 20)
#define LAS __attribute__((address_space(3)))
__device__ __forceinline__ unsigned xb_ld(unsigned* p) { return __hip_atomic_load(p, __ATOMIC_RELAXED, __HIP_MEMORY_SCOPE_AGENT); }
__device__ __forceinline__ unsigned xb_add(unsigned* p, unsigned v) { return __hip_atomic_fetch_add(p, v, __ATOMIC_RELAXED, __HIP_MEMORY_SCOPE_AGENT); }
__device__ __forceinline__ unsigned xb_xcc_id() { return (unsigned)__builtin_amdgcn_s_getreg((3 << 11) | 20) & 0xFu; }
#define XB_SPIN(cond, bar) do { unsigned _sp = 0; while (cond) { __builtin_amdgcn_s_sleep(1); \
    if ((++_sp & 255u) == 0u) { if (xb_ld(&(bar)[XB_TMO])) break; if (_sp > XB_SPIN_CAP) { atomicAdd(&(bar)[XB_TMO], 1u); break; } } } } while (0)
struct XcdBarrier { unsigned* bar; unsigned x; volatile LAS unsigned* st; };
__device__ __forceinline__ XcdBarrier xcd_barrier_post(unsigned* bar, volatile LAS unsigned* st) {
  XcdBarrier b; b.bar = bar; b.x = xb_xcc_id(); b.st = st;
  if (threadIdx.x == 0) (void)xb_add(&bar[XB_XCNT(b.x)], 1u);
  return b;
}
__device__ __forceinline__ void xcd_barrier_complete(unsigned* bar, unsigned x, unsigned& nloc, unsigned& nx) {
  const unsigned G = gridDim.x * gridDim.y * gridDim.z;
  unsigned sum, cnt, mine, sp = 0u;
  for (;;) {
    sum = 0u; cnt = 0u; mine = 0u;
#pragma unroll
    for (unsigned j = 0; j < 16; ++j) { const unsigned c = xb_ld(&bar[XB_XCNT(j)]); sum += c; cnt += (c > 0u) ? 1u : 0u; mine = (j == x) ? c : mine; }
    if (sum == G) break;
    __builtin_amdgcn_s_sleep(1);
    if ((++sp & 255u) == 0u) { if (xb_ld(&bar[XB_TMO])) break; if (sp > XB_SPIN_CAP) { atomicAdd(&bar[XB_TMO], 1u); break; } }
  }
  nloc = mine > 0u ? mine : 1u; nx = cnt > 0u ? cnt : 1u;
}
__device__ __forceinline__ void xcd_barrier(const XcdBarrier& b) {
  asm volatile("s_waitcnt vmcnt(0)" ::: "memory");
  __syncthreads();
  if (threadIdx.x == 0) {
    unsigned* bar = b.bar;
    __builtin_amdgcn_s_waitcnt(0);
    unsigned nloc = b.st[0], nx = b.st[1];
    if (nloc == 0u) { xcd_barrier_complete(bar, b.x, nloc, nx); b.st[0] = nloc; b.st[1] = nx; }
    const unsigned old = xb_add(&bar[XB_XSUB(b.x)], 1u);
    const unsigned gen = old / nloc;
    if (old + 1u == (gen + 1u) * nloc) {
      __builtin_amdgcn_fence(__ATOMIC_RELEASE, "agent");
      asm volatile("s_waitcnt vmcnt(0)" ::: "memory");
      const unsigned og = xb_add(&bar[XB_TOP], 1u);
      const unsigned tg = og / nx;
      if (og + 1u == (tg + 1u) * nx) xb_add(&bar[XB_TOPGEN], 1u);
      else XB_SPIN(xb_ld(&bar[XB_TOPGEN]) == tg, bar);
      __builtin_amdgcn_fence(__ATOMIC_ACQUIRE, "agent");
      xb_add(&bar[XB_XGEN(b.x)], 1u);
      asm volatile("s_waitcnt vmcnt(0)" ::: "memory");
    } else {
      XB_SPIN(xb_ld(&bar[XB_XGEN(b.x)]) == gen, bar);
      __builtin_amdgcn_fence(__ATOMIC_ACQUIRE, "agent");
      asm volatile("s_waitcnt vmcnt(0)" ::: "memory");
    }
  }
  __syncthreads();
}

__device__ void gla_item(const Params& p, int item, int pass, char* smem) {
  const int dvp = item & 1, seg = (item >> 1) & 15, dir = (item >> 5) & 1, h = (item >> 6) & 3, b = item >> 8;
  const int bhd = (b * 4 + h) * 2 + dir;
  u16* sQ = (u16*)smem;
  u16* sK = sQ + 64 * 136;
  u16* sKT = sK + 64 * 136;
  u16* sVT = sKT + 128 * 72;
  u16* sST = sVT + 64 * 72;
  float* sDec = (float*)(sST + 64 * 136);
  float* sTot = (float*)sVT;
  const int t = threadIdx.x, lane = t & 63, w = __builtin_amdgcn_readfirstlane(t >> 6), wr = w >> 1, wc = w & 1, fr = lane & 15, fq = lane >> 4;
  const int d0 = lane * 2;
  const u32* la16 = (const u32*)p.R6 + (size_t)dir * BT * 256 + h * 64 + lane;
  const u16* qk = p.R3;
  const u16* vv = p.R4;
  u16* obuf = dir ? p.R2 : p.R1;
  float* Lp = p.R7 + (size_t)(bhd * 16 + seg) * 32768 + (size_t)dvp * 128 * 128;

  f32x4 accS[2][2][4];
#pragma unroll
  for (int s = 0; s < 2; s++)
#pragma unroll
    for (int m = 0; m < 2; m++)
#pragma unroll
      for (int n = 0; n < 4; n++)
#pragma unroll
        for (int j = 0; j < 4; j++)
          accS[s][m][n][j] = (pass == 2) ? Lp[(s * 64 + wr * 32 + m * 16 + fq * 4 + j) * 128 + wc * 64 + n * 16 + fr] : 0.f;
  float dsum0 = 0.f, dsum1 = 0.f;

  for (int ci = 0; ci < 8; ci++) {
    const int c = seg * 8 + ci;
    __syncthreads();
    u32 qv[16], kv[16], lav[16], vreg[2][16];
#pragma unroll
    for (int ii = 0; ii < 16; ii++) {
      int f = c * 64 + w * 16 + ii;
      int pos = dir ? (SEQ - 1 - f) : f;
      size_t tokoff = (size_t)(b * SEQ + pos) * 1024;
      kv[ii] = *(const u32*)(qk + tokoff + 512 + h * 128 + d0);
      if (pass == 2) qv[ii] = *(const u32*)(qk + tokoff + h * 128 + d0);
      lav[ii] = la16[(size_t)(b * SEQ + pos) * 256];
      vreg[0][ii] = vv[tokoff + h * 256 + dvp * 128 + lane];
      vreg[1][ii] = vv[tokoff + h * 256 + dvp * 128 + 64 + lane];
    }
    float bl0[16], bl1[16];
    {
      float run0 = 0.f, run1 = 0.f;
#pragma unroll
      for (int ii = 0; ii < 16; ii++) {
        run0 += (float)__builtin_bit_cast(_Float16, (unsigned short)(lav[ii] & 0xffffu));
        run1 += (float)__builtin_bit_cast(_Float16, (unsigned short)(lav[ii] >> 16));
        bl0[ii] = run0; bl1[ii] = run1;
      }
      sTot[w * 128 + d0] = run0;
      sTot[w * 128 + d0 + 1] = run1;
    }
    __syncthreads();
    {
      float off0 = 0.f, off1 = 0.f, tot0 = 0.f, tot1 = 0.f;
#pragma unroll
      for (int ww = 0; ww < 4; ww++) {
        float a = sTot[ww * 128 + d0], bb = sTot[ww * 128 + d0 + 1];
        if (ww < w) { off0 += a; off1 += bb; }
        tot0 += a; tot1 += bb;
      }
      dsum0 += tot0; dsum1 += tot1;
      const float et0 = __expf(tot0), et1 = __expf(tot1);
      if (w == 0) { sDec[d0] = et0; sDec[d0 + 1] = et1; }
#pragma unroll
      for (int ii = 0; ii < 16; ii += 2) {
        float ke0[2], ke1[2];
#pragma unroll
        for (int s = 0; s < 2; s++) {
          const int i2 = ii + s;
          const float b0 = bl0[i2] + off0, b1 = bl1[i2] + off1;
          const float k0 = blo(kv[i2]), k1 = bhi(kv[i2]);
          const int i = w * 16 + i2;
          const float e0 = __expf(b0), e1 = __expf(b1);
          const float kt0 = k0 * __builtin_amdgcn_rcpf(e0), kt1 = k1 * __builtin_amdgcn_rcpf(e1);
          if (pass == 2) {
            *(u32*)(sQ + i * 136 + d0) = pack2(blo(qv[i2]) * e0, bhi(qv[i2]) * e1);
            *(u32*)(sK + i * 136 + d0) = pack2(kt0, kt1);
          }
          ke0[s] = kt0 * et0;
          ke1[s] = kt1 * et1;
        }
        *(u32*)(sKT + d0 * 72 + w * 16 + ii) = pack2(ke0[0], ke0[1]);
        *(u32*)(sKT + (d0 + 1) * 72 + w * 16 + ii) = pack2(ke1[0], ke1[1]);
      }
    }
    __syncthreads();
    u16* sP = sK;
    if (pass == 2) {
      f32x4 accP[2][2];
#pragma unroll
      for (int m = 0; m < 2; m++)
#pragma unroll
        for (int n = 0; n < 2; n++) accP[m][n] = f32x4{0.f, 0.f, 0.f, 0.f};
      mma_nt<2, 2, 4>(accP, sQ + wr * 32 * 136, 136, sK + wc * 32 * 136, 136, lane);
      __syncthreads();
#pragma unroll
      for (int m = 0; m < 2; m++)
#pragma unroll
        for (int n = 0; n < 2; n++)
#pragma unroll
          for (int j = 0; j < 4; j++) {
            int i = wr * 32 + m * 16 + fq * 4 + j, jj = wc * 32 + n * 16 + fr;
            sP[i * 72 + jj] = (i >= jj) ? f2b(accP[m][n][j]) : (u16)0;
          }
    }
#pragma unroll
    for (int s = 0; s < 2; s++) {
      if (pass == 2) {
#pragma unroll
        for (int m = 0; m < 2; m++)
#pragma unroll
          for (int n = 0; n < 4; n++)
#pragma unroll
            for (int j = 0; j < 4; j++) sST[(wr * 32 + m * 16 + fq * 4 + j) * 136 + wc * 64 + n * 16 + fr] = f2b(accS[s][m][n][j]);
      }
      {
        uint4 v0 = make_uint4(vreg[s][0] | (vreg[s][1] << 16), vreg[s][2] | (vreg[s][3] << 16), vreg[s][4] | (vreg[s][5] << 16),
                              vreg[s][6] | (vreg[s][7] << 16));
        uint4 v1 = make_uint4(vreg[s][8] | (vreg[s][9] << 16), vreg[s][10] | (vreg[s][11] << 16), vreg[s][12] | (vreg[s][13] << 16),
                              vreg[s][14] | (vreg[s][15] << 16));
        *(uint4*)(sVT + lane * 72 + w * 16) = v0;
        *(uint4*)(sVT + lane * 72 + w * 16 + 8) = v1;
      }
      __syncthreads();
      if (pass == 2) {
        f32x4 accO[2][2];
#pragma unroll
        for (int m = 0; m < 2; m++)
#pragma unroll
          for (int n = 0; n < 2; n++) accO[m][n] = f32x4{0.f, 0.f, 0.f, 0.f};
        mma_nt<2, 2, 4>(accO, sQ + wr * 32 * 136, 136, sST + wc * 32 * 136, 136, lane);
        mma_nt<2, 2, 2>(accO, sP + wr * 32 * 72, 72, sVT + wc * 32 * 72, 72, lane);
#pragma unroll
        for (int m = 0; m < 2; m++)
#pragma unroll
          for (int j = 0; j < 4; j++) {
            int i = wr * 32 + m * 16 + fq * 4 + j;
            int f = c * 64 + i;
            int pos = dir ? (SEQ - 1 - f) : f;
            size_t o = (size_t)(b * SEQ + pos) * 1024 + h * 256 + dvp * 128 + s * 64 + wc * 32 + fr;
#pragma unroll
            for (int n = 0; n < 2; n++) obuf[o + n * 16] = f2b(accO[m][n][j]);
          }
      }
#pragma unroll
      for (int n = 0; n < 4; n++) {
        float dc = sDec[wc * 64 + n * 16 + fr];
#pragma unroll
        for (int m = 0; m < 2; m++)
#pragma unroll
          for (int j = 0; j < 4; j++) accS[s][m][n][j] *= dc;
      }
      mma_nt<2, 4, 2>(accS[s], sVT + wr * 32 * 72, 72, sKT + wc * 64 * 72, 72, lane);
      if (s == 0) __syncthreads();
    }
  }
  if (pass == 1) {
#pragma unroll
    for (int s = 0; s < 2; s++)
#pragma unroll
      for (int m = 0; m < 2; m++)
#pragma unroll
        for (int n = 0; n < 4; n++)
#pragma unroll
          for (int j = 0; j < 4; j++) Lp[(s * 64 + wr * 32 + m * 16 + fq * 4 + j) * 128 + wc * 64 + n * 16 + fr] = accS[s][m][n][j];
    if (dvp == 0 && w == 0) {
      p.Dd[(bhd * 16 + seg) * 128 + d0] = __expf(dsum0);
      p.Dd[(bhd * 16 + seg) * 128 + d0 + 1] = __expf(dsum1);
    }
  }
}

__device__ void phase2(const Params& p, char* smem, const XcdBarrier& xb) {
  const int t = threadIdx.x;
  (void)xb;
  u16* ya = (u16*)p.out + (size_t)BT * 1024;
  for (int job = blockIdx.x; job < 512 + 2048; job += gridDim.x) {
    if (job < 512) {
      gla_item(p, job, 1, smem);
    } else {
      const int j = job - 512;
      const int ch = (t & 127) * 8;
      float w0[8], w1[8], w2[8], cb[8];
#pragma unroll
      for (int e = 0; e < 8; e++) { w0[e] = p.conv_w[ch + e]; w1[e] = p.conv_w[1024 + ch + e]; w2[e] = p.conv_w[2048 + ch + e]; cb[e] = p.conv_b[ch + e]; }
#pragma unroll
      for (int it = 0; it < 4; it++) {
        const int tok = j * 8 + it * 2 + (t >> 7);
        const int pos = tok & (SEQ - 1);
        const size_t o = (size_t)tok * 1024 + ch;
        uint4 pc = *(const uint4*)(p.R1 + o);
        uint4 pp = make_uint4(0, 0, 0, 0), pn = make_uint4(0, 0, 0, 0);
        if (pos > 0) pp = *(const uint4*)(p.R1 + o - 1024);
        if (pos < SEQ - 1) pn = *(const uint4*)(p.R1 + o + 1024);
        uint4 bb = *(const uint4*)(p.R2 + o);
        const u32 pcs[4] = {pc.x, pc.y, pc.z, pc.w}, pps[4] = {pp.x, pp.y, pp.z, pp.w}, pns[4] = {pn.x, pn.y, pn.z, pn.w},
                  bbs[4] = {bb.x, bb.y, bb.z, bb.w};
        u32 ov[4];
#pragma unroll
        for (int q = 0; q < 4; q++) {
          float y0 = cb[2 * q] + w0[2 * q] * blo(pps[q]) + w1[2 * q] * blo(pcs[q]) + w2[2 * q] * blo(pns[q]);
          float y1 = cb[2 * q + 1] + w0[2 * q + 1] * bhi(pps[q]) + w1[2 * q + 1] * bhi(pcs[q]) + w2[2 * q + 1] * bhi(pns[q]);
          ov[q] = pack2(blo(bbs[q]) * y0, bhi(bbs[q]) * y1);
        }
        *(uint4*)(ya + o) = make_uint4(ov[0], ov[1], ov[2], ov[3]);
      }
    }
  }
}

__device__ void phase3(const Params& p) {
  for (int gid = blockIdx.x * 256 + threadIdx.x; gid < 16 * 32768; gid += gridDim.x * 256) {
    const int bhd = gid >> 15, e = gid & 32767, dk = e & 127;
    float carry = 0.f;
    for (int s = 0; s < 16; s++) {
      float* lp = p.R7 + (size_t)(bhd * 16 + s) * 32768 + e;
      float tmp = *lp;
      *lp = carry;
      carry = p.Dd[(bhd * 16 + s) * 128 + dk] * carry + tmp;
    }
  }
}

__device__ void phase5(const Params& p) {
  const int t = threadIdx.x, lane = t & 63, w = t >> 6;
  for (int it = blockIdx.x * 4 + w; it < BT * 4; it += gridDim.x * 4) {
    const int tok = it >> 2, h = it & 3;
    const size_t o = (size_t)tok * 1024 + h * 256 + lane * 4;
    uint2 a = *(const uint2*)(p.R1 + o), b = *(const uint2*)(p.R2 + o), r = *(const uint2*)(p.R5 + o);
    float ov[4] = {blo(a.x) + blo(b.x), bhi(a.x) + bhi(b.x), blo(a.y) + blo(b.y), bhi(a.y) + bhi(b.y)};
    float rv[4] = {blo(r.x), bhi(r.x), blo(r.y), bhi(r.y)};
    float ss = ov[0] * ov[0] + ov[1] * ov[1] + ov[2] * ov[2] + ov[3] * ov[3];
    ss = wave_sum(ss);
    const float rstd = rsqrtf(ss * (1.f / 256.f) + 1e-6f);
    float4 g = *(const float4*)(p.gng + h * 256 + lane * 4);
    const float gv[4] = {g.x, g.y, g.z, g.w};
    float res[4];
#pragma unroll
    for (int e = 0; e < 4; e++) res[e] = ov[e] * rstd * gv[e] * (rv[e] * sigmoidf_(rv[e]));
    uint2 out;
    out.x = pack2(res[0], res[1]);
    out.y = pack2(res[2], res[3]);
    *(uint2*)(p.R6 + o) = out;
  }
}

__device__ void phase6(const Params& p, char* smem) {
  const int t = threadIdx.x, lane = t & 63, w = t >> 6, wr = w >> 1, wc = w & 1, fr = lane & 15, fq = lane >> 4;
  const u16* xn = (const u16*)p.out;
  const u16* ya = xn + (size_t)BT * 1024;
  uint4* sG = (uint4*)((char*)p.R2 + (size_t)blockIdx.x * 65536 + t * 256);
  uint4* sH = sG + 8;
  TileIter ti(8);
  int mt, nt;
  while (ti.next(mt, nt)) {
    const int colb = nt * 128 + wc * 64 + fq * 4;
    f32x4 acc[4][4];
    zero_acc(acc);
    gemm_acc_db(acc, xn + (size_t)mt * 128 * 1024, 1024, p.WinT + (size_t)(6272 + nt * 128) * 1024, 1024, 1024, smem);
    {
      float4 gb[4];
#pragma unroll
      for (int n = 0; n < 4; n++) gb[n] = *(const float4*)(p.gbias + colb + n * 16);
#pragma unroll
      for (int m = 0; m < 4; m++)
#pragma unroll
        for (int h = 0; h < 2; h++)
          sG[m * 2 + h] = make_uint4(pack2(sigmoidf_(acc[m][2 * h][0] + gb[2 * h].x), sigmoidf_(acc[m][2 * h][1] + gb[2 * h].y)),
                                     pack2(sigmoidf_(acc[m][2 * h][2] + gb[2 * h].z), sigmoidf_(acc[m][2 * h][3] + gb[2 * h].w)),
                                     pack2(sigmoidf_(acc[m][2 * h + 1][0] + gb[2 * h + 1].x), sigmoidf_(acc[m][2 * h + 1][1] + gb[2 * h + 1].y)),
                                     pack2(sigmoidf_(acc[m][2 * h + 1][2] + gb[2 * h + 1].z), sigmoidf_(acc[m][2 * h + 1][3] + gb[2 * h + 1].w)));
    }
    zero_acc(acc);
    gemm_acc_db(acc, ya + (size_t)mt * 128 * 1024, 1024, p.WaT + (size_t)nt * 128 * 1024, 1024, 1024, smem);
#pragma unroll
    for (int m = 0; m < 4; m++)
#pragma unroll
      for (int h = 0; h < 2; h++) {
        const uint4 g = sG[m * 2 + h];
        sG[m * 2 + h] = make_uint4(pack2(acc[m][2 * h][0] * blo(g.x), acc[m][2 * h][1] * bhi(g.x)),
                                   pack2(acc[m][2 * h][2] * blo(g.y), acc[m][2 * h][3] * bhi(g.y)),
                                   pack2(acc[m][2 * h + 1][0] * blo(g.z), acc[m][2 * h + 1][1] * bhi(g.z)),
                                   pack2(acc[m][2 * h + 1][2] * blo(g.w), acc[m][2 * h + 1][3] * bhi(g.w)));
      }
    zero_acc(acc);
    gemm_acc_db(acc, p.R6 + (size_t)mt * 128 * 1024, 1024, p.WbT + (size_t)nt * 128 * 1024, 1024, 1024, smem);
#pragma unroll
    for (int m = 0; m < 4; m++)
#pragma unroll
      for (int h = 0; h < 2; h++)
        sH[m * 2 + h] = make_uint4(pack2(acc[m][2 * h][0], acc[m][2 * h][1]), pack2(acc[m][2 * h][2], acc[m][2 * h][3]),
                                   pack2(acc[m][2 * h + 1][0], acc[m][2 * h + 1][1]), pack2(acc[m][2 * h + 1][2], acc[m][2 * h + 1][3]));
    zero_acc(acc);
    gemm_acc_db(acc, xn + (size_t)mt * 128 * 1024, 1024, p.WinT + (size_t)(6272 + 1024 + nt * 128) * 1024, 1024, 1024, smem);
    const int rowb = mt * 128 + wr * 64 + fr;
    {
      float4 gb[4];
#pragma unroll
      for (int n = 0; n < 4; n++) gb[n] = *(const float4*)(p.gbias + 1024 + colb + n * 16);
#pragma unroll
      for (int m = 0; m < 4; m++)
#pragma unroll
        for (int h = 0; h < 2; h++) {
          const uint4 a = sG[m * 2 + h], b = sH[m * 2 + h];
          const u32 av[4] = {a.x, a.y, a.z, a.w}, bv[4] = {b.x, b.y, b.z, b.w};
#pragma unroll
          for (int nn = 0; nn < 2; nn++) {
            const int n = 2 * h + nn;
            float r0 = blo(av[nn * 2]) + blo(bv[nn * 2]) * sigmoidf_(acc[m][n][0] + gb[n].x);
            float r1 = bhi(av[nn * 2]) + bhi(bv[nn * 2]) * sigmoidf_(acc[m][n][1] + gb[n].y);
            float r2 = blo(av[nn * 2 + 1]) + blo(bv[nn * 2 + 1]) * sigmoidf_(acc[m][n][2] + gb[n].z);
            float r3 = bhi(av[nn * 2 + 1]) + bhi(bv[nn * 2 + 1]) * sigmoidf_(acc[m][n][3] + gb[n].w);
            *(uint2*)(p.R1 + (size_t)(rowb + m * 16) * 1024 + colb + n * 16) = make_uint2(pack2(r0, r1), pack2(r2, r3));
          }
        }
    }
  }
}

__device__ void phase7(const Params& p, char* smem) {
  u16* sA = (u16*)smem;
  u16* sB = sA + 128 * 64;
  const int t = threadIdx.x, lane = t & 63, w = t >> 6, wr = w >> 1, wc = w & 1, fr = lane & 15, fq = lane >> 4;
  float* x1 = (float*)p.R2;
  TileIter ti(8);
  int mt, nt;
  while (ti.next(mt, nt)) {
    f32x4 acc[4][4];
    zero_acc(acc);
    gemm_acc_db(acc, p.R1 + (size_t)mt * 128 * 1024, 1024, p.WoT + (size_t)nt * 128 * 1024, 1024, 1024, smem);
    const int rowb = mt * 128 + wr * 64 + fr;
    const int colb = nt * 128 + wc * 64 + fq * 4;
#pragma unroll
    for (int m = 0; m < 4; m++)
#pragma unroll
      for (int n = 0; n < 4; n++) {
        const size_t o = (size_t)(rowb + m * 16) * 1024 + colb + n * 16;
        const float4 xv = *(const float4*)(p.x + o);
        *(float4*)(x1 + o) = make_float4(xv.x + acc[m][n][0], xv.y + acc[m][n][1], xv.z + acc[m][n][2], xv.w + acc[m][n][3]);
      }
  }
}

constexpr float U_SCALE = 256.f, V_SCALE = 64.f;
__device__ __forceinline__ u32 enc_fp8x4(float a, float b, float c, float d) {
  int w = __builtin_amdgcn_cvt_pk_fp8_f32(a, b, 0, false);
  w = __builtin_amdgcn_cvt_pk_fp8_f32(c, d, w, true);
  return (u32)w;
}
__device__ __forceinline__ void table_convert_job(const Params& p, int j, int t) {
  unsigned char* Tb = (unsigned char*)p.R5;
  const float* src = (j < 4096) ? p.pu : p.pv;
  const float sc = (j < 4096) ? U_SCALE : V_SCALE;
  size_t base = (size_t)(j & 4095) * 4096 + t * 16;
  unsigned char* slot = Tb + (base >> 10) * 2048 + ((j < 4096) ? 0 : 1024) + (base & 1023);
  float4 a = *(const float4*)(src + base), b = *(const float4*)(src + base + 4), c = *(const float4*)(src + base + 8),
         d = *(const float4*)(src + base + 12);
  *(uint4*)slot = make_uint4(enc_fp8x4(a.x * sc, a.y * sc, a.z * sc, a.w * sc), enc_fp8x4(b.x * sc, b.y * sc, b.z * sc, b.w * sc),
                                     enc_fp8x4(c.x * sc, c.y * sc, c.z * sc, c.w * sc), enc_fp8x4(d.x * sc, d.y * sc, d.z * sc, d.w * sc));
}
__device__ void phase8(const Params& p) {
  const int t = threadIdx.x, lane = t & 63, w = t >> 6;
  const float* x1 = (const float*)p.R2;
  for (int job = blockIdx.x; job < 4096; job += gridDim.x) {
    int row = job * 4 + w;
    rms_row(x1 + (size_t)row * 1024, p.norm2_g, p.R4 + (size_t)row * 1024, lane);
  }
}

__device__ void phase9(const Params& p, char* smem) {
  u16* sA = (u16*)smem;
  u16* sB = sA + 128 * 64;
  const int t = threadIdx.x, lane = t & 63, w = t >> 6, wr = w >> 1, wc = w & 1, fr = lane & 15, fq = lane >> 4;
  u16* q = (u16*)p.out;
  TileIter ti(16);
  int mt, nt;
  while (ti.next(mt, nt)) {
    f32x4 acc[4][4];
    zero_acc(acc);
    gemm_acc_db(acc, p.R4 + (size_t)mt * 128 * 1024, 1024, p.WqT + (size_t)nt * 128 * 1024, 1024, 1024, smem);
    const int rowb = mt * 128 + wr * 64 + fr;
    const int colb = nt * 128 + wc * 64 + fq * 4;
#pragma unroll
    for (int m = 0; m < 4; m++)
#pragma unroll
      for (int n = 0; n < 4; n++)
        *(uint2*)(q + (size_t)(rowb + m * 16) * 2048 + colb + n * 16) = make_uint2(pack2(acc[m][n][0], acc[m][n][1]), pack2(acc[m][n][2], acc[m][n][3]));
#pragma unroll 1
    for (int r = 0; r < 4; r++) table_convert_job(p, (mt * 16 + nt) * 4 + r, t);
  }
}

__device__ __forceinline__ void select16q(u32* rowbase, int part, u32 (&tk)[16], unsigned char* idxp) {
  u32* myp = rowbase + part * 32;
#pragma unroll
  for (int it = 0; it < 16; it++) {
    u32 m = 0;
#pragma unroll
    for (int c = 0; c < 8; c++) {
      uint4 kk = *(const uint4*)(myp + c * 4);
      m = max(m, max(max(kk.x, kk.y), max(kk.z, kk.w)));
    }
    m = max(m, (u32)__shfl_xor((int)m, 1));
    m = max(m, (u32)__shfl_xor((int)m, 2));
    tk[it] = m;
    const int idx = 127 - (int)(m & 127u);
    if ((idx >> 5) == part) { rowbase[idx] = 0; idxp[it] = (unsigned char)idx; }
  }
}

__device__ void phase10(const Params& p, char* smem) {
  u16* sKeys = (u16*)smem;
  u32* sSc = (u32*)(smem + 128 * 136 * 2);
  unsigned char* sIdx = (unsigned char*)(smem + 128 * 136 * 2 + 64 * 132 * 4);
  const int t = threadIdx.x, lane = t & 63, w = t >> 6, fr = lane & 15, fq = lane >> 4;
  const int rl = lane >> 2, part = lane & 3, row = w * 16 + rl;
  const u16* q = (const u16*)p.out;
  int* experts = (int*)p.R7;
  float* gates = p.R7 + (size_t)BT * 128;
#define P10_DECL(S) uint4 S##k0, S##k1, S##k2, S##k3, S##k4, S##k5, S##k6, S##k7; bf16x8 S##q0, S##q1, S##q2, S##q3
#define P10_LOAD(S, ITEM, PP)                                                                               \
  do {                                                                                                      \
    const int it_ = ((ITEM) < 256 * 8) ? (ITEM) : (int)blockIdx.x;                                          \
    const int tt_ = it_ >> 3, h_ = it_ & 7;                                                                 \
    const u16* ks_ = p.KeysB + (size_t)(h_ * 2 + (PP)) * 128 * 128 + (t >> 4) * 128 + (t & 15) * 8;         \
    S##k0 = *(const uint4*)(ks_); S##k1 = *(const uint4*)(ks_ + 16 * 128); S##k2 = *(const uint4*)(ks_ + 32 * 128);   \
    S##k3 = *(const uint4*)(ks_ + 48 * 128); S##k4 = *(const uint4*)(ks_ + 64 * 128); S##k5 = *(const uint4*)(ks_ + 80 * 128); \
    S##k6 = *(const uint4*)(ks_ + 96 * 128); S##k7 = *(const uint4*)(ks_ + 112 * 128);                      \
    const u16* qp_ = q + (size_t)(tt_ * 64 + w * 16 + fr) * 2048 + h_ * 256 + (PP) * 128 + fq * 8;          \
    S##q0 = *(const bf16x8*)(qp_); S##q1 = *(const bf16x8*)(qp_ + 32); S##q2 = *(const bf16x8*)(qp_ + 64);  \
    S##q3 = *(const bf16x8*)(qp_ + 96);                                                                     \
  } while (0)
#define P10_MFMA_K(QK, KI)                                                                                  \
  _Pragma("unroll") for (int n_ = 0; n_ < 8; n_++) {                                                        \
    bf16x8 bv_ = *(const bf16x8*)(sKeys + (n_ * 16 + fr) * 136 + (KI) * 32 + fq * 8);                       \
    acc_[n_] = __builtin_amdgcn_mfma_f32_16x16x32_bf16(QK, bv_, acc_[n_], 0, 0, 0);                         \
  }
#define P10_SCORE(S)                                                                                        \
  do {                                                                                                      \
    __syncthreads();                                                                                        \
    u16* kd_ = sKeys + (t >> 4) * 136 + (t & 15) * 8;                                                       \
    *(uint4*)(kd_) = S##k0; *(uint4*)(kd_ + 16 * 136) = S##k1; *(uint4*)(kd_ + 32 * 136) = S##k2;           \
    *(uint4*)(kd_ + 48 * 136) = S##k3; *(uint4*)(kd_ + 64 * 136) = S##k4; *(uint4*)(kd_ + 80 * 136) = S##k5; \
    *(uint4*)(kd_ + 96 * 136) = S##k6; *(uint4*)(kd_ + 112 * 136) = S##k7;                                  \
    __syncthreads();                                                                                        \
    f32x4 acc_[8];                                                                                          \
    _Pragma("unroll") for (int n_ = 0; n_ < 8; n_++) acc_[n_] = f32x4{0.f, 0.f, 0.f, 0.f};                  \
    P10_MFMA_K(S##q0, 0) P10_MFMA_K(S##q1, 1) P10_MFMA_K(S##q2, 2) P10_MFMA_K(S##q3, 3)                     \
    _Pragma("unroll") for (int n_ = 0; n_ < 8; n_++)                                                        \
      _Pragma("unroll") for (int j_ = 0; j_ < 4; j_++) {                                                    \
        int r_ = w * 16 + fq * 4 + j_, col_ = n_ * 16 + fr;                                                 \
        sSc[r_ * 132 + col_] = (ordf(acc_[n_][j_]) & ~127u) | (u32)(127 - col_);                            \
      }                                                                                                     \
    __syncthreads();                                                                                        \
  } while (0)
  P10_DECL(sa);
  P10_DECL(sb);
  P10_LOAD(sa, (int)blockIdx.x, 0);
  for (int item = blockIdx.x; item < 256 * 8; item += gridDim.x) {
    const int tt = item >> 3, h = item & 7;
    u32 ta[16], tb[16];
    P10_SCORE(sa);
    P10_LOAD(sb, item, 1);
    select16q(sSc + row * 132, part, ta, sIdx + row * 32);
    P10_SCORE(sb);
    P10_LOAD(sa, item + (int)gridDim.x, 0);
    select16q(sSc + row * 132, part, tb, sIdx + row * 32 + 16);
    __syncthreads();
    {
      float fa[4], fb[16];
#pragma unroll
      for (int r = 0; r < 4; r++) {
        const u32 s0 = ta[4 * r], s1 = ta[4 * r + 1], s2 = ta[4 * r + 2], s3 = ta[4 * r + 3];
        const u32 sel = part == 0 ? s0 : (part == 1 ? s1 : (part == 2 ? s2 : s3));
        fa[r] = unordf(sel & ~127u);
      }
#pragma unroll
      for (int j = 0; j < 16; j++) fb[j] = unordf(tb[j] & ~127u);
      constexpr int NJ[4] = {16, 3, 1, 1};
      u32 cand[4][16];
#pragma unroll
      for (int r = 0; r < 4; r++) {
        const int irow = part + 4 * r;
        const int jlim = 16 / (irow + 1);
#pragma unroll
        for (int j = 0; j < 16; j++)
          if (j < NJ[r]) cand[r][j] = (j < jlim) ? ((ordf(fa[r] + fb[j]) & ~255u) | (u32)(255 - (irow * 16 + j))) : 0u;
      }
      const int tok = tt * 64 + row;
      float sv[16];
      int ev[16];
#pragma unroll
      for (int it = 0; it < 16; it++) {
        u32 m = 0;
#pragma unroll
        for (int r = 0; r < 4; r++)
#pragma unroll
          for (int j = 0; j < 16; j++)
            if (j < NJ[r]) m = max(m, cand[r][j]);
        m = max(m, (u32)__shfl_xor((int)m, 1));
        m = max(m, (u32)__shfl_xor((int)m, 2));
#pragma unroll
        for (int r = 0; r < 4; r++)
#pragma unroll
          for (int j = 0; j < 16; j++)
            if (j < NJ[r]) cand[r][j] = (cand[r][j] == m) ? 0u : cand[r][j];
        const int c = 255 - (int)(m & 255u);
        const int i1 = sIdx[row * 32 + (c >> 4)], i2 = sIdx[row * 32 + 16 + (c & 15)];
        ev[it] = i1 * 128 + i2;
        sv[it] = unordf(m & ~255u);
      }
      const float mx = sv[0];
      float sum = 0.f;
#pragma unroll
      for (int it = 0; it < 16; it++) { sv[it] = __expf(sv[it] - mx); sum += sv[it]; }
      const float inv = 1.f / sum;
#pragma unroll
      for (int g = 0; g < 4; g++) {
        if (part == g) {
          *(int4*)(experts + (size_t)tok * 128 + h * 16 + g * 4) = make_int4(ev[g * 4], ev[g * 4 + 1], ev[g * 4 + 2], ev[g * 4 + 3]);
          *(float4*)(gates + (size_t)tok * 128 + h * 16 + g * 4) =
              make_float4(sv[g * 4] * inv, sv[g * 4 + 1] * inv, sv[g * 4 + 2] * inv, sv[g * 4 + 3] * inv);
        }
      }
    }
  }
}

#undef P10_LOAD
#undef P10_SCORE
#undef P10_MFMA_K
#undef P10_DECL
typedef float f32x2 __attribute__((ext_vector_type(2)));
__device__ __forceinline__ void dec16(const uint4& q, float (&o)[16]) {
  const u32 ws_[4] = {q.x, q.y, q.z, q.w};
#pragma unroll
  for (int i = 0; i < 4; i++) {
    f32x2 lo = __builtin_amdgcn_cvt_pk_f32_fp8((int)ws_[i], false);
    f32x2 hi = __builtin_amdgcn_cvt_pk_f32_fp8((int)ws_[i], true);
    o[i * 4 + 0] = lo[0]; o[i * 4 + 1] = lo[1]; o[i * 4 + 2] = hi[0]; o[i * 4 + 3] = hi[1];
  }
}
__device__ __forceinline__ void peer_load8(uint4 (&U)[8], uint4 (&V)[8], const unsigned char* Ub, const unsigned char* Vb, int ev, int l0,
                                           int lane) {
#pragma unroll
  for (int u = 0; u < 8; u++) {
    const int e = __builtin_amdgcn_readlane(ev, l0 + u);
    U[u] = *(const uint4*)(Ub + (size_t)e * 2048 + lane * 16);
    V[u] = *(const uint4*)(Vb + (size_t)e * 2048 + lane * 16);
  }
}
__device__ __forceinline__ void peer_proc8(const uint4 (&U)[8], const uint4 (&V)[8], const f32x2 (&xp)[8], f32x2 (&accp)[8], float gate_lane,
                                           int lane) {
  float d[8];
#pragma unroll
  for (int u = 0; u < 8; u++) {
    const u32 ws_[4] = {U[u].x, U[u].y, U[u].z, U[u].w};
    f32x2 s = {0.f, 0.f};
#pragma unroll
    for (int q = 0; q < 4; q++) {
      s += xp[2 * q] * __builtin_amdgcn_cvt_pk_f32_fp8((int)ws_[q], false);
      s += xp[2 * q + 1] * __builtin_amdgcn_cvt_pk_f32_fp8((int)ws_[q], true);
    }
    d[u] = s[0] + s[1];
  }
  {
    const bool b4 = (lane & 4) != 0, b2 = (lane & 2) != 0, b1 = (lane & 1) != 0;
#pragma unroll
    for (int i = 0; i < 4; i++) {
      const float send = b4 ? d[i] : d[i + 4], keep = b4 ? d[i + 4] : d[i];
      d[i] = keep + __shfl_xor(send, 4);
    }
#pragma unroll
    for (int i = 0; i < 2; i++) {
      const float send = b2 ? d[i] : d[i + 2], keep = b2 ? d[i + 2] : d[i];
      d[i] = keep + __shfl_xor(send, 2);
    }
    {
      const float send = b1 ? d[0] : d[1], keep = b1 ? d[1] : d[0];
      d[0] = keep + __shfl_xor(send, 1);
    }
    d[0] += __shfl_xor(d[0], 8);
    d[0] += __shfl_xor(d[0], 16);
    d[0] += __shfl_xor(d[0], 32);
  }
  const float dd = d[0] * (1.f / U_SCALE);
  const float hd = 0.5f * dd * (1.f + erff(dd * 0.70710678118654752f));
  const int cl = __float_as_int(hd * gate_lane * (1.f / V_SCALE));
#pragma unroll
  for (int u = 0; u < 8; u++) {
    const float c = __int_as_float(__builtin_amdgcn_readlane(cl, u));
    const f32x2 c2 = {c, c};
    const u32 ws_[4] = {V[u].x, V[u].y, V[u].z, V[u].w};
#pragma unroll
    for (int q = 0; q < 4; q++) {
      accp[2 * q] += c2 * __builtin_amdgcn_cvt_pk_f32_fp8((int)ws_[q], false);
      accp[2 * q + 1] += c2 * __builtin_amdgcn_cvt_pk_f32_fp8((int)ws_[q], true);
    }
  }
}
__device__ __forceinline__ float dot16_fp8(const f32x2 (&xp)[8], const uint4& q) {
  const u32 ws_[4] = {q.x, q.y, q.z, q.w};
  f32x2 s = {0.f, 0.f};
#pragma unroll
  for (int i = 0; i < 4; i++) {
    s += xp[2 * i] * __builtin_amdgcn_cvt_pk_f32_fp8((int)ws_[i], false);
    s += xp[2 * i + 1] * __builtin_amdgcn_cvt_pk_f32_fp8((int)ws_[i], true);
  }
  return s[0] + s[1];
}
__device__ __forceinline__ void pe_load_tab(const unsigned char* Tb, unsigned loff, int e0, int e1, int g, uint4 (&U)[16]) {
#pragma unroll
  for (int kb = 0; kb < 16; kb++) {
    const int e = __shfl((kb < 8) ? e0 : e1, (kb & 7) * 8 + g);
    U[kb] = *(const uint4*)(Tb + ((unsigned)e * 2048u + loff));
  }
}
__device__ __forceinline__ void pe_load_x(const u16* xr, f32x2 (&xp)[8]) {
  uint4 a = *(const uint4*)(xr), b = *(const uint4*)(xr + 8);
  xp[0] = f32x2{blo(a.x), bhi(a.x)}; xp[1] = f32x2{blo(a.y), bhi(a.y)}; xp[2] = f32x2{blo(a.z), bhi(a.z)}; xp[3] = f32x2{blo(a.w), bhi(a.w)};
  xp[4] = f32x2{blo(b.x), bhi(b.x)}; xp[5] = f32x2{blo(b.y), bhi(b.y)}; xp[6] = f32x2{blo(b.z), bhi(b.z)}; xp[7] = f32x2{blo(b.w), bhi(b.w)};
}
__device__ __forceinline__ void pe_dot_store(const f32x2 (&xp)[8], const uint4 (&U)[16], float* pr, int lane, int r) {
  float d[16];
#pragma unroll
  for (int kb = 0; kb < 16; kb++) d[kb] = dot16_fp8(xp, U[kb]);
  const bool b4 = (lane & 4) != 0, b2 = (lane & 2) != 0, b1 = (lane & 1) != 0;
#pragma unroll
  for (int i = 0; i < 8; i++) { const float send = b4 ? d[i] : d[i + 8], keep = b4 ? d[i + 8] : d[i]; d[i] = keep + __shfl_xor(send, 4); }
#pragma unroll
  for (int i = 0; i < 4; i++) { const float send = b2 ? d[i] : d[i + 4], keep = b2 ? d[i + 4] : d[i]; d[i] = keep + __shfl_xor(send, 2); }
#pragma unroll
  for (int i = 0; i < 2; i++) { const float send = b1 ? d[i] : d[i + 2], keep = b1 ? d[i + 2] : d[i]; d[i] = keep + __shfl_xor(send, 1); }
  pr[(2 * r) * 8] = d[0];
  pr[(2 * r + 1) * 8] = d[1];
}
__device__ void phase11a(const Params& p) {
  const int t = threadIdx.x, lane = t & 63, w = t >> 6, g = lane >> 3, r = lane & 7;
  const int s = blockIdx.x & 7, jb = blockIdx.x >> 3, ns = (gridDim.x - s + 7) >> 3;
  const u16* xn2 = p.R4 + s * 128 + r * 16;
  const unsigned char* Tb = (const unsigned char*)p.R5 + s * 128;
  const unsigned loff = r * 16;
  const int* experts = (const int*)p.R7 + lane;
  float* part = p.out + (size_t)s * BT * 128 + g;
  const int first = jb * 4 + w, stride = ns * 4;
  if (first >= BT) return;
#define TOKC(T) (((T) < BT) ? (T) : first)
  int eA0, eA1, eB0, eB1;
  uint4 UA[16], UB[16];
  f32x2 xA[8], xB[8];
  eA0 = experts[(size_t)first * 128]; eA1 = experts[(size_t)first * 128 + 64];
  pe_load_tab(Tb, loff, eA0, eA1, g, UA);
  pe_load_x(xn2 + (size_t)first * 1024, xA);
  { const int t1 = TOKC(first + stride); eB0 = experts[(size_t)t1 * 128]; eB1 = experts[(size_t)t1 * 128 + 64]; }
#pragma unroll 1
  for (int tok = first; tok < BT; tok += 2 * stride) {
    const int t1 = tok + stride, t2 = tok + 2 * stride, t3 = tok + 3 * stride;
    pe_load_tab(Tb, loff, eB0, eB1, g, UB);
    pe_load_x(xn2 + (size_t)TOKC(t1) * 1024, xB);
    { const int tc = TOKC(t2); eA0 = experts[(size_t)tc * 128]; eA1 = experts[(size_t)tc * 128 + 64]; }
    pe_dot_store(xA, UA, part + (size_t)tok * 128, lane, r);
    pe_load_tab(Tb, loff, eA0, eA1, g, UA);
    pe_load_x(xn2 + (size_t)TOKC(t2) * 1024, xA);
    { const int tc = TOKC(t3); eB0 = experts[(size_t)tc * 128]; eB1 = experts[(size_t)tc * 128 + 64]; }
    if (t1 < BT) pe_dot_store(xB, UB, part + (size_t)t1 * 128, lane, r);
  }
}

__device__ void phase11r(const Params& p) {
  float* gates = p.R7 + (size_t)BT * 128;
  const float* part = p.out;
  for (int idx = blockIdx.x * 256 + threadIdx.x; idx < BT * 128 / 4; idx += gridDim.x * 256) {
    float4 h = *(const float4*)(part + (size_t)idx * 4);
#pragma unroll
    for (int ss = 1; ss < 8; ss++) {
      const float4 q = *(const float4*)(part + (size_t)ss * BT * 128 + (size_t)idx * 4);
      h.x += q.x; h.y += q.y; h.z += q.z; h.w += q.w;
    }
    float4 gt = *(const float4*)(gates + (size_t)idx * 4);
    const float hv[4] = {h.x * (1.f / U_SCALE), h.y * (1.f / U_SCALE), h.z * (1.f / U_SCALE), h.w * (1.f / U_SCALE)};
    const float gv[4] = {gt.x, gt.y, gt.z, gt.w};
    float c[4];
#pragma unroll
    for (int q = 0; q < 4; q++) c[q] = 0.5f * hv[q] * (1.f + erff(hv[q] * 0.70710678118654752f)) * gv[q] * (1.f / V_SCALE);
    *(float4*)(gates + (size_t)idx * 4) = make_float4(c[0], c[1], c[2], c[3]);
  }
}

struct PeTok { int e0, e1; float g0, g1; };
__device__ __forceinline__ PeTok pe_load_tok(const int* experts, const float* gates, int tok) {
  PeTok k;
  k.e0 = experts[(size_t)tok * 128]; k.e1 = experts[(size_t)tok * 128 + 64];
  k.g0 = gates[(size_t)tok * 128]; k.g1 = gates[(size_t)tok * 128 + 64];
  return k;
}
__device__ __forceinline__ void pe_value_store(const PeTok& k, const uint4 (&V)[16], u16* drow, int lane, int g) {
  const float c0 = k.g0, c1 = k.g1;
  f32x2 accp[8];
#pragma unroll
  for (int i = 0; i < 8; i++) accp[i] = f32x2{0.f, 0.f};
#pragma unroll
  for (int kb = 0; kb < 16; kb++) {
    const float c = __shfl((kb < 8) ? c0 : c1, (kb & 7) * 8 + g);
    const f32x2 c2 = {c, c};
    const u32 ws_[4] = {V[kb].x, V[kb].y, V[kb].z, V[kb].w};
#pragma unroll
    for (int q = 0; q < 4; q++) {
      accp[2 * q] += c2 * __builtin_amdgcn_cvt_pk_f32_fp8((int)ws_[q], false);
      accp[2 * q + 1] += c2 * __builtin_amdgcn_cvt_pk_f32_fp8((int)ws_[q], true);
    }
  }
  float a[16];
#pragma unroll
  for (int i = 0; i < 8; i++) { a[2 * i] = accp[i][0]; a[2 * i + 1] = accp[i][1]; }
  const bool b32 = (lane & 32) != 0, b16 = (lane & 16) != 0, b8 = (lane & 8) != 0;
#pragma unroll
  for (int i = 0; i < 8; i++) { const float send = b32 ? a[i] : a[i + 8], keep = b32 ? a[i + 8] : a[i]; a[i] = keep + __shfl_xor(send, 32); }
#pragma unroll
  for (int i = 0; i < 4; i++) { const float send = b16 ? a[i] : a[i + 4], keep = b16 ? a[i + 4] : a[i]; a[i] = keep + __shfl_xor(send, 16); }
#pragma unroll
  for (int i = 0; i < 2; i++) { const float send = b8 ? a[i] : a[i + 2], keep = b8 ? a[i + 2] : a[i]; a[i] = keep + __shfl_xor(send, 8); }
  *(u32*)drow = pack2(a[0], a[1]);
}
__device__ void phase11b(const Params& p) {
  const int t = threadIdx.x, lane = t & 63, w = t >> 6, g = lane >> 3, r = lane & 7;
  const int s = blockIdx.x & 7, jb = blockIdx.x >> 3, ns = (gridDim.x - s + 7) >> 3;
  const unsigned char* Tb = (const unsigned char*)p.R5 + 1024 + s * 128;
  const unsigned loff = r * 16;
  const int* experts = (const int*)p.R7 + lane;
  const float* gates = p.R7 + (size_t)BT * 128 + lane;
  u16* x1 = p.R1 + s * 128 + r * 16 + 2 * g;
  const int first = jb * 4 + w, stride = ns * 4;
  if (first >= BT) return;
  PeTok kA, kB;
  uint4 VA[16], VB[16];
  kA = pe_load_tok(experts, gates, first);
  pe_load_tab(Tb, loff, kA.e0, kA.e1, g, VA);
  kB = pe_load_tok(experts, gates, TOKC(first + stride));
#pragma unroll 1
  for (int tok = first; tok < BT; tok += 2 * stride) {
    const int t1 = tok + stride, t2 = tok + 2 * stride, t3 = tok + 3 * stride;
    pe_load_tab(Tb, loff, kB.e0, kB.e1, g, VB);
    const PeTok kC = pe_load_tok(experts, gates, TOKC(t2));
    pe_value_store(kA, VA, x1 + (size_t)tok * 1024, lane, g);
    pe_load_tab(Tb, loff, kC.e0, kC.e1, g, VA);
    const PeTok kD = pe_load_tok(experts, gates, TOKC(t3));
    if (t1 < BT) pe_value_store(kB, VB, x1 + (size_t)t1 * 1024, lane, g);
    kA = kC; kB = kD;
  }
#undef TOKC
}

__device__ void phase11c(const Params& p) {
  const int t = threadIdx.x, lane = t & 63, w = t >> 6;
  const float* x1 = (const float*)p.R2;
  for (int tok = blockIdx.x * 4 + w; tok < BT; tok += gridDim.x * 4) {
    const float* xr = x1 + (size_t)tok * 1024 + lane * 16;
    const u16* dl = p.R1 + (size_t)tok * 1024 + lane * 16;
    float4 v[4];
    float ss = 0.f;
#pragma unroll
    for (int i = 0; i < 4; i++) {
      v[i] = *(const float4*)(xr + i * 4);
      const uint2 dd = *(const uint2*)(dl + i * 4);
      v[i].x += blo(dd.x); v[i].y += bhi(dd.x); v[i].z += blo(dd.y); v[i].w += bhi(dd.y);
      ss += v[i].x * v[i].x + v[i].y * v[i].y + v[i].z * v[i].z + v[i].w * v[i].w;
    }
    ss = wave_sum(ss);
    const float rstd = rsqrtf(ss * (1.f / 1024.f) + 1e-6f);
    float* orow = p.out + (size_t)tok * 1024 + lane * 16;
#pragma unroll
    for (int i = 0; i < 4; i++) {
      float4 gg = *(const float4*)(p.fng + lane * 16 + i * 4);
      *(float4*)(orow + i * 4) = make_float4(v[i].x * rstd * gg.x, v[i].y * rstd * gg.y, v[i].z * rstd * gg.z, v[i].w * rstd * gg.w);
    }
  }
}

__global__ void __launch_bounds__(256, 2) fwd_mega(Params p, int ph_lo, int ph_hi) {
  extern __shared__ __attribute__((aligned(16))) char smem[];
  cg::grid_group grid = cg::this_grid();
  __shared__ uint4 xb_words;
  if (threadIdx.x == 0) xb_words = make_uint4(0u, 0u, 0u, 0u);
  __syncthreads();
  const XcdBarrier xb = xcd_barrier_post(p.bar, (volatile LAS unsigned*)&xb_words);
  if (ph_lo > ph_hi) grid.sync();
constexpr int REP0=1,REP1=1,REP2=1,REP3=1,REP4=1,REP5=1,REP6=1,REP7=1,REP8=1,REP9=1,REP10=1,REP11=1,REP12=1,REP13=1,REP14=1;
#define RUN_PHASE(k, call)                         \
  if (PH_ON(k) && ph_lo <= (k) && (k) < ph_hi) {   \
    for (int rep_ = 0; rep_ < REP##k; rep_++) { call; }  \
    if ((k) + 1 < ph_hi) xcd_barrier(xb);          \
  }
  RUN_PHASE(0, phase0(p, smem))
  RUN_PHASE(1, phase1(p, smem))
  RUN_PHASE(2, phase2(p, smem, xb))
  RUN_PHASE(3, phase3(p); weights_late(p, smem))
  RUN_PHASE(4, for (int item = blockIdx.x; item < 512; item += gridDim.x) gla_item(p, item, 2, smem))
  RUN_PHASE(5, phase5(p))
  RUN_PHASE(6, phase6(p, smem))
  RUN_PHASE(7, phase7(p, smem))
  RUN_PHASE(8, phase8(p))
  RUN_PHASE(9, phase9(p, smem))
  RUN_PHASE(10, phase10(p, smem))
  RUN_PHASE(11, phase11a(p))
  RUN_PHASE(12, phase11r(p))
  RUN_PHASE(13, phase11b(p))
  RUN_PHASE(14, phase11c(p))
}

extern "C" void kernel_launch(void* const* d_in, const int* in_sizes, int n_in, void* d_out, int out_size, void* d_ws,
                              size_t ws_size, hipStream_t stream) {
  (void)in_sizes; (void)n_in; (void)out_size; (void)ws_size;
  static int grid_blocks = 0;
  if (!grid_blocks) {
    int dev = 0, cus = 0, per_cu = 0;
    hipGetDevice(&dev);
    hipDeviceGetAttribute(&cus, hipDeviceAttributeMultiprocessorCount, dev);
    hipFuncSetAttribute((const void*)fwd_mega, hipFuncAttributeMaxDynamicSharedMemorySize, LDS_BYTES);
    hipOccupancyMaxActiveBlocksPerMultiprocessor(&per_cu, (const void*)fwd_mega, 256, LDS_BYTES);
    if (per_cu < 1) per_cu = 1;
    if (per_cu > 2) per_cu = 2;
    grid_blocks = cus * per_cu;
  }
  Params p{};
  const float* const* in = (const float* const*)d_in;
  p.x = in[0]; p.norm1_g = in[1]; p.w_in = in[2]; p.conv_w = in[3]; p.conv_b = in[4]; p.wa = in[5];
  p.dupf = in[6]; p.dbf = in[7]; p.dupb = in[8]; p.dbb = in[9]; p.gng = in[10]; p.wb = in[11];
  p.gbias = in[12]; p.wo = in[13]; p.norm2_g = in[14]; p.wq = in[15]; p.keys = in[16]; p.pu = in[17];
  p.pv = in[18]; p.fng = in[19];
  p.out = (float*)d_out;
  char* ws = (char*)d_ws;
  const size_t MiB = 1u << 20;
  p.WinT = (u16*)ws;
  p.WaT = (u16*)(ws + 17039360);
  p.WbT = (u16*)(ws + 17039360 + 2097152);
  p.WoT = (u16*)(ws + 17039360 + 2 * 2097152);
  p.WqT = (u16*)(ws + 17039360 + 3 * 2097152);
  p.KeysB = (u16*)(ws + 17039360 + 3 * 2097152 + 4194304);
  p.R1 = (u16*)(ws + 27 * MiB);
  p.R2 = (u16*)(ws + 59 * MiB);
  p.R3 = (u16*)(ws + 91 * MiB);
  p.R4 = (u16*)(ws + 123 * MiB);
  p.R5 = (u16*)(ws + 155 * MiB);
  p.R6 = (u16*)(ws + 187 * MiB);
  p.R7 = (float*)(ws + 219 * MiB);
  p.z = (float*)(ws + 251 * MiB);
  p.Dd = (float*)(ws + 253 * MiB);
  p.bar = (unsigned*)(ws + 254 * MiB);
  hipMemsetAsync(p.bar, 0, XCD_BAR_WORDS * sizeof(unsigned), stream);
#if MULTI_LAUNCH
  for (int ph = 0; ph < NPHASE; ph++) {
    hipLaunchKernelGGL(fwd_mega, dim3(grid_blocks), dim3(256), LDS_BYTES, stream, p, ph, ph + 1);
  }
#else
  int lo = 0, hi = NPHASE;
  void* args[] = {&p, &lo, &hi};
  hipError_t e = hipLaunchCooperativeKernel((const void*)fwd_mega, dim3(grid_blocks), dim3(256), args, LDS_BYTES, stream);
  if (e != hipSuccess) fprintf(stderr, "cooperative launch failed: %s (grid %d)\n", hipGetErrorString(e), grid_blocks);
#endif
}
```

```cpp
#include <hip/hip_runtime.h>
#include <hip/hip_cooperative_groups.h>
#include <cstdio>
namespace cg = cooperative_groups;

typedef unsigned short u16;
typedef unsigned int u32;
using bf16x8 = __attribute__((ext_vector_type(8))) short;
using f32x4 = __attribute__((ext_vector_type(4))) float;

#ifndef ONLY_PHASE
#define ONLY_PHASE -1
#endif
#define PH_ON(k) (ONLY_PHASE < 0 || ONLY_PHASE == (k))
#ifndef MULTI_LAUNCH
#define MULTI_LAUNCH 0
#endif

constexpr int BT = 16384, SEQ = 8192;
constexpr int LDS_BYTES = 80896;
constexpr int NPHASE = 15;

struct Params {
  const float *x, *norm1_g, *w_in, *conv_w, *conv_b, *wa, *dupf, *dbf, *dupb, *dbb, *gng, *wb, *gbias, *wo,
      *norm2_g, *wq, *keys, *pu, *pv, *fng;
  float* out;
  u16 *WinT, *WaT, *WbT, *WoT, *WqT, *KeysB;
  u16 *R1, *R2, *R3, *R4, *R5, *R6;
  float *R7, *z, *Dd;
  unsigned* bar;
};

__device__ __forceinline__ u16 f2b(float f) { u32 u = __float_as_uint(f); u += 0x7fffu + ((u >> 16) & 1u); return (u16)(u >> 16); }
__device__ __forceinline__ float b2f(u16 h) { return __uint_as_float(((u32)h) << 16); }
__device__ __forceinline__ u32 pack2(float a, float b) { return (u32)f2b(a) | ((u32)f2b(b) << 16); }
__device__ __forceinline__ float blo(u32 w) { return __uint_as_float(w << 16); }
__device__ __forceinline__ float bhi(u32 w) { return __uint_as_float(w & 0xffff0000u); }
__device__ __forceinline__ float wave_sum(float v) {
#pragma unroll
  for (int o = 32; o > 0; o >>= 1) v += __shfl_xor(v, o);
  return v;
}
__device__ __forceinline__ float sigmoidf_(float v) { return 1.f / (1.f + __expf(-v)); }
__device__ __forceinline__ u32 ordf(float v) { u32 u = __float_as_uint(v); return (u & 0x80000000u) ? ~u : (u | 0x80000000u); }
__device__ __forceinline__ float unordf(u32 k) { return __uint_as_float((k & 0x80000000u) ? (k ^ 0x80000000u) : ~k); }

template <int MT, int NT, int KT>
__device__ __forceinline__ void mma_nt(f32x4 (&acc)[MT][NT], const u16* A, int sa, const u16* B, int sb, int lane) {
  const int fr = lane & 15, fq = lane >> 4;
  const u16* pa = A + fr * sa + fq * 8;
  const u16* pb = B + fr * sb + fq * 8;
#pragma unroll
  for (int k = 0; k < KT; k++) {
    bf16x8 a[MT], b[NT];
#pragma unroll
    for (int m = 0; m < MT; m++) a[m] = *(const bf16x8*)(pa + m * 16 * sa + k * 32);
#pragma unroll
    for (int n = 0; n < NT; n++) b[n] = *(const bf16x8*)(pb + n * 16 * sb + k * 32);
#pragma unroll
    for (int m = 0; m < MT; m++)
#pragma unroll
      for (int n = 0; n < NT; n++) acc[m][n] = __builtin_amdgcn_mfma_f32_16x16x32_bf16(a[m], b[n], acc[m][n], 0, 0, 0);
  }
}

template <int MT, int NT>
__device__ __forceinline__ void mma_sw64(f32x4 (&acc)[MT][NT], const u16* A, const u16* B, int lane) {
  const int fr = lane & 15, fq = lane >> 4;
  const int cb = fq ^ ((fr >> 1) & 7);
  const u16* pa = A + fr * 64;
  const u16* pb = B + fr * 64;
#pragma unroll
  for (int k = 0; k < 2; k++) {
    const int co = (cb ^ (k * 4)) * 8;
    bf16x8 a[MT], b[NT];
#pragma unroll
    for (int m = 0; m < MT; m++) a[m] = *(const bf16x8*)(pa + m * 16 * 64 + co);
#pragma unroll
    for (int n = 0; n < NT; n++) b[n] = *(const bf16x8*)(pb + n * 16 * 64 + co);
#pragma unroll
    for (int m = 0; m < MT; m++)
#pragma unroll
      for (int n = 0; n < NT; n++) acc[m][n] = __builtin_amdgcn_mfma_f32_16x16x32_bf16(b[n], a[m], acc[m][n], 0, 0, 0);
  }
}

#define ST_DECL(S) uint4 S##a0, S##a1, S##a2, S##a3, S##b0, S##b1, S##b2, S##b3
#define ST_LOAD(S, PA, PB)                                                                                           \
  do {                                                                                                               \
    const char* pa_ = (const char*)(PA);                                                                             \
    const char* pb_ = (const char*)(PB);                                                                             \
    S##a0 = *(const uint4*)(pa_ + voffA); S##a1 = *(const uint4*)(pa_ + (size_t)64 * lda + voffA);                   \
    S##a2 = *(const uint4*)(pa_ + (size_t)128 * lda + voffA); S##a3 = *(const uint4*)(pa_ + (size_t)192 * lda + voffA); \
    S##b0 = *(const uint4*)(pb_ + voffB); S##b1 = *(const uint4*)(pb_ + (size_t)64 * ldb + voffB);                   \
    S##b2 = *(const uint4*)(pb_ + (size_t)128 * ldb + voffB); S##b3 = *(const uint4*)(pb_ + (size_t)192 * ldb + voffB); \
  } while (0)
#define ST_WRITE(S, WA, WB)                                                                                          \
  do {                                                                                                               \
    *(uint4*)(WA) = S##a0; *(uint4*)((WA) + 32 * 64) = S##a1; *(uint4*)((WA) + 64 * 64) = S##a2; *(uint4*)((WA) + 96 * 64) = S##a3; \
    *(uint4*)(WB) = S##b0; *(uint4*)((WB) + 32 * 64) = S##b1; *(uint4*)((WB) + 64 * 64) = S##b2; *(uint4*)((WB) + 96 * 64) = S##b3; \
  } while (0)

#define GLDS16(G, L) __builtin_amdgcn_global_load_lds((const void*)(G), (__attribute__((address_space(3))) void*)(L), 16, 0, 0)
__device__ __forceinline__ void gemm_acc_db(f32x4 (&acc)[4][4], const u16* __restrict__ A, int lda, const u16* __restrict__ B,
                                            int ldb, int K, char* smem) {
  const int t = threadIdx.x, lane = t & 63, w = t >> 6, wr = w >> 1, wc = w & 1;
  const int lr = t >> 3;
  const int gc = ((t & 7) ^ ((lr >> 1) & 7)) * 8;
  const u16* pa = A + (size_t)lr * lda + gc;
  const u16* pb = B + (size_t)lr * ldb + gc;
  char* l0 = smem + t * 16;
  u16* b0 = (u16*)smem;
  u16* b1 = b0 + 2 * 128 * 64;
#define ISSUE_TILE(KT, BUFOFF)                                                                     \
  do {                                                                                             \
    const u16* qa = pa + (KT) * 64;                                                                \
    const u16* qb = pb + (KT) * 64;                                                                \
    char* lb = l0 + (BUFOFF);                                                                      \
    GLDS16(qa, lb); GLDS16(qa + (size_t)32 * lda, lb + 4096);                                      \
    GLDS16(qa + (size_t)64 * lda, lb + 8192); GLDS16(qa + (size_t)96 * lda, lb + 12288);           \
    GLDS16(qb, lb + 16384); GLDS16(qb + (size_t)32 * ldb, lb + 16384 + 4096);                      \
    GLDS16(qb + (size_t)64 * ldb, lb + 16384 + 8192); GLDS16(qb + (size_t)96 * ldb, lb + 16384 + 12288); \
  } while (0)
  const int nk = K >> 6;
  __syncthreads();
  ISSUE_TILE(0, 0);
  if (blockIdx.x >= (gridDim.x >> 1)) __builtin_amdgcn_s_sleep(8);
#define KSTEP(BUF, ISSUE_STMT)                                                 \
  do {                                                                         \
    asm volatile("s_waitcnt vmcnt(0) lgkmcnt(0)" ::: "memory");    \
    __builtin_amdgcn_s_barrier();                                              \
    asm volatile("" ::: "memory");                                             \
    ISSUE_STMT;                                                                \
    mma_sw64<4, 4>(acc, BUF + wr * 64 * 64, BUF + 128 * 64 + wc * 64 * 64, lane); \
  } while (0)
  for (int kt = 0; kt + 2 < nk; kt += 2) {
    KSTEP(b0, ISSUE_TILE(kt + 1, 32768));
    KSTEP(b1, ISSUE_TILE(kt + 2, 0));
  }
  KSTEP(b0, ISSUE_TILE(nk - 1, 32768));
  KSTEP(b1, (void)0);
  asm volatile("s_waitcnt lgkmcnt(0)" ::: "memory");
#undef KSTEP
#undef ISSUE_TILE
}

struct TileIter {
  int i, step, lim, NT, xcd; bool swz;
  __device__ __forceinline__ TileIter(int nt_) {
    NT = nt_;
    swz = (gridDim.x & 7) == 0;
    if (swz) { xcd = blockIdx.x & 7; i = blockIdx.x >> 3; step = gridDim.x >> 3; lim = 16 * NT; }
    else { xcd = 0; i = blockIdx.x; step = gridDim.x; lim = 128 * NT; }
  }
  __device__ __forceinline__ bool next(int& mt, int& nt) {
    if (i >= lim) return false;
    if (swz) { int mg = i / (NT * 8), rem = i - mg * NT * 8; nt = rem >> 3; mt = xcd * 16 + mg * 8 + (rem & 7); }
    else { mt = i & 127; nt = i >> 7; }
    i += step;
    return true;
  }
};

__device__ __forceinline__ void zero_acc(f32x4 (&acc)[4][4]) {
#pragma unroll
  for (int m = 0; m < 4; m++)
#pragma unroll
    for (int n = 0; n < 4; n++) acc[m][n] = f32x4{0.f, 0.f, 0.f, 0.f};
}

__device__ __forceinline__ int winmap(int r) {
  if (r < 2048) { int tile = r >> 7, w = r & 127, grp = w >> 5; int ch = tile * 64 + (grp >> 1) * 32 + (w & 31); return ((grp & 1) ? 2048 : 0) + ch; }
  if (r < 3072) return r - 1024;
  if (r < 6176) return r;
  if (r < 6272) return -1;
  return r - 96;
}

__device__ __forceinline__ void tr_tile(const float* __restrict__ src, int ld, int col0, u16* __restrict__ dst, int r0, int k0, float* sT) {
  const int t = threadIdx.x;
  const int r = t >> 3, kc = t & 7;
  if (col0 < 0) {
    *(uint4*)(dst + (size_t)(r0 + r) * 1024 + k0 + kc * 8) = make_uint4(0, 0, 0, 0);
    return;
  }
  __syncthreads();
#pragma unroll
  for (int i = 0; i < 8; i++) {
    int k = (t >> 5) + i * 8, rr = t & 31;
    sT[k * 33 + rr] = src[(size_t)(k0 + k) * ld + col0 + rr];
  }
  __syncthreads();
  u32 wv[4];
#pragma unroll
  for (int j = 0; j < 4; j++) wv[j] = pack2(sT[(kc * 8 + 2 * j) * 33 + r], sT[(kc * 8 + 2 * j + 1) * 33 + r]);
  *(uint4*)(dst + (size_t)(r0 + r) * 1024 + k0 + kc * 8) = make_uint4(wv[0], wv[1], wv[2], wv[3]);
}

__device__ __forceinline__ void rms_row(const float* __restrict__ src, const float* __restrict__ g, u16* __restrict__ dst, int lane) {
  float4 v[4];
  float ss = 0.f;
#pragma unroll
  for (int i = 0; i < 4; i++) {
    v[i] = *(const float4*)(src + i * 256 + lane * 4);
    ss += v[i].x * v[i].x + v[i].y * v[i].y + v[i].z * v[i].z + v[i].w * v[i].w;
  }
  ss = wave_sum(ss);
  const float rstd = rsqrtf(ss * (1.f / 1024.f) + 1e-6f);
#pragma unroll
  for (int i = 0; i < 4; i++) {
    float4 gg = *(const float4*)(g + i * 256 + lane * 4);
    uint2 o;
    o.x = pack2(v[i].x * rstd * gg.x, v[i].y * rstd * gg.y);
    o.y = pack2(v[i].z * rstd * gg.z, v[i].w * rstd * gg.w);
    *(uint2*)(dst + i * 256 + lane * 4) = o;
  }
}

__device__ void phase0(const Params& p, char* smem) {
  float* sT = (float*)smem;
  const int t = threadIdx.x, lane = t & 63, w = t >> 6;
  u16* xn = (u16*)p.out;
  constexpr int J0 = 4160, J4 = J0 + 4096;
  for (int job = blockIdx.x; job < J4; job += gridDim.x) {
    if (job < J0) {
      int rb = job >> 4, kb = job & 15;
      tr_tile(p.w_in, 8224, winmap(rb * 32), p.WinT, rb * 32, kb * 64, sT);
    } else {
      int row = (job - J0) * 4 + w;
      rms_row(p.x + (size_t)row * 1024, p.norm1_g, xn + (size_t)row * 1024, lane);
    }
  }
}
__device__ void weights_late(const Params& p, char* smem) {
  float* sT = (float*)smem;
  const int t = threadIdx.x;
  constexpr int J1 = 1536, J2 = J1 + 1024, J3 = J2 + 128;
  for (int job = blockIdx.x; job < J3; job += gridDim.x) {
    if (job < J1) {
      int which = job >> 9, rb = (job & 511) >> 4, kb = job & 15;
      const float* src = which == 0 ? p.wa : (which == 1 ? p.wb : p.wo);
      u16* dst = which == 0 ? p.WaT : (which == 1 ? p.WbT : p.WoT);
      tr_tile(src, 1024, rb * 32, dst, rb * 32, kb * 64, sT);
    } else if (job < J2) {
      int j = job - J1, rb = j >> 4, kb = j & 15;
      tr_tile(p.wq, 2048, rb * 32, p.WqT, rb * 32, kb * 64, sT);
    } else {
      int j = job - J2;
      int base = (j * 256 + t) * 8;
      float4 a = *(const float4*)(p.keys + base), b = *(const float4*)(p.keys + base + 4);
      *(uint4*)(p.KeysB + base) = make_uint4(pack2(a.x, a.y), pack2(a.z, a.w), pack2(b.x, b.y), pack2(b.z, b.w));
    }
  }
}

__device__ void la_prep(const Params& p, char* smem) {
  float* sZ = (float*)smem;
  float* sPart = sZ + 1024;
  const int t = threadIdx.x, lane = t & 63, w = t >> 6, fr = lane & 15, fq = lane >> 4;
  const u16* xn = (const u16*)p.out;
  const u16* Wz = p.WinT + (size_t)6144 * 1024;
  u32* la16 = (u32*)p.R6;
  float uf0[16], uf1[16], ub0[16], ub1[16];
#pragma unroll
  for (int r = 0; r < 16; r++) {
    uf0[r] = p.dupf[r * 512 + 2 * t]; uf1[r] = p.dupf[r * 512 + 2 * t + 1];
    ub0[r] = p.dupb[r * 512 + 2 * t]; ub1[r] = p.dupb[r * 512 + 2 * t + 1];
  }
  const float bf0 = p.dbf[2 * t], bf1 = p.dbf[2 * t + 1], bb0 = p.dbb[2 * t], bb1 = p.dbb[2 * t + 1];
  for (int job = blockIdx.x; job < BT / 32; job += gridDim.x) {
    f32x4 az[2][2];
#pragma unroll
    for (int m = 0; m < 2; m++)
#pragma unroll
      for (int n = 0; n < 2; n++) az[m][n] = f32x4{0.f, 0.f, 0.f, 0.f};
    {
      const u16* ap = xn + (size_t)(job * 32 + fr) * 1024 + w * 256 + fq * 8;
      const u16* bp = Wz + (size_t)fr * 1024 + w * 256 + fq * 8;
#pragma unroll
      for (int ks = 0; ks < 8; ks++) {
        bf16x8 a0 = *(const bf16x8*)(ap + ks * 32), a1 = *(const bf16x8*)(ap + 16 * 1024 + ks * 32);
        bf16x8 b0 = *(const bf16x8*)(bp + ks * 32), b1 = *(const bf16x8*)(bp + 16 * 1024 + ks * 32);
        az[0][0] = __builtin_amdgcn_mfma_f32_16x16x32_bf16(a0, b0, az[0][0], 0, 0, 0);
        az[0][1] = __builtin_amdgcn_mfma_f32_16x16x32_bf16(a0, b1, az[0][1], 0, 0, 0);
        az[1][0] = __builtin_amdgcn_mfma_f32_16x16x32_bf16(a1, b0, az[1][0], 0, 0, 0);
        az[1][1] = __builtin_amdgcn_mfma_f32_16x16x32_bf16(a1, b1, az[1][1], 0, 0, 0);
      }
    }
    __syncthreads();
#pragma unroll
    for (int m = 0; m < 2; m++)
#pragma unroll
      for (int n = 0; n < 2; n++)
#pragma unroll
        for (int j = 0; j < 4; j++) sPart[w * 1024 + (m * 16 + fq * 4 + j) * 32 + n * 16 + fr] = az[m][n][j];
    __syncthreads();
    {
      const float4 q0 = *(const float4*)(sPart + t * 4), q1 = *(const float4*)(sPart + 1024 + t * 4), q2 = *(const float4*)(sPart + 2048 + t * 4),
                   q3 = *(const float4*)(sPart + 3072 + t * 4);
      *(float4*)(sZ + t * 4) = make_float4(q0.x + q1.x + q2.x + q3.x, q0.y + q1.y + q2.y + q3.y, q0.z + q1.z + q2.z + q3.z, q0.w + q1.w + q2.w + q3.w);
    }
    __syncthreads();
    for (int i = 0; i < 32; i++) {
      const float* zr = sZ + i * 32;
      float a0 = bf0, a1 = bf1, c0 = bb0, c1 = bb1;
#pragma unroll
      for (int r = 0; r < 16; r++) {
        const float zf = zr[r], zb = zr[16 + r];
        a0 += zf * uf0[r]; a1 += zf * uf1[r];
        c0 += zb * ub0[r]; c1 += zb * ub1[r];
      }
      const float l0 = (fminf(a0, 0.f) - __logf(1.f + __expf(-fabsf(a0)))) * 0.0625f;
      const float l1 = (fminf(a1, 0.f) - __logf(1.f + __expf(-fabsf(a1)))) * 0.0625f;
      const float m0 = (fminf(c0, 0.f) - __logf(1.f + __expf(-fabsf(c0)))) * 0.0625f;
      const float m1 = (fminf(c1, 0.f) - __logf(1.f + __expf(-fabsf(c1)))) * 0.0625f;
      const int tok = job * 32 + i;
      la16[(size_t)tok * 256 + t] = (u32)__builtin_bit_cast(unsigned short, (_Float16)l0) | ((u32)__builtin_bit_cast(unsigned short, (_Float16)l1) << 16);
      la16[(size_t)(BT + tok) * 256 + t] = (u32)__builtin_bit_cast(unsigned short, (_Float16)m0) | ((u32)__builtin_bit_cast(unsigned short, (_Float16)m1) << 16);
    }
  }
}

__device__ void phase1(const Params& p, char* smem) {
  u16* sA = (u16*)smem;
  u16* sB = sA + 128 * 64;
  const int t = threadIdx.x, lane = t & 63, w = t >> 6, wr = w >> 1, wc = w & 1, fr = lane & 15, fq = lane >> 4;
  const u16* xn = (const u16*)p.out;
  la_prep(p, smem);
  TileIter ti(48);
  int mt, nt;
  while (ti.next(mt, nt)) {
    f32x4 acc[4][4];
    zero_acc(acc);
    gemm_acc_db(acc, xn + (size_t)mt * 128 * 1024, 1024, p.WinT + (size_t)nt * 128 * 1024, 1024, 1024, smem);
    const int rowb = mt * 128 + wr * 64 + fr;
    if (nt < 16) {
#pragma unroll
      for (int m = 0; m < 4; m++)
#pragma unroll
        for (int n = 0; n < 2; n++) {
          const int ch = nt * 64 + wc * 32 + n * 16 + fq * 4;
          *(uint2*)(p.R1 + (size_t)(rowb + m * 16) * 1024 + ch) =
              make_uint2(pack2(acc[m][n][0] * acc[m][n + 2][0], acc[m][n][1] * acc[m][n + 2][1]),
                         pack2(acc[m][n][2] * acc[m][n + 2][2], acc[m][n][3] * acc[m][n + 2][3]));
        }
    } else {
      const int g = (nt - 16) >> 3;
      u16* dst = g == 0 ? p.R2 : (g == 1 ? p.R3 : (g == 2 ? p.R4 : p.R5));
      const int cb = ((nt - 16) & 7) * 128 + wc * 64;
      const float sc = (g == 1 && cb < 512) ? 0.08838834764831845f : 1.f;
#pragma unroll
      for (int m = 0; m < 4; m++)
#pragma unroll
        for (int n = 0; n < 4; n++)
          *(uint2*)(dst + (size_t)(rowb + m * 16) * 1024 + cb + n * 16 + fq * 4) =
              make_uint2(pack2(acc[m][n][0] * sc, acc[m][n][1] * sc), pack2(acc[m][n][2] * sc, acc[m][n][3] * sc));
    }
  }
}

#define XB_TMO      128
#define XB_XCNT(j)  (256  + 64 * (j))
#define XB_XSUB(j)  (1280 + 64 * (j))
#define XB_XGEN(j)  (2304 + 64 * (j))
#define XB_TOP      3328
#define XB_TOPGEN   3392
#define XCD_BAR_WORDS 3456
#define XB_SPIN_CAP (1u << 20)
#define LAS __attribute__((address_space(3)))
__device__ __forceinline__ unsigned xb_ld(unsigned* p) { return __hip_atomic_load(p, __ATOMIC_RELAXED, __HIP_MEMORY_SCOPE_AGENT); }
__device__ __forceinline__ unsigned xb_add(unsigned* p, unsigned v) { return __hip_atomic_fetch_add(p, v, __ATOMIC_RELAXED, __HIP_MEMORY_SCOPE_AGENT); }
__device__ __forceinline__ unsigned xb_xcc_id() { return (unsigned)__builtin_amdgcn_s_getreg((3 << 11) | 20) & 0xFu; }
#define XB_SPIN(cond, bar) do { unsigned _sp = 0; while (cond) { __builtin_amdgcn_s_sleep(1); \
    if ((++_sp & 255u) == 0u) { if (xb_ld(&(bar)[XB_TMO])) break; if (_sp > XB_SPIN_CAP) { atomicAdd(&(bar)[XB_TMO], 1u); break; } } } } while (0)
struct XcdBarrier { unsigned* bar; unsigned x; volatile LAS unsigned* st; };
__device__ __forceinline__ XcdBarrier xcd_barrier_post(unsigned* bar, volatile LAS unsigned* st) {
  XcdBarrier b; b.bar = bar; b.x = xb_xcc_id(); b.st = st;
  if (threadIdx.x == 0) (void)xb_add(&bar[XB_XCNT(b.x)], 1u);
  return b;
}
__device__ __forceinline__ void xcd_barrier_complete(unsigned* bar, unsigned x, unsigned& nloc, unsigned& nx) {
  const unsigned G = gridDim.x * gridDim.y * gridDim.z;
  unsigned sum, cnt, mine, sp = 0u;
  for (;;) {
    sum = 0u; cnt = 0u; mine = 0u;
#pragma unroll
    for (unsigned j = 0; j < 16; ++j) { const unsigned c = xb_ld(&bar[XB_XCNT(j)]); sum += c; cnt += (c > 0u) ? 1u : 0u; mine = (j == x) ? c : mine; }
    if (sum == G) break;
    __builtin_amdgcn_s_sleep(1);
    if ((++sp & 255u) == 0u) { if (xb_ld(&bar[XB_TMO])) break; if (sp > XB_SPIN_CAP) { atomicAdd(&bar[XB_TMO], 1u); break; } }
  }
  nloc = mine > 0u ? mine : 1u; nx = cnt > 0u ? cnt : 1u;
}
__device__ __forceinline__ void xcd_barrier(const XcdBarrier& b) {
  asm volatile("s_waitcnt vmcnt(0)" ::: "memory");
  __syncthreads();
  if (threadIdx.x == 0) {
    unsigned* bar = b.bar;
    __builtin_amdgcn_s_waitcnt(0);
    unsigned nloc = b.st[0], nx = b.st[1];
    if (nloc == 0u) { xcd_barrier_complete(bar, b.x, nloc, nx); b.st[0] = nloc; b.st[1] = nx; }
    const unsigned old = xb_add(&bar[XB_XSUB(b.x)], 1u);
    const unsigned gen = old / nloc;
    if (old + 1u == (gen + 1u) * nloc) {
      __builtin_amdgcn_fence(__ATOMIC_RELEASE, "agent");
      asm volatile("s_waitcnt vmcnt(0)" ::: "memory");
      const unsigned og = xb_add(&bar[XB_TOP], 1u);
      const unsigned tg = og / nx;
      if (og + 1u == (tg + 1u) * nx) xb_add(&bar[XB_TOPGEN], 1u);
      else XB_SPIN(xb_ld(&bar[XB_TOPGEN]) == tg, bar);
      __builtin_amdgcn_fence(__ATOMIC_ACQUIRE, "agent");
      xb_add(&bar[XB_XGEN(b.x)], 1u);
      asm volatile("s_waitcnt vmcnt(0)" ::: "memory");
    } else {
      XB_SPIN(xb_ld(&bar[XB_XGEN(b.x)]) == gen, bar);
      __builtin_amdgcn_fence(__ATOMIC_ACQUIRE, "agent");
      asm volatile("s_waitcnt vmcnt(0)" ::: "memory");
    }
  }
  __syncthreads();
}

__device__ void gla_item(const Params& p, int item, int pass, char* smem) {
  const int dvp = item & 1, seg = (item >> 1) & 15, dir = (item >> 5) & 1, h = (item >> 6) & 3, b = item >> 8;
  const int bhd = (b * 4 + h) * 2 + dir;
  u16* sQ = (u16*)smem;
  u16* sK = sQ + 64 * 136;
  u16* sKT = sK + 64 * 136;
  u16* sVT = sKT + 128 * 72;
  u16* sST = sVT + 64 * 72;
  float* sDec = (float*)(sST + 64 * 136);
  float* sTot = (float*)sVT;
  const int t = threadIdx.x, lane = t & 63, w = __builtin_amdgcn_readfirstlane(t >> 6), wr = w >> 1, wc = w & 1, fr = lane & 15, fq = lane >> 4;
  const int d0 = lane * 2;
  const u32* la16 = (const u32*)p.R6 + (size_t)dir * BT * 256 + h * 64 + lane;
  const u16* qk = p.R3;
  const u16* vv = p.R4;
  u16* obuf = dir ? p.R2 : p.R1;
  float* Lp = p.R7 + (size_t)(bhd * 16 + seg) * 32768 + (size_t)dvp * 128 * 128;

  f32x4 accS[2][2][4];
#pragma unroll
  for (int s = 0; s < 2; s++)
#pragma unroll
    for (int m = 0; m < 2; m++)
#pragma unroll
      for (int n = 0; n < 4; n++)
#pragma unroll
        for (int j = 0; j < 4; j++)
          accS[s][m][n][j] = (pass == 2) ? Lp[(s * 64 + wr * 32 + m * 16 + fq * 4 + j) * 128 + wc * 64 + n * 16 + fr] : 0.f;
  float dsum0 = 0.f, dsum1 = 0.f;

  for (int ci = 0; ci < 8; ci++) {
    const int c = seg * 8 + ci;
    __syncthreads();
    u32 qv[16], kv[16], lav[16], vreg[2][16];
#pragma unroll
    for (int ii = 0; ii < 16; ii++) {
      int f = c * 64 + w * 16 + ii;
      int pos = dir ? (SEQ - 1 - f) : f;
      size_t tokoff = (size_t)(b * SEQ + pos) * 1024;
      kv[ii] = *(const u32*)(qk + tokoff + 512 + h * 128 + d0);
      if (pass == 2) qv[ii] = *(const u32*)(qk + tokoff + h * 128 + d0);
      lav[ii] = la16[(size_t)(b * SEQ + pos) * 256];
      vreg[0][ii] = vv[tokoff + h * 256 + dvp * 128 + lane];
      vreg[1][ii] = vv[tokoff + h * 256 + dvp * 128 + 64 + lane];
    }
    float bl0[16], bl1[16];
    {
      float run0 = 0.f, run1 = 0.f;
#pragma unroll
      for (int ii = 0; ii < 16; ii++) {
        run0 += (float)__builtin_bit_cast(_Float16, (unsigned short)(lav[ii] & 0xffffu));
        run1 += (float)__builtin_bit_cast(_Float16, (unsigned short)(lav[ii] >> 16));
        bl0[ii] = run0; bl1[ii] = run1;
      }
      sTot[w * 128 + d0] = run0;
      sTot[w * 128 + d0 + 1] = run1;
    }
    __syncthreads();
    {
      float off0 = 0.f, off1 = 0.f, tot0 = 0.f, tot1 = 0.f;
#pragma unroll
      for (int ww = 0; ww < 4; ww++) {
        float a = sTot[ww * 128 + d0], bb = sTot[ww * 128 + d0 + 1];
        if (ww < w) { off0 += a; off1 += bb; }
        tot0 += a; tot1 += bb;
      }
      dsum0 += tot0; dsum1 += tot1;
      const float et0 = __expf(tot0), et1 = __expf(tot1);
      if (w == 0) { sDec[d0] = et0; sDec[d0 + 1] = et1; }
#pragma unroll
      for (int ii = 0; ii < 16; ii += 2) {
        float ke0[2], ke1[2];
#pragma unroll
        for (int s = 0; s < 2; s++) {
          const int i2 = ii + s;
          const float b0 = bl0[i2] + off0, b1 = bl1[i2] + off1;
          const float k0 = blo(kv[i2]), k1 = bhi(kv[i2]);
          const int i = w * 16 + i2;
          const float e0 = __expf(b0), e1 = __expf(b1);
          const float kt0 = k0 * __builtin_amdgcn_rcpf(e0), kt1 = k1 * __builtin_amdgcn_rcpf(e1);
          if (pass == 2) {
            *(u32*)(sQ + i * 136 + d0) = pack2(blo(qv[i2]) * e0, bhi(qv[i2]) * e1);
            *(u32*)(sK + i * 136 + d0) = pack2(kt0, kt1);
          }
          ke0[s] = kt0 * et0;
          ke1[s] = kt1 * et1;
        }
        *(u32*)(sKT + d0 * 72 + w * 16 + ii) = pack2(ke0[0], ke0[1]);
        *(u32*)(sKT + (d0 + 1) * 72 + w * 16 + ii) = pack2(ke1[0], ke1[1]);
      }
    }
    __syncthreads();
    u16* sP = sK;
    if (pass == 2) {
      f32x4 accP[2][2];
#pragma unroll
      for (int m = 0; m < 2; m++)
#pragma unroll
        for (int n = 0; n < 2; n++) accP[m][n] = f32x4{0.f, 0.f, 0.f, 0.f};
      mma_nt<2, 2, 4>(accP, sQ + wr * 32 * 136, 136, sK + wc * 32 * 136, 136, lane);
      __syncthreads();
#pragma unroll
      for (int m = 0; m < 2; m++)
#pragma unroll
        for (int n = 0; n < 2; n++)
#pragma unroll
          for (int j = 0; j < 4; j++) {
            int i = wr * 32 + m * 16 + fq * 4 + j, jj = wc * 32 + n * 16 + fr;
            sP[i * 72 + jj] = (i >= jj) ? f2b(accP[m][n][j]) : (u16)0;
          }
    }
#pragma unroll
    for (int s = 0; s < 2; s++) {
      if (pass == 2) {
#pragma unroll
        for (int m = 0; m < 2; m++)
#pragma unroll
          for (int n = 0; n < 4; n++)
#pragma unroll
            for (int j = 0; j < 4; j++) sST[(wr * 32 + m * 16 + fq * 4 + j) * 136 + wc * 64 + n * 16 + fr] = f2b(accS[s][m][n][j]);
      }
      {
        uint4 v0 = make_uint4(vreg[s][0] | (vreg[s][1] << 16), vreg[s][2] | (vreg[s][3] << 16), vreg[s][4] | (vreg[s][5] << 16),
                              vreg[s][6] | (vreg[s][7] << 16));
        uint4 v1 = make_uint4(vreg[s][8] | (vreg[s][9] << 16), vreg[s][10] | (vreg[s][11] << 16), vreg[s][12] | (vreg[s][13] << 16),
                              vreg[s][14] | (vreg[s][15] << 16));
        *(uint4*)(sVT + lane * 72 + w * 16) = v0;
        *(uint4*)(sVT + lane * 72 + w * 16 + 8) = v1;
      }
      __syncthreads();
      if (pass == 2) {
        f32x4 accO[2][2];
#pragma unroll
        for (int m = 0; m < 2; m++)
#pragma unroll
          for (int n = 0; n < 2; n++) accO[m][n] = f32x4{0.f, 0.f, 0.f, 0.f};
        mma_nt<2, 2, 4>(accO, sQ + wr * 32 * 136, 136, sST + wc * 32 * 136, 136, lane);
        mma_nt<2, 2, 2>(accO, sP + wr * 32 * 72, 72, sVT + wc * 32 * 72, 72, lane);
#pragma unroll
        for (int m = 0; m < 2; m++)
#pragma unroll
          for (int j = 0; j < 4; j++) {
            int i = wr * 32 + m * 16 + fq * 4 + j;
            int f = c * 64 + i;
            int pos = dir ? (SEQ - 1 - f) : f;
            size_t o = (size_t)(b * SEQ + pos) * 1024 + h * 256 + dvp * 128 + s * 64 + wc * 32 + fr;
#pragma unroll
            for (int n = 0; n < 2; n++) obuf[o + n * 16] = f2b(accO[m][n][j]);
          }
      }
#pragma unroll
      for (int n = 0; n < 4; n++) {
        float dc = sDec[wc * 64 + n * 16 + fr];
#pragma unroll
        for (int m = 0; m < 2; m++)
#pragma unroll
          for (int j = 0; j < 4; j++) accS[s][m][n][j] *= dc;
      }
      mma_nt<2, 4, 2>(accS[s], sVT + wr * 32 * 72, 72, sKT + wc * 64 * 72, 72, lane);
      if (s == 0) __syncthreads();
    }
  }
  if (pass == 1) {
#pragma unroll
    for (int s = 0; s < 2; s++)
#pragma unroll
      for (int m = 0; m < 2; m++)
#pragma unroll
        for (int n = 0; n < 4; n++)
#pragma unroll
          for (int j = 0; j < 4; j++) Lp[(s * 64 + wr * 32 + m * 16 + fq * 4 + j) * 128 + wc * 64 + n * 16 + fr] = accS[s][m][n][j];
    if (dvp == 0 && w == 0) {
      p.Dd[(bhd * 16 + seg) * 128 + d0] = __expf(dsum0);
      p.Dd[(bhd * 16 + seg) * 128 + d0 + 1] = __expf(dsum1);
    }
  }
}

__device__ void phase2(const Params& p, char* smem, const XcdBarrier& xb) {
  const int t = threadIdx.x;
  (void)xb;
  u16* ya = (u16*)p.out + (size_t)BT * 1024;
  for (int job = blockIdx.x; job < 512 + 2048; job += gridDim.x) {
    if (job < 512) {
      gla_item(p, job, 1, smem);
    } else {
      const int j = job - 512;
      const int ch = (t & 127) * 8;
      float w0[8], w1[8], w2[8], cb[8];
#pragma unroll
      for (int e = 0; e < 8; e++) { w0[e] = p.conv_w[ch + e]; w1[e] = p.conv_w[1024 + ch + e]; w2[e] = p.conv_w[2048 + ch + e]; cb[e] = p.conv_b[ch + e]; }
#pragma unroll
      for (int it = 0; it < 4; it++) {
        const int tok = j * 8 + it * 2 + (t >> 7);
        const int pos = tok & (SEQ - 1);
        const size_t o = (size_t)tok * 1024 + ch;
        uint4 pc = *(const uint4*)(p.R1 + o);
        uint4 pp = make_uint4(0, 0, 0, 0), pn = make_uint4(0, 0, 0, 0);
        if (pos > 0) pp = *(const uint4*)(p.R1 + o - 1024);
        if (pos < SEQ - 1) pn = *(const uint4*)(p.R1 + o + 1024);
        uint4 bb = *(const uint4*)(p.R2 + o);
        const u32 pcs[4] = {pc.x, pc.y, pc.z, pc.w}, pps[4] = {pp.x, pp.y, pp.z, pp.w}, pns[4] = {pn.x, pn.y, pn.z, pn.w},
                  bbs[4] = {bb.x, bb.y, bb.z, bb.w};
        u32 ov[4];
#pragma unroll
        for (int q = 0; q < 4; q++) {
          float y0 = cb[2 * q] + w0[2 * q] * blo(pps[q]) + w1[2 * q] * blo(pcs[q]) + w2[2 * q] * blo(pns[q]);
          float y1 = cb[2 * q + 1] + w0[2 * q + 1] * bhi(pps[q]) + w1[2 * q + 1] * bhi(pcs[q]) + w2[2 * q + 1] * bhi(pns[q]);
          ov[q] = pack2(blo(bbs[q]) * y0, bhi(bbs[q]) * y1);
        }
        *(uint4*)(ya + o) = make_uint4(ov[0], ov[1], ov[2], ov[3]);
      }
    }
  }
}

__device__ void phase3(const Params& p) {
  for (int gid = blockIdx.x * 256 + threadIdx.x; gid < 16 * 32768; gid += gridDim.x * 256) {
    const int bhd = gid >> 15, e = gid & 32767, dk = e & 127;
    float carry = 0.f;
    for (int s = 0; s < 16; s++) {
      float* lp = p.R7 + (size_t)(bhd * 16 + s) * 32768 + e;
      float tmp = *lp;
      *lp = carry;
      carry = p.Dd[(bhd * 16 + s) * 128 + dk] * carry + tmp;
    }
  }
}

__device__ void phase5(const Params& p) {
  const int t = threadIdx.x, lane = t & 63, w = t >> 6;
  float gv[16];
#pragma unroll
  for (int i = 0; i < 4; i++) {
    const float4 g = *(const float4*)(p.gng + lane * 16 + i * 4);
    gv[i * 4 + 0] = g.x; gv[i * 4 + 1] = g.y; gv[i * 4 + 2] = g.z; gv[i * 4 + 3] = g.w;
  }
  for (int tok = blockIdx.x * 4 + w; tok < BT; tok += gridDim.x * 4) {
    const size_t o = (size_t)tok * 1024 + lane * 16;
    const uint4 a0 = *(const uint4*)(p.R1 + o), a1 = *(const uint4*)(p.R1 + o + 8);
    const uint4 b0 = *(const uint4*)(p.R2 + o), b1 = *(const uint4*)(p.R2 + o + 8);
    const uint4 r0 = *(const uint4*)(p.R5 + o), r1 = *(const uint4*)(p.R5 + o + 8);
    const u32 aw[8] = {a0.x, a0.y, a0.z, a0.w, a1.x, a1.y, a1.z, a1.w};
    const u32 bw[8] = {b0.x, b0.y, b0.z, b0.w, b1.x, b1.y, b1.z, b1.w};
    const u32 rw[8] = {r0.x, r0.y, r0.z, r0.w, r1.x, r1.y, r1.z, r1.w};
    float ov[16];
    float ss = 0.f;
#pragma unroll
    for (int i = 0; i < 8; i++) {
      ov[2 * i] = blo(aw[i]) + blo(bw[i]);
      ov[2 * i + 1] = bhi(aw[i]) + bhi(bw[i]);
      ss += ov[2 * i] * ov[2 * i] + ov[2 * i + 1] * ov[2 * i + 1];
    }
    ss += __shfl_xor(ss, 1); ss += __shfl_xor(ss, 2); ss += __shfl_xor(ss, 4); ss += __shfl_xor(ss, 8);
    const float rstd = rsqrtf(ss * (1.f / 256.f) + 1e-6f);
    u32 ow[8];
#pragma unroll
    for (int i = 0; i < 8; i++) {
      const float ra = blo(rw[i]), rb = bhi(rw[i]);
      ow[i] = pack2(ov[2 * i] * rstd * gv[2 * i] * (ra * sigmoidf_(ra)), ov[2 * i + 1] * rstd * gv[2 * i + 1] * (rb * sigmoidf_(rb)));
    }
    *(uint4*)(p.R6 + o) = make_uint4(ow[0], ow[1], ow[2], ow[3]);
    *(uint4*)(p.R6 + o + 8) = make_uint4(ow[4], ow[5], ow[6], ow[7]);
  }
}

__device__ void phase6(const Params& p, char* smem) {
  const int t = threadIdx.x, lane = t & 63, w = t >> 6, wr = w >> 1, wc = w & 1, fr = lane & 15, fq = lane >> 4;
  const u16* xn = (const u16*)p.out;
  const u16* ya = xn + (size_t)BT * 1024;
  uint4* sG = (uint4*)((char*)p.R2 + (size_t)blockIdx.x * 65536 + t * 256);
  uint4* sH = sG + 8;
  TileIter ti(8);
  int mt, nt;
  while (ti.next(mt, nt)) {
    const int colb = nt * 128 + wc * 64 + fq * 4;
    f32x4 acc[4][4];
    zero_acc(acc);
    gemm_acc_db(acc, xn + (size_t)mt * 128 * 1024, 1024, p.WinT + (size_t)(6272 + nt * 128) * 1024, 1024, 1024, smem);
    {
      float4 gb[4];
#pragma unroll
      for (int n = 0; n < 4; n++) gb[n] = *(const float4*)(p.gbias + colb + n * 16);
#pragma unroll
      for (int m = 0; m < 4; m++)
#pragma unroll
        for (int h = 0; h < 2; h++)
          sG[m * 2 + h] = make_uint4(pack2(sigmoidf_(acc[m][2 * h][0] + gb[2 * h].x), sigmoidf_(acc[m][2 * h][1] + gb[2 * h].y)),
                                     pack2(sigmoidf_(acc[m][2 * h][2] + gb[2 * h].z), sigmoidf_(acc[m][2 * h][3] + gb[2 * h].w)),
                                     pack2(sigmoidf_(acc[m][2 * h + 1][0] + gb[2 * h + 1].x), sigmoidf_(acc[m][2 * h + 1][1] + gb[2 * h + 1].y)),
                                     pack2(sigmoidf_(acc[m][2 * h + 1][2] + gb[2 * h + 1].z), sigmoidf_(acc[m][2 * h + 1][3] + gb[2 * h + 1].w)));
    }
    zero_acc(acc);
    gemm_acc_db(acc, ya + (size_t)mt * 128 * 1024, 1024, p.WaT + (size_t)nt * 128 * 1024, 1024, 1024, smem);
#pragma unroll
    for (int m = 0; m < 4; m++)
#pragma unroll
      for (int h = 0; h < 2; h++) {
        const uint4 g = sG[m * 2 + h];
        sG[m * 2 + h] = make_uint4(pack2(acc[m][2 * h][0] * blo(g.x), acc[m][2 * h][1] * bhi(g.x)),
                                   pack2(acc[m][2 * h][2] * blo(g.y), acc[m][2 * h][3] * bhi(g.y)),
                                   pack2(acc[m][2 * h + 1][0] * blo(g.z), acc[m][2 * h + 1][1] * bhi(g.z)),
                                   pack2(acc[m][2 * h + 1][2] * blo(g.w), acc[m][2 * h + 1][3] * bhi(g.w)));
      }
    zero_acc(acc);
    gemm_acc_db(acc, p.R6 + (size_t)mt * 128 * 1024, 1024, p.WbT + (size_t)nt * 128 * 1024, 1024, 1024, smem);
#pragma unroll
    for (int m = 0; m < 4; m++)
#pragma unroll
      for (int h = 0; h < 2; h++)
        sH[m * 2 + h] = make_uint4(pack2(acc[m][2 * h][0], acc[m][2 * h][1]), pack2(acc[m][2 * h][2], acc[m][2 * h][3]),
                                   pack2(acc[m][2 * h + 1][0], acc[m][2 * h + 1][1]), pack2(acc[m][2 * h + 1][2], acc[m][2 * h + 1][3]));
    zero_acc(acc);
    gemm_acc_db(acc, xn + (size_t)mt * 128 * 1024, 1024, p.WinT + (size_t)(6272 + 1024 + nt * 128) * 1024, 1024, 1024, smem);
    const int rowb = mt * 128 + wr * 64 + fr;
    {
      float4 gb[4];
#pragma unroll
      for (int n = 0; n < 4; n++) gb[n] = *(const float4*)(p.gbias + 1024 + colb + n * 16);
#pragma unroll
      for (int m = 0; m < 4; m++)
#pragma unroll
        for (int h = 0; h < 2; h++) {
          const uint4 a = sG[m * 2 + h], b = sH[m * 2 + h];
          const u32 av[4] = {a.x, a.y, a.z, a.w}, bv[4] = {b.x, b.y, b.z, b.w};
#pragma unroll
          for (int nn = 0; nn < 2; nn++) {
            const int n = 2 * h + nn;
            float r0 = blo(av[nn * 2]) + blo(bv[nn * 2]) * sigmoidf_(acc[m][n][0] + gb[n].x);
            float r1 = bhi(av[nn * 2]) + bhi(bv[nn * 2]) * sigmoidf_(acc[m][n][1] + gb[n].y);
            float r2 = blo(av[nn * 2 + 1]) + blo(bv[nn * 2 + 1]) * sigmoidf_(acc[m][n][2] + gb[n].z);
            float r3 = bhi(av[nn * 2 + 1]) + bhi(bv[nn * 2 + 1]) * sigmoidf_(acc[m][n][3] + gb[n].w);
            *(uint2*)(p.R1 + (size_t)(rowb + m * 16) * 1024 + colb + n * 16) = make_uint2(pack2(r0, r1), pack2(r2, r3));
          }
        }
    }
  }
}

__device__ void phase7(const Params& p, char* smem) {
  u16* sA = (u16*)smem;
  u16* sB = sA + 128 * 64;
  const int t = threadIdx.x, lane = t & 63, w = t >> 6, wr = w >> 1, wc = w & 1, fr = lane & 15, fq = lane >> 4;
  float* x1 = (float*)p.R2;
  TileIter ti(8);
  int mt, nt;
  while (ti.next(mt, nt)) {
    f32x4 acc[4][4];
    zero_acc(acc);
    gemm_acc_db(acc, p.R1 + (size_t)mt * 128 * 1024, 1024, p.WoT + (size_t)nt * 128 * 1024, 1024, 1024, smem);
    const int rowb = mt * 128 + wr * 64 + fr;
    const int colb = nt * 128 + wc * 64 + fq * 4;
#pragma unroll
    for (int m = 0; m < 4; m++)
#pragma unroll
      for (int n = 0; n < 4; n++) {
        const size_t o = (size_t)(rowb + m * 16) * 1024 + colb + n * 16;
        const float4 xv = *(const float4*)(p.x + o);
        *(float4*)(x1 + o) = make_float4(xv.x + acc[m][n][0], xv.y + acc[m][n][1], xv.z + acc[m][n][2], xv.w + acc[m][n][3]);
      }
  }
}

constexpr float U_SCALE = 256.f, V_SCALE = 64.f;
__device__ __forceinline__ u32 enc_fp8x4(float a, float b, float c, float d) {
  int w = __builtin_amdgcn_cvt_pk_fp8_f32(a, b, 0, false);
  w = __builtin_amdgcn_cvt_pk_fp8_f32(c, d, w, true);
  return (u32)w;
}
__device__ __forceinline__ void table_convert_job(const Params& p, int j, int t) {
  unsigned char* Tb = (unsigned char*)p.R5;
  const float* src = (j < 4096) ? p.pu : p.pv;
  const float sc = (j < 4096) ? U_SCALE : V_SCALE;
  size_t base = (size_t)(j & 4095) * 4096 + t * 16;
  unsigned char* slot = Tb + (base >> 10) * 2048 + ((j < 4096) ? 0 : 1024) + (base & 1023);
  float4 a = *(const float4*)(src + base), b = *(const float4*)(src + base + 4), c = *(const float4*)(src + base + 8),
         d = *(const float4*)(src + base + 12);
  *(uint4*)slot = make_uint4(enc_fp8x4(a.x * sc, a.y * sc, a.z * sc, a.w * sc), enc_fp8x4(b.x * sc, b.y * sc, b.z * sc, b.w * sc),
                                     enc_fp8x4(c.x * sc, c.y * sc, c.z * sc, c.w * sc), enc_fp8x4(d.x * sc, d.y * sc, d.z * sc, d.w * sc));
}
__device__ void phase8(const Params& p) {
  const int t = threadIdx.x, lane = t & 63, w = t >> 6;
  const float* x1 = (const float*)p.R2;
  for (int job = blockIdx.x; job < 4096; job += gridDim.x) {
    int row = job * 4 + w;
    rms_row(x1 + (size_t)row * 1024, p.norm2_g, p.R4 + (size_t)row * 1024, lane);
  }
}

__device__ void phase9(const Params& p, char* smem) {
  u16* sA = (u16*)smem;
  u16* sB = sA + 128 * 64;
  const int t = threadIdx.x, lane = t & 63, w = t >> 6, wr = w >> 1, wc = w & 1, fr = lane & 15, fq = lane >> 4;
  u16* q = (u16*)p.out;
  TileIter ti(16);
  int mt, nt;
  while (ti.next(mt, nt)) {
    f32x4 acc[4][4];
    zero_acc(acc);
    gemm_acc_db(acc, p.R4 + (size_t)mt * 128 * 1024, 1024, p.WqT + (size_t)nt * 128 * 1024, 1024, 1024, smem);
    const int rowb = mt * 128 + wr * 64 + fr;
    const int colb = nt * 128 + wc * 64 + fq * 4;
#pragma unroll
    for (int m = 0; m < 4; m++)
#pragma unroll
      for (int n = 0; n < 4; n++)
        *(uint2*)(q + (size_t)(rowb + m * 16) * 2048 + colb + n * 16) = make_uint2(pack2(acc[m][n][0], acc[m][n][1]), pack2(acc[m][n][2], acc[m][n][3]));
#pragma unroll 1
    for (int r = 0; r < 4; r++) table_convert_job(p, (mt * 16 + nt) * 4 + r, t);
  }
}

__device__ __forceinline__ void select16q(u32* rowbase, int part, u32 (&tk)[16], unsigned char* idxp) {
  u32* myp = rowbase + part * 32;
#pragma unroll
  for (int it = 0; it < 16; it++) {
    u32 m = 0;
#pragma unroll
    for (int c = 0; c < 8; c++) {
      uint4 kk = *(const uint4*)(myp + c * 4);
      m = max(m, max(max(kk.x, kk.y), max(kk.z, kk.w)));
    }
    m = max(m, (u32)__shfl_xor((int)m, 1));
    m = max(m, (u32)__shfl_xor((int)m, 2));
    tk[it] = m;
    const int idx = 127 - (int)(m & 127u);
    if ((idx >> 5) == part) { rowbase[idx] = 0; idxp[it] = (unsigned char)idx; }
  }
}

__device__ void phase10(const Params& p, char* smem) {
  u16* sKeys = (u16*)smem;
  u32* sSc = (u32*)(smem + 128 * 136 * 2);
  unsigned char* sIdx = (unsigned char*)(smem + 128 * 136 * 2 + 64 * 132 * 4);
  const int t = threadIdx.x, lane = t & 63, w = t >> 6, fr = lane & 15, fq = lane >> 4;
  const int rl = lane >> 2, part = lane & 3, row = w * 16 + rl;
  const u16* q = (const u16*)p.out;
  int* experts = (int*)p.R7;
  float* gates = p.R7 + (size_t)BT * 128;
#define P10_DECL(S) uint4 S##k0, S##k1, S##k2, S##k3, S##k4, S##k5, S##k6, S##k7; bf16x8 S##q0, S##q1, S##q2, S##q3
#define P10_LOAD(S, ITEM, PP)                                                                               \
  do {                                                                                                      \
    const int it_ = ((ITEM) < 256 * 8) ? (ITEM) : (int)blockIdx.x;                                          \
    const int tt_ = it_ >> 3, h_ = it_ & 7;                                                                 \
    const u16* ks_ = p.KeysB + (size_t)(h_ * 2 + (PP)) * 128 * 128 + (t >> 4) * 128 + (t & 15) * 8;         \
    S##k0 = *(const uint4*)(ks_); S##k1 = *(const uint4*)(ks_ + 16 * 128); S##k2 = *(const uint4*)(ks_ + 32 * 128);   \
    S##k3 = *(const uint4*)(ks_ + 48 * 128); S##k4 = *(const uint4*)(ks_ + 64 * 128); S##k5 = *(const uint4*)(ks_ + 80 * 128); \
    S##k6 = *(const uint4*)(ks_ + 96 * 128); S##k7 = *(const uint4*)(ks_ + 112 * 128);                      \
    const u16* qp_ = q + (size_t)(tt_ * 64 + w * 16 + fr) * 2048 + h_ * 256 + (PP) * 128 + fq * 8;          \
    S##q0 = *(const bf16x8*)(qp_); S##q1 = *(const bf16x8*)(qp_ + 32); S##q2 = *(const bf16x8*)(qp_ + 64);  \
    S##q3 = *(const bf16x8*)(qp_ + 96);                                                                     \
  } while (0)
#define P10_MFMA_K(QK, KI)                                                                                  \
  _Pragma("unroll") for (int n_ = 0; n_ < 8; n_++) {                                                        \
    bf16x8 bv_ = *(const bf16x8*)(sKeys + (n_ * 16 + fr) * 136 + (KI) * 32 + fq * 8);                       \
    acc_[n_] = __builtin_amdgcn_mfma_f32_16x16x32_bf16(QK, bv_, acc_[n_], 0, 0, 0);                         \
  }
#define P10_SCORE(S)                                                                                        \
  do {                                                                                                      \
    __syncthreads();                                                                                        \
    u16* kd_ = sKeys + (t >> 4) * 136 + (t & 15) * 8;                                                       \
    *(uint4*)(kd_) = S##k0; *(uint4*)(kd_ + 16 * 136) = S##k1; *(uint4*)(kd_ + 32 * 136) = S##k2;           \
    *(uint4*)(kd_ + 48 * 136) = S##k3; *(uint4*)(kd_ + 64 * 136) = S##k4; *(uint4*)(kd_ + 80 * 136) = S##k5; \
    *(uint4*)(kd_ + 96 * 136) = S##k6; *(uint4*)(kd_ + 112 * 136) = S##k7;                                  \
    __syncthreads();                                                                                        \
    f32x4 acc_[8];                                                                                          \
    _Pragma("unroll") for (int n_ = 0; n_ < 8; n_++) acc_[n_] = f32x4{0.f, 0.f, 0.f, 0.f};                  \
    P10_MFMA_K(S##q0, 0) P10_MFMA_K(S##q1, 1) P10_MFMA_K(S##q2, 2) P10_MFMA_K(S##q3, 3)                     \
    _Pragma("unroll") for (int n_ = 0; n_ < 8; n_++)                                                        \
      _Pragma("unroll") for (int j_ = 0; j_ < 4; j_++) {                                                    \
        int r_ = w * 16 + fq * 4 + j_, col_ = n_ * 16 + fr;                                                 \
        sSc[r_ * 132 + col_] = (ordf(acc_[n_][j_]) & ~127u) | (u32)(127 - col_);                            \
      }                                                                                                     \
    __syncthreads();                                                                                        \
  } while (0)
  P10_DECL(sa);
  P10_DECL(sb);
  P10_LOAD(sa, (int)blockIdx.x, 0);
  for (int item = blockIdx.x; item < 256 * 8; item += gridDim.x) {
    const int tt = item >> 3, h = item & 7;
    u32 ta[16], tb[16];
    P10_SCORE(sa);
    P10_LOAD(sb, item, 1);
    select16q(sSc + row * 132, part, ta, sIdx + row * 32);
    P10_SCORE(sb);
    P10_LOAD(sa, item + (int)gridDim.x, 0);
    select16q(sSc + row * 132, part, tb, sIdx + row * 32 + 16);
    __syncthreads();
    {
      float fa[4], fb[16];
#pragma unroll
      for (int r = 0; r < 4; r++) {
        const u32 s0 = ta[4 * r], s1 = ta[4 * r + 1], s2 = ta[4 * r + 2], s3 = ta[4 * r + 3];
        const u32 sel = part == 0 ? s0 : (part == 1 ? s1 : (part == 2 ? s2 : s3));
        fa[r] = unordf(sel & ~127u);
      }
#pragma unroll
      for (int j = 0; j < 16; j++) fb[j] = unordf(tb[j] & ~127u);
      constexpr int NJ[4] = {16, 3, 1, 1};
      u32 cand[4][16];
#pragma unroll
      for (int r = 0; r < 4; r++) {
        const int irow = part + 4 * r;
        const int jlim = 16 / (irow + 1);
#pragma unroll
        for (int j = 0; j < 16; j++)
          if (j < NJ[r]) cand[r][j] = (j < jlim) ? ((ordf(fa[r] + fb[j]) & ~255u) | (u32)(255 - (irow * 16 + j))) : 0u;
      }
      const int tok = tt * 64 + row;
      float sv[16];
      int ev[16];
#pragma unroll
      for (int it = 0; it < 16; it++) {
        u32 m = 0;
#pragma unroll
        for (int r = 0; r < 4; r++)
#pragma unroll
          for (int j = 0; j < 16; j++)
            if (j < NJ[r]) m = max(m, cand[r][j]);
        m = max(m, (u32)__shfl_xor((int)m, 1));
        m = max(m, (u32)__shfl_xor((int)m, 2));
#pragma unroll
        for (int r = 0; r < 4; r++)
#pragma unroll
          for (int j = 0; j < 16; j++)
            if (j < NJ[r]) cand[r][j] = (cand[r][j] == m) ? 0u : cand[r][j];
        const int c = 255 - (int)(m & 255u);
        const int i1 = sIdx[row * 32 + (c >> 4)], i2 = sIdx[row * 32 + 16 + (c & 15)];
        ev[it] = i1 * 128 + i2;
        sv[it] = unordf(m & ~255u);
      }
      const float mx = sv[0];
      float sum = 0.f;
#pragma unroll
      for (int it = 0; it < 16; it++) { sv[it] = __expf(sv[it] - mx); sum += sv[it]; }
      const float inv = 1.f / sum;
#pragma unroll
      for (int g = 0; g < 4; g++) {
        if (part == g) {
          *(int4*)(experts + (size_t)tok * 128 + h * 16 + g * 4) = make_int4(ev[g * 4], ev[g * 4 + 1], ev[g * 4 + 2], ev[g * 4 + 3]);
          *(float4*)(gates + (size_t)tok * 128 + h * 16 + g * 4) =
              make_float4(sv[g * 4] * inv, sv[g * 4 + 1] * inv, sv[g * 4 + 2] * inv, sv[g * 4 + 3] * inv);
        }
      }
    }
  }
}

#undef P10_LOAD
#undef P10_SCORE
#undef P10_MFMA_K
#undef P10_DECL
typedef float f32x2 __attribute__((ext_vector_type(2)));
__device__ __forceinline__ void dec16(const uint4& q, float (&o)[16]) {
  const u32 ws_[4] = {q.x, q.y, q.z, q.w};
#pragma unroll
  for (int i = 0; i < 4; i++) {
    f32x2 lo = __builtin_amdgcn_cvt_pk_f32_fp8((int)ws_[i], false);
    f32x2 hi = __builtin_amdgcn_cvt_pk_f32_fp8((int)ws_[i], true);
    o[i * 4 + 0] = lo[0]; o[i * 4 + 1] = lo[1]; o[i * 4 + 2] = hi[0]; o[i * 4 + 3] = hi[1];
  }
}
__device__ __forceinline__ void peer_load8(uint4 (&U)[8], uint4 (&V)[8], const unsigned char* Ub, const unsigned char* Vb, int ev, int l0,
                                           int lane) {
#pragma unroll
  for (int u = 0; u < 8; u++) {
    const int e = __builtin_amdgcn_readlane(ev, l0 + u);
    U[u] = *(const uint4*)(Ub + (size_t)e * 2048 + lane * 16);
    V[u] = *(const uint4*)(Vb + (size_t)e * 2048 + lane * 16);
  }
}
__device__ __forceinline__ void peer_proc8(const uint4 (&U)[8], const uint4 (&V)[8], const f32x2 (&xp)[8], f32x2 (&accp)[8], float gate_lane,
                                           int lane) {
  float d[8];
#pragma unroll
  for (int u = 0; u < 8; u++) {
    const u32 ws_[4] = {U[u].x, U[u].y, U[u].z, U[u].w};
    f32x2 s = {0.f, 0.f};
#pragma unroll
    for (int q = 0; q < 4; q++) {
      s += xp[2 * q] * __builtin_amdgcn_cvt_pk_f32_fp8((int)ws_[q], false);
      s += xp[2 * q + 1] * __builtin_amdgcn_cvt_pk_f32_fp8((int)ws_[q], true);
    }
    d[u] = s[0] + s[1];
  }
  {
    const bool b4 = (lane & 4) != 0, b2 = (lane & 2) != 0, b1 = (lane & 1) != 0;
#pragma unroll
    for (int i = 0; i < 4; i++) {
      const float send = b4 ? d[i] : d[i + 4], keep = b4 ? d[i + 4] : d[i];
      d[i] = keep + __shfl_xor(send, 4);
    }
#pragma unroll
    for (int i = 0; i < 2; i++) {
      const float send = b2 ? d[i] : d[i + 2], keep = b2 ? d[i + 2] : d[i];
      d[i] = keep + __shfl_xor(send, 2);
    }
    {
      const float send = b1 ? d[0] : d[1], keep = b1 ? d[1] : d[0];
      d[0] = keep + __shfl_xor(send, 1);
    }
    d[0] += __shfl_xor(d[0], 8);
    d[0] += __shfl_xor(d[0], 16);
    d[0] += __shfl_xor(d[0], 32);
  }
  const float dd = d[0] * (1.f / U_SCALE);
  const float hd = 0.5f * dd * (1.f + erff(dd * 0.70710678118654752f));
  const int cl = __float_as_int(hd * gate_lane * (1.f / V_SCALE));
#pragma unroll
  for (int u = 0; u < 8; u++) {
    const float c = __int_as_float(__builtin_amdgcn_readlane(cl, u));
    const f32x2 c2 = {c, c};
    const u32 ws_[4] = {V[u].x, V[u].y, V[u].z, V[u].w};
#pragma unroll
    for (int q = 0; q < 4; q++) {
      accp[2 * q] += c2 * __builtin_amdgcn_cvt_pk_f32_fp8((int)ws_[q], false);
      accp[2 * q + 1] += c2 * __builtin_amdgcn_cvt_pk_f32_fp8((int)ws_[q], true);
    }
  }
}
__device__ __forceinline__ float dot16_fp8(const f32x2 (&xp)[8], const uint4& q) {
  const u32 ws_[4] = {q.x, q.y, q.z, q.w};
  f32x2 s = {0.f, 0.f};
#pragma unroll
  for (int i = 0; i < 4; i++) {
    s += xp[2 * i] * __builtin_amdgcn_cvt_pk_f32_fp8((int)ws_[i], false);
    s += xp[2 * i + 1] * __builtin_amdgcn_cvt_pk_f32_fp8((int)ws_[i], true);
  }
  return s[0] + s[1];
}
__device__ __forceinline__ void pe_load_tab(const unsigned char* Tb, unsigned loff, int e0, int e1, int g, uint4 (&U)[16]) {
#pragma unroll
  for (int kb = 0; kb < 16; kb++) {
    const int e = __shfl((kb < 8) ? e0 : e1, (kb & 7) * 8 + g);
    U[kb] = *(const uint4*)(Tb + ((unsigned)e * 2048u + loff));
  }
}
__device__ __forceinline__ void pe_load_x(const u16* xr, f32x2 (&xp)[8]) {
  uint4 a = *(const uint4*)(xr), b = *(const uint4*)(xr + 8);
  xp[0] = f32x2{blo(a.x), bhi(a.x)}; xp[1] = f32x2{blo(a.y), bhi(a.y)}; xp[2] = f32x2{blo(a.z), bhi(a.z)}; xp[3] = f32x2{blo(a.w), bhi(a.w)};
  xp[4] = f32x2{blo(b.x), bhi(b.x)}; xp[5] = f32x2{blo(b.y), bhi(b.y)}; xp[6] = f32x2{blo(b.z), bhi(b.z)}; xp[7] = f32x2{blo(b.w), bhi(b.w)};
}
__device__ __forceinline__ void pe_dot_store(const f32x2 (&xp)[8], const uint4 (&U)[16], float* pr, int lane, int r) {
  float d[16];
#pragma unroll
  for (int kb = 0; kb < 16; kb++) d[kb] = dot16_fp8(xp, U[kb]);
  const bool b4 = (lane & 4) != 0, b2 = (lane & 2) != 0, b1 = (lane & 1) != 0;
#pragma unroll
  for (int i = 0; i < 8; i++) { const float send = b4 ? d[i] : d[i + 8], keep = b4 ? d[i + 8] : d[i]; d[i] = keep + __shfl_xor(send, 4); }
#pragma unroll
  for (int i = 0; i < 4; i++) { const float send = b2 ? d[i] : d[i + 4], keep = b2 ? d[i + 4] : d[i]; d[i] = keep + __shfl_xor(send, 2); }
#pragma unroll
  for (int i = 0; i < 2; i++) { const float send = b1 ? d[i] : d[i + 2], keep = b1 ? d[i + 2] : d[i]; d[i] = keep + __shfl_xor(send, 1); }
  pr[(2 * r) * 8] = d[0];
  pr[(2 * r + 1) * 8] = d[1];
}
__device__ void phase11a(const Params& p) {
  const int t = threadIdx.x, lane = t & 63, w = t >> 6, g = lane >> 3, r = lane & 7;
  const int s = blockIdx.x & 7, jb = blockIdx.x >> 3, ns = (gridDim.x - s + 7) >> 3;
  const u16* xn2 = p.R4 + s * 128 + r * 16;
  const unsigned char* Tb = (const unsigned char*)p.R5 + s * 128;
  const unsigned loff = r * 16;
  const int* experts = (const int*)p.R7 + lane;
  float* part = p.out + (size_t)s * BT * 128 + g;
  const int first = jb * 4 + w, stride = ns * 4;
  if (first >= BT) return;
#define TOKC(T) (((T) < BT) ? (T) : first)
  int eA0, eA1, eB0, eB1;
  uint4 UA[16], UB[16];
  f32x2 xA[8], xB[8];
  eA0 = experts[(size_t)first * 128]; eA1 = experts[(size_t)first * 128 + 64];
  pe_load_tab(Tb, loff, eA0, eA1, g, UA);
  pe_load_x(xn2 + (size_t)first * 1024, xA);
  { const int t1 = TOKC(first + stride); eB0 = experts[(size_t)t1 * 128]; eB1 = experts[(size_t)t1 * 128 + 64]; }
#pragma unroll 1
  for (int tok = first; tok < BT; tok += 2 * stride) {
    const int t1 = tok + stride, t2 = tok + 2 * stride, t3 = tok + 3 * stride;
    pe_load_tab(Tb, loff, eB0, eB1, g, UB);
    pe_load_x(xn2 + (size_t)TOKC(t1) * 1024, xB);
    { const int tc = TOKC(t2); eA0 = experts[(size_t)tc * 128]; eA1 = experts[(size_t)tc * 128 + 64]; }
    pe_dot_store(xA, UA, part + (size_t)tok * 128, lane, r);
    pe_load_tab(Tb, loff, eA0, eA1, g, UA);
    pe_load_x(xn2 + (size_t)TOKC(t2) * 1024, xA);
    { const int tc = TOKC(t3); eB0 = experts[(size_t)tc * 128]; eB1 = experts[(size_t)tc * 128 + 64]; }
    if (t1 < BT) pe_dot_store(xB, UB, part + (size_t)t1 * 128, lane, r);
  }
}

__device__ void phase11r(const Params& p) {
  float* gates = p.R7 + (size_t)BT * 128;
  const float* part = p.out;
  for (int idx = blockIdx.x * 256 + threadIdx.x; idx < BT * 128 / 4; idx += gridDim.x * 256) {
    float4 h = *(const float4*)(part + (size_t)idx * 4);
#pragma unroll
    for (int ss = 1; ss < 8; ss++) {
      const float4 q = *(const float4*)(part + (size_t)ss * BT * 128 + (size_t)idx * 4);
      h.x += q.x; h.y += q.y; h.z += q.z; h.w += q.w;
    }
    float4 gt = *(const float4*)(gates + (size_t)idx * 4);
    const float hv[4] = {h.x * (1.f / U_SCALE), h.y * (1.f / U_SCALE), h.z * (1.f / U_SCALE), h.w * (1.f / U_SCALE)};
    const float gv[4] = {gt.x, gt.y, gt.z, gt.w};
    float c[4];
#pragma unroll
    for (int q = 0; q < 4; q++) c[q] = 0.5f * hv[q] * (1.f + erff(hv[q] * 0.70710678118654752f)) * gv[q] * (1.f / V_SCALE);
    *(float4*)(gates + (size_t)idx * 4) = make_float4(c[0], c[1], c[2], c[3]);
  }
}

struct PeTok { int e0, e1; float g0, g1; };
__device__ __forceinline__ PeTok pe_load_tok(const int* experts, const float* gates, int tok) {
  PeTok k;
  k.e0 = experts[(size_t)tok * 128]; k.e1 = experts[(size_t)tok * 128 + 64];
  k.g0 = gates[(size_t)tok * 128]; k.g1 = gates[(size_t)tok * 128 + 64];
  return k;
}
__device__ __forceinline__ void pe_value_store(const PeTok& k, const uint4 (&V)[16], u16* drow, int lane, int g) {
  const float c0 = k.g0, c1 = k.g1;
  f32x2 accp[8];
#pragma unroll
  for (int i = 0; i < 8; i++) accp[i] = f32x2{0.f, 0.f};
#pragma unroll
  for (int kb = 0; kb < 16; kb++) {
    const float c = __shfl((kb < 8) ? c0 : c1, (kb & 7) * 8 + g);
    const f32x2 c2 = {c, c};
    const u32 ws_[4] = {V[kb].x, V[kb].y, V[kb].z, V[kb].w};
#pragma unroll
    for (int q = 0; q < 4; q++) {
      accp[2 * q] += c2 * __builtin_amdgcn_cvt_pk_f32_fp8((int)ws_[q], false);
      accp[2 * q + 1] += c2 * __builtin_amdgcn_cvt_pk_f32_fp8((int)ws_[q], true);
    }
  }
  float a[16];
#pragma unroll
  for (int i = 0; i < 8; i++) { a[2 * i] = accp[i][0]; a[2 * i + 1] = accp[i][1]; }
  const bool b32 = (lane & 32) != 0, b16 = (lane & 16) != 0, b8 = (lane & 8) != 0;
#pragma unroll
  for (int i = 0; i < 8; i++) { const float send = b32 ? a[i] : a[i + 8], keep = b32 ? a[i + 8] : a[i]; a[i] = keep + __shfl_xor(send, 32); }
#pragma unroll
  for (int i = 0; i < 4; i++) { const float send = b16 ? a[i] : a[i + 4], keep = b16 ? a[i + 4] : a[i]; a[i] = keep + __shfl_xor(send, 16); }
#pragma unroll
  for (int i = 0; i < 2; i++) { const float send = b8 ? a[i] : a[i + 2], keep = b8 ? a[i + 2] : a[i]; a[i] = keep + __shfl_xor(send, 8); }
  *(u32*)drow = pack2(a[0], a[1]);
}
__device__ void phase11b(const Params& p) {
  const int t = threadIdx.x, lane = t & 63, w = t >> 6, g = lane >> 3, r = lane & 7;
  const int s = blockIdx.x & 7, jb = blockIdx.x >> 3, ns = (gridDim.x - s + 7) >> 3;
  const unsigned char* Tb = (const unsigned char*)p.R5 + 1024 + s * 128;
  const unsigned loff = r * 16;
  const int* experts = (const int*)p.R7 + lane;
  const float* gates = p.R7 + (size_t)BT * 128 + lane;
  u16* x1 = p.R1 + s * 128 + r * 16 + 2 * g;
  const int first = jb * 4 + w, stride = ns * 4;
  if (first >= BT) return;
  PeTok kA, kB;
  uint4 VA[16], VB[16];
  kA = pe_load_tok(experts, gates, first);
  pe_load_tab(Tb, loff, kA.e0, kA.e1, g, VA);
  kB = pe_load_tok(experts, gates, TOKC(first + stride));
#pragma unroll 1
  for (int tok = first; tok < BT; tok += 2 * stride) {
    const int t1 = tok + stride, t2 = tok + 2 * stride, t3 = tok + 3 * stride;
    pe_load_tab(Tb, loff, kB.e0, kB.e1, g, VB);
    const PeTok kC = pe_load_tok(experts, gates, TOKC(t2));
    pe_value_store(kA, VA, x1 + (size_t)tok * 1024, lane, g);
    pe_load_tab(Tb, loff, kC.e0, kC.e1, g, VA);
    const PeTok kD = pe_load_tok(experts, gates, TOKC(t3));
    if (t1 < BT) pe_value_store(kB, VB, x1 + (size_t)t1 * 1024, lane, g);
    kA = kC; kB = kD;
  }
#undef TOKC
}

__device__ void phase11c(const Params& p) {
  const int t = threadIdx.x, lane = t & 63, w = t >> 6;
  const float* x1 = (const float*)p.R2;
  for (int tok = blockIdx.x * 4 + w; tok < BT; tok += gridDim.x * 4) {
    const float* xr = x1 + (size_t)tok * 1024 + lane * 16;
    const u16* dl = p.R1 + (size_t)tok * 1024 + lane * 16;
    float4 v[4];
    float ss = 0.f;
#pragma unroll
    for (int i = 0; i < 4; i++) {
      v[i] = *(const float4*)(xr + i * 4);
      const uint2 dd = *(const uint2*)(dl + i * 4);
      v[i].x += blo(dd.x); v[i].y += bhi(dd.x); v[i].z += blo(dd.y); v[i].w += bhi(dd.y);
      ss += v[i].x * v[i].x + v[i].y * v[i].y + v[i].z * v[i].z + v[i].w * v[i].w;
    }
    ss = wave_sum(ss);
    const float rstd = rsqrtf(ss * (1.f / 1024.f) + 1e-6f);
    float* orow = p.out + (size_t)tok * 1024 + lane * 16;
#pragma unroll
    for (int i = 0; i < 4; i++) {
      float4 gg = *(const float4*)(p.fng + lane * 16 + i * 4);
      *(float4*)(orow + i * 4) = make_float4(v[i].x * rstd * gg.x, v[i].y * rstd * gg.y, v[i].z * rstd * gg.z, v[i].w * rstd * gg.w);
    }
  }
}

__global__ void __launch_bounds__(256, 2) fwd_mega(Params p, int ph_lo, int ph_hi) {
  extern __shared__ __attribute__((aligned(16))) char smem[];
  cg::grid_group grid = cg::this_grid();
  __shared__ uint4 xb_words;
  if (threadIdx.x == 0) xb_words = make_uint4(0u, 0u, 0u, 0u);
  __syncthreads();
  const XcdBarrier xb = xcd_barrier_post(p.bar, (volatile LAS unsigned*)&xb_words);
  if (ph_lo > ph_hi) grid.sync();
constexpr int REP0=1,REP1=1,REP2=1,REP3=1,REP4=1,REP5=1,REP6=1,REP7=1,REP8=1,REP9=1,REP10=1,REP11=1,REP12=1,REP13=1,REP14=1;
#define RUN_PHASE(k, call)                         \
  if (PH_ON(k) && ph_lo <= (k) && (k) < ph_hi) {   \
    for (int rep_ = 0; rep_ < REP##k; rep_++) { call; }  \
    if ((k) + 1 < ph_hi) xcd_barrier(xb);          \
  }
  RUN_PHASE(0, phase0(p, smem))
  RUN_PHASE(1, phase1(p, smem))
  RUN_PHASE(2, phase2(p, smem, xb))
  RUN_PHASE(3, phase3(p); weights_late(p, smem))
  RUN_PHASE(4, for (int item = blockIdx.x; item < 512; item += gridDim.x) gla_item(p, item, 2, smem))
  RUN_PHASE(5, phase5(p))
  RUN_PHASE(6, phase6(p, smem))
  RUN_PHASE(7, phase7(p, smem))
  RUN_PHASE(8, phase8(p))
  RUN_PHASE(9, phase9(p, smem))
  RUN_PHASE(10, phase10(p, smem))
  RUN_PHASE(11, phase11a(p))
  RUN_PHASE(12, phase11r(p))
  RUN_PHASE(13, phase11b(p))
  RUN_PHASE(14, phase11c(p))
}

extern "C" void kernel_launch(void* const* d_in, const int* in_sizes, int n_in, void* d_out, int out_size, void* d_ws,
                              size_t ws_size, hipStream_t stream) {
  (void)in_sizes; (void)n_in; (void)out_size; (void)ws_size;
  static int grid_blocks = 0;
  if (!grid_blocks) {
    int dev = 0, cus = 0, per_cu = 0;
    hipGetDevice(&dev);
    hipDeviceGetAttribute(&cus, hipDeviceAttributeMultiprocessorCount, dev);
    hipFuncSetAttribute((const void*)fwd_mega, hipFuncAttributeMaxDynamicSharedMemorySize, LDS_BYTES);
    hipOccupancyMaxActiveBlocksPerMultiprocessor(&per_cu, (const void*)fwd_mega, 256, LDS_BYTES);
    if (per_cu < 1) per_cu = 1;
    if (per_cu > 2) per_cu = 2;
    grid_blocks = cus * per_cu;
  }
  Params p{};
  const float* const* in = (const float* const*)d_in;
  p.x = in[0]; p.norm1_g = in[1]; p.w_in = in[2]; p.conv_w = in[3]; p.conv_b = in[4]; p.wa = in[5];
  p.dupf = in[6]; p.dbf = in[7]; p.dupb = in[8]; p.dbb = in[9]; p.gng = in[10]; p.wb = in[11];
  p.gbias = in[12]; p.wo = in[13]; p.norm2_g = in[14]; p.wq = in[15]; p.keys = in[16]; p.pu = in[17];
  p.pv = in[18]; p.fng = in[19];
  p.out = (float*)d_out;
  char* ws = (char*)d_ws;
  const size_t MiB = 1u << 20;
  p.WinT = (u16*)ws;
  p.WaT = (u16*)(ws + 17039360);
  p.WbT = (u16*)(ws + 17039360 + 2097152);
  p.WoT = (u16*)(ws + 17039360 + 2 * 2097152);
  p.WqT = (u16*)(ws + 17039360 + 3 * 2097152);
  p.KeysB = (u16*)(ws + 17039360 + 3 * 2097152 + 4194304);
  p.R1 = (u16*)(ws + 27 * MiB);
  p.R2 = (u16*)(ws + 59 * MiB);
  p.R3 = (u16*)(ws + 91 * MiB);
  p.R4 = (u16*)(ws + 123 * MiB);
  p.R5 = (u16*)(ws + 155 * MiB);
  p.R6 = (u16*)(ws + 187 * MiB);
  p.R7 = (float*)(ws + 219 * MiB);
  p.z = (float*)(ws + 251 * MiB);
  p.Dd = (float*)(ws + 253 * MiB);
  p.bar = (unsigned*)(ws + 254 * MiB);
  hipMemsetAsync(p.bar, 0, XCD_BAR_WORDS * sizeof(unsigned), stream);
#if MULTI_LAUNCH
  for (int ph = 0; ph < NPHASE; ph++) {
    hipLaunchKernelGGL(fwd_mega, dim3(grid_blocks), dim3(256), LDS_BYTES, stream, p, ph, ph + 1);
  }
#else
  int lo = 0, hi = NPHASE;
  void* args[] = {&p, &lo, &hi};
  hipError_t e = hipLaunchCooperativeKernel((const void*)fwd_mega, dim3(grid_blocks), dim3(256), args, LDS_BYTES, stream);
  if (e != hipSuccess) fprintf(stderr, "cooperative launch failed: %s (grid %d)\n", hipGetErrorString(e), grid_blocks);
#endif
}
```

```cpp
#include <hip/hip_runtime.h>
#include <hip/hip_cooperative_groups.h>
#include <cstdio>
namespace cg = cooperative_groups;

typedef unsigned short u16;
typedef unsigned int u32;
using bf16x8 = __attribute__((ext_vector_type(8))) short;
using f32x4 = __attribute__((ext_vector_type(4))) float;

#ifndef ONLY_PHASE
#define ONLY_PHASE -1
#endif
#define PH_ON(k) (ONLY_PHASE < 0 || ONLY_PHASE == (k))
#ifndef MULTI_LAUNCH
#define MULTI_LAUNCH 0
#endif

constexpr int BT = 16384, SEQ = 8192;
constexpr int LDS_BYTES = 80896;
constexpr int NPHASE = 15;

struct Params {
  const float *x, *norm1_g, *w_in, *conv_w, *conv_b, *wa, *dupf, *dbf, *dupb, *dbb, *gng, *wb, *gbias, *wo,
      *norm2_g, *wq, *keys, *pu, *pv, *fng;
  float* out;
  u16 *WinT, *WaT, *WbT, *WoT, *WqT, *KeysB;
  u16 *R1, *R2, *R3, *R4, *R5, *R6;
  float *R7, *z, *Dd;
  unsigned* bar;
};

__device__ __forceinline__ u16 f2b(float f) { u32 u = __float_as_uint(f); u += 0x7fffu + ((u >> 16) & 1u); return (u16)(u >> 16); }
__device__ __forceinline__ float b2f(u16 h) { return __uint_as_float(((u32)h) << 16); }
__device__ __forceinline__ u32 pack2(float a, float b) { return (u32)f2b(a) | ((u32)f2b(b) << 16); }
__device__ __forceinline__ float blo(u32 w) { return __uint_as_float(w << 16); }
__device__ __forceinline__ float bhi(u32 w) { return __uint_as_float(w & 0xffff0000u); }
__device__ __forceinline__ float wave_sum(float v) {
#pragma unroll
  for (int o = 32; o > 0; o >>= 1) v += __shfl_xor(v, o);
  return v;
}
__device__ __forceinline__ float sigmoidf_(float v) { return 1.f / (1.f + __expf(-v)); }
__device__ __forceinline__ u32 ordf(float v) { u32 u = __float_as_uint(v); return (u & 0x80000000u) ? ~u : (u | 0x80000000u); }
__device__ __forceinline__ float unordf(u32 k) { return __uint_as_float((k & 0x80000000u) ? (k ^ 0x80000000u) : ~k); }

template <int MT, int NT, int KT>
__device__ __forceinline__ void mma_nt(f32x4 (&acc)[MT][NT], const u16* A, int sa, const u16* B, int sb, int lane) {
  const int fr = lane & 15, fq = lane >> 4;
  const u16* pa = A + fr * sa + fq * 8;
  const u16* pb = B + fr * sb + fq * 8;
#pragma unroll
  for (int k = 0; k < KT; k++) {
    bf16x8 a[MT], b[NT];
#pragma unroll
    for (int m = 0; m < MT; m++) a[m] = *(const bf16x8*)(pa + m * 16 * sa + k * 32);
#pragma unroll
    for (int n = 0; n < NT; n++) b[n] = *(const bf16x8*)(pb + n * 16 * sb + k * 32);
#pragma unroll
    for (int m = 0; m < MT; m++)
#pragma unroll
      for (int n = 0; n < NT; n++) acc[m][n] = __builtin_amdgcn_mfma_f32_16x16x32_bf16(a[m], b[n], acc[m][n], 0, 0, 0);
  }
}

template <int MT, int NT>
__device__ __forceinline__ void mma_sw64(f32x4 (&acc)[MT][NT], const u16* A, const u16* B, int lane) {
  const int fr = lane & 15, fq = lane >> 4;
  const int cb = fq ^ ((fr >> 1) & 7);
  const u16* pa = A + fr * 64;
  const u16* pb = B + fr * 64;
#pragma unroll
  for (int k = 0; k < 2; k++) {
    const int co = (cb ^ (k * 4)) * 8;
    bf16x8 a[MT], b[NT];
#pragma unroll
    for (int m = 0; m < MT; m++) a[m] = *(const bf16x8*)(pa + m * 16 * 64 + co);
#pragma unroll
    for (int n = 0; n < NT; n++) b[n] = *(const bf16x8*)(pb + n * 16 * 64 + co);
#pragma unroll
    for (int m = 0; m < MT; m++)
#pragma unroll
      for (int n = 0; n < NT; n++) acc[m][n] = __builtin_amdgcn_mfma_f32_16x16x32_bf16(b[n], a[m], acc[m][n], 0, 0, 0);
  }
}

#define ST_DECL(S) uint4 S##a0, S##a1, S##a2, S##a3, S##b0, S##b1, S##b2, S##b3
#define ST_LOAD(S, PA, PB)                                                                                           \
  do {                                                                                                               \
    const char* pa_ = (const char*)(PA);                                                                             \
    const char* pb_ = (const char*)(PB);                                                                             \
    S##a0 = *(const uint4*)(pa_ + voffA); S##a1 = *(const uint4*)(pa_ + (size_t)64 * lda + voffA);                   \
    S##a2 = *(const uint4*)(pa_ + (size_t)128 * lda + voffA); S##a3 = *(const uint4*)(pa_ + (size_t)192 * lda + voffA); \
    S##b0 = *(const uint4*)(pb_ + voffB); S##b1 = *(const uint4*)(pb_ + (size_t)64 * ldb + voffB);                   \
    S##b2 = *(const uint4*)(pb_ + (size_t)128 * ldb + voffB); S##b3 = *(const uint4*)(pb_ + (size_t)192 * ldb + voffB); \
  } while (0)
#define ST_WRITE(S, WA, WB)                                                                                          \
  do {                                                                                                               \
    *(uint4*)(WA) = S##a0; *(uint4*)((WA) + 32 * 64) = S##a1; *(uint4*)((WA) + 64 * 64) = S##a2; *(uint4*)((WA) + 96 * 64) = S##a3; \
    *(uint4*)(WB) = S##b0; *(uint4*)((WB) + 32 * 64) = S##b1; *(uint4*)((WB) + 64 * 64) = S##b2; *(uint4*)((WB) + 96 * 64) = S##b3; \
  } while (0)

#define GLDS16(G, L) __builtin_amdgcn_global_load_lds((const void*)(G), (__attribute__((address_space(3))) void*)(L), 16, 0, 0)
__device__ __forceinline__ void gemm_acc_db(f32x4 (&acc)[4][4], const u16* __restrict__ A, int lda, const u16* __restrict__ B,
                                            int ldb, int K, char* smem) {
  const int t = threadIdx.x, lane = t & 63, w = t >> 6, wr = w >> 1, wc = w & 1;
  const int lr = t >> 3;
  const int gc = ((t & 7) ^ ((lr >> 1) & 7)) * 8;
  const u16* pa = A + (size_t)lr * lda + gc;
  const u16* pb = B + (size_t)lr * ldb + gc;
  char* l0 = smem + t * 16;
  u16* b0 = (u16*)smem;
  u16* b1 = b0 + 2 * 128 * 64;
#define ISSUE_TILE(KT, BUFOFF)                                                                     \
  do {                                                                                             \
    const u16* qa = pa + (KT) * 64;                                                                \
    const u16* qb = pb + (KT) * 64;                                                                \
    char* lb = l0 + (BUFOFF);                                                                      \
    GLDS16(qa, lb); GLDS16(qa + (size_t)32 * lda, lb + 4096);                                      \
    GLDS16(qa + (size_t)64 * lda, lb + 8192); GLDS16(qa + (size_t)96 * lda, lb + 12288);           \
    GLDS16(qb, lb + 16384); GLDS16(qb + (size_t)32 * ldb, lb + 16384 + 4096);                      \
    GLDS16(qb + (size_t)64 * ldb, lb + 16384 + 8192); GLDS16(qb + (size_t)96 * ldb, lb + 16384 + 12288); \
  } while (0)
  const int nk = K >> 6;
  __syncthreads();
  ISSUE_TILE(0, 0);
  if (blockIdx.x >= (gridDim.x >> 1)) __builtin_amdgcn_s_sleep(8);
#define KSTEP(BUF, ISSUE_STMT)                                                 \
  do {                                                                         \
    asm volatile("s_waitcnt vmcnt(0) lgkmcnt(0)" ::: "memory");    \
    __builtin_amdgcn_s_barrier();                                              \
    asm volatile("" ::: "memory");                                             \
    ISSUE_STMT;                                                                \
    mma_sw64<4, 4>(acc, BUF + wr * 64 * 64, BUF + 128 * 64 + wc * 64 * 64, lane); \
  } while (0)
  for (int kt = 0; kt + 2 < nk; kt += 2) {
    KSTEP(b0, ISSUE_TILE(kt + 1, 32768));
    KSTEP(b1, ISSUE_TILE(kt + 2, 0));
  }
  KSTEP(b0, ISSUE_TILE(nk - 1, 32768));
  KSTEP(b1, (void)0);
  asm volatile("s_waitcnt lgkmcnt(0)" ::: "memory");
#undef KSTEP
#undef ISSUE_TILE
}

struct TileIter {
  int i, step, lim, NT, xcd; bool swz;
  __device__ __forceinline__ TileIter(int nt_) {
    NT = nt_;
    swz = (gridDim.x & 7) == 0;
    if (swz) { xcd = blockIdx.x & 7; i = blockIdx.x >> 3; step = gridDim.x >> 3; lim = 16 * NT; }
    else { xcd = 0; i = blockIdx.x; step = gridDim.x; lim = 128 * NT; }
  }
  __device__ __forceinline__ bool next(int& mt, int& nt) {
    if (i >= lim) return false;
    if (swz) { int mg = i / (NT * 8), rem = i - mg * NT * 8; nt = rem >> 3; mt = xcd * 16 + mg * 8 + (rem & 7); }
    else { mt = i & 127; nt = i >> 7; }
    i += step;
    return true;
  }
};

__device__ __forceinline__ void zero_acc(f32x4 (&acc)[4][4]) {
#pragma unroll
  for (int m = 0; m < 4; m++)
#pragma unroll
    for (int n = 0; n < 4; n++) acc[m][n] = f32x4{0.f, 0.f, 0.f, 0.f};
}

__device__ __forceinline__ int winmap(int r) {
  if (r < 2048) { int tile = r >> 7, w = r & 127, grp = w >> 5; int ch = tile * 64 + (grp >> 1) * 32 + (w & 31); return ((grp & 1) ? 2048 : 0) + ch; }
  if (r < 3072) return r - 1024;
  if (r < 6176) return r;
  if (r < 6272) return -1;
  return r - 96;
}

__device__ __forceinline__ void tr_tile(const float* __restrict__ src, int ld, int col0, u16* __restrict__ dst, int r0, int k0, float* sT) {
  const int t = threadIdx.x;
  const int r = t >> 3, kc = t & 7;
  if (col0 < 0) {
    *(uint4*)(dst + (size_t)(r0 + r) * 1024 + k0 + kc * 8) = make_uint4(0, 0, 0, 0);
    return;
  }
  __syncthreads();
#pragma unroll
  for (int i = 0; i < 8; i++) {
    int k = (t >> 5) + i * 8, rr = t & 31;
    sT[k * 33 + rr] = src[(size_t)(k0 + k) * ld + col0 + rr];
  }
  __syncthreads();
  u32 wv[4];
#pragma unroll
  for (int j = 0; j < 4; j++) wv[j] = pack2(sT[(kc * 8 + 2 * j) * 33 + r], sT[(kc * 8 + 2 * j + 1) * 33 + r]);
  *(uint4*)(dst + (size_t)(r0 + r) * 1024 + k0 + kc * 8) = make_uint4(wv[0], wv[1], wv[2], wv[3]);
}

__device__ __forceinline__ void rms_row(const float* __restrict__ src, const float* __restrict__ g, u16* __restrict__ dst, int lane) {
  float4 v[4];
  float ss = 0.f;
#pragma unroll
  for (int i = 0; i < 4; i++) {
    v[i] = *(const float4*)(src + i * 256 + lane * 4);
    ss += v[i].x * v[i].x + v[i].y * v[i].y + v[i].z * v[i].z + v[i].w * v[i].w;
  }
  ss = wave_sum(ss);
  const float rstd = rsqrtf(ss * (1.f / 1024.f) + 1e-6f);
#pragma unroll
  for (int i = 0; i < 4; i++) {
    float4 gg = *(const float4*)(g + i * 256 + lane * 4);
    uint2 o;
    o.x = pack2(v[i].x * rstd * gg.x, v[i].y * rstd * gg.y);
    o.y = pack2(v[i].z * rstd * gg.z, v[i].w * rstd * gg.w);
    *(uint2*)(dst + i * 256 + lane * 4) = o;
  }
}

__device__ void phase0(const Params& p, char* smem) {
  float* sT = (float*)smem;
  const int t = threadIdx.x, lane = t & 63, w = t >> 6;
  u16* xn = (u16*)p.out;
  constexpr int J0 = 4160, J4 = J0 + 4096;
  for (int job = blockIdx.x; job < J4; job += gridDim.x) {
    if (job < J0) {
      int rb = job >> 4, kb = job & 15;
      tr_tile(p.w_in, 8224, winmap(rb * 32), p.WinT, rb * 32, kb * 64, sT);
    } else {
      int row = (job - J0) * 4 + w;
      rms_row(p.x + (size_t)row * 1024, p.norm1_g, xn + (size_t)row * 1024, lane);
    }
  }
}
__device__ void weights_late(const Params& p, char* smem) {
  float* sT = (float*)smem;
  const int t = threadIdx.x;
  constexpr int J1 = 1536, J2 = J1 + 1024, J3 = J2 + 128;
  for (int job = blockIdx.x; job < J3; job += gridDim.x) {
    if (job < J1) {
      int which = job >> 9, rb = (job & 511) >> 4, kb = job & 15;
      const float* src = which == 0 ? p.wa : (which == 1 ? p.wb : p.wo);
      u16* dst = which == 0 ? p.WaT : (which == 1 ? p.WbT : p.WoT);
      tr_tile(src, 1024, rb * 32, dst, rb * 32, kb * 64, sT);
    } else if (job < J2) {
      int j = job - J1, rb = j >> 4, kb = j & 15;
      tr_tile(p.wq, 2048, rb * 32, p.WqT, rb * 32, kb * 64, sT);
    } else {
      int j = job - J2;
      int base = (j * 256 + t) * 8;
      float4 a = *(const float4*)(p.keys + base), b = *(const float4*)(p.keys + base + 4);
      *(uint4*)(p.KeysB + base) = make_uint4(pack2(a.x, a.y), pack2(a.z, a.w), pack2(b.x, b.y), pack2(b.z, b.w));
    }
  }
}

__device__ void la_prep(const Params& p, char* smem) {
  float* sZ = (float*)smem;
  float* sPart = sZ + 1024;
  const int t = threadIdx.x, lane = t & 63, w = t >> 6, fr = lane & 15, fq = lane >> 4;
  const u16* xn = (const u16*)p.out;
  const u16* Wz = p.WinT + (size_t)6144 * 1024;
  u32* la16 = (u32*)p.R6;
  float uf0[16], uf1[16], ub0[16], ub1[16];
#pragma unroll
  for (int r = 0; r < 16; r++) {
    uf0[r] = p.dupf[r * 512 + 2 * t]; uf1[r] = p.dupf[r * 512 + 2 * t + 1];
    ub0[r] = p.dupb[r * 512 + 2 * t]; ub1[r] = p.dupb[r * 512 + 2 * t + 1];
  }
  const float bf0 = p.dbf[2 * t], bf1 = p.dbf[2 * t + 1], bb0 = p.dbb[2 * t], bb1 = p.dbb[2 * t + 1];
  for (int job = blockIdx.x; job < BT / 32; job += gridDim.x) {
    f32x4 az[2][2];
#pragma unroll
    for (int m = 0; m < 2; m++)
#pragma unroll
      for (int n = 0; n < 2; n++) az[m][n] = f32x4{0.f, 0.f, 0.f, 0.f};
    {
      const u16* ap = xn + (size_t)(job * 32 + fr) * 1024 + w * 256 + fq * 8;
      const u16* bp = Wz + (size_t)fr * 1024 + w * 256 + fq * 8;
#pragma unroll
      for (int ks = 0; ks < 8; ks++) {
        bf16x8 a0 = *(const bf16x8*)(ap + ks * 32), a1 = *(const bf16x8*)(ap + 16 * 1024 + ks * 32);
        bf16x8 b0 = *(const bf16x8*)(bp + ks * 32), b1 = *(const bf16x8*)(bp + 16 * 1024 + ks * 32);
        az[0][0] = __builtin_amdgcn_mfma_f32_16x16x32_bf16(a0, b0, az[0][0], 0, 0, 0);
        az[0][1] = __builtin_amdgcn_mfma_f32_16x16x32_bf16(a0, b1, az[0][1], 0, 0, 0);
        az[1][0] = __builtin_amdgcn_mfma_f32_16x16x32_bf16(a1, b0, az[1][0], 0, 0, 0);
        az[1][1] = __builtin_amdgcn_mfma_f32_16x16x32_bf16(a1, b1, az[1][1], 0, 0, 0);
      }
    }
    __syncthreads();
#pragma unroll
    for (int m = 0; m < 2; m++)
#pragma unroll
      for (int n = 0; n < 2; n++)
#pragma unroll
        for (int j = 0; j < 4; j++) sPart[w * 1024 + (m * 16 + fq * 4 + j) * 32 + n * 16 + fr] = az[m][n][j];
    __syncthreads();
    {
      const float4 q0 = *(const float4*)(sPart + t * 4), q1 = *(const float4*)(sPart + 1024 + t * 4), q2 = *(const float4*)(sPart + 2048 + t * 4),
                   q3 = *(const float4*)(sPart + 3072 + t * 4);
      *(float4*)(sZ + t * 4) = make_float4(q0.x + q1.x + q2.x + q3.x, q0.y + q1.y + q2.y + q3.y, q0.z + q1.z + q2.z + q3.z, q0.w + q1.w + q2.w + q3.w);
    }
    __syncthreads();
    for (int i = 0; i < 32; i++) {
      const float* zr = sZ + i * 32;
      float a0 = bf0, a1 = bf1, c0 = bb0, c1 = bb1;
#pragma unroll
      for (int r = 0; r < 16; r++) {
        const float zf = zr[r], zb = zr[16 + r];
        a0 += zf * uf0[r]; a1 += zf * uf1[r];
        c0 += zb * ub0[r]; c1 += zb * ub1[r];
      }
      const float l0 = (fminf(a0, 0.f) - __logf(1.f + __expf(-fabsf(a0)))) * 0.0625f;
      const float l1 = (fminf(a1, 0.f) - __logf(1.f + __expf(-fabsf(a1)))) * 0.0625f;
      const float m0 = (fminf(c0, 0.f) - __logf(1.f + __expf(-fabsf(c0)))) * 0.0625f;
      const float m1 = (fminf(c1, 0.f) - __logf(1.f + __expf(-fabsf(c1)))) * 0.0625f;
      const int tok = job * 32 + i;
      la16[(size_t)tok * 256 + t] = (u32)__builtin_bit_cast(unsigned short, (_Float16)l0) | ((u32)__builtin_bit_cast(unsigned short, (_Float16)l1) << 16);
      la16[(size_t)(BT + tok) * 256 + t] = (u32)__builtin_bit_cast(unsigned short, (_Float16)m0) | ((u32)__builtin_bit_cast(unsigned short, (_Float16)m1) << 16);
    }
  }
}

__device__ void phase1(const Params& p, char* smem) {
  u16* sA = (u16*)smem;
  u16* sB = sA + 128 * 64;
  const int t = threadIdx.x, lane = t & 63, w = t >> 6, wr = w >> 1, wc = w & 1, fr = lane & 15, fq = lane >> 4;
  const u16* xn = (const u16*)p.out;
  la_prep(p, smem);
  TileIter ti(48);
  int mt, nt;
  while (ti.next(mt, nt)) {
    f32x4 acc[4][4];
    zero_acc(acc);
    gemm_acc_db(acc, xn + (size_t)mt * 128 * 1024, 1024, p.WinT + (size_t)nt * 128 * 1024, 1024, 1024, smem);
    const int rowb = mt * 128 + wr * 64 + fr;
    if (nt < 16) {
#pragma unroll
      for (int m = 0; m < 4; m++)
#pragma unroll
        for (int n = 0; n < 2; n++) {
          const int ch = nt * 64 + wc * 32 + n * 16 + fq * 4;
          *(uint2*)(p.R1 + (size_t)(rowb + m * 16) * 1024 + ch) =
              make_uint2(pack2(acc[m][n][0] * acc[m][n + 2][0], acc[m][n][1] * acc[m][n + 2][1]),
                         pack2(acc[m][n][2] * acc[m][n + 2][2], acc[m][n][3] * acc[m][n + 2][3]));
        }
    } else {
      const int g = (nt - 16) >> 3;
      u16* dst = g == 0 ? p.R2 : (g == 1 ? p.R3 : (g == 2 ? p.R4 : p.R5));
      const int cb = ((nt - 16) & 7) * 128 + wc * 64;
      const float sc = (g == 1 && cb < 512) ? 0.08838834764831845f : 1.f;
#pragma unroll
      for (int m = 0; m < 4; m++)
#pragma unroll
        for (int n = 0; n < 4; n++)
          *(uint2*)(dst + (size_t)(rowb + m * 16) * 1024 + cb + n * 16 + fq * 4) =
              make_uint2(pack2(acc[m][n][0] * sc, acc[m][n][1] * sc), pack2(acc[m][n][2] * sc, acc[m][n][3] * sc));
    }
  }
}

#define XB_TMO      128
#define XB_XCNT(j)  (256  + 64 * (j))
#define XB_XSUB(j)  (1280 + 64 * (j))
#define XB_XGEN(j)  (2304 + 64 * (j))
#define XB_TOP      3328
#define XB_TOPGEN   3392
#define XCD_BAR_WORDS 3456
#define XB_SPIN_CAP (1u << 20)
#define LAS __attribute__((address_space(3)))
__device__ __forceinline__ unsigned xb_ld(unsigned* p) { return __hip_atomic_load(p, __ATOMIC_RELAXED, __HIP_MEMORY_SCOPE_AGENT); }
__device__ __forceinline__ unsigned xb_add(unsigned* p, unsigned v) { return __hip_atomic_fetch_add(p, v, __ATOMIC_RELAXED, __HIP_MEMORY_SCOPE_AGENT); }
__device__ __forceinline__ unsigned xb_xcc_id() { return (unsigned)__builtin_amdgcn_s_getreg((3 << 11) | 20) & 0xFu; }
#define XB_SPIN(cond, bar) do { unsigned _sp = 0; while (cond) { __builtin_amdgcn_s_sleep(1); \
    if ((++_sp & 255u) == 0u) { if (xb_ld(&(bar)[XB_TMO])) break; if (_sp > XB_SPIN_CAP) { atomicAdd(&(bar)[XB_TMO], 1u); break; } } } } while (0)
struct XcdBarrier { unsigned* bar; unsigned x; volatile LAS unsigned* st; };
__device__ __forceinline__ XcdBarrier xcd_barrier_post(unsigned* bar, volatile LAS unsigned* st) {
  XcdBarrier b; b.bar = bar; b.x = xb_xcc_id(); b.st = st;
  if (threadIdx.x == 0) (void)xb_add(&bar[XB_XCNT(b.x)], 1u);
  return b;
}
__device__ __forceinline__ void xcd_barrier_complete(unsigned* bar, unsigned x, unsigned& nloc, unsigned& nx) {
  const unsigned G = gridDim.x * gridDim.y * gridDim.z;
  unsigned sum, cnt, mine, sp = 0u;
  for (;;) {
    sum = 0u; cnt = 0u; mine = 0u;
#pragma unroll
    for (unsigned j = 0; j < 16; ++j) { const unsigned c = xb_ld(&bar[XB_XCNT(j)]); sum += c; cnt += (c > 0u) ? 1u : 0u; mine = (j == x) ? c : mine; }
    if (sum == G) break;
    __builtin_amdgcn_s_sleep(1);
    if ((++sp & 255u) == 0u) { if (xb_ld(&bar[XB_TMO])) break; if (sp > XB_SPIN_CAP) { atomicAdd(&bar[XB_TMO], 1u); break; } }
  }
  nloc = mine > 0u ? mine : 1u; nx = cnt > 0u ? cnt : 1u;
}
__device__ __forceinline__ void xcd_barrier(const XcdBarrier& b) {
  asm volatile("s_waitcnt vmcnt(0)" ::: "memory");
  __syncthreads();
  if (threadIdx.x == 0) {
    unsigned* bar = b.bar;
    __builtin_amdgcn_s_waitcnt(0);
    unsigned nloc = b.st[0], nx = b.st[1];
    if (nloc == 0u) { xcd_barrier_complete(bar, b.x, nloc, nx); b.st[0] = nloc; b.st[1] = nx; }
    const unsigned old = xb_add(&bar[XB_XSUB(b.x)], 1u);
    const unsigned gen = old / nloc;
    if (old + 1u == (gen + 1u) * nloc) {
      __builtin_amdgcn_fence(__ATOMIC_RELEASE, "agent");
      asm volatile("s_waitcnt vmcnt(0)" ::: "memory");
      const unsigned og = xb_add(&bar[XB_TOP], 1u);
      const unsigned tg = og / nx;
      if (og + 1u == (tg + 1u) * nx) xb_add(&bar[XB_TOPGEN], 1u);
      else XB_SPIN(xb_ld(&bar[XB_TOPGEN]) == tg, bar);
      __builtin_amdgcn_fence(__ATOMIC_ACQUIRE, "agent");
      xb_add(&bar[XB_XGEN(b.x)], 1u);
      asm volatile("s_waitcnt vmcnt(0)" ::: "memory");
    } else {
      XB_SPIN(xb_ld(&bar[XB_XGEN(b.x)]) == gen, bar);
      __builtin_amdgcn_fence(__ATOMIC_ACQUIRE, "agent");
      asm volatile("s_waitcnt vmcnt(0)" ::: "memory");
    }
  }
  __syncthreads();
}

__device__ void gla_item(const Params& p, int item, int pass, char* smem) {
  const int dvp = item & 1, seg = (item >> 1) & 15, dir = (item >> 5) & 1, h = (item >> 6) & 3, b = item >> 8;
  const int bhd = (b * 4 + h) * 2 + dir;
  u16* sQ = (u16*)smem;
  u16* sK = sQ + 64 * 136;
  u16* sKT = sK + 64 * 136;
  u16* sVT = sKT + 128 * 72;
  u16* sST = sVT + 64 * 72;
  float* sDec = (float*)(sST + 64 * 136);
  float* sTot = (float*)sVT;
  const int t = threadIdx.x, lane = t & 63, w = __builtin_amdgcn_readfirstlane(t >> 6), wr = w >> 1, wc = w & 1, fr = lane & 15, fq = lane >> 4;
  const int d0 = lane * 2;
  const u32* la16 = (const u32*)p.R6 + (size_t)dir * BT * 256 + h * 64 + lane;
  const u16* qk = p.R3;
  const u16* vv = p.R4;
  u16* obuf = dir ? p.R2 : p.R1;
  float* Lp = p.R7 + (size_t)(bhd * 16 + seg) * 32768 + (size_t)dvp * 128 * 128;

  f32x4 accS[2][2][4];
#pragma unroll
  for (int s = 0; s < 2; s++)
#pragma unroll
    for (int m = 0; m < 2; m++)
#pragma unroll
      for (int n = 0; n < 4; n++)
#pragma unroll
        for (int j = 0; j < 4; j++)
          accS[s][m][n][j] = (pass == 2) ? Lp[(s * 64 + wr * 32 + m * 16 + fq * 4 + j) * 128 + wc * 64 + n * 16 + fr] : 0.f;
  float dsum0 = 0.f, dsum1 = 0.f;

  for (int ci = 0; ci < 8; ci++) {
    const int c = seg * 8 + ci;
    __syncthreads();
    u32 qv[16], kv[16], lav[16], vreg[2][16];
#pragma unroll
    for (int ii = 0; ii < 16; ii++) {
      int f = c * 64 + w * 16 + ii;
      int pos = dir ? (SEQ - 1 - f) : f;
      size_t tokoff = (size_t)(b * SEQ + pos) * 1024;
      kv[ii] = *(const u32*)(qk + tokoff + 512 + h * 128 + d0);
      if (pass == 2) qv[ii] = *(const u32*)(qk + tokoff + h * 128 + d0);
      lav[ii] = la16[(size_t)(b * SEQ + pos) * 256];
      vreg[0][ii] = vv[tokoff + h * 256 + dvp * 128 + lane];
      vreg[1][ii] = vv[tokoff + h * 256 + dvp * 128 + 64 + lane];
    }
    float bl0[16], bl1[16];
    {
      float run0 = 0.f, run1 = 0.f;
#pragma unroll
      for (int ii = 0; ii < 16; ii++) {
        run0 += (float)__builtin_bit_cast(_Float16, (unsigned short)(lav[ii] & 0xffffu));
        run1 += (float)__builtin_bit_cast(_Float16, (unsigned short)(lav[ii] >> 16));
        bl0[ii] = run0; bl1[ii] = run1;
      }
      sTot[w * 128 + d0] = run0;
      sTot[w * 128 + d0 + 1] = run1;
    }
    __syncthreads();
    {
      float off0 = 0.f, off1 = 0.f, tot0 = 0.f, tot1 = 0.f;
#pragma unroll
      for (int ww = 0; ww < 4; ww++) {
        float a = sTot[ww * 128 + d0], bb = sTot[ww * 128 + d0 + 1];
        if (ww < w) { off0 += a; off1 += bb; }
        tot0 += a; tot1 += bb;
      }
      dsum0 += tot0; dsum1 += tot1;
      const float et0 = __expf(tot0), et1 = __expf(tot1);
      if (w == 0) { sDec[d0] = et0; sDec[d0 + 1] = et1; }
#pragma unroll
      for (int ii = 0; ii < 16; ii += 2) {
        float ke0[2], ke1[2];
#pragma unroll
        for (int s = 0; s < 2; s++) {
          const int i2 = ii + s;
          const float b0 = bl0[i2] + off0, b1 = bl1[i2] + off1;
          const float k0 = blo(kv[i2]), k1 = bhi(kv[i2]);
          const int i = w * 16 + i2;
          const float e0 = __expf(b0), e1 = __expf(b1);
          const float kt0 = k0 * __builtin_amdgcn_rcpf(e0), kt1 = k1 * __builtin_amdgcn_rcpf(e1);
          if (pass == 2) {
            *(u32*)(sQ + i * 136 + d0) = pack2(blo(qv[i2]) * e0, bhi(qv[i2]) * e1);
            *(u32*)(sK + i * 136 + d0) = pack2(kt0, kt1);
          }
          ke0[s] = kt0 * et0;
          ke1[s] = kt1 * et1;
        }
        *(u32*)(sKT + d0 * 72 + w * 16 + ii) = pack2(ke0[0], ke0[1]);
        *(u32*)(sKT + (d0 + 1) * 72 + w * 16 + ii) = pack2(ke1[0], ke1[1]);
      }
    }
    __syncthreads();
    u16* sP = sK;
    if (pass == 2) {
      f32x4 accP[2][2];
#pragma unroll
      for (int m = 0; m < 2; m++)
#pragma unroll
        for (int n = 0; n < 2; n++) accP[m][n] = f32x4{0.f, 0.f, 0.f, 0.f};
      mma_nt<2, 2, 4>(accP, sQ + wr * 32 * 136, 136, sK + wc * 32 * 136, 136, lane);
      __syncthreads();
#pragma unroll
      for (int m = 0; m < 2; m++)
#pragma unroll
        for (int n = 0; n < 2; n++)
#pragma unroll
          for (int j = 0; j < 4; j++) {
            int i = wr * 32 + m * 16 + fq * 4 + j, jj = wc * 32 + n * 16 + fr;
            sP[i * 72 + jj] = (i >= jj) ? f2b(accP[m][n][j]) : (u16)0;
          }
    }
#pragma unroll
    for (int s = 0; s < 2; s++) {
      if (pass == 2) {
#pragma unroll
        for (int m = 0; m < 2; m++)
#pragma unroll
          for (int n = 0; n < 4; n++)
#pragma unroll
            for (int j = 0; j < 4; j++) sST[(wr * 32 + m * 16 + fq * 4 + j) * 136 + wc * 64 + n * 16 + fr] = f2b(accS[s][m][n][j]);
      }
      {
        uint4 v0 = make_uint4(vreg[s][0] | (vreg[s][1] << 16), vreg[s][2] | (vreg[s][3] << 16), vreg[s][4] | (vreg[s][5] << 16),
                              vreg[s][6] | (vreg[s][7] << 16));
        uint4 v1 = make_uint4(vreg[s][8] | (vreg[s][9] << 16), vreg[s][10] | (vreg[s][11] << 16), vreg[s][12] | (vreg[s][13] << 16),
                              vreg[s][14] | (vreg[s][15] << 16));
        *(uint4*)(sVT + lane * 72 + w * 16) = v0;
        *(uint4*)(sVT + lane * 72 + w * 16 + 8) = v1;
      }
      __syncthreads();
      if (pass == 2) {
        f32x4 accO[2][2];
#pragma unroll
        for (int m = 0; m < 2; m++)
#pragma unroll
          for (int n = 0; n < 2; n++) accO[m][n] = f32x4{0.f, 0.f, 0.f, 0.f};
        mma_nt<2, 2, 4>(accO, sQ + wr * 32 * 136, 136, sST + wc * 32 * 136, 136, lane);
        mma_nt<2, 2, 2>(accO, sP + wr * 32 * 72, 72, sVT + wc * 32 * 72, 72, lane);
#pragma unroll
        for (int m = 0; m < 2; m++)
#pragma unroll
          for (int j = 0; j < 4; j++) {
            int i = wr * 32 + m * 16 + fq * 4 + j;
            int f = c * 64 + i;
            int pos = dir ? (SEQ - 1 - f) : f;
            size_t o = (size_t)(b * SEQ + pos) * 1024 + h * 256 + dvp * 128 + s * 64 + wc * 32 + fr;
#pragma unroll
            for (int n = 0; n < 2; n++) obuf[o + n * 16] = f2b(accO[m][n][j]);
          }
      }
#pragma unroll
      for (int n = 0; n < 4; n++) {
        float dc = sDec[wc * 64 + n * 16 + fr];
#pragma unroll
        for (int m = 0; m < 2; m++)
#pragma unroll
          for (int j = 0; j < 4; j++) accS[s][m][n][j] *= dc;
      }
      mma_nt<2, 4, 2>(accS[s], sVT + wr * 32 * 72, 72, sKT + wc * 64 * 72, 72, lane);
      if (s == 0) __syncthreads();
    }
  }
  if (pass == 1) {
#pragma unroll
    for (int s = 0; s < 2; s++)
#pragma unroll
      for (int m = 0; m < 2; m++)
#pragma unroll
        for (int n = 0; n < 4; n++)
#pragma unroll
          for (int j = 0; j < 4; j++) Lp[(s * 64 + wr * 32 + m * 16 + fq * 4 + j) * 128 + wc * 64 + n * 16 + fr] = accS[s][m][n][j];
    if (dvp == 0 && w == 0) {
      p.Dd[(bhd * 16 + seg) * 128 + d0] = __expf(dsum0);
      p.Dd[(bhd * 16 + seg) * 128 + d0 + 1] = __expf(dsum1);
    }
  }
}

__device__ void phase2(const Params& p, char* smem, const XcdBarrier& xb) {
  const int t = threadIdx.x;
  (void)xb;
  u16* ya = (u16*)p.out + (size_t)BT * 1024;
  for (int job = blockIdx.x; job < 512 + 2048; job += gridDim.x) {
    if (job < 512) {
      gla_item(p, job, 1, smem);
    } else {
      const int j = job - 512;
      const int ch = (t & 127) * 8;
      float w0[8], w1[8], w2[8], cb[8];
#pragma unroll
      for (int e = 0; e < 8; e++) { w0[e] = p.conv_w[ch + e]; w1[e] = p.conv_w[1024 + ch + e]; w2[e] = p.conv_w[2048 + ch + e]; cb[e] = p.conv_b[ch + e]; }
#pragma unroll
      for (int it = 0; it < 4; it++) {
        const int tok = j * 8 + it * 2 + (t >> 7);
        const int pos = tok & (SEQ - 1);
        const size_t o = (size_t)tok * 1024 + ch;
        uint4 pc = *(const uint4*)(p.R1 + o);
        uint4 pp = make_uint4(0, 0, 0, 0), pn = make_uint4(0, 0, 0, 0);
        if (pos > 0) pp = *(const uint4*)(p.R1 + o - 1024);
        if (pos < SEQ - 1) pn = *(const uint4*)(p.R1 + o + 1024);
        uint4 bb = *(const uint4*)(p.R2 + o);
        const u32 pcs[4] = {pc.x, pc.y, pc.z, pc.w}, pps[4] = {pp.x, pp.y, pp.z, pp.w}, pns[4] = {pn.x, pn.y, pn.z, pn.w},
                  bbs[4] = {bb.x, bb.y, bb.z, bb.w};
        u32 ov[4];
#pragma unroll
        for (int q = 0; q < 4; q++) {
          float y0 = cb[2 * q] + w0[2 * q] * blo(pps[q]) + w1[2 * q] * blo(pcs[q]) + w2[2 * q] * blo(pns[q]);
          float y1 = cb[2 * q + 1] + w0[2 * q + 1] * bhi(pps[q]) + w1[2 * q + 1] * bhi(pcs[q]) + w2[2 * q + 1] * bhi(pns[q]);
          ov[q] = pack2(blo(bbs[q]) * y0, bhi(bbs[q]) * y1);
        }
        *(uint4*)(ya + o) = make_uint4(ov[0], ov[1], ov[2], ov[3]);
      }
    }
  }
}

__device__ void phase3(const Params& p) {
  for (int gid = blockIdx.x * 256 + threadIdx.x; gid < 16 * 8192; gid += gridDim.x * 256) {
    const int bhd = gid >> 13, e = (gid & 8191) * 4, dk = e & 127;
    float4 carry = make_float4(0.f, 0.f, 0.f, 0.f);
    for (int s = 0; s < 16; s++) {
      float4* lp = (float4*)(p.R7 + (size_t)(bhd * 16 + s) * 32768 + e);
      const float4 tmp = *lp;
      const float4 d = *(const float4*)(p.Dd + (bhd * 16 + s) * 128 + dk);
      *lp = carry;
      carry = make_float4(d.x * carry.x + tmp.x, d.y * carry.y + tmp.y, d.z * carry.z + tmp.z, d.w * carry.w + tmp.w);
    }
  }
}

__device__ void phase5(const Params& p) {
  const int t = threadIdx.x, lane = t & 63, w = t >> 6;
  float gv[16];
#pragma unroll
  for (int i = 0; i < 4; i++) {
    const float4 g = *(const float4*)(p.gng + lane * 16 + i * 4);
    gv[i * 4 + 0] = g.x; gv[i * 4 + 1] = g.y; gv[i * 4 + 2] = g.z; gv[i * 4 + 3] = g.w;
  }
  for (int tok = blockIdx.x * 4 + w; tok < BT; tok += gridDim.x * 4) {
    const size_t o = (size_t)tok * 1024 + lane * 16;
    const uint4 a0 = *(const uint4*)(p.R1 + o), a1 = *(const uint4*)(p.R1 + o + 8);
    const uint4 b0 = *(const uint4*)(p.R2 + o), b1 = *(const uint4*)(p.R2 + o + 8);
    const uint4 r0 = *(const uint4*)(p.R5 + o), r1 = *(const uint4*)(p.R5 + o + 8);
    const u32 aw[8] = {a0.x, a0.y, a0.z, a0.w, a1.x, a1.y, a1.z, a1.w};
    const u32 bw[8] = {b0.x, b0.y, b0.z, b0.w, b1.x, b1.y, b1.z, b1.w};
    const u32 rw[8] = {r0.x, r0.y, r0.z, r0.w, r1.x, r1.y, r1.z, r1.w};
    float ov[16];
    float ss = 0.f;
#pragma unroll
    for (int i = 0; i < 8; i++) {
      ov[2 * i] = blo(aw[i]) + blo(bw[i]);
      ov[2 * i + 1] = bhi(aw[i]) + bhi(bw[i]);
      ss += ov[2 * i] * ov[2 * i] + ov[2 * i + 1] * ov[2 * i + 1];
    }
    ss += __shfl_xor(ss, 1); ss += __shfl_xor(ss, 2); ss += __shfl_xor(ss, 4); ss += __shfl_xor(ss, 8);
    const float rstd = rsqrtf(ss * (1.f / 256.f) + 1e-6f);
    u32 ow[8];
#pragma unroll
    for (int i = 0; i < 8; i++) {
      const float ra = blo(rw[i]), rb = bhi(rw[i]);
      ow[i] = pack2(ov[2 * i] * rstd * gv[2 * i] * (ra * sigmoidf_(ra)), ov[2 * i + 1] * rstd * gv[2 * i + 1] * (rb * sigmoidf_(rb)));
    }
    *(uint4*)(p.R6 + o) = make_uint4(ow[0], ow[1], ow[2], ow[3]);
    *(uint4*)(p.R6 + o + 8) = make_uint4(ow[4], ow[5], ow[6], ow[7]);
  }
}

__device__ void phase6(const Params& p, char* smem) {
  const int t = threadIdx.x, lane = t & 63, w = t >> 6, wr = w >> 1, wc = w & 1, fr = lane & 15, fq = lane >> 4;
  const u16* xn = (const u16*)p.out;
  const u16* ya = xn + (size_t)BT * 1024;
  uint4* sG = (uint4*)((char*)p.R2 + (size_t)blockIdx.x * 65536 + t * 256);
  uint4* sH = sG + 8;
  TileIter ti(8);
  int mt, nt;
  while (ti.next(mt, nt)) {
    const int colb = nt * 128 + wc * 64 + fq * 4;
    f32x4 acc[4][4];
    zero_acc(acc);
    gemm_acc_db(acc, xn + (size_t)mt * 128 * 1024, 1024, p.WinT + (size_t)(6272 + nt * 128) * 1024, 1024, 1024, smem);
    {
      float4 gb[4];
#pragma unroll
      for (int n = 0; n < 4; n++) gb[n] = *(const float4*)(p.gbias + colb + n * 16);
#pragma unroll
      for (int m = 0; m < 4; m++)
#pragma unroll
        for (int h = 0; h < 2; h++)
          sG[m * 2 + h] = make_uint4(pack2(sigmoidf_(acc[m][2 * h][0] + gb[2 * h].x), sigmoidf_(acc[m][2 * h][1] + gb[2 * h].y)),
                                     pack2(sigmoidf_(acc[m][2 * h][2] + gb[2 * h].z), sigmoidf_(acc[m][2 * h][3] + gb[2 * h].w)),
                                     pack2(sigmoidf_(acc[m][2 * h + 1][0] + gb[2 * h + 1].x), sigmoidf_(acc[m][2 * h + 1][1] + gb[2 * h + 1].y)),
                                     pack2(sigmoidf_(acc[m][2 * h + 1][2] + gb[2 * h + 1].z), sigmoidf_(acc[m][2 * h + 1][3] + gb[2 * h + 1].w)));
    }
    zero_acc(acc);
    gemm_acc_db(acc, ya + (size_t)mt * 128 * 1024, 1024, p.WaT + (size_t)nt * 128 * 1024, 1024, 1024, smem);
#pragma unroll
    for (int m = 0; m < 4; m++)
#pragma unroll
      for (int h = 0; h < 2; h++) {
        const uint4 g = sG[m * 2 + h];
        sG[m * 2 + h] = make_uint4(pack2(acc[m][2 * h][0] * blo(g.x), acc[m][2 * h][1] * bhi(g.x)),
                                   pack2(acc[m][2 * h][2] * blo(g.y), acc[m][2 * h][3] * bhi(g.y)),
                                   pack2(acc[m][2 * h + 1][0] * blo(g.z), acc[m][2 * h + 1][1] * bhi(g.z)),
                                   pack2(acc[m][2 * h + 1][2] * blo(g.w), acc[m][2 * h + 1][3] * bhi(g.w)));
      }
    zero_acc(acc);
    gemm_acc_db(acc, p.R6 + (size_t)mt * 128 * 1024, 1024, p.WbT + (size_t)nt * 128 * 1024, 1024, 1024, smem);
#pragma unroll
    for (int m = 0; m < 4; m++)
#pragma unroll
      for (int h = 0; h < 2; h++)
        sH[m * 2 + h] = make_uint4(pack2(acc[m][2 * h][0], acc[m][2 * h][1]), pack2(acc[m][2 * h][2], acc[m][2 * h][3]),
                                   pack2(acc[m][2 * h + 1][0], acc[m][2 * h + 1][1]), pack2(acc[m][2 * h + 1][2], acc[m][2 * h + 1][3]));
    zero_acc(acc);
    gemm_acc_db(acc, xn + (size_t)mt * 128 * 1024, 1024, p.WinT + (size_t)(6272 + 1024 + nt * 128) * 1024, 1024, 1024, smem);
    const int rowb = mt * 128 + wr * 64 + fr;
    {
      float4 gb[4];
#pragma unroll
      for (int n = 0; n < 4; n++) gb[n] = *(const float4*)(p.gbias + 1024 + colb + n * 16);
#pragma unroll
      for (int m = 0; m < 4; m++)
#pragma unroll
        for (int h = 0; h < 2; h++) {
          const uint4 a = sG[m * 2 + h], b = sH[m * 2 + h];
          const u32 av[4] = {a.x, a.y, a.z, a.w}, bv[4] = {b.x, b.y, b.z, b.w};
#pragma unroll
          for (int nn = 0; nn < 2; nn++) {
            const int n = 2 * h + nn;
            float r0 = blo(av[nn * 2]) + blo(bv[nn * 2]) * sigmoidf_(acc[m][n][0] + gb[n].x);
            float r1 = bhi(av[nn * 2]) + bhi(bv[nn * 2]) * sigmoidf_(acc[m][n][1] + gb[n].y);
            float r2 = blo(av[nn * 2 + 1]) + blo(bv[nn * 2 + 1]) * sigmoidf_(acc[m][n][2] + gb[n].z);
            float r3 = bhi(av[nn * 2 + 1]) + bhi(bv[nn * 2 + 1]) * sigmoidf_(acc[m][n][3] + gb[n].w);
            *(uint2*)(p.R1 + (size_t)(rowb + m * 16) * 1024 + colb + n * 16) = make_uint2(pack2(r0, r1), pack2(r2, r3));
          }
        }
    }
  }
}

__device__ void phase7(const Params& p, char* smem) {
  u16* sA = (u16*)smem;
  u16* sB = sA + 128 * 64;
  const int t = threadIdx.x, lane = t & 63, w = t >> 6, wr = w >> 1, wc = w & 1, fr = lane & 15, fq = lane >> 4;
  float* x1 = (float*)p.R2;
  TileIter ti(8);
  int mt, nt;
  while (ti.next(mt, nt)) {
    f32x4 acc[4][4];
    zero_acc(acc);
    gemm_acc_db(acc, p.R1 + (size_t)mt * 128 * 1024, 1024, p.WoT + (size_t)nt * 128 * 1024, 1024, 1024, smem);
    const int rowb = mt * 128 + wr * 64 + fr;
    const int colb = nt * 128 + wc * 64 + fq * 4;
#pragma unroll
    for (int m = 0; m < 4; m++)
#pragma unroll
      for (int n = 0; n < 4; n++) {
        const size_t o = (size_t)(rowb + m * 16) * 1024 + colb + n * 16;
        const float4 xv = *(const float4*)(p.x + o);
        *(float4*)(x1 + o) = make_float4(xv.x + acc[m][n][0], xv.y + acc[m][n][1], xv.z + acc[m][n][2], xv.w + acc[m][n][3]);
      }
  }
}

constexpr float U_SCALE = 256.f, V_SCALE = 64.f;
__device__ __forceinline__ u32 enc_fp8x4(float a, float b, float c, float d) {
  int w = __builtin_amdgcn_cvt_pk_fp8_f32(a, b, 0, false);
  w = __builtin_amdgcn_cvt_pk_fp8_f32(c, d, w, true);
  return (u32)w;
}
__device__ __forceinline__ void table_convert_job(const Params& p, int j, int t) {
  unsigned char* Tb = (unsigned char*)p.R5;
  const float* src = (j < 4096) ? p.pu : p.pv;
  const float sc = (j < 4096) ? U_SCALE : V_SCALE;
  size_t base = (size_t)(j & 4095) * 4096 + t * 16;
  unsigned char* slot = Tb + (base >> 10) * 2048 + ((j < 4096) ? 0 : 1024) + (base & 1023);
  float4 a = *(const float4*)(src + base), b = *(const float4*)(src + base + 4), c = *(const float4*)(src + base + 8),
         d = *(const float4*)(src + base + 12);
  *(uint4*)slot = make_uint4(enc_fp8x4(a.x * sc, a.y * sc, a.z * sc, a.w * sc), enc_fp8x4(b.x * sc, b.y * sc, b.z * sc, b.w * sc),
                                     enc_fp8x4(c.x * sc, c.y * sc, c.z * sc, c.w * sc), enc_fp8x4(d.x * sc, d.y * sc, d.z * sc, d.w * sc));
}
__device__ void phase8(const Params& p) {
  const int t = threadIdx.x, lane = t & 63, w = t >> 6;
  const float* x1 = (const float*)p.R2;
  for (int job = blockIdx.x; job < 4096; job += gridDim.x) {
    int row = job * 4 + w;
    rms_row(x1 + (size_t)row * 1024, p.norm2_g, p.R4 + (size_t)row * 1024, lane);
  }
}

__device__ void phase9(const Params& p, char* smem) {
  u16* sA = (u16*)smem;
  u16* sB = sA + 128 * 64;
  const int t = threadIdx.x, lane = t & 63, w = t >> 6, wr = w >> 1, wc = w & 1, fr = lane & 15, fq = lane >> 4;
  u16* q = (u16*)p.out;
  TileIter ti(16);
  int mt, nt;
  while (ti.next(mt, nt)) {
    f32x4 acc[4][4];
    zero_acc(acc);
    gemm_acc_db(acc, p.R4 + (size_t)mt * 128 * 1024, 1024, p.WqT + (size_t)nt * 128 * 1024, 1024, 1024, smem);
    const int rowb = mt * 128 + wr * 64 + fr;
    const int colb = nt * 128 + wc * 64 + fq * 4;
#pragma unroll
    for (int m = 0; m < 4; m++)
#pragma unroll
      for (int n = 0; n < 4; n++)
        *(uint2*)(q + (size_t)(rowb + m * 16) * 2048 + colb + n * 16) = make_uint2(pack2(acc[m][n][0], acc[m][n][1]), pack2(acc[m][n][2], acc[m][n][3]));
#pragma unroll 1
    for (int r = 0; r < 4; r++) table_convert_job(p, (mt * 16 + nt) * 4 + r, t);
  }
}

__device__ __forceinline__ void select16q(u32* rowbase, int part, u32 (&tk)[16], unsigned char* idxp) {
  u32* myp = rowbase + part * 32;
#pragma unroll
  for (int it = 0; it < 16; it++) {
    u32 m = 0;
#pragma unroll
    for (int c = 0; c < 8; c++) {
      uint4 kk = *(const uint4*)(myp + c * 4);
      m = max(m, max(max(kk.x, kk.y), max(kk.z, kk.w)));
    }
    m = max(m, (u32)__shfl_xor((int)m, 1));
    m = max(m, (u32)__shfl_xor((int)m, 2));
    tk[it] = m;
    const int idx = 127 - (int)(m & 127u);
    if ((idx >> 5) == part) { rowbase[idx] = 0; idxp[it] = (unsigned char)idx; }
  }
}

__device__ void phase10(const Params& p, char* smem) {
  u16* sKeys = (u16*)smem;
  u32* sSc = (u32*)(smem + 128 * 136 * 2);
  unsigned char* sIdx = (unsigned char*)(smem + 128 * 136 * 2 + 64 * 132 * 4);
  const int t = threadIdx.x, lane = t & 63, w = t >> 6, fr = lane & 15, fq = lane >> 4;
  const int rl = lane >> 2, part = lane & 3, row = w * 16 + rl;
  const u16* q = (const u16*)p.out;
  int* experts = (int*)p.R7;
  float* gates = p.R7 + (size_t)BT * 128;
#define P10_DECL(S) uint4 S##k0, S##k1, S##k2, S##k3, S##k4, S##k5, S##k6, S##k7; bf16x8 S##q0, S##q1, S##q2, S##q3
#define P10_LOAD(S, ITEM, PP)                                                                               \
  do {                                                                                                      \
    const int it_ = ((ITEM) < 256 * 8) ? (ITEM) : (int)blockIdx.x;                                          \
    const int tt_ = it_ >> 3, h_ = it_ & 7;                                                                 \
    const u16* ks_ = p.KeysB + (size_t)(h_ * 2 + (PP)) * 128 * 128 + (t >> 4) * 128 + (t & 15) * 8;         \
    S##k0 = *(const uint4*)(ks_); S##k1 = *(const uint4*)(ks_ + 16 * 128); S##k2 = *(const uint4*)(ks_ + 32 * 128);   \
    S##k3 = *(const uint4*)(ks_ + 48 * 128); S##k4 = *(const uint4*)(ks_ + 64 * 128); S##k5 = *(const uint4*)(ks_ + 80 * 128); \
    S##k6 = *(const uint4*)(ks_ + 96 * 128); S##k7 = *(const uint4*)(ks_ + 112 * 128);                      \
    const u16* qp_ = q + (size_t)(tt_ * 64 + w * 16 + fr) * 2048 + h_ * 256 + (PP) * 128 + fq * 8;          \
    S##q0 = *(const bf16x8*)(qp_); S##q1 = *(const bf16x8*)(qp_ + 32); S##q2 = *(const bf16x8*)(qp_ + 64);  \
    S##q3 = *(const bf16x8*)(qp_ + 96);                                                                     \
  } while (0)
#define P10_MFMA_K(QK, KI)                                                                                  \
  _Pragma("unroll") for (int n_ = 0; n_ < 8; n_++) {                                                        \
    bf16x8 bv_ = *(const bf16x8*)(sKeys + (n_ * 16 + fr) * 136 + (KI) * 32 + fq * 8);                       \
    acc_[n_] = __builtin_amdgcn_mfma_f32_16x16x32_bf16(QK, bv_, acc_[n_], 0, 0, 0);                         \
  }
#define P10_SCORE(S)                                                                                        \
  do {                                                                                                      \
    __syncthreads();                                                                                        \
    u16* kd_ = sKeys + (t >> 4) * 136 + (t & 15) * 8;                                                       \
    *(uint4*)(kd_) = S##k0; *(uint4*)(kd_ + 16 * 136) = S##k1; *(uint4*)(kd_ + 32 * 136) = S##k2;           \
    *(uint4*)(kd_ + 48 * 136) = S##k3; *(uint4*)(kd_ + 64 * 136) = S##k4; *(uint4*)(kd_ + 80 * 136) = S##k5; \
    *(uint4*)(kd_ + 96 * 136) = S##k6; *(uint4*)(kd_ + 112 * 136) = S##k7;                                  \
    __syncthreads();                                                                                        \
    f32x4 acc_[8];                                                                                          \
    _Pragma("unroll") for (int n_ = 0; n_ < 8; n_++) acc_[n_] = f32x4{0.f, 0.f, 0.f, 0.f};                  \
    P10_MFMA_K(S##q0, 0) P10_MFMA_K(S##q1, 1) P10_MFMA_K(S##q2, 2) P10_MFMA_K(S##q3, 3)                     \
    _Pragma("unroll") for (int n_ = 0; n_ < 8; n_++)                                                        \
      _Pragma("unroll") for (int j_ = 0; j_ < 4; j_++) {                                                    \
        int r_ = w * 16 + fq * 4 + j_, col_ = n_ * 16 + fr;                                                 \
        sSc[r_ * 132 + col_] = (ordf(acc_[n_][j_]) & ~127u) | (u32)(127 - col_);                            \
      }                                                                                                     \
    __syncthreads();                                                                                        \
  } while (0)
  P10_DECL(sa);
  P10_DECL(sb);
  P10_LOAD(sa, (int)blockIdx.x, 0);
  for (int item = blockIdx.x; item < 256 * 8; item += gridDim.x) {
    const int tt = item >> 3, h = item & 7;
    u32 ta[16], tb[16];
    P10_SCORE(sa);
    P10_LOAD(sb, item, 1);
    select16q(sSc + row * 132, part, ta, sIdx + row * 32);
    P10_SCORE(sb);
    P10_LOAD(sa, item + (int)gridDim.x, 0);
    select16q(sSc + row * 132, part, tb, sIdx + row * 32 + 16);
    __syncthreads();
    {
      float fa[4], fb[16];
#pragma unroll
      for (int r = 0; r < 4; r++) {
        const u32 s0 = ta[4 * r], s1 = ta[4 * r + 1], s2 = ta[4 * r + 2], s3 = ta[4 * r + 3];
        const u32 sel = part == 0 ? s0 : (part == 1 ? s1 : (part == 2 ? s2 : s3));
        fa[r] = unordf(sel & ~127u);
      }
#pragma unroll
      for (int j = 0; j < 16; j++) fb[j] = unordf(tb[j] & ~127u);
      constexpr int NJ[4] = {16, 3, 1, 1};
      u32 cand[4][16];
#pragma unroll
      for (int r = 0; r < 4; r++) {
        const int irow = part + 4 * r;
        const int jlim = 16 / (irow + 1);
#pragma unroll
        for (int j = 0; j < 16; j++)
          if (j < NJ[r]) cand[r][j] = (j < jlim) ? ((ordf(fa[r] + fb[j]) & ~255u) | (u32)(255 - (irow * 16 + j))) : 0u;
      }
      const int tok = tt * 64 + row;
      float sv[16];
      int ev[16];
#pragma unroll
      for (int it = 0; it < 16; it++) {
        u32 m = 0;
#pragma unroll
        for (int r = 0; r < 4; r++)
#pragma unroll
          for (int j = 0; j < 16; j++)
            if (j < NJ[r]) m = max(m, cand[r][j]);
        m = max(m, (u32)__shfl_xor((int)m, 1));
        m = max(m, (u32)__shfl_xor((int)m, 2));
#pragma unroll
        for (int r = 0; r < 4; r++)
#pragma unroll
          for (int j = 0; j < 16; j++)
            if (j < NJ[r]) cand[r][j] = (cand[r][j] == m) ? 0u : cand[r][j];
        const int c = 255 - (int)(m & 255u);
        const int i1 = sIdx[row * 32 + (c >> 4)], i2 = sIdx[row * 32 + 16 + (c & 15)];
        ev[it] = i1 * 128 + i2;
        sv[it] = unordf(m & ~255u);
      }
      const float mx = sv[0];
      float sum = 0.f;
#pragma unroll
      for (int it = 0; it < 16; it++) { sv[it] = __expf(sv[it] - mx); sum += sv[it]; }
      const float inv = 1.f / sum;
#pragma unroll
      for (int g = 0; g < 4; g++) {
        if (part == g) {
          *(int4*)(experts + (size_t)tok * 128 + h * 16 + g * 4) = make_int4(ev[g * 4], ev[g * 4 + 1], ev[g * 4 + 2], ev[g * 4 + 3]);
          *(float4*)(gates + (size_t)tok * 128 + h * 16 + g * 4) =
              make_float4(sv[g * 4] * inv, sv[g * 4 + 1] * inv, sv[g * 4 + 2] * inv, sv[g * 4 + 3] * inv);
        }
      }
    }
  }
}

#undef P10_LOAD
#undef P10_SCORE
#undef P10_MFMA_K
#undef P10_DECL
typedef float f32x2 __attribute__((ext_vector_type(2)));
__device__ __forceinline__ void dec16(const uint4& q, float (&o)[16]) {
  const u32 ws_[4] = {q.x, q.y, q.z, q.w};
#pragma unroll
  for (int i = 0; i < 4; i++) {
    f32x2 lo = __builtin_amdgcn_cvt_pk_f32_fp8((int)ws_[i], false);
    f32x2 hi = __builtin_amdgcn_cvt_pk_f32_fp8((int)ws_[i], true);
    o[i * 4 + 0] = lo[0]; o[i * 4 + 1] = lo[1]; o[i * 4 + 2] = hi[0]; o[i * 4 + 3] = hi[1];
  }
}
__device__ __forceinline__ void peer_load8(uint4 (&U)[8], uint4 (&V)[8], const unsigned char* Ub, const unsigned char* Vb, int ev, int l0,
                                           int lane) {
#pragma unroll
  for (int u = 0; u < 8; u++) {
    const int e = __builtin_amdgcn_readlane(ev, l0 + u);
    U[u] = *(const uint4*)(Ub + (size_t)e * 2048 + lane * 16);
    V[u] = *(const uint4*)(Vb + (size_t)e * 2048 + lane * 16);
  }
}
__device__ __forceinline__ void peer_proc8(const uint4 (&U)[8], const uint4 (&V)[8], const f32x2 (&xp)[8], f32x2 (&accp)[8], float gate_lane,
                                           int lane) {
  float d[8];
#pragma unroll
  for (int u = 0; u < 8; u++) {
    const u32 ws_[4] = {U[u].x, U[u].y, U[u].z, U[u].w};
    f32x2 s = {0.f, 0.f};
#pragma unroll
    for (int q = 0; q < 4; q++) {
      s += xp[2 * q] * __builtin_amdgcn_cvt_pk_f32_fp8((int)ws_[q], false);
      s += xp[2 * q + 1] * __builtin_amdgcn_cvt_pk_f32_fp8((int)ws_[q], true);
    }
    d[u] = s[0] + s[1];
  }
  {
    const bool b4 = (lane & 4) != 0, b2 = (lane & 2) != 0, b1 = (lane & 1) != 0;
#pragma unroll
    for (int i = 0; i < 4; i++) {
      const float send = b4 ? d[i] : d[i + 4], keep = b4 ? d[i + 4] : d[i];
      d[i] = keep + __shfl_xor(send, 4);
    }
#pragma unroll
    for (int i = 0; i < 2; i++) {
      const float send = b2 ? d[i] : d[i + 2], keep = b2 ? d[i + 2] : d[i];
      d[i] = keep + __shfl_xor(send, 2);
    }
    {
      const float send = b1 ? d[0] : d[1], keep = b1 ? d[1] : d[0];
      d[0] = keep + __shfl_xor(send, 1);
    }
    d[0] += __shfl_xor(d[0], 8);
    d[0] += __shfl_xor(d[0], 16);
    d[0] += __shfl_xor(d[0], 32);
  }
  const float dd = d[0] * (1.f / U_SCALE);
  const float hd = 0.5f * dd * (1.f + erff(dd * 0.70710678118654752f));
  const int cl = __float_as_int(hd * gate_lane * (1.f / V_SCALE));
#pragma unroll
  for (int u = 0; u < 8; u++) {
    const float c = __int_as_float(__builtin_amdgcn_readlane(cl, u));
    const f32x2 c2 = {c, c};
    const u32 ws_[4] = {V[u].x, V[u].y, V[u].z, V[u].w};
#pragma unroll
    for (int q = 0; q < 4; q++) {
      accp[2 * q] += c2 * __builtin_amdgcn_cvt_pk_f32_fp8((int)ws_[q], false);
      accp[2 * q + 1] += c2 * __builtin_amdgcn_cvt_pk_f32_fp8((int)ws_[q], true);
    }
  }
}
__device__ __forceinline__ float dot16_fp8(const f32x2 (&xp)[8], const uint4& q) {
  const u32 ws_[4] = {q.x, q.y, q.z, q.w};
  f32x2 s = {0.f, 0.f};
#pragma unroll
  for (int i = 0; i < 4; i++) {
    s += xp[2 * i] * __builtin_amdgcn_cvt_pk_f32_fp8((int)ws_[i], false);
    s += xp[2 * i + 1] * __builtin_amdgcn_cvt_pk_f32_fp8((int)ws_[i], true);
  }
  return s[0] + s[1];
}
__device__ __forceinline__ void pe_load_tab(const unsigned char* Tb, unsigned loff, int e0, int e1, int g, uint4 (&U)[16]) {
#pragma unroll
  for (int kb = 0; kb < 16; kb++) {
    const int e = __shfl((kb < 8) ? e0 : e1, (kb & 7) * 8 + g);
    U[kb] = *(const uint4*)(Tb + ((unsigned)e * 2048u + loff));
  }
}
__device__ __forceinline__ void pe_load_x(const u16* xr, f32x2 (&xp)[8]) {
  uint4 a = *(const uint4*)(xr), b = *(const uint4*)(xr + 8);
  xp[0] = f32x2{blo(a.x), bhi(a.x)}; xp[1] = f32x2{blo(a.y), bhi(a.y)}; xp[2] = f32x2{blo(a.z), bhi(a.z)}; xp[3] = f32x2{blo(a.w), bhi(a.w)};
  xp[4] = f32x2{blo(b.x), bhi(b.x)}; xp[5] = f32x2{blo(b.y), bhi(b.y)}; xp[6] = f32x2{blo(b.z), bhi(b.z)}; xp[7] = f32x2{blo(b.w), bhi(b.w)};
}
__device__ __forceinline__ void pe_dot_store(const f32x2 (&xp)[8], const uint4 (&U)[16], float* pr, int lane, int r) {
  float d[16];
#pragma unroll
  for (int kb = 0; kb < 16; kb++) d[kb] = dot16_fp8(xp, U[kb]);
  const bool b4 = (lane & 4) != 0, b2 = (lane & 2) != 0, b1 = (lane & 1) != 0;
#pragma unroll
  for (int i = 0; i < 8; i++) { const float send = b4 ? d[i] : d[i + 8], keep = b4 ? d[i + 8] : d[i]; d[i] = keep + __shfl_xor(send, 4); }
#pragma unroll
  for (int i = 0; i < 4; i++) { const float send = b2 ? d[i] : d[i + 4], keep = b2 ? d[i + 4] : d[i]; d[i] = keep + __shfl_xor(send, 2); }
#pragma unroll
  for (int i = 0; i < 2; i++) { const float send = b1 ? d[i] : d[i + 2], keep = b1 ? d[i + 2] : d[i]; d[i] = keep + __shfl_xor(send, 1); }
  pr[(2 * r) * 8] = d[0];
  pr[(2 * r + 1) * 8] = d[1];
}
__device__ void phase11a(const Params& p) {
  const int t = threadIdx.x, lane = t & 63, w = t >> 6, g = lane >> 3, r = lane & 7;
  const int s = blockIdx.x & 7, jb = blockIdx.x >> 3, ns = (gridDim.x - s + 7) >> 3;
  const u16* xn2 = p.R4 + s * 128 + r * 16;
  const unsigned char* Tb = (const unsigned char*)p.R5 + s * 128;
  const unsigned loff = r * 16;
  const int* experts = (const int*)p.R7 + lane;
  float* part = p.out + (size_t)s * BT * 128 + g;
  const int first = jb * 4 + w, stride = ns * 4;
  if (first >= BT) return;
#define TOKC(T) (((T) < BT) ? (T) : first)
  int eA0, eA1, eB0, eB1;
  uint4 UA[16], UB[16];
  f32x2 xA[8], xB[8];
  eA0 = experts[(size_t)first * 128]; eA1 = experts[(size_t)first * 128 + 64];
  pe_load_tab(Tb, loff, eA0, eA1, g, UA);
  pe_load_x(xn2 + (size_t)first * 1024, xA);
  { const int t1 = TOKC(first + stride); eB0 = experts[(size_t)t1 * 128]; eB1 = experts[(size_t)t1 * 128 + 64]; }
#pragma unroll 1
  for (int tok = first; tok < BT; tok += 2 * stride) {
    const int t1 = tok + stride, t2 = tok + 2 * stride, t3 = tok + 3 * stride;
    pe_load_tab(Tb, loff, eB0, eB1, g, UB);
    pe_load_x(xn2 + (size_t)TOKC(t1) * 1024, xB);
    { const int tc = TOKC(t2); eA0 = experts[(size_t)tc * 128]; eA1 = experts[(size_t)tc * 128 + 64]; }
    pe_dot_store(xA, UA, part + (size_t)tok * 128, lane, r);
    pe_load_tab(Tb, loff, eA0, eA1, g, UA);
    pe_load_x(xn2 + (size_t)TOKC(t2) * 1024, xA);
    { const int tc = TOKC(t3); eB0 = experts[(size_t)tc * 128]; eB1 = experts[(size_t)tc * 128 + 64]; }
    if (t1 < BT) pe_dot_store(xB, UB, part + (size_t)t1 * 128, lane, r);
  }
}

__device__ void phase11r(const Params& p) {
  float* gates = p.R7 + (size_t)BT * 128;
  const float* part = p.out;
  for (int idx = blockIdx.x * 256 + threadIdx.x; idx < BT * 128 / 4; idx += gridDim.x * 256) {
    float4 h = *(const float4*)(part + (size_t)idx * 4);
#pragma unroll
    for (int ss = 1; ss < 8; ss++) {
      const float4 q = *(const float4*)(part + (size_t)ss * BT * 128 + (size_t)idx * 4);
      h.x += q.x; h.y += q.y; h.z += q.z; h.w += q.w;
    }
    float4 gt = *(const float4*)(gates + (size_t)idx * 4);
    const float hv[4] = {h.x * (1.f / U_SCALE), h.y * (1.f / U_SCALE), h.z * (1.f / U_SCALE), h.w * (1.f / U_SCALE)};
    const float gv[4] = {gt.x, gt.y, gt.z, gt.w};
    float c[4];
#pragma unroll
    for (int q = 0; q < 4; q++) c[q] = 0.5f * hv[q] * (1.f + erff(hv[q] * 0.70710678118654752f)) * gv[q] * (1.f / V_SCALE);
    *(float4*)(gates + (size_t)idx * 4) = make_float4(c[0], c[1], c[2], c[3]);
  }
}

struct PeTok { int e0, e1; float g0, g1; };
__device__ __forceinline__ PeTok pe_load_tok(const int* experts, const float* gates, int tok) {
  PeTok k;
  k.e0 = experts[(size_t)tok * 128]; k.e1 = experts[(size_t)tok * 128 + 64];
  k.g0 = gates[(size_t)tok * 128]; k.g1 = gates[(size_t)tok * 128 + 64];
  return k;
}
__device__ __forceinline__ void pe_value_store(const PeTok& k, const uint4 (&V)[16], u16* drow, int lane, int g) {
  const float c0 = k.g0, c1 = k.g1;
  f32x2 accp[8];
#pragma unroll
  for (int i = 0; i < 8; i++) accp[i] = f32x2{0.f, 0.f};
#pragma unroll
  for (int kb = 0; kb < 16; kb++) {
    const float c = __shfl((kb < 8) ? c0 : c1, (kb & 7) * 8 + g);
    const f32x2 c2 = {c, c};
    const u32 ws_[4] = {V[kb].x, V[kb].y, V[kb].z, V[kb].w};
#pragma unroll
    for (int q = 0; q < 4; q++) {
      accp[2 * q] += c2 * __builtin_amdgcn_cvt_pk_f32_fp8((int)ws_[q], false);
      accp[2 * q + 1] += c2 * __builtin_amdgcn_cvt_pk_f32_fp8((int)ws_[q], true);
    }
  }
  float a[16];
#pragma unroll
  for (int i = 0; i < 8; i++) { a[2 * i] = accp[i][0]; a[2 * i + 1] = accp[i][1]; }
  const bool b32 = (lane & 32) != 0, b16 = (lane & 16) != 0, b8 = (lane & 8) != 0;
#pragma unroll
  for (int i = 0; i < 8; i++) { const float send = b32 ? a[i] : a[i + 8], keep = b32 ? a[i + 8] : a[i]; a[i] = keep + __shfl_xor(send, 32); }
#pragma unroll
  for (int i = 0; i < 4; i++) { const float send = b16 ? a[i] : a[i + 4], keep = b16 ? a[i + 4] : a[i]; a[i] = keep + __shfl_xor(send, 16); }
#pragma unroll
  for (int i = 0; i < 2; i++) { const float send = b8 ? a[i] : a[i + 2], keep = b8 ? a[i + 2] : a[i]; a[i] = keep + __shfl_xor(send, 8); }
  *(u32*)drow = pack2(a[0], a[1]);
}
__device__ void phase11b(const Params& p) {
  const int t = threadIdx.x, lane = t & 63, w = t >> 6, g = lane >> 3, r = lane & 7;
  const int s = blockIdx.x & 7, jb = blockIdx.x >> 3, ns = (gridDim.x - s + 7) >> 3;
  const unsigned char* Tb = (const unsigned char*)p.R5 + 1024 + s * 128;
  const unsigned loff = r * 16;
  const int* experts = (const int*)p.R7 + lane;
  const float* gates = p.R7 + (size_t)BT * 128 + lane;
  u16* x1 = p.R1 + s * 128 + r * 16 + 2 * g;
  const int first = jb * 4 + w, stride = ns * 4;
  if (first >= BT) return;
  PeTok kA, kB;
  uint4 VA[16], VB[16];
  kA = pe_load_tok(experts, gates, first);
  pe_load_tab(Tb, loff, kA.e0, kA.e1, g, VA);
  kB = pe_load_tok(experts, gates, TOKC(first + stride));
#pragma unroll 1
  for (int tok = first; tok < BT; tok += 2 * stride) {
    const int t1 = tok + stride, t2 = tok + 2 * stride, t3 = tok + 3 * stride;
    pe_load_tab(Tb, loff, kB.e0, kB.e1, g, VB);
    const PeTok kC = pe_load_tok(experts, gates, TOKC(t2));
    pe_value_store(kA, VA, x1 + (size_t)tok * 1024, lane, g);
    pe_load_tab(Tb, loff, kC.e0, kC.e1, g, VA);
    const PeTok kD = pe_load_tok(experts, gates, TOKC(t3));
    if (t1 < BT) pe_value_store(kB, VB, x1 + (size_t)t1 * 1024, lane, g);
    kA = kC; kB = kD;
  }
#undef TOKC
}

__device__ void phase11c(const Params& p) {
  const int t = threadIdx.x, lane = t & 63, w = t >> 6;
  const float* x1 = (const float*)p.R2;
  for (int tok = blockIdx.x * 4 + w; tok < BT; tok += gridDim.x * 4) {
    const float* xr = x1 + (size_t)tok * 1024 + lane * 16;
    const u16* dl = p.R1 + (size_t)tok * 1024 + lane * 16;
    float4 v[4];
    float ss = 0.f;
#pragma unroll
    for (int i = 0; i < 4; i++) {
      v[i] = *(const float4*)(xr + i * 4);
      const uint2 dd = *(const uint2*)(dl + i * 4);
      v[i].x += blo(dd.x); v[i].y += bhi(dd.x); v[i].z += blo(dd.y); v[i].w += bhi(dd.y);
      ss += v[i].x * v[i].x + v[i].y * v[i].y + v[i].z * v[i].z + v[i].w * v[i].w;
    }
    ss = wave_sum(ss);
    const float rstd = rsqrtf(ss * (1.f / 1024.f) + 1e-6f);
    float* orow = p.out + (size_t)tok * 1024 + lane * 16;
#pragma unroll
    for (int i = 0; i < 4; i++) {
      float4 gg = *(const float4*)(p.fng + lane * 16 + i * 4);
      *(float4*)(orow + i * 4) = make_float4(v[i].x * rstd * gg.x, v[i].y * rstd * gg.y, v[i].z * rstd * gg.z, v[i].w * rstd * gg.w);
    }
  }
}

__global__ void __launch_bounds__(256, 2) fwd_mega(Params p, int ph_lo, int ph_hi) {
  extern __shared__ __attribute__((aligned(16))) char smem[];
  cg::grid_group grid = cg::this_grid();
  __shared__ uint4 xb_words;
  if (threadIdx.x == 0) xb_words = make_uint4(0u, 0u, 0u, 0u);
  __syncthreads();
  const XcdBarrier xb = xcd_barrier_post(p.bar, (volatile LAS unsigned*)&xb_words);
  if (ph_lo > ph_hi) grid.sync();
constexpr int REP0=1,REP1=1,REP2=1,REP3=1,REP4=1,REP5=1,REP6=1,REP7=1,REP8=1,REP9=1,REP10=1,REP11=1,REP12=1,REP13=1,REP14=1;
#define RUN_PHASE(k, call)                         \
  if (PH_ON(k) && ph_lo <= (k) && (k) < ph_hi) {   \
    for (int rep_ = 0; rep_ < REP##k; rep_++) { call; }  \
    if ((k) + 1 < ph_hi) xcd_barrier(xb);          \
  }
  RUN_PHASE(0, phase0(p, smem))
  RUN_PHASE(1, phase1(p, smem))
  RUN_PHASE(2, phase2(p, smem, xb))
  RUN_PHASE(3, phase3(p); weights_late(p, smem))
  RUN_PHASE(4, for (int item = blockIdx.x; item < 512; item += gridDim.x) gla_item(p, item, 2, smem))
  RUN_PHASE(5, phase5(p))
  RUN_PHASE(6, phase6(p, smem))
  RUN_PHASE(7, phase7(p, smem))
  RUN_PHASE(8, phase8(p))
  RUN_PHASE(9, phase9(p, smem))
  RUN_PHASE(10, phase10(p, smem))
  RUN_PHASE(11, phase11a(p))
  RUN_PHASE(12, phase11r(p))
  RUN_PHASE(13, phase11b(p))
  RUN_PHASE(14, phase11c(p))
}

extern "C" void kernel_launch(void* const* d_in, const int* in_sizes, int n_in, void* d_out, int out_size, void* d_ws,
                              size_t ws_size, hipStream_t stream) {
  (void)in_sizes; (void)n_in; (void)out_size; (void)ws_size;
  static int grid_blocks = 0;
  if (!grid_blocks) {
    int dev = 0, cus = 0, per_cu = 0;
    hipGetDevice(&dev);
    hipDeviceGetAttribute(&cus, hipDeviceAttributeMultiprocessorCount, dev);
    hipFuncSetAttribute((const void*)fwd_mega, hipFuncAttributeMaxDynamicSharedMemorySize, LDS_BYTES);
    hipOccupancyMaxActiveBlocksPerMultiprocessor(&per_cu, (const void*)fwd_mega, 256, LDS_BYTES);
    if (per_cu < 1) per_cu = 1;
    if (per_cu > 2) per_cu = 2;
    grid_blocks = cus * per_cu;
  }
  Params p{};
  const float* const* in = (const float* const*)d_in;
  p.x = in[0]; p.norm1_g = in[1]; p.w_in = in[2]; p.conv_w = in[3]; p.conv_b = in[4]; p.wa = in[5];
  p.dupf = in[6]; p.dbf = in[7]; p.dupb = in[8]; p.dbb = in[9]; p.gng = in[10]; p.wb = in[11];
  p.gbias = in[12]; p.wo = in[13]; p.norm2_g = in[14]; p.wq = in[15]; p.keys = in[16]; p.pu = in[17];
  p.pv = in[18]; p.fng = in[19];
  p.out = (float*)d_out;
  char* ws = (char*)d_ws;
  const size_t MiB = 1u << 20;
  p.WinT = (u16*)ws;
  p.WaT = (u16*)(ws + 17039360);
  p.WbT = (u16*)(ws + 17039360 + 2097152);
  p.WoT = (u16*)(ws + 17039360 + 2 * 2097152);
  p.WqT = (u16*)(ws + 17039360 + 3 * 2097152);
  p.KeysB = (u16*)(ws + 17039360 + 3 * 2097152 + 4194304);
  p.R1 = (u16*)(ws + 27 * MiB);
  p.R2 = (u16*)(ws + 59 * MiB);
  p.R3 = (u16*)(ws + 91 * MiB);
  p.R4 = (u16*)(ws + 123 * MiB);
  p.R5 = (u16*)(ws + 155 * MiB);
  p.R6 = (u16*)(ws + 187 * MiB);
  p.R7 = (float*)(ws + 219 * MiB);
  p.z = (float*)(ws + 251 * MiB);
  p.Dd = (float*)(ws + 253 * MiB);
  p.bar = (unsigned*)(ws + 254 * MiB);
  hipMemsetAsync(p.bar, 0, XCD_BAR_WORDS * sizeof(unsigned), stream);
#if MULTI_LAUNCH
  for (int ph = 0; ph < NPHASE; ph++) {
    hipLaunchKernelGGL(fwd_mega, dim3(grid_blocks), dim3(256), LDS_BYTES, stream, p, ph, ph + 1);
  }
#else
  int lo = 0, hi = NPHASE;
  void* args[] = {&p, &lo, &hi};
  hipError_t e = hipLaunchCooperativeKernel((const void*)fwd_mega, dim3(grid_blocks), dim3(256), args, LDS_BYTES, stream);
  if (e != hipSuccess) fprintf(stderr, "cooperative launch failed: %s (grid %d)\n", hipGetErrorString(e), grid_blocks);
#endif
}
```

```cpp
#include <hip/hip_runtime.h>
#include <hip/hip_cooperative_groups.h>
#include <cstdio>
namespace cg = cooperative_groups;

typedef unsigned short u16;
typedef unsigned int u32;
using bf16x8 = __attribute__((ext_vector_type(8))) short;
using f32x4 = __attribute__((ext_vector_type(4))) float;

#ifndef ONLY_PHASE
#define ONLY_PHASE -1
#endif
#define PH_ON(k) (ONLY_PHASE < 0 || ONLY_PHASE == (k))
#ifndef MULTI_LAUNCH
#define MULTI_LAUNCH 0
#endif

constexpr int BT = 16384, SEQ = 8192;
constexpr int LDS_BYTES = 80896;
constexpr int NPHASE = 15;

struct Params {
  const float *x, *norm1_g, *w_in, *conv_w, *conv_b, *wa, *dupf, *dbf, *dupb, *dbb, *gng, *wb, *gbias, *wo,
      *norm2_g, *wq, *keys, *pu, *pv, *fng;
  float* out;
  u16 *WinT, *WaT, *WbT, *WoT, *WqT, *KeysB;
  u16 *R1, *R2, *R3, *R4, *R5, *R6;
  float *R7, *z, *Dd;
  unsigned* bar;
};

__device__ __forceinline__ u16 f2b(float f) { u32 u = __float_as_uint(f); u += 0x7fffu + ((u >> 16) & 1u); return (u16)(u >> 16); }
__device__ __forceinline__ float b2f(u16 h) { return __uint_as_float(((u32)h) << 16); }
__device__ __forceinline__ u32 pack2(float a, float b) { return (u32)f2b(a) | ((u32)f2b(b) << 16); }
__device__ __forceinline__ float blo(u32 w) { return __uint_as_float(w << 16); }
__device__ __forceinline__ float bhi(u32 w) { return __uint_as_float(w & 0xffff0000u); }
__device__ __forceinline__ float wave_sum(float v) {
#pragma unroll
  for (int o = 32; o > 0; o >>= 1) v += __shfl_xor(v, o);
  return v;
}
__device__ __forceinline__ float sigmoidf_(float v) { return 1.f / (1.f + __expf(-v)); }
__device__ __forceinline__ u32 ordf(float v) { u32 u = __float_as_uint(v); return (u & 0x80000000u) ? ~u : (u | 0x80000000u); }
__device__ __forceinline__ float unordf(u32 k) { return __uint_as_float((k & 0x80000000u) ? (k ^ 0x80000000u) : ~k); }

template <int MT, int NT, int KT>
__device__ __forceinline__ void mma_nt(f32x4 (&acc)[MT][NT], const u16* A, int sa, const u16* B, int sb, int lane) {
  const int fr = lane & 15, fq = lane >> 4;
  const u16* pa = A + fr * sa + fq * 8;
  const u16* pb = B + fr * sb + fq * 8;
#pragma unroll
  for (int k = 0; k < KT; k++) {
    bf16x8 a[MT], b[NT];
#pragma unroll
    for (int m = 0; m < MT; m++) a[m] = *(const bf16x8*)(pa + m * 16 * sa + k * 32);
#pragma unroll
    for (int n = 0; n < NT; n++) b[n] = *(const bf16x8*)(pb + n * 16 * sb + k * 32);
#pragma unroll
    for (int m = 0; m < MT; m++)
#pragma unroll
      for (int n = 0; n < NT; n++) acc[m][n] = __builtin_amdgcn_mfma_f32_16x16x32_bf16(a[m], b[n], acc[m][n], 0, 0, 0);
  }
}

template <int MT, int NT>
__device__ __forceinline__ void mma_sw64(f32x4 (&acc)[MT][NT], const u16* A, const u16* B, int lane) {
  const int fr = lane & 15, fq = lane >> 4;
  const int cb = fq ^ ((fr >> 1) & 7);
  const u16* pa = A + fr * 64;
  const u16* pb = B + fr * 64;
#pragma unroll
  for (int k = 0; k < 2; k++) {
    const int co = (cb ^ (k * 4)) * 8;
    bf16x8 a[MT], b[NT];
#pragma unroll
    for (int m = 0; m < MT; m++) a[m] = *(const bf16x8*)(pa + m * 16 * 64 + co);
#pragma unroll
    for (int n = 0; n < NT; n++) b[n] = *(const bf16x8*)(pb + n * 16 * 64 + co);
#pragma unroll
    for (int m = 0; m < MT; m++)
#pragma unroll
      for (int n = 0; n < NT; n++) acc[m][n] = __builtin_amdgcn_mfma_f32_16x16x32_bf16(b[n], a[m], acc[m][n], 0, 0, 0);
  }
}

#define ST_DECL(S) uint4 S##a0, S##a1, S##a2, S##a3, S##b0, S##b1, S##b2, S##b3
#define ST_LOAD(S, PA, PB)                                                                                           \
  do {                                                                                                               \
    const char* pa_ = (const char*)(PA);                                                                             \
    const char* pb_ = (const char*)(PB);                                                                             \
    S##a0 = *(const uint4*)(pa_ + voffA); S##a1 = *(const uint4*)(pa_ + (size_t)64 * lda + voffA);                   \
    S##a2 = *(const uint4*)(pa_ + (size_t)128 * lda + voffA); S##a3 = *(const uint4*)(pa_ + (size_t)192 * lda + voffA); \
    S##b0 = *(const uint4*)(pb_ + voffB); S##b1 = *(const uint4*)(pb_ + (size_t)64 * ldb + voffB);                   \
    S##b2 = *(const uint4*)(pb_ + (size_t)128 * ldb + voffB); S##b3 = *(const uint4*)(pb_ + (size_t)192 * ldb + voffB); \
  } while (0)
#define ST_WRITE(S, WA, WB)                                                                                          \
  do {                                                                                                               \
    *(uint4*)(WA) = S##a0; *(uint4*)((WA) + 32 * 64) = S##a1; *(uint4*)((WA) + 64 * 64) = S##a2; *(uint4*)((WA) + 96 * 64) = S##a3; \
    *(uint4*)(WB) = S##b0; *(uint4*)((WB) + 32 * 64) = S##b1; *(uint4*)((WB) + 64 * 64) = S##b2; *(uint4*)((WB) + 96 * 64) = S##b3; \
  } while (0)

#define GLDS16(G, L) __builtin_amdgcn_global_load_lds((const void*)(G), (__attribute__((address_space(3))) void*)(L), 16, 0, 0)
__device__ __forceinline__ void gemm_acc_db(f32x4 (&acc)[4][4], const u16* __restrict__ A, int lda, const u16* __restrict__ B,
                                            int ldb, int K, char* smem) {
  const int t = threadIdx.x, lane = t & 63, w = t >> 6, wr = w >> 1, wc = w & 1;
  const int lr = t >> 3;
  const int gc = ((t & 7) ^ ((lr >> 1) & 7)) * 8;
  const u16* pa = A + (size_t)lr * lda + gc;
  const u16* pb = B + (size_t)lr * ldb + gc;
  char* l0 = smem + t * 16;
  u16* b0 = (u16*)smem;
  u16* b1 = b0 + 2 * 128 * 64;
#define ISSUE_TILE(KT, BUFOFF)                                                                     \
  do {                                                                                             \
    const u16* qa = pa + (KT) * 64;                                                                \
    const u16* qb = pb + (KT) * 64;                                                                \
    char* lb = l0 + (BUFOFF);                                                                      \
    GLDS16(qa, lb); GLDS16(qa + (size_t)32 * lda, lb + 4096);                                      \
    GLDS16(qa + (size_t)64 * lda, lb + 8192); GLDS16(qa + (size_t)96 * lda, lb + 12288);           \
    GLDS16(qb, lb + 16384); GLDS16(qb + (size_t)32 * ldb, lb + 16384 + 4096);                      \
    GLDS16(qb + (size_t)64 * ldb, lb + 16384 + 8192); GLDS16(qb + (size_t)96 * ldb, lb + 16384 + 12288); \
  } while (0)
  const int nk = K >> 6;
  __syncthreads();
  ISSUE_TILE(0, 0);
  if (blockIdx.x >= (gridDim.x >> 1)) __builtin_amdgcn_s_sleep(8);
#define KSTEP(BUF, ISSUE_STMT)                                                 \
  do {                                                                         \
    asm volatile("s_waitcnt vmcnt(0) lgkmcnt(0)" ::: "memory");    \
    __builtin_amdgcn_s_barrier();                                              \
    asm volatile("" ::: "memory");                                             \
    ISSUE_STMT;                                                                \
    mma_sw64<4, 4>(acc, BUF + wr * 64 * 64, BUF + 128 * 64 + wc * 64 * 64, lane); \
  } while (0)
  for (int kt = 0; kt + 2 < nk; kt += 2) {
    KSTEP(b0, ISSUE_TILE(kt + 1, 32768));
    KSTEP(b1, ISSUE_TILE(kt + 2, 0));
  }
  KSTEP(b0, ISSUE_TILE(nk - 1, 32768));
  KSTEP(b1, (void)0);
  asm volatile("s_waitcnt lgkmcnt(0)" ::: "memory");
#undef KSTEP
#undef ISSUE_TILE
}

struct TileIter {
  int i, step, lim, NT, xcd; bool swz;
  __device__ __forceinline__ TileIter(int nt_) {
    NT = nt_;
    swz = (gridDim.x & 7) == 0;
    if (swz) { xcd = blockIdx.x & 7; i = blockIdx.x >> 3; step = gridDim.x >> 3; lim = 16 * NT; }
    else { xcd = 0; i = blockIdx.x; step = gridDim.x; lim = 128 * NT; }
  }
  __device__ __forceinline__ bool next(int& mt, int& nt) {
    if (i >= lim) return false;
    if (swz) { int mg = i / (NT * 8), rem = i - mg * NT * 8; nt = rem >> 3; mt = xcd * 16 + mg * 8 + (rem & 7); }
    else { mt = i & 127; nt = i >> 7; }
    i += step;
    return true;
  }
};

__device__ __forceinline__ void zero_acc(f32x4 (&acc)[4][4]) {
#pragma unroll
  for (int m = 0; m < 4; m++)
#pragma unroll
    for (int n = 0; n < 4; n++) acc[m][n] = f32x4{0.f, 0.f, 0.f, 0.f};
}

__device__ __forceinline__ int winmap(int r) {
  if (r < 2048) { int tile = r >> 7, w = r & 127, grp = w >> 5; int ch = tile * 64 + (grp >> 1) * 32 + (w & 31); return ((grp & 1) ? 2048 : 0) + ch; }
  if (r < 3072) return r - 1024;
  if (r < 6176) return r;
  if (r < 6272) return -1;
  return r - 96;
}

__device__ __forceinline__ void tr_tile(const float* __restrict__ src, int ld, int col0, u16* __restrict__ dst, int r0, int k0, float* sT) {
  const int t = threadIdx.x;
  const int r = t >> 3, kc = t & 7;
  if (col0 < 0) {
    *(uint4*)(dst + (size_t)(r0 + r) * 1024 + k0 + kc * 8) = make_uint4(0, 0, 0, 0);
    return;
  }
  __syncthreads();
#pragma unroll
  for (int i = 0; i < 8; i++) {
    int k = (t >> 5) + i * 8, rr = t & 31;
    sT[k * 33 + rr] = src[(size_t)(k0 + k) * ld + col0 + rr];
  }
  __syncthreads();
  u32 wv[4];
#pragma unroll
  for (int j = 0; j < 4; j++) wv[j] = pack2(sT[(kc * 8 + 2 * j) * 33 + r], sT[(kc * 8 + 2 * j + 1) * 33 + r]);
  *(uint4*)(dst + (size_t)(r0 + r) * 1024 + k0 + kc * 8) = make_uint4(wv[0], wv[1], wv[2], wv[3]);
}

__device__ __forceinline__ void rms_row(const float* __restrict__ src, const float* __restrict__ g, u16* __restrict__ dst, int lane) {
  float4 v[4];
  float ss = 0.f;
#pragma unroll
  for (int i = 0; i < 4; i++) {
    v[i] = *(const float4*)(src + i * 256 + lane * 4);
    ss += v[i].x * v[i].x + v[i].y * v[i].y + v[i].z * v[i].z + v[i].w * v[i].w;
  }
  ss = wave_sum(ss);
  const float rstd = rsqrtf(ss * (1.f / 1024.f) + 1e-6f);
#pragma unroll
  for (int i = 0; i < 4; i++) {
    float4 gg = *(const float4*)(g + i * 256 + lane * 4);
    uint2 o;
    o.x = pack2(v[i].x * rstd * gg.x, v[i].y * rstd * gg.y);
    o.y = pack2(v[i].z * rstd * gg.z, v[i].w * rstd * gg.w);
    *(uint2*)(dst + i * 256 + lane * 4) = o;
  }
}

__device__ void phase0(const Params& p, char* smem) {
  float* sT = (float*)smem;
  const int t = threadIdx.x, lane = t & 63, w = t >> 6;
  u16* xn = (u16*)p.out;
  constexpr int J0 = 4160, J4 = J0 + 4096;
  for (int job = blockIdx.x; job < J4; job += gridDim.x) {
    if (job < J0) {
      int rb = job >> 4, kb = job & 15;
      tr_tile(p.w_in, 8224, winmap(rb * 32), p.WinT, rb * 32, kb * 64, sT);
    } else {
      int row = (job - J0) * 4 + w;
      rms_row(p.x + (size_t)row * 1024, p.norm1_g, xn + (size_t)row * 1024, lane);
    }
  }
}
__device__ void weights_late(const Params& p, char* smem) {
  float* sT = (float*)smem;
  const int t = threadIdx.x;
  constexpr int J1 = 1536, J2 = J1 + 1024, J3 = J2 + 128;
  for (int job = blockIdx.x; job < J3; job += gridDim.x) {
    if (job < J1) {
      int which = job >> 9, rb = (job & 511) >> 4, kb = job & 15;
      const float* src = which == 0 ? p.wa : (which == 1 ? p.wb : p.wo);
      u16* dst = which == 0 ? p.WaT : (which == 1 ? p.WbT : p.WoT);
      tr_tile(src, 1024, rb * 32, dst, rb * 32, kb * 64, sT);
    } else if (job < J2) {
      int j = job - J1, rb = j >> 4, kb = j & 15;
      tr_tile(p.wq, 2048, rb * 32, p.WqT, rb * 32, kb * 64, sT);
    } else {
      int j = job - J2;
      int base = (j * 256 + t) * 8;
      float4 a = *(const float4*)(p.keys + base), b = *(const float4*)(p.keys + base + 4);
      *(uint4*)(p.KeysB + base) = make_uint4(pack2(a.x, a.y), pack2(a.z, a.w), pack2(b.x, b.y), pack2(b.z, b.w));
    }
  }
}

__device__ void la_prep(const Params& p, char* smem) {
  float* sZ = (float*)smem;
  float* sPart = sZ + 1024;
  const int t = threadIdx.x, lane = t & 63, w = t >> 6, fr = lane & 15, fq = lane >> 4;
  const u16* xn = (const u16*)p.out;
  const u16* Wz = p.WinT + (size_t)6144 * 1024;
  u32* la16 = (u32*)p.R6;
  float uf0[16], uf1[16], ub0[16], ub1[16];
#pragma unroll
  for (int r = 0; r < 16; r++) {
    uf0[r] = p.dupf[r * 512 + 2 * t]; uf1[r] = p.dupf[r * 512 + 2 * t + 1];
    ub0[r] = p.dupb[r * 512 + 2 * t]; ub1[r] = p.dupb[r * 512 + 2 * t + 1];
  }
  const float bf0 = p.dbf[2 * t], bf1 = p.dbf[2 * t + 1], bb0 = p.dbb[2 * t], bb1 = p.dbb[2 * t + 1];
  for (int job = blockIdx.x; job < BT / 32; job += gridDim.x) {
    f32x4 az[2][2];
#pragma unroll
    for (int m = 0; m < 2; m++)
#pragma unroll
      for (int n = 0; n < 2; n++) az[m][n] = f32x4{0.f, 0.f, 0.f, 0.f};
    {
      const u16* ap = xn + (size_t)(job * 32 + fr) * 1024 + w * 256 + fq * 8;
      const u16* bp = Wz + (size_t)fr * 1024 + w * 256 + fq * 8;
#pragma unroll
      for (int ks = 0; ks < 8; ks++) {
        bf16x8 a0 = *(const bf16x8*)(ap + ks * 32), a1 = *(const bf16x8*)(ap + 16 * 1024 + ks * 32);
        bf16x8 b0 = *(const bf16x8*)(bp + ks * 32), b1 = *(const bf16x8*)(bp + 16 * 1024 + ks * 32);
        az[0][0] = __builtin_amdgcn_mfma_f32_16x16x32_bf16(a0, b0, az[0][0], 0, 0, 0);
        az[0][1] = __builtin_amdgcn_mfma_f32_16x16x32_bf16(a0, b1, az[0][1], 0, 0, 0);
        az[1][0] = __builtin_amdgcn_mfma_f32_16x16x32_bf16(a1, b0, az[1][0], 0, 0, 0);
        az[1][1] = __builtin_amdgcn_mfma_f32_16x16x32_bf16(a1, b1, az[1][1], 0, 0, 0);
      }
    }
    __syncthreads();
#pragma unroll
    for (int m = 0; m < 2; m++)
#pragma unroll
      for (int n = 0; n < 2; n++)
#pragma unroll
        for (int j = 0; j < 4; j++) sPart[w * 1024 + (m * 16 + fq * 4 + j) * 32 + n * 16 + fr] = az[m][n][j];
    __syncthreads();
    {
      const float4 q0 = *(const float4*)(sPart + t * 4), q1 = *(const float4*)(sPart + 1024 + t * 4), q2 = *(const float4*)(sPart + 2048 + t * 4),
                   q3 = *(const float4*)(sPart + 3072 + t * 4);
      *(float4*)(sZ + t * 4) = make_float4(q0.x + q1.x + q2.x + q3.x, q0.y + q1.y + q2.y + q3.y, q0.z + q1.z + q2.z + q3.z, q0.w + q1.w + q2.w + q3.w);
    }
    __syncthreads();
    for (int i = 0; i < 32; i++) {
      const float* zr = sZ + i * 32;
      float a0 = bf0, a1 = bf1, c0 = bb0, c1 = bb1;
#pragma unroll
      for (int r = 0; r < 16; r++) {
        const float zf = zr[r], zb = zr[16 + r];
        a0 += zf * uf0[r]; a1 += zf * uf1[r];
        c0 += zb * ub0[r]; c1 += zb * ub1[r];
      }
      const float l0 = (fminf(a0, 0.f) - __logf(1.f + __expf(-fabsf(a0)))) * 0.0625f;
      const float l1 = (fminf(a1, 0.f) - __logf(1.f + __expf(-fabsf(a1)))) * 0.0625f;
      const float m0 = (fminf(c0, 0.f) - __logf(1.f + __expf(-fabsf(c0)))) * 0.0625f;
      const float m1 = (fminf(c1, 0.f) - __logf(1.f + __expf(-fabsf(c1)))) * 0.0625f;
      const int tok = job * 32 + i;
      la16[(size_t)tok * 256 + t] = (u32)__builtin_bit_cast(unsigned short, (_Float16)l0) | ((u32)__builtin_bit_cast(unsigned short, (_Float16)l1) << 16);
      la16[(size_t)(BT + tok) * 256 + t] = (u32)__builtin_bit_cast(unsigned short, (_Float16)m0) | ((u32)__builtin_bit_cast(unsigned short, (_Float16)m1) << 16);
    }
  }
}

__device__ void phase1(const Params& p, char* smem) {
  u16* sA = (u16*)smem;
  u16* sB = sA + 128 * 64;
  const int t = threadIdx.x, lane = t & 63, w = t >> 6, wr = w >> 1, wc = w & 1, fr = lane & 15, fq = lane >> 4;
  const u16* xn = (const u16*)p.out;
  la_prep(p, smem);
  TileIter ti(48);
  int mt, nt;
  while (ti.next(mt, nt)) {
    f32x4 acc[4][4];
    zero_acc(acc);
    gemm_acc_db(acc, xn + (size_t)mt * 128 * 1024, 1024, p.WinT + (size_t)nt * 128 * 1024, 1024, 1024, smem);
    const int rowb = mt * 128 + wr * 64 + fr;
    if (nt < 16) {
#pragma unroll
      for (int m = 0; m < 4; m++)
#pragma unroll
        for (int n = 0; n < 2; n++) {
          const int ch = nt * 64 + wc * 32 + n * 16 + fq * 4;
          *(uint2*)(p.R1 + (size_t)(rowb + m * 16) * 1024 + ch) =
              make_uint2(pack2(acc[m][n][0] * acc[m][n + 2][0], acc[m][n][1] * acc[m][n + 2][1]),
                         pack2(acc[m][n][2] * acc[m][n + 2][2], acc[m][n][3] * acc[m][n + 2][3]));
        }
    } else {
      const int g = (nt - 16) >> 3;
      u16* dst = g == 0 ? p.R2 : (g == 1 ? p.R3 : (g == 2 ? p.R4 : p.R5));
      const int cb = ((nt - 16) & 7) * 128 + wc * 64;
      const float sc = (g == 1 && cb < 512) ? 0.08838834764831845f : 1.f;
#pragma unroll
      for (int m = 0; m < 4; m++)
#pragma unroll
        for (int n = 0; n < 4; n++)
          *(uint2*)(dst + (size_t)(rowb + m * 16) * 1024 + cb + n * 16 + fq * 4) =
              make_uint2(pack2(acc[m][n][0] * sc, acc[m][n][1] * sc), pack2(acc[m][n][2] * sc, acc[m][n][3] * sc));
    }
  }
}

#define XB_TMO      128
#define XB_XCNT(j)  (256  + 64 * (j))
#define XB_XSUB(j)  (1280 + 64 * (j))
#define XB_XGEN(j)  (2304 + 64 * (j))
#define XB_TOP      3328
#define XB_TOPGEN   3392
#define XCD_BAR_WORDS 3456
#define XB_SPIN_CAP (1u << 20)
#define LAS __attribute__((address_space(3)))
__device__ __forceinline__ unsigned xb_ld(unsigned* p) { return __hip_atomic_load(p, __ATOMIC_RELAXED, __HIP_MEMORY_SCOPE_AGENT); }
__device__ __forceinline__ unsigned xb_add(unsigned* p, unsigned v) { return __hip_atomic_fetch_add(p, v, __ATOMIC_RELAXED, __HIP_MEMORY_SCOPE_AGENT); }
__device__ __forceinline__ unsigned xb_xcc_id() { return (unsigned)__builtin_amdgcn_s_getreg((3 << 11) | 20) & 0xFu; }
#define XB_SPIN(cond, bar) do { unsigned _sp = 0; while (cond) { __builtin_amdgcn_s_sleep(1); \
    if ((++_sp & 255u) == 0u) { if (xb_ld(&(bar)[XB_TMO])) break; if (_sp > XB_SPIN_CAP) { atomicAdd(&(bar)[XB_TMO], 1u); break; } } } } while (0)
struct XcdBarrier { unsigned* bar; unsigned x; volatile LAS unsigned* st; };
__device__ __forceinline__ XcdBarrier xcd_barrier_post(unsigned* bar, volatile LAS unsigned* st) {
  XcdBarrier b; b.bar = bar; b.x = xb_xcc_id(); b.st = st;
  if (threadIdx.x == 0) (void)xb_add(&bar[XB_XCNT(b.x)], 1u);
  return b;
}
__device__ __forceinline__ void xcd_barrier_complete(unsigned* bar, unsigned x, unsigned& nloc, unsigned& nx) {
  const unsigned G = gridDim.x * gridDim.y * gridDim.z;
  unsigned sum, cnt, mine, sp = 0u;
  for (;;) {
    sum = 0u; cnt = 0u; mine = 0u;
#pragma unroll
    for (unsigned j = 0; j < 16; ++j) { const unsigned c = xb_ld(&bar[XB_XCNT(j)]); sum += c; cnt += (c > 0u) ? 1u : 0u; mine = (j == x) ? c : mine; }
    if (sum == G) break;
    __builtin_amdgcn_s_sleep(1);
    if ((++sp & 255u) == 0u) { if (xb_ld(&bar[XB_TMO])) break; if (sp > XB_SPIN_CAP) { atomicAdd(&bar[XB_TMO], 1u); break; } }
  }
  nloc = mine > 0u ? mine : 1u; nx = cnt > 0u ? cnt : 1u;
}
__device__ __forceinline__ void xcd_barrier(const XcdBarrier& b) {
  asm volatile("s_waitcnt vmcnt(0)" ::: "memory");
  __syncthreads();
  if (threadIdx.x == 0) {
    unsigned* bar = b.bar;
    __builtin_amdgcn_s_waitcnt(0);
    unsigned nloc = b.st[0], nx = b.st[1];
    if (nloc == 0u) { xcd_barrier_complete(bar, b.x, nloc, nx); b.st[0] = nloc; b.st[1] = nx; }
    const unsigned old = xb_add(&bar[XB_XSUB(b.x)], 1u);
    const unsigned gen = old / nloc;
    if (old + 1u == (gen + 1u) * nloc) {
      __builtin_amdgcn_fence(__ATOMIC_RELEASE, "agent");
      asm volatile("s_waitcnt vmcnt(0)" ::: "memory");
      const unsigned og = xb_add(&bar[XB_TOP], 1u);
      const unsigned tg = og / nx;
      if (og + 1u == (tg + 1u) * nx) xb_add(&bar[XB_TOPGEN], 1u);
      else XB_SPIN(xb_ld(&bar[XB_TOPGEN]) == tg, bar);
      __builtin_amdgcn_fence(__ATOMIC_ACQUIRE, "agent");
      xb_add(&bar[XB_XGEN(b.x)], 1u);
      asm volatile("s_waitcnt vmcnt(0)" ::: "memory");
    } else {
      XB_SPIN(xb_ld(&bar[XB_XGEN(b.x)]) == gen, bar);
      __builtin_amdgcn_fence(__ATOMIC_ACQUIRE, "agent");
      asm volatile("s_waitcnt vmcnt(0)" ::: "memory");
    }
  }
  __syncthreads();
}

__device__ void gla_item(const Params& p, int item, int pass, char* smem) {
  const int dvp = item & 1, seg = (item >> 1) & 15, dir = (item >> 5) & 1, h = (item >> 6) & 3, b = item >> 8;
  const int bhd = (b * 4 + h) * 2 + dir;
  u16* sQ = (u16*)smem;
  u16* sK = sQ + 64 * 136;
  u16* sKT = sK + 64 * 136;
  u16* sVT = sKT + 128 * 72;
  u16* sST = sVT + 64 * 72;
  float* sDec = (float*)(sST + 64 * 136);
  float* sTot = (float*)sVT;
  const int t = threadIdx.x, lane = t & 63, w = __builtin_amdgcn_readfirstlane(t >> 6), wr = w >> 1, wc = w & 1, fr = lane & 15, fq = lane >> 4;
  const int d0 = lane * 2;
  const u32* la16 = (const u32*)p.R6 + (size_t)dir * BT * 256 + h * 64 + lane;
  const u16* qk = p.R3;
  const u16* vv = p.R4;
  u16* obuf = dir ? p.R2 : p.R1;
  float* Lp = p.R7 + (size_t)(bhd * 16 + seg) * 32768 + (size_t)dvp * 128 * 128;

  f32x4 accS[2][2][4];
#pragma unroll
  for (int s = 0; s < 2; s++)
#pragma unroll
    for (int m = 0; m < 2; m++)
#pragma unroll
      for (int n = 0; n < 4; n++)
#pragma unroll
        for (int j = 0; j < 4; j++)
          accS[s][m][n][j] = (pass == 2) ? Lp[(s * 64 + wr * 32 + m * 16 + fq * 4 + j) * 128 + wc * 64 + n * 16 + fr] : 0.f;
  float dsum0 = 0.f, dsum1 = 0.f;

  for (int ci = 0; ci < 8; ci++) {
    const int c = seg * 8 + ci;
    __syncthreads();
    u32 qv[16], kv[16], lav[16], vreg[2][16];
#pragma unroll
    for (int ii = 0; ii < 16; ii++) {
      int f = c * 64 + w * 16 + ii;
      int pos = dir ? (SEQ - 1 - f) : f;
      size_t tokoff = (size_t)(b * SEQ + pos) * 1024;
      kv[ii] = *(const u32*)(qk + tokoff + 512 + h * 128 + d0);
      if (pass == 2) qv[ii] = *(const u32*)(qk + tokoff + h * 128 + d0);
      lav[ii] = la16[(size_t)(b * SEQ + pos) * 256];
      vreg[0][ii] = vv[tokoff + h * 256 + dvp * 128 + lane];
      vreg[1][ii] = vv[tokoff + h * 256 + dvp * 128 + 64 + lane];
    }
    float bl0[16], bl1[16];
    {
      float run0 = 0.f, run1 = 0.f;
#pragma unroll
      for (int ii = 0; ii < 16; ii++) {
        run0 += (float)__builtin_bit_cast(_Float16, (unsigned short)(lav[ii] & 0xffffu));
        run1 += (float)__builtin_bit_cast(_Float16, (unsigned short)(lav[ii] >> 16));
        bl0[ii] = run0; bl1[ii] = run1;
      }
      sTot[w * 128 + d0] = run0;
      sTot[w * 128 + d0 + 1] = run1;
    }
    __syncthreads();
    {
      float off0 = 0.f, off1 = 0.f, tot0 = 0.f, tot1 = 0.f;
#pragma unroll
      for (int ww = 0; ww < 4; ww++) {
        float a = sTot[ww * 128 + d0], bb = sTot[ww * 128 + d0 + 1];
        if (ww < w) { off0 += a; off1 += bb; }
        tot0 += a; tot1 += bb;
      }
      dsum0 += tot0; dsum1 += tot1;
      const float et0 = __expf(tot0), et1 = __expf(tot1);
      if (w == 0) { sDec[d0] = et0; sDec[d0 + 1] = et1; }
#pragma unroll
      for (int ii = 0; ii < 16; ii += 2) {
        float ke0[2], ke1[2];
#pragma unroll
        for (int s = 0; s < 2; s++) {
          const int i2 = ii + s;
          const float b0 = bl0[i2] + off0, b1 = bl1[i2] + off1;
          const float k0 = blo(kv[i2]), k1 = bhi(kv[i2]);
          const int i = w * 16 + i2;
          const float e0 = __expf(b0), e1 = __expf(b1);
          const float kt0 = k0 * __builtin_amdgcn_rcpf(e0), kt1 = k1 * __builtin_amdgcn_rcpf(e1);
          if (pass == 2) {
            *(u32*)(sQ + i * 136 + d0) = pack2(blo(qv[i2]) * e0, bhi(qv[i2]) * e1);
            *(u32*)(sK + i * 136 + d0) = pack2(kt0, kt1);
          }
          ke0[s] = kt0 * et0;
          ke1[s] = kt1 * et1;
        }
        *(u32*)(sKT + d0 * 72 + w * 16 + ii) = pack2(ke0[0], ke0[1]);
        *(u32*)(sKT + (d0 + 1) * 72 + w * 16 + ii) = pack2(ke1[0], ke1[1]);
      }
    }
    __syncthreads();
    u16* sP = sK;
    if (pass == 2) {
      f32x4 accP[2][2];
#pragma unroll
      for (int m = 0; m < 2; m++)
#pragma unroll
        for (int n = 0; n < 2; n++) accP[m][n] = f32x4{0.f, 0.f, 0.f, 0.f};
      mma_nt<2, 2, 4>(accP, sQ + wr * 32 * 136, 136, sK + wc * 32 * 136, 136, lane);
      __syncthreads();
#pragma unroll
      for (int m = 0; m < 2; m++)
#pragma unroll
        for (int n = 0; n < 2; n++)
#pragma unroll
          for (int j = 0; j < 4; j++) {
            int i = wr * 32 + m * 16 + fq * 4 + j, jj = wc * 32 + n * 16 + fr;
            sP[i * 72 + jj] = (i >= jj) ? f2b(accP[m][n][j]) : (u16)0;
          }
    }
#pragma unroll
    for (int s = 0; s < 2; s++) {
      if (pass == 2) {
#pragma unroll
        for (int m = 0; m < 2; m++)
#pragma unroll
          for (int n = 0; n < 4; n++)
#pragma unroll
            for (int j = 0; j < 4; j++) sST[(wr * 32 + m * 16 + fq * 4 + j) * 136 + wc * 64 + n * 16 + fr] = f2b(accS[s][m][n][j]);
      }
      {
        uint4 v0 = make_uint4(vreg[s][0] | (vreg[s][1] << 16), vreg[s][2] | (vreg[s][3] << 16), vreg[s][4] | (vreg[s][5] << 16),
                              vreg[s][6] | (vreg[s][7] << 16));
        uint4 v1 = make_uint4(vreg[s][8] | (vreg[s][9] << 16), vreg[s][10] | (vreg[s][11] << 16), vreg[s][12] | (vreg[s][13] << 16),
                              vreg[s][14] | (vreg[s][15] << 16));
        *(uint4*)(sVT + lane * 72 + w * 16) = v0;
        *(uint4*)(sVT + lane * 72 + w * 16 + 8) = v1;
      }
      __syncthreads();
      if (pass == 2) {
        f32x4 accO[2][2];
#pragma unroll
        for (int m = 0; m < 2; m++)
#pragma unroll
          for (int n = 0; n < 2; n++) accO[m][n] = f32x4{0.f, 0.f, 0.f, 0.f};
        mma_nt<2, 2, 4>(accO, sQ + wr * 32 * 136, 136, sST + wc * 32 * 136, 136, lane);
        mma_nt<2, 2, 2>(accO, sP + wr * 32 * 72, 72, sVT + wc * 32 * 72, 72, lane);
#pragma unroll
        for (int m = 0; m < 2; m++)
#pragma unroll
          for (int j = 0; j < 4; j++) {
            int i = wr * 32 + m * 16 + fq * 4 + j;
            int f = c * 64 + i;
            int pos = dir ? (SEQ - 1 - f) : f;
            size_t o = (size_t)(b * SEQ + pos) * 1024 + h * 256 + dvp * 128 + s * 64 + wc * 32 + fr;
#pragma unroll
            for (int n = 0; n < 2; n++) obuf[o + n * 16] = f2b(accO[m][n][j]);
          }
      }
#pragma unroll
      for (int n = 0; n < 4; n++) {
        float dc = sDec[wc * 64 + n * 16 + fr];
#pragma unroll
        for (int m = 0; m < 2; m++)
#pragma unroll
          for (int j = 0; j < 4; j++) accS[s][m][n][j] *= dc;
      }
      mma_nt<2, 4, 2>(accS[s], sVT + wr * 32 * 72, 72, sKT + wc * 64 * 72, 72, lane);
      if (s == 0) __syncthreads();
    }
  }
  if (pass == 1) {
#pragma unroll
    for (int s = 0; s < 2; s++)
#pragma unroll
      for (int m = 0; m < 2; m++)
#pragma unroll
        for (int n = 0; n < 4; n++)
#pragma unroll
          for (int j = 0; j < 4; j++) Lp[(s * 64 + wr * 32 + m * 16 + fq * 4 + j) * 128 + wc * 64 + n * 16 + fr] = accS[s][m][n][j];
    if (dvp == 0 && w == 0) {
      p.Dd[(bhd * 16 + seg) * 128 + d0] = __expf(dsum0);
      p.Dd[(bhd * 16 + seg) * 128 + d0 + 1] = __expf(dsum1);
    }
  }
}

__device__ void phase2(const Params& p, char* smem, const XcdBarrier& xb) {
  const int t = threadIdx.x;
  (void)xb;
  u16* ya = (u16*)p.out + (size_t)BT * 1024;
  for (int job = blockIdx.x; job < 512 + 2048; job += gridDim.x) {
    if (job < 512) {
      gla_item(p, job, 1, smem);
    } else {
      const int j = job - 512;
      const int ch = (t & 127) * 8;
      float w0[8], w1[8], w2[8], cb[8];
#pragma unroll
      for (int e = 0; e < 8; e++) { w0[e] = p.conv_w[ch + e]; w1[e] = p.conv_w[1024 + ch + e]; w2[e] = p.conv_w[2048 + ch + e]; cb[e] = p.conv_b[ch + e]; }
#pragma unroll
      for (int it = 0; it < 4; it++) {
        const int tok = j * 8 + it * 2 + (t >> 7);
        const int pos = tok & (SEQ - 1);
        const size_t o = (size_t)tok * 1024 + ch;
        uint4 pc = *(const uint4*)(p.R1 + o);
        uint4 pp = make_uint4(0, 0, 0, 0), pn = make_uint4(0, 0, 0, 0);
        if (pos > 0) pp = *(const uint4*)(p.R1 + o - 1024);
        if (pos < SEQ - 1) pn = *(const uint4*)(p.R1 + o + 1024);
        uint4 bb = *(const uint4*)(p.R2 + o);
        const u32 pcs[4] = {pc.x, pc.y, pc.z, pc.w}, pps[4] = {pp.x, pp.y, pp.z, pp.w}, pns[4] = {pn.x, pn.y, pn.z, pn.w},
                  bbs[4] = {bb.x, bb.y, bb.z, bb.w};
        u32 ov[4];
#pragma unroll
        for (int q = 0; q < 4; q++) {
          float y0 = cb[2 * q] + w0[2 * q] * blo(pps[q]) + w1[2 * q] * blo(pcs[q]) + w2[2 * q] * blo(pns[q]);
          float y1 = cb[2 * q + 1] + w0[2 * q + 1] * bhi(pps[q]) + w1[2 * q + 1] * bhi(pcs[q]) + w2[2 * q + 1] * bhi(pns[q]);
          ov[q] = pack2(blo(bbs[q]) * y0, bhi(bbs[q]) * y1);
        }
        *(uint4*)(ya + o) = make_uint4(ov[0], ov[1], ov[2], ov[3]);
      }
    }
  }
}

__device__ void phase3(const Params& p) {
  for (int gid = blockIdx.x * 256 + threadIdx.x; gid < 16 * 8192; gid += gridDim.x * 256) {
    const int bhd = gid >> 13, e = (gid & 8191) * 4, dk = e & 127;
    float4 carry = make_float4(0.f, 0.f, 0.f, 0.f);
    for (int s = 0; s < 16; s++) {
      float4* lp = (float4*)(p.R7 + (size_t)(bhd * 16 + s) * 32768 + e);
      const float4 tmp = *lp;
      const float4 d = *(const float4*)(p.Dd + (bhd * 16 + s) * 128 + dk);
      *lp = carry;
      carry = make_float4(d.x * carry.x + tmp.x, d.y * carry.y + tmp.y, d.z * carry.z + tmp.z, d.w * carry.w + tmp.w);
    }
  }
}

__device__ void phase5(const Params& p) {
  const int t = threadIdx.x, lane = t & 63, w = t >> 6;
  float gv[16];
#pragma unroll
  for (int i = 0; i < 4; i++) {
    const float4 g = *(const float4*)(p.gng + lane * 16 + i * 4);
    gv[i * 4 + 0] = g.x; gv[i * 4 + 1] = g.y; gv[i * 4 + 2] = g.z; gv[i * 4 + 3] = g.w;
  }
  for (int tok = blockIdx.x * 4 + w; tok < BT; tok += gridDim.x * 4) {
    const size_t o = (size_t)tok * 1024 + lane * 16;
    const uint4 a0 = *(const uint4*)(p.R1 + o), a1 = *(const uint4*)(p.R1 + o + 8);
    const uint4 b0 = *(const uint4*)(p.R2 + o), b1 = *(const uint4*)(p.R2 + o + 8);
    const uint4 r0 = *(const uint4*)(p.R5 + o), r1 = *(const uint4*)(p.R5 + o + 8);
    const u32 aw[8] = {a0.x, a0.y, a0.z, a0.w, a1.x, a1.y, a1.z, a1.w};
    const u32 bw[8] = {b0.x, b0.y, b0.z, b0.w, b1.x, b1.y, b1.z, b1.w};
    const u32 rw[8] = {r0.x, r0.y, r0.z, r0.w, r1.x, r1.y, r1.z, r1.w};
    float ov[16];
    float ss = 0.f;
#pragma unroll
    for (int i = 0; i < 8; i++) {
      ov[2 * i] = blo(aw[i]) + blo(bw[i]);
      ov[2 * i + 1] = bhi(aw[i]) + bhi(bw[i]);
      ss += ov[2 * i] * ov[2 * i] + ov[2 * i + 1] * ov[2 * i + 1];
    }
    ss += __shfl_xor(ss, 1); ss += __shfl_xor(ss, 2); ss += __shfl_xor(ss, 4); ss += __shfl_xor(ss, 8);
    const float rstd = rsqrtf(ss * (1.f / 256.f) + 1e-6f);
    u32 ow[8];
#pragma unroll
    for (int i = 0; i < 8; i++) {
      const float ra = blo(rw[i]), rb = bhi(rw[i]);
      ow[i] = pack2(ov[2 * i] * rstd * gv[2 * i] * (ra * sigmoidf_(ra)), ov[2 * i + 1] * rstd * gv[2 * i + 1] * (rb * sigmoidf_(rb)));
    }
    *(uint4*)(p.R6 + o) = make_uint4(ow[0], ow[1], ow[2], ow[3]);
    *(uint4*)(p.R6 + o + 8) = make_uint4(ow[4], ow[5], ow[6], ow[7]);
  }
}

__device__ void phase6(const Params& p, char* smem) {
  const int t = threadIdx.x, lane = t & 63, w = t >> 6, wr = w >> 1, wc = w & 1, fr = lane & 15, fq = lane >> 4;
  const u16* xn = (const u16*)p.out;
  const u16* ya = xn + (size_t)BT * 1024;
  uint4* sG = (uint4*)((char*)p.R2 + (size_t)blockIdx.x * 65536 + t * 256);
  uint4* sH = sG + 8;
  TileIter ti(8);
  int mt, nt;
  while (ti.next(mt, nt)) {
    const int colb = nt * 128 + wc * 64 + fq * 4;
    f32x4 acc[4][4];
    zero_acc(acc);
    gemm_acc_db(acc, xn + (size_t)mt * 128 * 1024, 1024, p.WinT + (size_t)(6272 + nt * 128) * 1024, 1024, 1024, smem);
    {
      float4 gb[4];
#pragma unroll
      for (int n = 0; n < 4; n++) gb[n] = *(const float4*)(p.gbias + colb + n * 16);
#pragma unroll
      for (int m = 0; m < 4; m++)
#pragma unroll
        for (int h = 0; h < 2; h++)
          sG[m * 2 + h] = make_uint4(pack2(sigmoidf_(acc[m][2 * h][0] + gb[2 * h].x), sigmoidf_(acc[m][2 * h][1] + gb[2 * h].y)),
                                     pack2(sigmoidf_(acc[m][2 * h][2] + gb[2 * h].z), sigmoidf_(acc[m][2 * h][3] + gb[2 * h].w)),
                                     pack2(sigmoidf_(acc[m][2 * h + 1][0] + gb[2 * h + 1].x), sigmoidf_(acc[m][2 * h + 1][1] + gb[2 * h + 1].y)),
                                     pack2(sigmoidf_(acc[m][2 * h + 1][2] + gb[2 * h + 1].z), sigmoidf_(acc[m][2 * h + 1][3] + gb[2 * h + 1].w)));
    }
    zero_acc(acc);
    gemm_acc_db(acc, ya + (size_t)mt * 128 * 1024, 1024, p.WaT + (size_t)nt * 128 * 1024, 1024, 1024, smem);
#pragma unroll
    for (int m = 0; m < 4; m++)
#pragma unroll
      for (int h = 0; h < 2; h++) {
        const uint4 g = sG[m * 2 + h];
        sG[m * 2 + h] = make_uint4(pack2(acc[m][2 * h][0] * blo(g.x), acc[m][2 * h][1] * bhi(g.x)),
                                   pack2(acc[m][2 * h][2] * blo(g.y), acc[m][2 * h][3] * bhi(g.y)),
                                   pack2(acc[m][2 * h + 1][0] * blo(g.z), acc[m][2 * h + 1][1] * bhi(g.z)),
                                   pack2(acc[m][2 * h + 1][2] * blo(g.w), acc[m][2 * h + 1][3] * bhi(g.w)));
      }
    zero_acc(acc);
    gemm_acc_db(acc, p.R6 + (size_t)mt * 128 * 1024, 1024, p.WbT + (size_t)nt * 128 * 1024, 1024, 1024, smem);
#pragma unroll
    for (int m = 0; m < 4; m++)
#pragma unroll
      for (int h = 0; h < 2; h++)
        sH[m * 2 + h] = make_uint4(pack2(acc[m][2 * h][0], acc[m][2 * h][1]), pack2(acc[m][2 * h][2], acc[m][2 * h][3]),
                                   pack2(acc[m][2 * h + 1][0], acc[m][2 * h + 1][1]), pack2(acc[m][2 * h + 1][2], acc[m][2 * h + 1][3]));
    zero_acc(acc);
    gemm_acc_db(acc, xn + (size_t)mt * 128 * 1024, 1024, p.WinT + (size_t)(6272 + 1024 + nt * 128) * 1024, 1024, 1024, smem);
    const int rowb = mt * 128 + wr * 64 + fr;
    {
      float4 gb[4];
#pragma unroll
      for (int n = 0; n < 4; n++) gb[n] = *(const float4*)(p.gbias + 1024 + colb + n * 16);
#pragma unroll
      for (int m = 0; m < 4; m++)
#pragma unroll
        for (int h = 0; h < 2; h++) {
          const uint4 a = sG[m * 2 + h], b = sH[m * 2 + h];
          const u32 av[4] = {a.x, a.y, a.z, a.w}, bv[4] = {b.x, b.y, b.z, b.w};
#pragma unroll
          for (int nn = 0; nn < 2; nn++) {
            const int n = 2 * h + nn;
            float r0 = blo(av[nn * 2]) + blo(bv[nn * 2]) * sigmoidf_(acc[m][n][0] + gb[n].x);
            float r1 = bhi(av[nn * 2]) + bhi(bv[nn * 2]) * sigmoidf_(acc[m][n][1] + gb[n].y);
            float r2 = blo(av[nn * 2 + 1]) + blo(bv[nn * 2 + 1]) * sigmoidf_(acc[m][n][2] + gb[n].z);
            float r3 = bhi(av[nn * 2 + 1]) + bhi(bv[nn * 2 + 1]) * sigmoidf_(acc[m][n][3] + gb[n].w);
            *(uint2*)(p.R1 + (size_t)(rowb + m * 16) * 1024 + colb + n * 16) = make_uint2(pack2(r0, r1), pack2(r2, r3));
          }
        }
    }
  }
}

__device__ void phase7(const Params& p, char* smem) {
  u16* sA = (u16*)smem;
  u16* sB = sA + 128 * 64;
  const int t = threadIdx.x, lane = t & 63, w = t >> 6, wr = w >> 1, wc = w & 1, fr = lane & 15, fq = lane >> 4;
  float* x1 = (float*)p.R2;
  TileIter ti(8);
  int mt, nt;
  while (ti.next(mt, nt)) {
    f32x4 acc[4][4];
    zero_acc(acc);
    gemm_acc_db(acc, p.R1 + (size_t)mt * 128 * 1024, 1024, p.WoT + (size_t)nt * 128 * 1024, 1024, 1024, smem);
    const int rowb = mt * 128 + wr * 64 + fr;
    const int colb = nt * 128 + wc * 64 + fq * 4;
#pragma unroll
    for (int m = 0; m < 4; m++)
#pragma unroll
      for (int n = 0; n < 4; n++) {
        const size_t o = (size_t)(rowb + m * 16) * 1024 + colb + n * 16;
        const float4 xv = *(const float4*)(p.x + o);
        *(float4*)(x1 + o) = make_float4(xv.x + acc[m][n][0], xv.y + acc[m][n][1], xv.z + acc[m][n][2], xv.w + acc[m][n][3]);
      }
  }
}

constexpr float U_SCALE = 256.f, V_SCALE = 64.f;
__device__ __forceinline__ u32 enc_fp8x4(float a, float b, float c, float d) {
  int w = __builtin_amdgcn_cvt_pk_fp8_f32(a, b, 0, false);
  w = __builtin_amdgcn_cvt_pk_fp8_f32(c, d, w, true);
  return (u32)w;
}
__device__ __forceinline__ void table_convert_job(const Params& p, int j, int t) {
  unsigned char* Tb = (unsigned char*)p.R5;
  const float* src = (j < 4096) ? p.pu : p.pv;
  const float sc = (j < 4096) ? U_SCALE : V_SCALE;
  size_t base = (size_t)(j & 4095) * 4096 + t * 16;
  unsigned char* slot = Tb + (base >> 10) * 2048 + ((j < 4096) ? 0 : 1024) + (base & 1023);
  float4 a = *(const float4*)(src + base), b = *(const float4*)(src + base + 4), c = *(const float4*)(src + base + 8),
         d = *(const float4*)(src + base + 12);
  *(uint4*)slot = make_uint4(enc_fp8x4(a.x * sc, a.y * sc, a.z * sc, a.w * sc), enc_fp8x4(b.x * sc, b.y * sc, b.z * sc, b.w * sc),
                                     enc_fp8x4(c.x * sc, c.y * sc, c.z * sc, c.w * sc), enc_fp8x4(d.x * sc, d.y * sc, d.z * sc, d.w * sc));
}
__device__ void phase8(const Params& p) {
  const int t = threadIdx.x, lane = t & 63, w = t >> 6;
  const float* x1 = (const float*)p.R2;
  for (int job = blockIdx.x; job < 4096; job += gridDim.x) {
    int row = job * 4 + w;
    rms_row(x1 + (size_t)row * 1024, p.norm2_g, p.R4 + (size_t)row * 1024, lane);
  }
}

__device__ void phase9(const Params& p, char* smem) {
  u16* sA = (u16*)smem;
  u16* sB = sA + 128 * 64;
  const int t = threadIdx.x, lane = t & 63, w = t >> 6, wr = w >> 1, wc = w & 1, fr = lane & 15, fq = lane >> 4;
  u16* q = (u16*)p.out;
  TileIter ti(16);
  int mt, nt;
  while (ti.next(mt, nt)) {
    f32x4 acc[4][4];
    zero_acc(acc);
    gemm_acc_db(acc, p.R4 + (size_t)mt * 128 * 1024, 1024, p.WqT + (size_t)nt * 128 * 1024, 1024, 1024, smem);
    const int rowb = mt * 128 + wr * 64 + fr;
    const int colb = nt * 128 + wc * 64 + fq * 4;
#pragma unroll
    for (int m = 0; m < 4; m++)
#pragma unroll
      for (int n = 0; n < 4; n++)
        *(uint2*)(q + (size_t)(rowb + m * 16) * 2048 + colb + n * 16) = make_uint2(pack2(acc[m][n][0], acc[m][n][1]), pack2(acc[m][n][2], acc[m][n][3]));
#pragma unroll 1
    for (int r = 0; r < 4; r++) table_convert_job(p, (mt * 16 + nt) * 4 + r, t);
  }
}

__device__ __forceinline__ void select16q(u32* rowbase, int part, u32 (&tk)[16], unsigned char* idxp) {
  u32* myp = rowbase + part * 32;
#pragma unroll
  for (int it = 0; it < 16; it++) {
    u32 m = 0;
#pragma unroll
    for (int c = 0; c < 8; c++) {
      uint4 kk = *(const uint4*)(myp + c * 4);
      m = max(m, max(max(kk.x, kk.y), max(kk.z, kk.w)));
    }
    m = max(m, (u32)__shfl_xor((int)m, 1));
    m = max(m, (u32)__shfl_xor((int)m, 2));
    tk[it] = m;
    const int idx = 127 - (int)(m & 127u);
    if ((idx >> 5) == part) { rowbase[idx] = 0; idxp[it] = (unsigned char)idx; }
  }
}

__device__ void phase10(const Params& p, char* smem) {
  u16* sKeys = (u16*)smem;
  u32* sSc = (u32*)(smem + 128 * 136 * 2);
  unsigned char* sIdx = (unsigned char*)(smem + 128 * 136 * 2 + 64 * 132 * 4);
  const int t = threadIdx.x, lane = t & 63, w = t >> 6, fr = lane & 15, fq = lane >> 4;
  const int rl = lane >> 2, part = lane & 3, row = w * 16 + rl;
  const u16* q = (const u16*)p.out;
  int* experts = (int*)p.R7;
  float* gates = p.R7 + (size_t)BT * 128;
#define P10_DECL(S) uint4 S##k0, S##k1, S##k2, S##k3, S##k4, S##k5, S##k6, S##k7; bf16x8 S##q0, S##q1, S##q2, S##q3
#define P10_LOAD(S, ITEM, PP)                                                                               \
  do {                                                                                                      \
    const int it_ = ((ITEM) < 256 * 8) ? (ITEM) : (int)blockIdx.x;                                          \
    const int tt_ = it_ >> 3, h_ = it_ & 7;                                                                 \
    const u16* ks_ = p.KeysB + (size_t)(h_ * 2 + (PP)) * 128 * 128 + (t >> 4) * 128 + (t & 15) * 8;         \
    S##k0 = *(const uint4*)(ks_); S##k1 = *(const uint4*)(ks_ + 16 * 128); S##k2 = *(const uint4*)(ks_ + 32 * 128);   \
    S##k3 = *(const uint4*)(ks_ + 48 * 128); S##k4 = *(const uint4*)(ks_ + 64 * 128); S##k5 = *(const uint4*)(ks_ + 80 * 128); \
    S##k6 = *(const uint4*)(ks_ + 96 * 128); S##k7 = *(const uint4*)(ks_ + 112 * 128);                      \
    const u16* qp_ = q + (size_t)(tt_ * 64 + w * 16 + fr) * 2048 + h_ * 256 + (PP) * 128 + fq * 8;          \
    S##q0 = *(const bf16x8*)(qp_); S##q1 = *(const bf16x8*)(qp_ + 32); S##q2 = *(const bf16x8*)(qp_ + 64);  \
    S##q3 = *(const bf16x8*)(qp_ + 96);                                                                     \
  } while (0)
#define P10_MFMA_K(QK, KI)                                                                                  \
  _Pragma("unroll") for (int n_ = 0; n_ < 8; n_++) {                                                        \
    bf16x8 bv_ = *(const bf16x8*)(sKeys + (n_ * 16 + fr) * 136 + (KI) * 32 + fq * 8);                       \
    acc_[n_] = __builtin_amdgcn_mfma_f32_16x16x32_bf16(QK, bv_, acc_[n_], 0, 0, 0);                         \
  }
#define P10_SCORE(S)                                                                                        \
  do {                                                                                                      \
    __syncthreads();                                                                                        \
    u16* kd_ = sKeys + (t >> 4) * 136 + (t & 15) * 8;                                                       \
    *(uint4*)(kd_) = S##k0; *(uint4*)(kd_ + 16 * 136) = S##k1; *(uint4*)(kd_ + 32 * 136) = S##k2;           \
    *(uint4*)(kd_ + 48 * 136) = S##k3; *(uint4*)(kd_ + 64 * 136) = S##k4; *(uint4*)(kd_ + 80 * 136) = S##k5; \
    *(uint4*)(kd_ + 96 * 136) = S##k6; *(uint4*)(kd_ + 112 * 136) = S##k7;                                  \
    __syncthreads();                                                                                        \
    f32x4 acc_[8];                                                                                          \
    _Pragma("unroll") for (int n_ = 0; n_ < 8; n_++) acc_[n_] = f32x4{0.f, 0.f, 0.f, 0.f};                  \
    P10_MFMA_K(S##q0, 0) P10_MFMA_K(S##q1, 1) P10_MFMA_K(S##q2, 2) P10_MFMA_K(S##q3, 3)                     \
    _Pragma("unroll") for (int n_ = 0; n_ < 8; n_++)                                                        \
      _Pragma("unroll") for (int j_ = 0; j_ < 4; j_++) {                                                    \
        int r_ = w * 16 + fq * 4 + j_, col_ = n_ * 16 + fr;                                                 \
        sSc[r_ * 132 + col_] = (ordf(acc_[n_][j_]) & ~127u) | (u32)(127 - col_);                            \
      }                                                                                                     \
    __syncthreads();                                                                                        \
  } while (0)
  P10_DECL(sa);
  P10_DECL(sb);
  P10_LOAD(sa, (int)blockIdx.x, 0);
  for (int item = blockIdx.x; item < 256 * 8; item += gridDim.x) {
    const int tt = item >> 3, h = item & 7;
    u32 ta[16], tb[16];
    P10_SCORE(sa);
    P10_LOAD(sb, item, 1);
    select16q(sSc + row * 132, part, ta, sIdx + row * 32);
    P10_SCORE(sb);
    P10_LOAD(sa, item + (int)gridDim.x, 0);
    select16q(sSc + row * 132, part, tb, sIdx + row * 32 + 16);
    __syncthreads();
    {
      float fa[4], fb[16];
#pragma unroll
      for (int r = 0; r < 4; r++) {
        const u32 s0 = ta[4 * r], s1 = ta[4 * r + 1], s2 = ta[4 * r + 2], s3 = ta[4 * r + 3];
        const u32 sel = part == 0 ? s0 : (part == 1 ? s1 : (part == 2 ? s2 : s3));
        fa[r] = unordf(sel & ~127u);
      }
#pragma unroll
      for (int j = 0; j < 16; j++) fb[j] = unordf(tb[j] & ~127u);
      constexpr int NJ[4] = {16, 3, 1, 1};
      u32 cand[4][16];
#pragma unroll
      for (int r = 0; r < 4; r++) {
        const int irow = part + 4 * r;
        const int jlim = 16 / (irow + 1);
#pragma unroll
        for (int j = 0; j < 16; j++)
          if (j < NJ[r]) cand[r][j] = (j < jlim) ? ((ordf(fa[r] + fb[j]) & ~255u) | (u32)(255 - (irow * 16 + j))) : 0u;
      }
      const int tok = tt * 64 + row;
      float sv[16];
      int ev[16];
#pragma unroll
      for (int it = 0; it < 16; it++) {
        u32 m = 0;
#pragma unroll
        for (int r = 0; r < 4; r++)
#pragma unroll
          for (int j = 0; j < 16; j++)
            if (j < NJ[r]) m = max(m, cand[r][j]);
        m = max(m, (u32)__shfl_xor((int)m, 1));
        m = max(m, (u32)__shfl_xor((int)m, 2));
#pragma unroll
        for (int r = 0; r < 4; r++)
#pragma unroll
          for (int j = 0; j < 16; j++)
            if (j < NJ[r]) cand[r][j] = (cand[r][j] == m) ? 0u : cand[r][j];
        const int c = 255 - (int)(m & 255u);
        const int i1 = sIdx[row * 32 + (c >> 4)], i2 = sIdx[row * 32 + 16 + (c & 15)];
        ev[it] = i1 * 128 + i2;
        sv[it] = unordf(m & ~255u);
      }
      const float mx = sv[0];
      float sum = 0.f;
#pragma unroll
      for (int it = 0; it < 16; it++) { sv[it] = __expf(sv[it] - mx); sum += sv[it]; }
      const float inv = 1.f / sum;
#pragma unroll
      for (int g = 0; g < 4; g++) {
        if (part == g) {
          *(int4*)(experts + (size_t)tok * 128 + h * 16 + g * 4) = make_int4(ev[g * 4], ev[g * 4 + 1], ev[g * 4 + 2], ev[g * 4 + 3]);
          *(float4*)(gates + (size_t)tok * 128 + h * 16 + g * 4) =
              make_float4(sv[g * 4] * inv, sv[g * 4 + 1] * inv, sv[g * 4 + 2] * inv, sv[g * 4 + 3] * inv);
        }
      }
    }
  }
}

#undef P10_LOAD
#undef P10_SCORE
#undef P10_MFMA_K
#undef P10_DECL
typedef float f32x2 __attribute__((ext_vector_type(2)));
__device__ __forceinline__ void dec16(const uint4& q, float (&o)[16]) {
  const u32 ws_[4] = {q.x, q.y, q.z, q.w};
#pragma unroll
  for (int i = 0; i < 4; i++) {
    f32x2 lo = __builtin_amdgcn_cvt_pk_f32_fp8((int)ws_[i], false);
    f32x2 hi = __builtin_amdgcn_cvt_pk_f32_fp8((int)ws_[i], true);
    o[i * 4 + 0] = lo[0]; o[i * 4 + 1] = lo[1]; o[i * 4 + 2] = hi[0]; o[i * 4 + 3] = hi[1];
  }
}
__device__ __forceinline__ void peer_load8(uint4 (&U)[8], uint4 (&V)[8], const unsigned char* Ub, const unsigned char* Vb, int ev, int l0,
                                           int lane) {
#pragma unroll
  for (int u = 0; u < 8; u++) {
    const int e = __builtin_amdgcn_readlane(ev, l0 + u);
    U[u] = *(const uint4*)(Ub + (size_t)e * 2048 + lane * 16);
    V[u] = *(const uint4*)(Vb + (size_t)e * 2048 + lane * 16);
  }
}
__device__ __forceinline__ void peer_proc8(const uint4 (&U)[8], const uint4 (&V)[8], const f32x2 (&xp)[8], f32x2 (&accp)[8], float gate_lane,
                                           int lane) {
  float d[8];
#pragma unroll
  for (int u = 0; u < 8; u++) {
    const u32 ws_[4] = {U[u].x, U[u].y, U[u].z, U[u].w};
    f32x2 s = {0.f, 0.f};
#pragma unroll
    for (int q = 0; q < 4; q++) {
      s += xp[2 * q] * __builtin_amdgcn_cvt_pk_f32_fp8((int)ws_[q], false);
      s += xp[2 * q + 1] * __builtin_amdgcn_cvt_pk_f32_fp8((int)ws_[q], true);
    }
    d[u] = s[0] + s[1];
  }
  {
    const bool b4 = (lane & 4) != 0, b2 = (lane & 2) != 0, b1 = (lane & 1) != 0;
#pragma unroll
    for (int i = 0; i < 4; i++) {
      const float send = b4 ? d[i] : d[i + 4], keep = b4 ? d[i + 4] : d[i];
      d[i] = keep + __shfl_xor(send, 4);
    }
#pragma unroll
    for (int i = 0; i < 2; i++) {
      const float send = b2 ? d[i] : d[i + 2], keep = b2 ? d[i + 2] : d[i];
      d[i] = keep + __shfl_xor(send, 2);
    }
    {
      const float send = b1 ? d[0] : d[1], keep = b1 ? d[1] : d[0];
      d[0] = keep + __shfl_xor(send, 1);
    }
    d[0] += __shfl_xor(d[0], 8);
    d[0] += __shfl_xor(d[0], 16);
    d[0] += __shfl_xor(d[0], 32);
  }
  const float dd = d[0] * (1.f / U_SCALE);
  const float hd = 0.5f * dd * (1.f + erff(dd * 0.70710678118654752f));
  const int cl = __float_as_int(hd * gate_lane * (1.f / V_SCALE));
#pragma unroll
  for (int u = 0; u < 8; u++) {
    const float c = __int_as_float(__builtin_amdgcn_readlane(cl, u));
    const f32x2 c2 = {c, c};
    const u32 ws_[4] = {V[u].x, V[u].y, V[u].z, V[u].w};
#pragma unroll
    for (int q = 0; q < 4; q++) {
      accp[2 * q] += c2 * __builtin_amdgcn_cvt_pk_f32_fp8((int)ws_[q], false);
      accp[2 * q + 1] += c2 * __builtin_amdgcn_cvt_pk_f32_fp8((int)ws_[q], true);
    }
  }
}
__device__ __forceinline__ float dot16_fp8(const f32x2 (&xp)[8], const uint4& q) {
  const u32 ws_[4] = {q.x, q.y, q.z, q.w};
  f32x2 s = {0.f, 0.f};
#pragma unroll
  for (int i = 0; i < 4; i++) {
    s += xp[2 * i] * __builtin_amdgcn_cvt_pk_f32_fp8((int)ws_[i], false);
    s += xp[2 * i + 1] * __builtin_amdgcn_cvt_pk_f32_fp8((int)ws_[i], true);
  }
  return s[0] + s[1];
}
__device__ __forceinline__ void pe_load_tab(const unsigned char* Tb, unsigned loff, int e0, int e1, int g, uint4 (&U)[16]) {
#pragma unroll
  for (int kb = 0; kb < 16; kb++) {
    const int e = __shfl((kb < 8) ? e0 : e1, (kb & 7) * 8 + g);
    U[kb] = *(const uint4*)(Tb + ((unsigned)e * 2048u + loff));
  }
}
__device__ __forceinline__ void pe_load_x(const u16* xr, f32x2 (&xp)[8]) {
  uint4 a = *(const uint4*)(xr), b = *(const uint4*)(xr + 8);
  xp[0] = f32x2{blo(a.x), bhi(a.x)}; xp[1] = f32x2{blo(a.y), bhi(a.y)}; xp[2] = f32x2{blo(a.z), bhi(a.z)}; xp[3] = f32x2{blo(a.w), bhi(a.w)};
  xp[4] = f32x2{blo(b.x), bhi(b.x)}; xp[5] = f32x2{blo(b.y), bhi(b.y)}; xp[6] = f32x2{blo(b.z), bhi(b.z)}; xp[7] = f32x2{blo(b.w), bhi(b.w)};
}
__device__ __forceinline__ void pe_dot_store(const f32x2 (&xp)[8], const uint4 (&U)[16], float* pr, int lane, int r) {
  float d[16];
#pragma unroll
  for (int kb = 0; kb < 16; kb++) d[kb] = dot16_fp8(xp, U[kb]);
  const bool b4 = (lane & 4) != 0, b2 = (lane & 2) != 0, b1 = (lane & 1) != 0;
#pragma unroll
  for (int i = 0; i < 8; i++) { const float send = b4 ? d[i] : d[i + 8], keep = b4 ? d[i + 8] : d[i]; d[i] = keep + __shfl_xor(send, 4); }
#pragma unroll
  for (int i = 0; i < 4; i++) { const float send = b2 ? d[i] : d[i + 4], keep = b2 ? d[i + 4] : d[i]; d[i] = keep + __shfl_xor(send, 2); }
#pragma unroll
  for (int i = 0; i < 2; i++) { const float send = b1 ? d[i] : d[i + 2], keep = b1 ? d[i + 2] : d[i]; d[i] = keep + __shfl_xor(send, 1); }
  pr[(2 * r) * 8] = d[0];
  pr[(2 * r + 1) * 8] = d[1];
}
__device__ void phase11a(const Params& p) {
  const int t = threadIdx.x, lane = t & 63, w = t >> 6, g = lane >> 3, r = lane & 7;
  const int s = blockIdx.x & 7, jb = blockIdx.x >> 3, ns = (gridDim.x - s + 7) >> 3;
  const u16* xn2 = p.R4 + s * 128 + r * 16;
  const unsigned char* Tb = (const unsigned char*)p.R5 + s * 128;
  const unsigned loff = r * 16;
  const int* experts = (const int*)p.R7 + lane;
  float* part = p.out + (size_t)s * BT * 128 + g;
  const int first = jb * 4 + w, stride = ns * 4;
  if (first >= BT) return;
#define TOKC(T) (((T) < BT) ? (T) : first)
  int eA0, eA1, eB0, eB1;
  uint4 UA[16], UB[16];
  f32x2 xA[8], xB[8];
  eA0 = experts[(size_t)first * 128]; eA1 = experts[(size_t)first * 128 + 64];
  pe_load_tab(Tb, loff, eA0, eA1, g, UA);
  pe_load_x(xn2 + (size_t)first * 1024, xA);
  { const int t1 = TOKC(first + stride); eB0 = experts[(size_t)t1 * 128]; eB1 = experts[(size_t)t1 * 128 + 64]; }
#pragma unroll 1
  for (int tok = first; tok < BT; tok += 2 * stride) {
    const int t1 = tok + stride, t2 = tok + 2 * stride, t3 = tok + 3 * stride;
    pe_load_tab(Tb, loff, eB0, eB1, g, UB);
    pe_load_x(xn2 + (size_t)TOKC(t1) * 1024, xB);
    { const int tc = TOKC(t2); eA0 = experts[(size_t)tc * 128]; eA1 = experts[(size_t)tc * 128 + 64]; }
    pe_dot_store(xA, UA, part + (size_t)tok * 128, lane, r);
    pe_load_tab(Tb, loff, eA0, eA1, g, UA);
    pe_load_x(xn2 + (size_t)TOKC(t2) * 1024, xA);
    { const int tc = TOKC(t3); eB0 = experts[(size_t)tc * 128]; eB1 = experts[(size_t)tc * 128 + 64]; }
    if (t1 < BT) pe_dot_store(xB, UB, part + (size_t)t1 * 128, lane, r);
  }
}

__device__ void phase11r(const Params& p) {
  float* gates = p.R7 + (size_t)BT * 128;
  const float* part = p.out;
  for (int idx = blockIdx.x * 256 + threadIdx.x; idx < BT * 128 / 4; idx += gridDim.x * 256) {
    float4 h = *(const float4*)(part + (size_t)idx * 4);
#pragma unroll
    for (int ss = 1; ss < 8; ss++) {
      const float4 q = *(const float4*)(part + (size_t)ss * BT * 128 + (size_t)idx * 4);
      h.x += q.x; h.y += q.y; h.z += q.z; h.w += q.w;
    }
    float4 gt = *(const float4*)(gates + (size_t)idx * 4);
    const float hv[4] = {h.x * (1.f / U_SCALE), h.y * (1.f / U_SCALE), h.z * (1.f / U_SCALE), h.w * (1.f / U_SCALE)};
    const float gv[4] = {gt.x, gt.y, gt.z, gt.w};
    float c[4];
#pragma unroll
    for (int q = 0; q < 4; q++) c[q] = 0.5f * hv[q] * (1.f + erff(hv[q] * 0.70710678118654752f)) * gv[q] * (1.f / V_SCALE);
    *(float4*)(gates + (size_t)idx * 4) = make_float4(c[0], c[1], c[2], c[3]);
  }
}

struct PeTok { int e0, e1; float g0, g1; };
__device__ __forceinline__ PeTok pe_load_tok(const int* experts, const float* gates, int tok) {
  PeTok k;
  k.e0 = experts[(size_t)tok * 128]; k.e1 = experts[(size_t)tok * 128 + 64];
  k.g0 = gates[(size_t)tok * 128]; k.g1 = gates[(size_t)tok * 128 + 64];
  return k;
}
__device__ __forceinline__ void pe_value_store(const PeTok& k, const uint4 (&V)[16], u16* drow, int lane, int g) {
  const float c0 = k.g0, c1 = k.g1;
  f32x2 accp[8];
#pragma unroll
  for (int i = 0; i < 8; i++) accp[i] = f32x2{0.f, 0.f};
#pragma unroll
  for (int kb = 0; kb < 16; kb++) {
    const float c = __shfl((kb < 8) ? c0 : c1, (kb & 7) * 8 + g);
    const f32x2 c2 = {c, c};
    const u32 ws_[4] = {V[kb].x, V[kb].y, V[kb].z, V[kb].w};
#pragma unroll
    for (int q = 0; q < 4; q++) {
      accp[2 * q] += c2 * __builtin_amdgcn_cvt_pk_f32_fp8((int)ws_[q], false);
      accp[2 * q + 1] += c2 * __builtin_amdgcn_cvt_pk_f32_fp8((int)ws_[q], true);
    }
  }
  float a[16];
#pragma unroll
  for (int i = 0; i < 8; i++) { a[2 * i] = accp[i][0]; a[2 * i + 1] = accp[i][1]; }
  const bool b32 = (lane & 32) != 0, b16 = (lane & 16) != 0, b8 = (lane & 8) != 0;
#pragma unroll
  for (int i = 0; i < 8; i++) { const float send = b32 ? a[i] : a[i + 8], keep = b32 ? a[i + 8] : a[i]; a[i] = keep + __shfl_xor(send, 32); }
#pragma unroll
  for (int i = 0; i < 4; i++) { const float send = b16 ? a[i] : a[i + 4], keep = b16 ? a[i + 4] : a[i]; a[i] = keep + __shfl_xor(send, 16); }
#pragma unroll
  for (int i = 0; i < 2; i++) { const float send = b8 ? a[i] : a[i + 2], keep = b8 ? a[i + 2] : a[i]; a[i] = keep + __shfl_xor(send, 8); }
  *(u32*)drow = pack2(a[0], a[1]);
}
__device__ void phase11b(const Params& p) {
  const int t = threadIdx.x, lane = t & 63, w = t >> 6, g = lane >> 3, r = lane & 7;
  const int s = blockIdx.x & 7, jb = blockIdx.x >> 3, ns = (gridDim.x - s + 7) >> 3;
  const unsigned char* Tb = (const unsigned char*)p.R5 + 1024 + s * 128;
  const unsigned loff = r * 16;
  const int* experts = (const int*)p.R7 + lane;
  const float* gates = p.R7 + (size_t)BT * 128 + lane;
  u16* x1 = p.R1 + s * 128 + r * 16 + 2 * g;
  const int first = jb * 4 + w, stride = ns * 4;
  if (first >= BT) return;
  PeTok kA, kB;
  uint4 VA[16], VB[16];
  kA = pe_load_tok(experts, gates, first);
  pe_load_tab(Tb, loff, kA.e0, kA.e1, g, VA);
  kB = pe_load_tok(experts, gates, TOKC(first + stride));
#pragma unroll 1
  for (int tok = first; tok < BT; tok += 2 * stride) {
    const int t1 = tok + stride, t2 = tok + 2 * stride, t3 = tok + 3 * stride;
    pe_load_tab(Tb, loff, kB.e0, kB.e1, g, VB);
    const PeTok kC = pe_load_tok(experts, gates, TOKC(t2));
    pe_value_store(kA, VA, x1 + (size_t)tok * 1024, lane, g);
    pe_load_tab(Tb, loff, kC.e0, kC.e1, g, VA);
    const PeTok kD = pe_load_tok(experts, gates, TOKC(t3));
    if (t1 < BT) pe_value_store(kB, VB, x1 + (size_t)t1 * 1024, lane, g);
    kA = kC; kB = kD;
  }
#undef TOKC
}

__device__ void phase11c(const Params& p) {
  const int t = threadIdx.x, lane = t & 63, w = t >> 6;
  const float* x1 = (const float*)p.R2;
  for (int tok = blockIdx.x * 4 + w; tok < BT; tok += gridDim.x * 4) {
    const float* xr = x1 + (size_t)tok * 1024 + lane * 4;
    const u16* dl = p.R1 + (size_t)tok * 1024 + lane * 4;
    float4 v[4];
    float ss = 0.f;
#pragma unroll
    for (int i = 0; i < 4; i++) {
      v[i] = *(const float4*)(xr + i * 256);
      const uint2 dd = *(const uint2*)(dl + i * 256);
      v[i].x += blo(dd.x); v[i].y += bhi(dd.x); v[i].z += blo(dd.y); v[i].w += bhi(dd.y);
      ss += v[i].x * v[i].x + v[i].y * v[i].y + v[i].z * v[i].z + v[i].w * v[i].w;
    }
    ss = wave_sum(ss);
    const float rstd = rsqrtf(ss * (1.f / 1024.f) + 1e-6f);
    float* orow = p.out + (size_t)tok * 1024 + lane * 4;
#pragma unroll
    for (int i = 0; i < 4; i++) {
      float4 gg = *(const float4*)(p.fng + i * 256 + lane * 4);
      *(float4*)(orow + i * 256) = make_float4(v[i].x * rstd * gg.x, v[i].y * rstd * gg.y, v[i].z * rstd * gg.z, v[i].w * rstd * gg.w);
    }
  }
}

__global__ void __launch_bounds__(256, 2) fwd_mega(Params p, int ph_lo, int ph_hi) {
  extern __shared__ __attribute__((aligned(16))) char smem[];
  cg::grid_group grid = cg::this_grid();
  __shared__ uint4 xb_words;
  if (threadIdx.x == 0) xb_words = make_uint4(0u, 0u, 0u, 0u);
  __syncthreads();
  const XcdBarrier xb = xcd_barrier_post(p.bar, (volatile LAS unsigned*)&xb_words);
  if (ph_lo > ph_hi) grid.sync();
constexpr int REP0=1,REP1=1,REP2=1,REP3=1,REP4=1,REP5=1,REP6=1,REP7=1,REP8=1,REP9=1,REP10=1,REP11=1,REP12=1,REP13=1,REP14=1;
#define RUN_PHASE(k, call)                         \
  if (PH_ON(k) && ph_lo <= (k) && (k) < ph_hi) {   \
    for (int rep_ = 0; rep_ < REP##k; rep_++) { call; }  \
    if ((k) + 1 < ph_hi) xcd_barrier(xb);          \
  }
  RUN_PHASE(0, phase0(p, smem))
  RUN_PHASE(1, phase1(p, smem))
  RUN_PHASE(2, phase2(p, smem, xb))
  RUN_PHASE(3, phase3(p); weights_late(p, smem))
  RUN_PHASE(4, for (int item = blockIdx.x; item < 512; item += gridDim.x) gla_item(p, item, 2, smem))
  RUN_PHASE(5, phase5(p))
  RUN_PHASE(6, phase6(p, smem))
  RUN_PHASE(7, phase7(p, smem))
  RUN_PHASE(8, phase8(p))
  RUN_PHASE(9, phase9(p, smem))
  RUN_PHASE(10, phase10(p, smem))
  RUN_PHASE(11, phase11a(p))
  RUN_PHASE(12, phase11r(p))
  RUN_PHASE(13, phase11b(p))
  RUN_PHASE(14, phase11c(p))
}

extern "C" void kernel_launch(void* const* d_in, const int* in_sizes, int n_in, void* d_out, int out_size, void* d_ws,
                              size_t ws_size, hipStream_t stream) {
  (void)in_sizes; (void)n_in; (void)out_size; (void)ws_size;
  static int grid_blocks = 0;
  if (!grid_blocks) {
    int dev = 0, cus = 0, per_cu = 0;
    hipGetDevice(&dev);
    hipDeviceGetAttribute(&cus, hipDeviceAttributeMultiprocessorCount, dev);
    hipFuncSetAttribute((const void*)fwd_mega, hipFuncAttributeMaxDynamicSharedMemorySize, LDS_BYTES);
    hipOccupancyMaxActiveBlocksPerMultiprocessor(&per_cu, (const void*)fwd_mega, 256, LDS_BYTES);
    if (per_cu < 1) per_cu = 1;
    if (per_cu > 2) per_cu = 2;
    grid_blocks = cus * per_cu;
  }
  Params p{};
  const float* const* in = (const float* const*)d_in;
  p.x = in[0]; p.norm1_g = in[1]; p.w_in = in[2]; p.conv_w = in[3]; p.conv_b = in[4]; p.wa = in[5];
  p.dupf = in[6]; p.dbf = in[7]; p.dupb = in[8]; p.dbb = in[9]; p.gng = in[10]; p.wb = in[11];
  p.gbias = in[12]; p.wo = in[13]; p.norm2_g = in[14]; p.wq = in[15]; p.keys = in[16]; p.pu = in[17];
  p.pv = in[18]; p.fng = in[19];
  p.out = (float*)d_out;
  char* ws = (char*)d_ws;
  const size_t MiB = 1u << 20;
  p.WinT = (u16*)ws;
  p.WaT = (u16*)(ws + 17039360);
  p.WbT = (u16*)(ws + 17039360 + 2097152);
  p.WoT = (u16*)(ws + 17039360 + 2 * 2097152);
  p.WqT = (u16*)(ws + 17039360 + 3 * 2097152);
  p.KeysB = (u16*)(ws + 17039360 + 3 * 2097152 + 4194304);
  p.R1 = (u16*)(ws + 27 * MiB);
  p.R2 = (u16*)(ws + 59 * MiB);
  p.R3 = (u16*)(ws + 91 * MiB);
  p.R4 = (u16*)(ws + 123 * MiB);
  p.R5 = (u16*)(ws + 155 * MiB);
  p.R6 = (u16*)(ws + 187 * MiB);
  p.R7 = (float*)(ws + 219 * MiB);
  p.z = (float*)(ws + 251 * MiB);
  p.Dd = (float*)(ws + 253 * MiB);
  p.bar = (unsigned*)(ws + 254 * MiB);
  hipMemsetAsync(p.bar, 0, XCD_BAR_WORDS * sizeof(unsigned), stream);
#if MULTI_LAUNCH
  for (int ph = 0; ph < NPHASE; ph++) {
    hipLaunchKernelGGL(fwd_mega, dim3(grid_blocks), dim3(256), LDS_BYTES, stream, p, ph, ph + 1);
  }
#else
  int lo = 0, hi = NPHASE;
  void* args[] = {&p, &lo, &hi};
  hipError_t e = hipLaunchCooperativeKernel((const void*)fwd_mega, dim3(grid_blocks), dim3(256), args, LDS_BYTES, stream);
  if (e != hipSuccess) fprintf(stderr, "cooperative launch failed: %s (grid %d)\n", hipGetErrorString(e), grid_blocks);
#endif
}
```

```cpp
#include <hip/hip_runtime.h>
#include <hip/hip_cooperative_groups.h>
#include <cstdio>
namespace cg = cooperative_groups;

typedef unsigned short u16;
typedef unsigned int u32;
using bf16x8 = __attribute__((ext_vector_type(8))) short;
using f32x4 = __attribute__((ext_vector_type(4))) float;

#ifndef ONLY_PHASE
#define ONLY_PHASE -1
#endif
#define PH_ON(k) (ONLY_PHASE < 0 || ONLY_PHASE == (k))
#ifndef MULTI_LAUNCH
#define MULTI_LAUNCH 0
#endif

constexpr int BT = 16384, SEQ = 8192;
constexpr int LDS_BYTES = 80896;
constexpr int NPHASE = 15;

struct Params {
  const float *x, *norm1_g, *w_in, *conv_w, *conv_b, *wa, *dupf, *dbf, *dupb, *dbb, *gng, *wb, *gbias, *wo,
      *norm2_g, *wq, *keys, *pu, *pv, *fng;
  float* out;
  u16 *WinT, *WaT, *WbT, *WoT, *WqT, *KeysB;
  u16 *R1, *R2, *R3, *R4, *R5, *R6;
  float *R7, *z, *Dd;
  unsigned* bar;
};

__device__ __forceinline__ u16 f2b(float f) { u32 u = __float_as_uint(f); u += 0x7fffu + ((u >> 16) & 1u); return (u16)(u >> 16); }
__device__ __forceinline__ float b2f(u16 h) { return __uint_as_float(((u32)h) << 16); }
__device__ __forceinline__ u32 pack2(float a, float b) { return (u32)f2b(a) | ((u32)f2b(b) << 16); }
__device__ __forceinline__ float blo(u32 w) { return __uint_as_float(w << 16); }
__device__ __forceinline__ float bhi(u32 w) { return __uint_as_float(w & 0xffff0000u); }
__device__ __forceinline__ float wave_sum(float v) {
#pragma unroll
  for (int o = 32; o > 0; o >>= 1) v += __shfl_xor(v, o);
  return v;
}
__device__ __forceinline__ float sigmoidf_(float v) { return 1.f / (1.f + __expf(-v)); }
__device__ __forceinline__ u32 ordf(float v) { u32 u = __float_as_uint(v); return (u & 0x80000000u) ? ~u : (u | 0x80000000u); }
__device__ __forceinline__ float unordf(u32 k) { return __uint_as_float((k & 0x80000000u) ? (k ^ 0x80000000u) : ~k); }

template <int MT, int NT, int KT>
__device__ __forceinline__ void mma_nt(f32x4 (&acc)[MT][NT], const u16* A, int sa, const u16* B, int sb, int lane) {
  const int fr = lane & 15, fq = lane >> 4;
  const u16* pa = A + fr * sa + fq * 8;
  const u16* pb = B + fr * sb + fq * 8;
#pragma unroll
  for (int k = 0; k < KT; k++) {
    bf16x8 a[MT], b[NT];
#pragma unroll
    for (int m = 0; m < MT; m++) a[m] = *(const bf16x8*)(pa + m * 16 * sa + k * 32);
#pragma unroll
    for (int n = 0; n < NT; n++) b[n] = *(const bf16x8*)(pb + n * 16 * sb + k * 32);
#pragma unroll
    for (int m = 0; m < MT; m++)
#pragma unroll
      for (int n = 0; n < NT; n++) acc[m][n] = __builtin_amdgcn_mfma_f32_16x16x32_bf16(a[m], b[n], acc[m][n], 0, 0, 0);
  }
}

template <int MT, int NT>
__device__ __forceinline__ void mma_sw64(f32x4 (&acc)[MT][NT], const u16* A, const u16* B, int lane) {
  const int fr = lane & 15, fq = lane >> 4;
  const int cb = fq ^ ((fr >> 1) & 7);
  const u16* pa = A + fr * 64;
  const u16* pb = B + fr * 64;
#pragma unroll
  for (int k = 0; k < 2; k++) {
    const int co = (cb ^ (k * 4)) * 8;
    bf16x8 a[MT], b[NT];
#pragma unroll
    for (int m = 0; m < MT; m++) a[m] = *(const bf16x8*)(pa + m * 16 * 64 + co);
#pragma unroll
    for (int n = 0; n < NT; n++) b[n] = *(const bf16x8*)(pb + n * 16 * 64 + co);
#pragma unroll
    for (int m = 0; m < MT; m++)
#pragma unroll
      for (int n = 0; n < NT; n++) acc[m][n] = __builtin_amdgcn_mfma_f32_16x16x32_bf16(b[n], a[m], acc[m][n], 0, 0, 0);
  }
}

#define ST_DECL(S) uint4 S##a0, S##a1, S##a2, S##a3, S##b0, S##b1, S##b2, S##b3
#define ST_LOAD(S, PA, PB)                                                                                           \
  do {                                                                                                               \
    const char* pa_ = (const char*)(PA);                                                                             \
    const char* pb_ = (const char*)(PB);                                                                             \
    S##a0 = *(const uint4*)(pa_ + voffA); S##a1 = *(const uint4*)(pa_ + (size_t)64 * lda + voffA);                   \
    S##a2 = *(const uint4*)(pa_ + (size_t)128 * lda + voffA); S##a3 = *(const uint4*)(pa_ + (size_t)192 * lda + voffA); \
    S##b0 = *(const uint4*)(pb_ + voffB); S##b1 = *(const uint4*)(pb_ + (size_t)64 * ldb + voffB);                   \
    S##b2 = *(const uint4*)(pb_ + (size_t)128 * ldb + voffB); S##b3 = *(const uint4*)(pb_ + (size_t)192 * ldb + voffB); \
  } while (0)
#define ST_WRITE(S, WA, WB)                                                                                          \
  do {                                                                                                               \
    *(uint4*)(WA) = S##a0; *(uint4*)((WA) + 32 * 64) = S##a1; *(uint4*)((WA) + 64 * 64) = S##a2; *(uint4*)((WA) + 96 * 64) = S##a3; \
    *(uint4*)(WB) = S##b0; *(uint4*)((WB) + 32 * 64) = S##b1; *(uint4*)((WB) + 64 * 64) = S##b2; *(uint4*)((WB) + 96 * 64) = S##b3; \
  } while (0)

#define GLDS16(G, L) __builtin_amdgcn_global_load_lds((const void*)(G), (__attribute__((address_space(3))) void*)(L), 16, 0, 0)
__device__ __forceinline__ void gemm_acc_db(f32x4 (&acc)[4][4], const u16* __restrict__ A, int lda, const u16* __restrict__ B,
                                            int ldb, int K, char* smem) {
  const int t = threadIdx.x, lane = t & 63, w = t >> 6, wr = w >> 1, wc = w & 1;
  const int lr = t >> 3;
  const int gc = ((t & 7) ^ ((lr >> 1) & 7)) * 8;
  const u16* pa = A + (size_t)lr * lda + gc;
  const u16* pb = B + (size_t)lr * ldb + gc;
  char* l0 = smem + t * 16;
  u16* b0 = (u16*)smem;
  u16* b1 = b0 + 2 * 128 * 64;
#define ISSUE_TILE(KT, BUFOFF)                                                                     \
  do {                                                                                             \
    const u16* qa = pa + (KT) * 64;                                                                \
    const u16* qb = pb + (KT) * 64;                                                                \
    char* lb = l0 + (BUFOFF);                                                                      \
    GLDS16(qa, lb); GLDS16(qa + (size_t)32 * lda, lb + 4096);                                      \
    GLDS16(qa + (size_t)64 * lda, lb + 8192); GLDS16(qa + (size_t)96 * lda, lb + 12288);           \
    GLDS16(qb, lb + 16384); GLDS16(qb + (size_t)32 * ldb, lb + 16384 + 4096);                      \
    GLDS16(qb + (size_t)64 * ldb, lb + 16384 + 8192); GLDS16(qb + (size_t)96 * ldb, lb + 16384 + 12288); \
  } while (0)
  const int nk = K >> 6;
  __syncthreads();
  ISSUE_TILE(0, 0);
  if (blockIdx.x >= (gridDim.x >> 1)) __builtin_amdgcn_s_sleep(8);
#define KSTEP(BUF, ISSUE_STMT)                                                 \
  do {                                                                         \
    asm volatile("s_waitcnt vmcnt(0) lgkmcnt(0)" ::: "memory");    \
    __builtin_amdgcn_s_barrier();                                              \
    asm volatile("" ::: "memory");                                             \
    ISSUE_STMT;                                                                \
    mma_sw64<4, 4>(acc, BUF + wr * 64 * 64, BUF + 128 * 64 + wc * 64 * 64, lane); \
  } while (0)
  for (int kt = 0; kt + 2 < nk; kt += 2) {
    KSTEP(b0, ISSUE_TILE(kt + 1, 32768));
    KSTEP(b1, ISSUE_TILE(kt + 2, 0));
  }
  KSTEP(b0, ISSUE_TILE(nk - 1, 32768));
  KSTEP(b1, (void)0);
  asm volatile("s_waitcnt lgkmcnt(0)" ::: "memory");
#undef KSTEP
#undef ISSUE_TILE
}

struct TileIter {
  int i, step, lim, NT, xcd; bool swz;
  __device__ __forceinline__ TileIter(int nt_) {
    NT = nt_;
    swz = (gridDim.x & 7) == 0;
    if (swz) { xcd = blockIdx.x & 7; i = blockIdx.x >> 3; step = gridDim.x >> 3; lim = 16 * NT; }
    else { xcd = 0; i = blockIdx.x; step = gridDim.x; lim = 128 * NT; }
  }
  __device__ __forceinline__ bool next(int& mt, int& nt) {
    if (i >= lim) return false;
    if (swz) { int mg = i / (NT * 8), rem = i - mg * NT * 8; nt = rem >> 3; mt = xcd * 16 + mg * 8 + (rem & 7); }
    else { mt = i & 127; nt = i >> 7; }
    i += step;
    return true;
  }
};

__device__ __forceinline__ void zero_acc(f32x4 (&acc)[4][4]) {
#pragma unroll
  for (int m = 0; m < 4; m++)
#pragma unroll
    for (int n = 0; n < 4; n++) acc[m][n] = f32x4{0.f, 0.f, 0.f, 0.f};
}

__device__ __forceinline__ int winmap(int r) {
  if (r < 2048) { int tile = r >> 7, w = r & 127, grp = w >> 5; int ch = tile * 64 + (grp >> 1) * 32 + (w & 31); return ((grp & 1) ? 2048 : 0) + ch; }
  if (r < 3072) return r - 1024;
  if (r < 6176) return r;
  if (r < 6272) return -1;
  return r - 96;
}

__device__ __forceinline__ void tr_tile(const float* __restrict__ src, int ld, int col0, u16* __restrict__ dst, int r0, int k0, float* sT) {
  const int t = threadIdx.x;
  const int r = t >> 3, kc = t & 7;
  if (col0 < 0) {
    *(uint4*)(dst + (size_t)(r0 + r) * 1024 + k0 + kc * 8) = make_uint4(0, 0, 0, 0);
    return;
  }
  __syncthreads();
#pragma unroll
  for (int i = 0; i < 8; i++) {
    int k = (t >> 5) + i * 8, rr = t & 31;
    sT[k * 33 + rr] = src[(size_t)(k0 + k) * ld + col0 + rr];
  }
  __syncthreads();
  u32 wv[4];
#pragma unroll
  for (int j = 0; j < 4; j++) wv[j] = pack2(sT[(kc * 8 + 2 * j) * 33 + r], sT[(kc * 8 + 2 * j + 1) * 33 + r]);
  *(uint4*)(dst + (size_t)(r0 + r) * 1024 + k0 + kc * 8) = make_uint4(wv[0], wv[1], wv[2], wv[3]);
}

__device__ __forceinline__ void rms_row(const float* __restrict__ src, const float* __restrict__ g, u16* __restrict__ dst, int lane) {
  float4 v[4];
  float ss = 0.f;
#pragma unroll
  for (int i = 0; i < 4; i++) {
    v[i] = *(const float4*)(src + i * 256 + lane * 4);
    ss += v[i].x * v[i].x + v[i].y * v[i].y + v[i].z * v[i].z + v[i].w * v[i].w;
  }
  ss = wave_sum(ss);
  const float rstd = rsqrtf(ss * (1.f / 1024.f) + 1e-6f);
#pragma unroll
  for (int i = 0; i < 4; i++) {
    float4 gg = *(const float4*)(g + i * 256 + lane * 4);
    uint2 o;
    o.x = pack2(v[i].x * rstd * gg.x, v[i].y * rstd * gg.y);
    o.y = pack2(v[i].z * rstd * gg.z, v[i].w * rstd * gg.w);
    *(uint2*)(dst + i * 256 + lane * 4) = o;
  }
}

__device__ void phase0(const Params& p, char* smem) {
  float* sT = (float*)smem;
  const int t = threadIdx.x, lane = t & 63, w = t >> 6;
  u16* xn = (u16*)p.out;
  constexpr int J0 = 4160, J4 = J0 + 4096;
  for (int job = blockIdx.x; job < J4; job += gridDim.x) {
    if (job < J0) {
      int rb = job >> 4, kb = job & 15;
      tr_tile(p.w_in, 8224, winmap(rb * 32), p.WinT, rb * 32, kb * 64, sT);
    } else {
      int row = (job - J0) * 4 + w;
      rms_row(p.x + (size_t)row * 1024, p.norm1_g, xn + (size_t)row * 1024, lane);
    }
  }
}
__device__ void weights_late(const Params& p, char* smem) {
  float* sT = (float*)smem;
  const int t = threadIdx.x;
  constexpr int J1 = 1536, J2 = J1 + 1024, J3 = J2 + 128;
  for (int job = blockIdx.x; job < J3; job += gridDim.x) {
    if (job < J1) {
      int which = job >> 9, rb = (job & 511) >> 4, kb = job & 15;
      const float* src = which == 0 ? p.wa : (which == 1 ? p.wb : p.wo);
      u16* dst = which == 0 ? p.WaT : (which == 1 ? p.WbT : p.WoT);
      tr_tile(src, 1024, rb * 32, dst, rb * 32, kb * 64, sT);
    } else if (job < J2) {
      int j = job - J1, rb = j >> 4, kb = j & 15;
      tr_tile(p.wq, 2048, rb * 32, p.WqT, rb * 32, kb * 64, sT);
    } else {
      int j = job - J2;
      int base = (j * 256 + t) * 8;
      float4 a = *(const float4*)(p.keys + base), b = *(const float4*)(p.keys + base + 4);
      *(uint4*)(p.KeysB + base) = make_uint4(pack2(a.x, a.y), pack2(a.z, a.w), pack2(b.x, b.y), pack2(b.z, b.w));
    }
  }
}

__device__ void la_prep(const Params& p, char* smem) {
  float* sZ = (float*)smem;
  float* sPart = sZ + 1024;
  const int t = threadIdx.x, lane = t & 63, w = t >> 6, fr = lane & 15, fq = lane >> 4;
  const u16* xn = (const u16*)p.out;
  const u16* Wz = p.WinT + (size_t)6144 * 1024;
  u32* la16 = (u32*)p.R6;
  float uf0[16], uf1[16], ub0[16], ub1[16];
#pragma unroll
  for (int r = 0; r < 16; r++) {
    uf0[r] = p.dupf[r * 512 + 2 * t]; uf1[r] = p.dupf[r * 512 + 2 * t + 1];
    ub0[r] = p.dupb[r * 512 + 2 * t]; ub1[r] = p.dupb[r * 512 + 2 * t + 1];
  }
  const float bf0 = p.dbf[2 * t], bf1 = p.dbf[2 * t + 1], bb0 = p.dbb[2 * t], bb1 = p.dbb[2 * t + 1];
  for (int job = blockIdx.x; job < BT / 32; job += gridDim.x) {
    f32x4 az[2][2];
#pragma unroll
    for (int m = 0; m < 2; m++)
#pragma unroll
      for (int n = 0; n < 2; n++) az[m][n] = f32x4{0.f, 0.f, 0.f, 0.f};
    {
      const u16* ap = xn + (size_t)(job * 32 + fr) * 1024 + w * 256 + fq * 8;
      const u16* bp = Wz + (size_t)fr * 1024 + w * 256 + fq * 8;
#pragma unroll
      for (int ks = 0; ks < 8; ks++) {
        bf16x8 a0 = *(const bf16x8*)(ap + ks * 32), a1 = *(const bf16x8*)(ap + 16 * 1024 + ks * 32);
        bf16x8 b0 = *(const bf16x8*)(bp + ks * 32), b1 = *(const bf16x8*)(bp + 16 * 1024 + ks * 32);
        az[0][0] = __builtin_amdgcn_mfma_f32_16x16x32_bf16(a0, b0, az[0][0], 0, 0, 0);
        az[0][1] = __builtin_amdgcn_mfma_f32_16x16x32_bf16(a0, b1, az[0][1], 0, 0, 0);
        az[1][0] = __builtin_amdgcn_mfma_f32_16x16x32_bf16(a1, b0, az[1][0], 0, 0, 0);
        az[1][1] = __builtin_amdgcn_mfma_f32_16x16x32_bf16(a1, b1, az[1][1], 0, 0, 0);
      }
    }
    __syncthreads();
#pragma unroll
    for (int m = 0; m < 2; m++)
#pragma unroll
      for (int n = 0; n < 2; n++)
#pragma unroll
        for (int j = 0; j < 4; j++) sPart[w * 1024 + (m * 16 + fq * 4 + j) * 32 + n * 16 + fr] = az[m][n][j];
    __syncthreads();
    {
      const float4 q0 = *(const float4*)(sPart + t * 4), q1 = *(const float4*)(sPart + 1024 + t * 4), q2 = *(const float4*)(sPart + 2048 + t * 4),
                   q3 = *(const float4*)(sPart + 3072 + t * 4);
      *(float4*)(sZ + t * 4) = make_float4(q0.x + q1.x + q2.x + q3.x, q0.y + q1.y + q2.y + q3.y, q0.z + q1.z + q2.z + q3.z, q0.w + q1.w + q2.w + q3.w);
    }
    __syncthreads();
    for (int i = 0; i < 32; i++) {
      const float* zr = sZ + i * 32;
      float a0 = bf0, a1 = bf1, c0 = bb0, c1 = bb1;
#pragma unroll
      for (int r = 0; r < 16; r++) {
        const float zf = zr[r], zb = zr[16 + r];
        a0 += zf * uf0[r]; a1 += zf * uf1[r];
        c0 += zb * ub0[r]; c1 += zb * ub1[r];
      }
      const float l0 = (fminf(a0, 0.f) - __logf(1.f + __expf(-fabsf(a0)))) * 0.0625f;
      const float l1 = (fminf(a1, 0.f) - __logf(1.f + __expf(-fabsf(a1)))) * 0.0625f;
      const float m0 = (fminf(c0, 0.f) - __logf(1.f + __expf(-fabsf(c0)))) * 0.0625f;
      const float m1 = (fminf(c1, 0.f) - __logf(1.f + __expf(-fabsf(c1)))) * 0.0625f;
      const int tok = job * 32 + i;
      la16[(size_t)tok * 256 + t] = (u32)__builtin_bit_cast(unsigned short, (_Float16)l0) | ((u32)__builtin_bit_cast(unsigned short, (_Float16)l1) << 16);
      la16[(size_t)(BT + tok) * 256 + t] = (u32)__builtin_bit_cast(unsigned short, (_Float16)m0) | ((u32)__builtin_bit_cast(unsigned short, (_Float16)m1) << 16);
    }
  }
}

__device__ void phase1(const Params& p, char* smem) {
  u16* sA = (u16*)smem;
  u16* sB = sA + 128 * 64;
  const int t = threadIdx.x, lane = t & 63, w = t >> 6, wr = w >> 1, wc = w & 1, fr = lane & 15, fq = lane >> 4;
  const u16* xn = (const u16*)p.out;
  la_prep(p, smem);
  TileIter ti(48);
  int mt, nt;
  while (ti.next(mt, nt)) {
    f32x4 acc[4][4];
    zero_acc(acc);
    gemm_acc_db(acc, xn + (size_t)mt * 128 * 1024, 1024, p.WinT + (size_t)nt * 128 * 1024, 1024, 1024, smem);
    const int rowb = mt * 128 + wr * 64 + fr;
    if (nt < 16) {
#pragma unroll
      for (int m = 0; m < 4; m++)
#pragma unroll
        for (int n = 0; n < 2; n++) {
          const int ch = nt * 64 + wc * 32 + n * 16 + fq * 4;
          *(uint2*)(p.R1 + (size_t)(rowb + m * 16) * 1024 + ch) =
              make_uint2(pack2(acc[m][n][0] * acc[m][n + 2][0], acc[m][n][1] * acc[m][n + 2][1]),
                         pack2(acc[m][n][2] * acc[m][n + 2][2], acc[m][n][3] * acc[m][n + 2][3]));
        }
    } else {
      const int g = (nt - 16) >> 3;
      u16* dst = g == 0 ? p.R2 : (g == 1 ? p.R3 : (g == 2 ? p.R4 : p.R5));
      const int cb = ((nt - 16) & 7) * 128 + wc * 64;
      const float sc = (g == 1 && cb < 512) ? 0.08838834764831845f : 1.f;
#pragma unroll
      for (int m = 0; m < 4; m++)
#pragma unroll
        for (int n = 0; n < 4; n++)
          *(uint2*)(dst + (size_t)(rowb + m * 16) * 1024 + cb + n * 16 + fq * 4) =
              make_uint2(pack2(acc[m][n][0] * sc, acc[m][n][1] * sc), pack2(acc[m][n][2] * sc, acc[m][n][3] * sc));
    }
  }
}

#define XB_TMO      128
#define XB_XCNT(j)  (256  + 64 * (j))
#define XB_XSUB(j)  (1280 + 64 * (j))
#define XB_XGEN(j)  (2304 + 64 * (j))
#define XB_TOP      3328
#define XB_TOPGEN   3392
#define XCD_BAR_WORDS 3456
#define XB_SPIN_CAP (1u << 20)
#define LAS __attribute__((address_space(3)))
__device__ __forceinline__ unsigned xb_ld(unsigned* p) { return __hip_atomic_load(p, __ATOMIC_RELAXED, __HIP_MEMORY_SCOPE_AGENT); }
__device__ __forceinline__ unsigned xb_add(unsigned* p, unsigned v) { return __hip_atomic_fetch_add(p, v, __ATOMIC_RELAXED, __HIP_MEMORY_SCOPE_AGENT); }
__device__ __forceinline__ unsigned xb_xcc_id() { return (unsigned)__builtin_amdgcn_s_getreg((3 << 11) | 20) & 0xFu; }
#define XB_SPIN(cond, bar) do { unsigned _sp = 0; while (cond) { __builtin_amdgcn_s_sleep(1); \
    if ((++_sp & 255u) == 0u) { if (xb_ld(&(bar)[XB_TMO])) break; if (_sp > XB_SPIN_CAP) { atomicAdd(&(bar)[XB_TMO], 1u); break; } } } } while (0)
struct XcdBarrier { unsigned* bar; unsigned x; volatile LAS unsigned* st; };
__device__ __forceinline__ XcdBarrier xcd_barrier_post(unsigned* bar, volatile LAS unsigned* st) {
  XcdBarrier b; b.bar = bar; b.x = xb_xcc_id(); b.st = st;
  if (threadIdx.x == 0) (void)xb_add(&bar[XB_XCNT(b.x)], 1u);
  return b;
}
__device__ __forceinline__ void xcd_barrier_complete(unsigned* bar, unsigned x, unsigned& nloc, unsigned& nx) {
  const unsigned G = gridDim.x * gridDim.y * gridDim.z;
  unsigned sum, cnt, mine, sp = 0u;
  for (;;) {
    sum = 0u; cnt = 0u; mine = 0u;
#pragma unroll
    for (unsigned j = 0; j < 16; ++j) { const unsigned c = xb_ld(&bar[XB_XCNT(j)]); sum += c; cnt += (c > 0u) ? 1u : 0u; mine = (j == x) ? c : mine; }
    if (sum == G) break;
    __builtin_amdgcn_s_sleep(1);
    if ((++sp & 255u) == 0u) { if (xb_ld(&bar[XB_TMO])) break; if (sp > XB_SPIN_CAP) { atomicAdd(&bar[XB_TMO], 1u); break; } }
  }
  nloc = mine > 0u ? mine : 1u; nx = cnt > 0u ? cnt : 1u;
}
__device__ __forceinline__ void xcd_barrier(const XcdBarrier& b) {
  asm volatile("s_waitcnt vmcnt(0)" ::: "memory");
  __syncthreads();
  if (threadIdx.x == 0) {
    unsigned* bar = b.bar;
    __builtin_amdgcn_s_waitcnt(0);
    unsigned nloc = b.st[0], nx = b.st[1];
    if (nloc == 0u) { xcd_barrier_complete(bar, b.x, nloc, nx); b.st[0] = nloc; b.st[1] = nx; }
    const unsigned old = xb_add(&bar[XB_XSUB(b.x)], 1u);
    const unsigned gen = old / nloc;
    if (old + 1u == (gen + 1u) * nloc) {
      __builtin_amdgcn_fence(__ATOMIC_RELEASE, "agent");
      asm volatile("s_waitcnt vmcnt(0)" ::: "memory");
      const unsigned og = xb_add(&bar[XB_TOP], 1u);
      const unsigned tg = og / nx;
      if (og + 1u == (tg + 1u) * nx) xb_add(&bar[XB_TOPGEN], 1u);
      else XB_SPIN(xb_ld(&bar[XB_TOPGEN]) == tg, bar);
      __builtin_amdgcn_fence(__ATOMIC_ACQUIRE, "agent");
      xb_add(&bar[XB_XGEN(b.x)], 1u);
      asm volatile("s_waitcnt vmcnt(0)" ::: "memory");
    } else {
      XB_SPIN(xb_ld(&bar[XB_XGEN(b.x)]) == gen, bar);
      __builtin_amdgcn_fence(__ATOMIC_ACQUIRE, "agent");
      asm volatile("s_waitcnt vmcnt(0)" ::: "memory");
    }
  }
  __syncthreads();
}

__device__ void gla_item(const Params& p, int item, int pass, char* smem) {
  const int dvp = item & 1, seg = (item >> 1) & 15, dir = (item >> 5) & 1, h = (item >> 6) & 3, b = item >> 8;
  const int bhd = (b * 4 + h) * 2 + dir;
  u16* sQ = (u16*)smem;
  u16* sK = sQ + 64 * 136;
  u16* sKT = sK + 64 * 136;
  u16* sVT = sKT + 128 * 72;
  u16* sST = sVT + 64 * 72;
  float* sDec = (float*)(sST + 64 * 136);
  float* sTot = (float*)sVT;
  const int t = threadIdx.x, lane = t & 63, w = __builtin_amdgcn_readfirstlane(t >> 6), wr = w >> 1, wc = w & 1, fr = lane & 15, fq = lane >> 4;
  const int d0 = lane * 2;
  const u32* la16 = (const u32*)p.R6 + (size_t)dir * BT * 256 + h * 64 + lane;
  const u16* qk = p.R3;
  const u16* vv = p.R4;
  u16* obuf = dir ? p.R2 : p.R1;
  float* Lp = p.R7 + (size_t)(bhd * 16 + seg) * 32768 + (size_t)dvp * 128 * 128;

  f32x4 accS[2][2][4];
#pragma unroll
  for (int s = 0; s < 2; s++)
#pragma unroll
    for (int m = 0; m < 2; m++)
#pragma unroll
      for (int n = 0; n < 4; n++)
#pragma unroll
        for (int j = 0; j < 4; j++)
          accS[s][m][n][j] = (pass == 2) ? Lp[(s * 64 + wr * 32 + m * 16 + fq * 4 + j) * 128 + wc * 64 + n * 16 + fr] : 0.f;
  float dsum0 = 0.f, dsum1 = 0.f;

  for (int ci = 0; ci < 8; ci++) {
    const int c = seg * 8 + ci;
    __syncthreads();
    u32 qv[16], kv[16], lav[16], vreg[2][16];
#pragma unroll
    for (int ii = 0; ii < 16; ii++) {
      int f = c * 64 + w * 16 + ii;
      int pos = dir ? (SEQ - 1 - f) : f;
      size_t tokoff = (size_t)(b * SEQ + pos) * 1024;
      kv[ii] = *(const u32*)(qk + tokoff + 512 + h * 128 + d0);
      if (pass == 2) qv[ii] = *(const u32*)(qk + tokoff + h * 128 + d0);
      lav[ii] = la16[(size_t)(b * SEQ + pos) * 256];
      vreg[0][ii] = vv[tokoff + h * 256 + dvp * 128 + lane];
      vreg[1][ii] = vv[tokoff + h * 256 + dvp * 128 + 64 + lane];
    }
    float bl0[16], bl1[16];
    {
      float run0 = 0.f, run1 = 0.f;
#pragma unroll
      for (int ii = 0; ii < 16; ii++) {
        run0 += (float)__builtin_bit_cast(_Float16, (unsigned short)(lav[ii] & 0xffffu));
        run1 += (float)__builtin_bit_cast(_Float16, (unsigned short)(lav[ii] >> 16));
        bl0[ii] = run0; bl1[ii] = run1;
      }
      sTot[w * 128 + d0] = run0;
      sTot[w * 128 + d0 + 1] = run1;
    }
    __syncthreads();
    {
      float off0 = 0.f, off1 = 0.f, tot0 = 0.f, tot1 = 0.f;
#pragma unroll
      for (int ww = 0; ww < 4; ww++) {
        float a = sTot[ww * 128 + d0], bb = sTot[ww * 128 + d0 + 1];
        if (ww < w) { off0 += a; off1 += bb; }
        tot0 += a; tot1 += bb;
      }
      dsum0 += tot0; dsum1 += tot1;
      const float et0 = __expf(tot0), et1 = __expf(tot1);
      if (w == 0) { sDec[d0] = et0; sDec[d0 + 1] = et1; }
#pragma unroll
      for (int ii = 0; ii < 16; ii += 2) {
        float ke0[2], ke1[2];
#pragma unroll
        for (int s = 0; s < 2; s++) {
          const int i2 = ii + s;
          const float b0 = bl0[i2] + off0, b1 = bl1[i2] + off1;
          const float k0 = blo(kv[i2]), k1 = bhi(kv[i2]);
          const int i = w * 16 + i2;
          const float e0 = __expf(b0), e1 = __expf(b1);
          const float kt0 = k0 * __builtin_amdgcn_rcpf(e0), kt1 = k1 * __builtin_amdgcn_rcpf(e1);
          if (pass == 2) {
            *(u32*)(sQ + i * 136 + d0) = pack2(blo(qv[i2]) * e0, bhi(qv[i2]) * e1);
            *(u32*)(sK + i * 136 + d0) = pack2(kt0, kt1);
          }
          ke0[s] = kt0 * et0;
          ke1[s] = kt1 * et1;
        }
        *(u32*)(sKT + d0 * 72 + w * 16 + ii) = pack2(ke0[0], ke0[1]);
        *(u32*)(sKT + (d0 + 1) * 72 + w * 16 + ii) = pack2(ke1[0], ke1[1]);
      }
    }
    __syncthreads();
    u16* sP = sK;
    if (pass == 2) {
      f32x4 accP[2][2];
#pragma unroll
      for (int m = 0; m < 2; m++)
#pragma unroll
        for (int n = 0; n < 2; n++) accP[m][n] = f32x4{0.f, 0.f, 0.f, 0.f};
      mma_nt<2, 2, 4>(accP, sQ + wr * 32 * 136, 136, sK + wc * 32 * 136, 136, lane);
      __syncthreads();
#pragma unroll
      for (int m = 0; m < 2; m++)
#pragma unroll
        for (int n = 0; n < 2; n++)
#pragma unroll
          for (int j = 0; j < 4; j++) {
            int i = wr * 32 + m * 16 + fq * 4 + j, jj = wc * 32 + n * 16 + fr;
            sP[i * 72 + jj] = (i >= jj) ? f2b(accP[m][n][j]) : (u16)0;
          }
    }
#pragma unroll
    for (int s = 0; s < 2; s++) {
      if (pass == 2) {
#pragma unroll
        for (int m = 0; m < 2; m++)
#pragma unroll
          for (int n = 0; n < 4; n++)
#pragma unroll
            for (int j = 0; j < 4; j++) sST[(wr * 32 + m * 16 + fq * 4 + j) * 136 + wc * 64 + n * 16 + fr] = f2b(accS[s][m][n][j]);
      }
      {
        uint4 v0 = make_uint4(vreg[s][0] | (vreg[s][1] << 16), vreg[s][2] | (vreg[s][3] << 16), vreg[s][4] | (vreg[s][5] << 16),
                              vreg[s][6] | (vreg[s][7] << 16));
        uint4 v1 = make_uint4(vreg[s][8] | (vreg[s][9] << 16), vreg[s][10] | (vreg[s][11] << 16), vreg[s][12] | (vreg[s][13] << 16),
                              vreg[s][14] | (vreg[s][15] << 16));
        *(uint4*)(sVT + lane * 72 + w * 16) = v0;
        *(uint4*)(sVT + lane * 72 + w * 16 + 8) = v1;
      }
      __syncthreads();
      if (pass == 2) {
        f32x4 accO[2][2];
#pragma unroll
        for (int m = 0; m < 2; m++)
#pragma unroll
          for (int n = 0; n < 2; n++) accO[m][n] = f32x4{0.f, 0.f, 0.f, 0.f};
        mma_nt<2, 2, 4>(accO, sQ + wr * 32 * 136, 136, sST + wc * 32 * 136, 136, lane);
        mma_nt<2, 2, 2>(accO, sP + wr * 32 * 72, 72, sVT + wc * 32 * 72, 72, lane);
#pragma unroll
        for (int m = 0; m < 2; m++)
#pragma unroll
          for (int j = 0; j < 4; j++) {
            int i = wr * 32 + m * 16 + fq * 4 + j;
            int f = c * 64 + i;
            int pos = dir ? (SEQ - 1 - f) : f;
            size_t o = (size_t)(b * SEQ + pos) * 1024 + h * 256 + dvp * 128 + s * 64 + wc * 32 + fr;
#pragma unroll
            for (int n = 0; n < 2; n++) obuf[o + n * 16] = f2b(accO[m][n][j]);
          }
      }
#pragma unroll
      for (int n = 0; n < 4; n++) {
        float dc = sDec[wc * 64 + n * 16 + fr];
#pragma unroll
        for (int m = 0; m < 2; m++)
#pragma unroll
          for (int j = 0; j < 4; j++) accS[s][m][n][j] *= dc;
      }
      mma_nt<2, 4, 2>(accS[s], sVT + wr * 32 * 72, 72, sKT + wc * 64 * 72, 72, lane);
      if (s == 0) __syncthreads();
    }
  }
  if (pass == 1) {
#pragma unroll
    for (int s = 0; s < 2; s++)
#pragma unroll
      for (int m = 0; m < 2; m++)
#pragma unroll
        for (int n = 0; n < 4; n++)
#pragma unroll
          for (int j = 0; j < 4; j++) Lp[(s * 64 + wr * 32 + m * 16 + fq * 4 + j) * 128 + wc * 64 + n * 16 + fr] = accS[s][m][n][j];
    if (dvp == 0 && w == 0) {
      p.Dd[(bhd * 16 + seg) * 128 + d0] = __expf(dsum0);
      p.Dd[(bhd * 16 + seg) * 128 + d0 + 1] = __expf(dsum1);
    }
  }
}

__device__ void phase2(const Params& p, char* smem, const XcdBarrier& xb) {
  const int t = threadIdx.x;
  (void)xb;
  u16* ya = (u16*)p.out + (size_t)BT * 1024;
  for (int job = blockIdx.x; job < 512 + 2048; job += gridDim.x) {
    if (job < 512) {
      gla_item(p, job, 1, smem);
    } else {
      const int j = job - 512;
      const int ch = (t & 127) * 8;
      float w0[8], w1[8], w2[8], cb[8];
#pragma unroll
      for (int e = 0; e < 8; e++) { w0[e] = p.conv_w[ch + e]; w1[e] = p.conv_w[1024 + ch + e]; w2[e] = p.conv_w[2048 + ch + e]; cb[e] = p.conv_b[ch + e]; }
#pragma unroll
      for (int it = 0; it < 4; it++) {
        const int tok = j * 8 + it * 2 + (t >> 7);
        const int pos = tok & (SEQ - 1);
        const size_t o = (size_t)tok * 1024 + ch;
        uint4 pc = *(const uint4*)(p.R1 + o);
        uint4 pp = make_uint4(0, 0, 0, 0), pn = make_uint4(0, 0, 0, 0);
        if (pos > 0) pp = *(const uint4*)(p.R1 + o - 1024);
        if (pos < SEQ - 1) pn = *(const uint4*)(p.R1 + o + 1024);
        uint4 bb = *(const uint4*)(p.R2 + o);
        const u32 pcs[4] = {pc.x, pc.y, pc.z, pc.w}, pps[4] = {pp.x, pp.y, pp.z, pp.w}, pns[4] = {pn.x, pn.y, pn.z, pn.w},
                  bbs[4] = {bb.x, bb.y, bb.z, bb.w};
        u32 ov[4];
#pragma unroll
        for (int q = 0; q < 4; q++) {
          float y0 = cb[2 * q] + w0[2 * q] * blo(pps[q]) + w1[2 * q] * blo(pcs[q]) + w2[2 * q] * blo(pns[q]);
          float y1 = cb[2 * q + 1] + w0[2 * q + 1] * bhi(pps[q]) + w1[2 * q + 1] * bhi(pcs[q]) + w2[2 * q + 1] * bhi(pns[q]);
          ov[q] = pack2(blo(bbs[q]) * y0, bhi(bbs[q]) * y1);
        }
        *(uint4*)(ya + o) = make_uint4(ov[0], ov[1], ov[2], ov[3]);
      }
    }
  }
}

__device__ void phase3(const Params& p) {
  for (int gid = blockIdx.x * 256 + threadIdx.x; gid < 16 * 8192; gid += gridDim.x * 256) {
    const int bhd = gid >> 13, e = (gid & 8191) * 4, dk = e & 127;
    float4 carry = make_float4(0.f, 0.f, 0.f, 0.f);
    for (int s = 0; s < 16; s++) {
      float4* lp = (float4*)(p.R7 + (size_t)(bhd * 16 + s) * 32768 + e);
      const float4 tmp = *lp;
      const float4 d = *(const float4*)(p.Dd + (bhd * 16 + s) * 128 + dk);
      *lp = carry;
      carry = make_float4(d.x * carry.x + tmp.x, d.y * carry.y + tmp.y, d.z * carry.z + tmp.z, d.w * carry.w + tmp.w);
    }
  }
}

__device__ void phase5(const Params& p) {
  const int t = threadIdx.x, lane = t & 63, w = t >> 6;
  float gv[2][8];
#pragma unroll
  for (int i = 0; i < 2; i++) {
    const float4 g0 = *(const float4*)(p.gng + i * 512 + lane * 8), g1 = *(const float4*)(p.gng + i * 512 + lane * 8 + 4);
    gv[i][0] = g0.x; gv[i][1] = g0.y; gv[i][2] = g0.z; gv[i][3] = g0.w; gv[i][4] = g1.x; gv[i][5] = g1.y; gv[i][6] = g1.z; gv[i][7] = g1.w;
  }
  for (int tok = blockIdx.x * 4 + w; tok < BT; tok += gridDim.x * 4) {
    const size_t o = (size_t)tok * 1024 + lane * 8;
    uint4 a[2], b[2], r[2];
#pragma unroll
    for (int i = 0; i < 2; i++) { a[i] = *(const uint4*)(p.R1 + o + i * 512); b[i] = *(const uint4*)(p.R2 + o + i * 512); r[i] = *(const uint4*)(p.R5 + o + i * 512); }
#pragma unroll
    for (int i = 0; i < 2; i++) {
      const u32 aw[4] = {a[i].x, a[i].y, a[i].z, a[i].w}, bw[4] = {b[i].x, b[i].y, b[i].z, b[i].w}, rw[4] = {r[i].x, r[i].y, r[i].z, r[i].w};
      float ov[8];
      float ss = 0.f;
#pragma unroll
      for (int q = 0; q < 4; q++) {
        ov[2 * q] = blo(aw[q]) + blo(bw[q]);
        ov[2 * q + 1] = bhi(aw[q]) + bhi(bw[q]);
        ss += ov[2 * q] * ov[2 * q] + ov[2 * q + 1] * ov[2 * q + 1];
      }
      ss += __shfl_xor(ss, 1); ss += __shfl_xor(ss, 2); ss += __shfl_xor(ss, 4); ss += __shfl_xor(ss, 8); ss += __shfl_xor(ss, 16);
      const float rstd = rsqrtf(ss * (1.f / 256.f) + 1e-6f);
      u32 ow[4];
#pragma unroll
      for (int q = 0; q < 4; q++) {
        const float ra = blo(rw[q]), rb = bhi(rw[q]);
        ow[q] = pack2(ov[2 * q] * rstd * gv[i][2 * q] * (ra * sigmoidf_(ra)), ov[2 * q + 1] * rstd * gv[i][2 * q + 1] * (rb * sigmoidf_(rb)));
      }
      *(uint4*)(p.R6 + o + i * 512) = make_uint4(ow[0], ow[1], ow[2], ow[3]);
    }
  }
}

__device__ void phase6(const Params& p, char* smem) {
  const int t = threadIdx.x, lane = t & 63, w = t >> 6, wr = w >> 1, wc = w & 1, fr = lane & 15, fq = lane >> 4;
  const u16* xn = (const u16*)p.out;
  const u16* ya = xn + (size_t)BT * 1024;
  uint4* sG = (uint4*)((char*)p.R2 + (size_t)blockIdx.x * 65536 + t * 256);
  uint4* sH = sG + 8;
  TileIter ti(8);
  int mt, nt;
  while (ti.next(mt, nt)) {
    const int colb = nt * 128 + wc * 64 + fq * 4;
    f32x4 acc[4][4];
    zero_acc(acc);
    gemm_acc_db(acc, xn + (size_t)mt * 128 * 1024, 1024, p.WinT + (size_t)(6272 + nt * 128) * 1024, 1024, 1024, smem);
    {
      float4 gb[4];
#pragma unroll
      for (int n = 0; n < 4; n++) gb[n] = *(const float4*)(p.gbias + colb + n * 16);
#pragma unroll
      for (int m = 0; m < 4; m++)
#pragma unroll
        for (int h = 0; h < 2; h++)
          sG[m * 2 + h] = make_uint4(pack2(sigmoidf_(acc[m][2 * h][0] + gb[2 * h].x), sigmoidf_(acc[m][2 * h][1] + gb[2 * h].y)),
                                     pack2(sigmoidf_(acc[m][2 * h][2] + gb[2 * h].z), sigmoidf_(acc[m][2 * h][3] + gb[2 * h].w)),
                                     pack2(sigmoidf_(acc[m][2 * h + 1][0] + gb[2 * h + 1].x), sigmoidf_(acc[m][2 * h + 1][1] + gb[2 * h + 1].y)),
                                     pack2(sigmoidf_(acc[m][2 * h + 1][2] + gb[2 * h + 1].z), sigmoidf_(acc[m][2 * h + 1][3] + gb[2 * h + 1].w)));
    }
    zero_acc(acc);
    gemm_acc_db(acc, ya + (size_t)mt * 128 * 1024, 1024, p.WaT + (size_t)nt * 128 * 1024, 1024, 1024, smem);
#pragma unroll
    for (int m = 0; m < 4; m++)
#pragma unroll
      for (int h = 0; h < 2; h++) {
        const uint4 g = sG[m * 2 + h];
        sG[m * 2 + h] = make_uint4(pack2(acc[m][2 * h][0] * blo(g.x), acc[m][2 * h][1] * bhi(g.x)),
                                   pack2(acc[m][2 * h][2] * blo(g.y), acc[m][2 * h][3] * bhi(g.y)),
                                   pack2(acc[m][2 * h + 1][0] * blo(g.z), acc[m][2 * h + 1][1] * bhi(g.z)),
                                   pack2(acc[m][2 * h + 1][2] * blo(g.w), acc[m][2 * h + 1][3] * bhi(g.w)));
      }
    zero_acc(acc);
    gemm_acc_db(acc, p.R6 + (size_t)mt * 128 * 1024, 1024, p.WbT + (size_t)nt * 128 * 1024, 1024, 1024, smem);
#pragma unroll
    for (int m = 0; m < 4; m++)
#pragma unroll
      for (int h = 0; h < 2; h++)
        sH[m * 2 + h] = make_uint4(pack2(acc[m][2 * h][0], acc[m][2 * h][1]), pack2(acc[m][2 * h][2], acc[m][2 * h][3]),
                                   pack2(acc[m][2 * h + 1][0], acc[m][2 * h + 1][1]), pack2(acc[m][2 * h + 1][2], acc[m][2 * h + 1][3]));
    zero_acc(acc);
    gemm_acc_db(acc, xn + (size_t)mt * 128 * 1024, 1024, p.WinT + (size_t)(6272 + 1024 + nt * 128) * 1024, 1024, 1024, smem);
    const int rowb = mt * 128 + wr * 64 + fr;
    {
      float4 gb[4];
#pragma unroll
      for (int n = 0; n < 4; n++) gb[n] = *(const float4*)(p.gbias + 1024 + colb + n * 16);
#pragma unroll
      for (int m = 0; m < 4; m++)
#pragma unroll
        for (int h = 0; h < 2; h++) {
          const uint4 a = sG[m * 2 + h], b = sH[m * 2 + h];
          const u32 av[4] = {a.x, a.y, a.z, a.w}, bv[4] = {b.x, b.y, b.z, b.w};
#pragma unroll
          for (int nn = 0; nn < 2; nn++) {
            const int n = 2 * h + nn;
            float r0 = blo(av[nn * 2]) + blo(bv[nn * 2]) * sigmoidf_(acc[m][n][0] + gb[n].x);
            float r1 = bhi(av[nn * 2]) + bhi(bv[nn * 2]) * sigmoidf_(acc[m][n][1] + gb[n].y);
            float r2 = blo(av[nn * 2 + 1]) + blo(bv[nn * 2 + 1]) * sigmoidf_(acc[m][n][2] + gb[n].z);
            float r3 = bhi(av[nn * 2 + 1]) + bhi(bv[nn * 2 + 1]) * sigmoidf_(acc[m][n][3] + gb[n].w);
            *(uint2*)(p.R1 + (size_t)(rowb + m * 16) * 1024 + colb + n * 16) = make_uint2(pack2(r0, r1), pack2(r2, r3));
          }
        }
    }
  }
}

__device__ void phase7(const Params& p, char* smem) {
  u16* sA = (u16*)smem;
  u16* sB = sA + 128 * 64;
  const int t = threadIdx.x, lane = t & 63, w = t >> 6, wr = w >> 1, wc = w & 1, fr = lane & 15, fq = lane >> 4;
  float* x1 = (float*)p.R2;
  TileIter ti(8);
  int mt, nt;
  while (ti.next(mt, nt)) {
    f32x4 acc[4][4];
    zero_acc(acc);
    gemm_acc_db(acc, p.R1 + (size_t)mt * 128 * 1024, 1024, p.WoT + (size_t)nt * 128 * 1024, 1024, 1024, smem);
    const int rowb = mt * 128 + wr * 64 + fr;
    const int colb = nt * 128 + wc * 64 + fq * 4;
#pragma unroll
    for (int m = 0; m < 4; m++)
#pragma unroll
      for (int n = 0; n < 4; n++) {
        const size_t o = (size_t)(rowb + m * 16) * 1024 + colb + n * 16;
        const float4 xv = *(const float4*)(p.x + o);
        *(float4*)(x1 + o) = make_float4(xv.x + acc[m][n][0], xv.y + acc[m][n][1], xv.z + acc[m][n][2], xv.w + acc[m][n][3]);
      }
  }
}

constexpr float U_SCALE = 256.f, V_SCALE = 64.f;
__device__ __forceinline__ u32 enc_fp8x4(float a, float b, float c, float d) {
  int w = __builtin_amdgcn_cvt_pk_fp8_f32(a, b, 0, false);
  w = __builtin_amdgcn_cvt_pk_fp8_f32(c, d, w, true);
  return (u32)w;
}
__device__ __forceinline__ void table_convert_job(const Params& p, int j, int t) {
  unsigned char* Tb = (unsigned char*)p.R5;
  const float* src = (j < 4096) ? p.pu : p.pv;
  const float sc = (j < 4096) ? U_SCALE : V_SCALE;
  const size_t jb = (size_t)(j & 4095) * 4096;
  float4 v[4];
#pragma unroll
  for (int i = 0; i < 4; i++) v[i] = *(const float4*)(src + jb + i * 1024 + t * 4);
#pragma unroll
  for (int i = 0; i < 4; i++) {
    const size_t row = (jb >> 10) + i;
    *(u32*)(Tb + row * 2048 + ((j < 4096) ? 0 : 1024) + t * 4) = enc_fp8x4(v[i].x * sc, v[i].y * sc, v[i].z * sc, v[i].w * sc);
  }
}
__device__ void phase8(const Params& p) {
  const int t = threadIdx.x, lane = t & 63, w = t >> 6;
  const float* x1 = (const float*)p.R2;
  for (int job = blockIdx.x; job < 4096; job += gridDim.x) {
    int row = job * 4 + w;
    rms_row(x1 + (size_t)row * 1024, p.norm2_g, p.R4 + (size_t)row * 1024, lane);
  }
}

__device__ void phase9(const Params& p, char* smem) {
  u16* sA = (u16*)smem;
  u16* sB = sA + 128 * 64;
  const int t = threadIdx.x, lane = t & 63, w = t >> 6, wr = w >> 1, wc = w & 1, fr = lane & 15, fq = lane >> 4;
  u16* q = (u16*)p.out;
  TileIter ti(16);
  int mt, nt;
  while (ti.next(mt, nt)) {
    f32x4 acc[4][4];
    zero_acc(acc);
    gemm_acc_db(acc, p.R4 + (size_t)mt * 128 * 1024, 1024, p.WqT + (size_t)nt * 128 * 1024, 1024, 1024, smem);
    const int rowb = mt * 128 + wr * 64 + fr;
    const int colb = nt * 128 + wc * 64 + fq * 4;
#pragma unroll
    for (int m = 0; m < 4; m++)
#pragma unroll
      for (int n = 0; n < 4; n++)
        *(uint2*)(q + (size_t)(rowb + m * 16) * 2048 + colb + n * 16) = make_uint2(pack2(acc[m][n][0], acc[m][n][1]), pack2(acc[m][n][2], acc[m][n][3]));
#pragma unroll 1
    for (int r = 0; r < 4; r++) table_convert_job(p, (mt * 16 + nt) * 4 + r, t);
  }
}

__device__ __forceinline__ void select16q(u32* rowbase, int part, u32 (&tk)[16], unsigned char* idxp) {
  u32* myp = rowbase + part * 32;
#pragma unroll
  for (int it = 0; it < 16; it++) {
    u32 m = 0;
#pragma unroll
    for (int c = 0; c < 8; c++) {
      uint4 kk = *(const uint4*)(myp + c * 4);
      m = max(m, max(max(kk.x, kk.y), max(kk.z, kk.w)));
    }
    m = max(m, (u32)__shfl_xor((int)m, 1));
    m = max(m, (u32)__shfl_xor((int)m, 2));
    tk[it] = m;
    const int idx = 127 - (int)(m & 127u);
    if ((idx >> 5) == part) { rowbase[idx] = 0; idxp[it] = (unsigned char)idx; }
  }
}

__device__ void phase10(const Params& p, char* smem) {
  u16* sKeys = (u16*)smem;
  u32* sSc = (u32*)(smem + 128 * 136 * 2);
  unsigned char* sIdx = (unsigned char*)(smem + 128 * 136 * 2 + 64 * 132 * 4);
  const int t = threadIdx.x, lane = t & 63, w = t >> 6, fr = lane & 15, fq = lane >> 4;
  const int rl = lane >> 2, part = lane & 3, row = w * 16 + rl;
  const u16* q = (const u16*)p.out;
  int* experts = (int*)p.R7;
  float* gates = p.R7 + (size_t)BT * 128;
#define P10_DECL(S) uint4 S##k0, S##k1, S##k2, S##k3, S##k4, S##k5, S##k6, S##k7; bf16x8 S##q0, S##q1, S##q2, S##q3
#define P10_LOAD(S, ITEM, PP)                                                                               \
  do {                                                                                                      \
    const int it_ = ((ITEM) < 256 * 8) ? (ITEM) : (int)blockIdx.x;                                          \
    const int tt_ = it_ >> 3, h_ = it_ & 7;                                                                 \
    const u16* ks_ = p.KeysB + (size_t)(h_ * 2 + (PP)) * 128 * 128 + (t >> 4) * 128 + (t & 15) * 8;         \
    S##k0 = *(const uint4*)(ks_); S##k1 = *(const uint4*)(ks_ + 16 * 128); S##k2 = *(const uint4*)(ks_ + 32 * 128);   \
    S##k3 = *(const uint4*)(ks_ + 48 * 128); S##k4 = *(const uint4*)(ks_ + 64 * 128); S##k5 = *(const uint4*)(ks_ + 80 * 128); \
    S##k6 = *(const uint4*)(ks_ + 96 * 128); S##k7 = *(const uint4*)(ks_ + 112 * 128);                      \
    const u16* qp_ = q + (size_t)(tt_ * 64 + w * 16 + fr) * 2048 + h_ * 256 + (PP) * 128 + fq * 8;          \
    S##q0 = *(const bf16x8*)(qp_); S##q1 = *(const bf16x8*)(qp_ + 32); S##q2 = *(const bf16x8*)(qp_ + 64);  \
    S##q3 = *(const bf16x8*)(qp_ + 96);                                                                     \
  } while (0)
#define P10_MFMA_K(QK, KI)                                                                                  \
  _Pragma("unroll") for (int n_ = 0; n_ < 8; n_++) {                                                        \
    bf16x8 bv_ = *(const bf16x8*)(sKeys + (n_ * 16 + fr) * 136 + (KI) * 32 + fq * 8);                       \
    acc_[n_] = __builtin_amdgcn_mfma_f32_16x16x32_bf16(QK, bv_, acc_[n_], 0, 0, 0);                         \
  }
#define P10_SCORE(S)                                                                                        \
  do {                                                                                                      \
    __syncthreads();                                                                                        \
    u16* kd_ = sKeys + (t >> 4) * 136 + (t & 15) * 8;                                                       \
    *(uint4*)(kd_) = S##k0; *(uint4*)(kd_ + 16 * 136) = S##k1; *(uint4*)(kd_ + 32 * 136) = S##k2;           \
    *(uint4*)(kd_ + 48 * 136) = S##k3; *(uint4*)(kd_ + 64 * 136) = S##k4; *(uint4*)(kd_ + 80 * 136) = S##k5; \
    *(uint4*)(kd_ + 96 * 136) = S##k6; *(uint4*)(kd_ + 112 * 136) = S##k7;                                  \
    __syncthreads();                                                                                        \
    f32x4 acc_[8];                                                                                          \
    _Pragma("unroll") for (int n_ = 0; n_ < 8; n_++) acc_[n_] = f32x4{0.f, 0.f, 0.f, 0.f};                  \
    P10_MFMA_K(S##q0, 0) P10_MFMA_K(S##q1, 1) P10_MFMA_K(S##q2, 2) P10_MFMA_K(S##q3, 3)                     \
    _Pragma("unroll") for (int n_ = 0; n_ < 8; n_++)                                                        \
      _Pragma("unroll") for (int j_ = 0; j_ < 4; j_++) {                                                    \
        int r_ = w * 16 + fq * 4 + j_, col_ = n_ * 16 + fr;                                                 \
        sSc[r_ * 132 + col_] = (ordf(acc_[n_][j_]) & ~127u) | (u32)(127 - col_);                            \
      }                                                                                                     \
    __syncthreads();                                                                                        \
  } while (0)
  P10_DECL(sa);
  P10_DECL(sb);
  P10_LOAD(sa, (int)blockIdx.x, 0);
  for (int item = blockIdx.x; item < 256 * 8; item += gridDim.x) {
    const int tt = item >> 3, h = item & 7;
    u32 ta[16], tb[16];
    P10_SCORE(sa);
    P10_LOAD(sb, item, 1);
    select16q(sSc + row * 132, part, ta, sIdx + row * 32);
    P10_SCORE(sb);
    P10_LOAD(sa, item + (int)gridDim.x, 0);
    select16q(sSc + row * 132, part, tb, sIdx + row * 32 + 16);
    __syncthreads();
    {
      float fa[4], fb[16];
#pragma unroll
      for (int r = 0; r < 4; r++) {
        const u32 s0 = ta[4 * r], s1 = ta[4 * r + 1], s2 = ta[4 * r + 2], s3 = ta[4 * r + 3];
        const u32 sel = part == 0 ? s0 : (part == 1 ? s1 : (part == 2 ? s2 : s3));
        fa[r] = unordf(sel & ~127u);
      }
#pragma unroll
      for (int j = 0; j < 16; j++) fb[j] = unordf(tb[j] & ~127u);
      constexpr int NJ[4] = {16, 3, 1, 1};
      u32 cand[4][16];
#pragma unroll
      for (int r = 0; r < 4; r++) {
        const int irow = part + 4 * r;
        const int jlim = 16 / (irow + 1);
#pragma unroll
        for (int j = 0; j < 16; j++)
          if (j < NJ[r]) cand[r][j] = (j < jlim) ? ((ordf(fa[r] + fb[j]) & ~255u) | (u32)(255 - (irow * 16 + j))) : 0u;
      }
      const int tok = tt * 64 + row;
      float sv[16];
      int ev[16];
#pragma unroll
      for (int it = 0; it < 16; it++) {
        u32 m = 0;
#pragma unroll
        for (int r = 0; r < 4; r++)
#pragma unroll
          for (int j = 0; j < 16; j++)
            if (j < NJ[r]) m = max(m, cand[r][j]);
        m = max(m, (u32)__shfl_xor((int)m, 1));
        m = max(m, (u32)__shfl_xor((int)m, 2));
#pragma unroll
        for (int r = 0; r < 4; r++)
#pragma unroll
          for (int j = 0; j < 16; j++)
            if (j < NJ[r]) cand[r][j] = (cand[r][j] == m) ? 0u : cand[r][j];
        const int c = 255 - (int)(m & 255u);
        const int i1 = sIdx[row * 32 + (c >> 4)], i2 = sIdx[row * 32 + 16 + (c & 15)];
        ev[it] = i1 * 128 + i2;
        sv[it] = unordf(m & ~255u);
      }
      const float mx = sv[0];
      float sum = 0.f;
#pragma unroll
      for (int it = 0; it < 16; it++) { sv[it] = __expf(sv[it] - mx); sum += sv[it]; }
      const float inv = 1.f / sum;
#pragma unroll
      for (int g = 0; g < 4; g++) {
        if (part == g) {
          *(int4*)(experts + (size_t)tok * 128 + h * 16 + g * 4) = make_int4(ev[g * 4], ev[g * 4 + 1], ev[g * 4 + 2], ev[g * 4 + 3]);
          *(float4*)(gates + (size_t)tok * 128 + h * 16 + g * 4) =
              make_float4(sv[g * 4] * inv, sv[g * 4 + 1] * inv, sv[g * 4 + 2] * inv, sv[g * 4 + 3] * inv);
        }
      }
    }
  }
}

#undef P10_LOAD
#undef P10_SCORE
#undef P10_MFMA_K
#undef P10_DECL
typedef float f32x2 __attribute__((ext_vector_type(2)));
__device__ __forceinline__ void dec16(const uint4& q, float (&o)[16]) {
  const u32 ws_[4] = {q.x, q.y, q.z, q.w};
#pragma unroll
  for (int i = 0; i < 4; i++) {
    f32x2 lo = __builtin_amdgcn_cvt_pk_f32_fp8((int)ws_[i], false);
    f32x2 hi = __builtin_amdgcn_cvt_pk_f32_fp8((int)ws_[i], true);
    o[i * 4 + 0] = lo[0]; o[i * 4 + 1] = lo[1]; o[i * 4 + 2] = hi[0]; o[i * 4 + 3] = hi[1];
  }
}
__device__ __forceinline__ void peer_load8(uint4 (&U)[8], uint4 (&V)[8], const unsigned char* Ub, const unsigned char* Vb, int ev, int l0,
                                           int lane) {
#pragma unroll
  for (int u = 0; u < 8; u++) {
    const int e = __builtin_amdgcn_readlane(ev, l0 + u);
    U[u] = *(const uint4*)(Ub + (size_t)e * 2048 + lane * 16);
    V[u] = *(const uint4*)(Vb + (size_t)e * 2048 + lane * 16);
  }
}
__device__ __forceinline__ void peer_proc8(const uint4 (&U)[8], const uint4 (&V)[8], const f32x2 (&xp)[8], f32x2 (&accp)[8], float gate_lane,
                                           int lane) {
  float d[8];
#pragma unroll
  for (int u = 0; u < 8; u++) {
    const u32 ws_[4] = {U[u].x, U[u].y, U[u].z, U[u].w};
    f32x2 s = {0.f, 0.f};
#pragma unroll
    for (int q = 0; q < 4; q++) {
      s += xp[2 * q] * __builtin_amdgcn_cvt_pk_f32_fp8((int)ws_[q], false);
      s += xp[2 * q + 1] * __builtin_amdgcn_cvt_pk_f32_fp8((int)ws_[q], true);
    }
    d[u] = s[0] + s[1];
  }
  {
    const bool b4 = (lane & 4) != 0, b2 = (lane & 2) != 0, b1 = (lane & 1) != 0;
#pragma unroll
    for (int i = 0; i < 4; i++) {
      const float send = b4 ? d[i] : d[i + 4], keep = b4 ? d[i + 4] : d[i];
      d[i] = keep + __shfl_xor(send, 4);
    }
#pragma unroll
    for (int i = 0; i < 2; i++) {
      const float send = b2 ? d[i] : d[i + 2], keep = b2 ? d[i + 2] : d[i];
      d[i] = keep + __shfl_xor(send, 2);
    }
    {
      const float send = b1 ? d[0] : d[1], keep = b1 ? d[1] : d[0];
      d[0] = keep + __shfl_xor(send, 1);
    }
    d[0] += __shfl_xor(d[0], 8);
    d[0] += __shfl_xor(d[0], 16);
    d[0] += __shfl_xor(d[0], 32);
  }
  const float dd = d[0] * (1.f / U_SCALE);
  const float hd = 0.5f * dd * (1.f + erff(dd * 0.70710678118654752f));
  const int cl = __float_as_int(hd * gate_lane * (1.f / V_SCALE));
#pragma unroll
  for (int u = 0; u < 8; u++) {
    const float c = __int_as_float(__builtin_amdgcn_readlane(cl, u));
    const f32x2 c2 = {c, c};
    const u32 ws_[4] = {V[u].x, V[u].y, V[u].z, V[u].w};
#pragma unroll
    for (int q = 0; q < 4; q++) {
      accp[2 * q] += c2 * __builtin_amdgcn_cvt_pk_f32_fp8((int)ws_[q], false);
      accp[2 * q + 1] += c2 * __builtin_amdgcn_cvt_pk_f32_fp8((int)ws_[q], true);
    }
  }
}
__device__ __forceinline__ float dot16_fp8(const f32x2 (&xp)[8], const uint4& q) {
  const u32 ws_[4] = {q.x, q.y, q.z, q.w};
  f32x2 s = {0.f, 0.f};
#pragma unroll
  for (int i = 0; i < 4; i++) {
    s += xp[2 * i] * __builtin_amdgcn_cvt_pk_f32_fp8((int)ws_[i], false);
    s += xp[2 * i + 1] * __builtin_amdgcn_cvt_pk_f32_fp8((int)ws_[i], true);
  }
  return s[0] + s[1];
}
__device__ __forceinline__ void pe_load_tab(const unsigned char* Tb, unsigned loff, int e0, int e1, int g, uint4 (&U)[16]) {
#pragma unroll
  for (int kb = 0; kb < 16; kb++) {
    const int e = __shfl((kb < 8) ? e0 : e1, (kb & 7) * 8 + g);
    U[kb] = *(const uint4*)(Tb + ((unsigned)e * 2048u + loff));
  }
}
__device__ __forceinline__ void pe_load_x(const u16* xr, f32x2 (&xp)[8]) {
  uint4 a = *(const uint4*)(xr), b = *(const uint4*)(xr + 8);
  xp[0] = f32x2{blo(a.x), bhi(a.x)}; xp[1] = f32x2{blo(a.y), bhi(a.y)}; xp[2] = f32x2{blo(a.z), bhi(a.z)}; xp[3] = f32x2{blo(a.w), bhi(a.w)};
  xp[4] = f32x2{blo(b.x), bhi(b.x)}; xp[5] = f32x2{blo(b.y), bhi(b.y)}; xp[6] = f32x2{blo(b.z), bhi(b.z)}; xp[7] = f32x2{blo(b.w), bhi(b.w)};
}
__device__ __forceinline__ void pe_dot_store(const f32x2 (&xp)[8], const uint4 (&U)[16], float* pr, int lane, int r) {
  float d[16];
#pragma unroll
  for (int kb = 0; kb < 16; kb++) d[kb] = dot16_fp8(xp, U[kb]);
  const bool b4 = (lane & 4) != 0, b2 = (lane & 2) != 0, b1 = (lane & 1) != 0;
#pragma unroll
  for (int i = 0; i < 8; i++) { const float send = b4 ? d[i] : d[i + 8], keep = b4 ? d[i + 8] : d[i]; d[i] = keep + __shfl_xor(send, 4); }
#pragma unroll
  for (int i = 0; i < 4; i++) { const float send = b2 ? d[i] : d[i + 4], keep = b2 ? d[i + 4] : d[i]; d[i] = keep + __shfl_xor(send, 2); }
#pragma unroll
  for (int i = 0; i < 2; i++) { const float send = b1 ? d[i] : d[i + 2], keep = b1 ? d[i + 2] : d[i]; d[i] = keep + __shfl_xor(send, 1); }
  pr[(2 * r) * 8] = d[0];
  pr[(2 * r + 1) * 8] = d[1];
}
__device__ void phase11a(const Params& p) {
  const int t = threadIdx.x, lane = t & 63, w = t >> 6, g = lane >> 3, r = lane & 7;
  const int s = blockIdx.x & 7, jb = blockIdx.x >> 3, ns = (gridDim.x - s + 7) >> 3;
  const u16* xn2 = p.R4 + s * 128 + r * 16;
  const unsigned char* Tb = (const unsigned char*)p.R5 + s * 128;
  const unsigned loff = r * 16;
  const int* experts = (const int*)p.R7 + lane;
  float* part = p.out + (size_t)s * BT * 128 + g;
  const int first = jb * 4 + w, stride = ns * 4;
  if (first >= BT) return;
#define TOKC(T) (((T) < BT) ? (T) : first)
  int eA0, eA1, eB0, eB1;
  uint4 UA[16], UB[16];
  f32x2 xA[8], xB[8];
  eA0 = experts[(size_t)first * 128]; eA1 = experts[(size_t)first * 128 + 64];
  pe_load_tab(Tb, loff, eA0, eA1, g, UA);
  pe_load_x(xn2 + (size_t)first * 1024, xA);
  { const int t1 = TOKC(first + stride); eB0 = experts[(size_t)t1 * 128]; eB1 = experts[(size_t)t1 * 128 + 64]; }
#pragma unroll 1
  for (int tok = first; tok < BT; tok += 2 * stride) {
    const int t1 = tok + stride, t2 = tok + 2 * stride, t3 = tok + 3 * stride;
    pe_load_tab(Tb, loff, eB0, eB1, g, UB);
    pe_load_x(xn2 + (size_t)TOKC(t1) * 1024, xB);
    { const int tc = TOKC(t2); eA0 = experts[(size_t)tc * 128]; eA1 = experts[(size_t)tc * 128 + 64]; }
    pe_dot_store(xA, UA, part + (size_t)tok * 128, lane, r);
    pe_load_tab(Tb, loff, eA0, eA1, g, UA);
    pe_load_x(xn2 + (size_t)TOKC(t2) * 1024, xA);
    { const int tc = TOKC(t3); eB0 = experts[(size_t)tc * 128]; eB1 = experts[(size_t)tc * 128 + 64]; }
    if (t1 < BT) pe_dot_store(xB, UB, part + (size_t)t1 * 128, lane, r);
  }
}

__device__ void phase11r(const Params& p) {
  float* gates = p.R7 + (size_t)BT * 128;
  const float* part = p.out;
  for (int idx = blockIdx.x * 256 + threadIdx.x; idx < BT * 128 / 4; idx += gridDim.x * 256) {
    float4 h = *(const float4*)(part + (size_t)idx * 4);
#pragma unroll
    for (int ss = 1; ss < 8; ss++) {
      const float4 q = *(const float4*)(part + (size_t)ss * BT * 128 + (size_t)idx * 4);
      h.x += q.x; h.y += q.y; h.z += q.z; h.w += q.w;
    }
    float4 gt = *(const float4*)(gates + (size_t)idx * 4);
    const float hv[4] = {h.x * (1.f / U_SCALE), h.y * (1.f / U_SCALE), h.z * (1.f / U_SCALE), h.w * (1.f / U_SCALE)};
    const float gv[4] = {gt.x, gt.y, gt.z, gt.w};
    float c[4];
#pragma unroll
    for (int q = 0; q < 4; q++) c[q] = 0.5f * hv[q] * (1.f + erff(hv[q] * 0.70710678118654752f)) * gv[q] * (1.f / V_SCALE);
    *(float4*)(gates + (size_t)idx * 4) = make_float4(c[0], c[1], c[2], c[3]);
  }
}

struct PeTok { int e0, e1; float g0, g1; };
__device__ __forceinline__ PeTok pe_load_tok(const int* experts, const float* gates, int tok) {
  PeTok k;
  k.e0 = experts[(size_t)tok * 128]; k.e1 = experts[(size_t)tok * 128 + 64];
  k.g0 = gates[(size_t)tok * 128]; k.g1 = gates[(size_t)tok * 128 + 64];
  return k;
}
__device__ __forceinline__ void pe_value_store(const PeTok& k, const uint4 (&V)[16], u16* drow, int lane, int g) {
  const float c0 = k.g0, c1 = k.g1;
  f32x2 accp[8];
#pragma unroll
  for (int i = 0; i < 8; i++) accp[i] = f32x2{0.f, 0.f};
#pragma unroll
  for (int kb = 0; kb < 16; kb++) {
    const float c = __shfl((kb < 8) ? c0 : c1, (kb & 7) * 8 + g);
    const f32x2 c2 = {c, c};
    const u32 ws_[4] = {V[kb].x, V[kb].y, V[kb].z, V[kb].w};
#pragma unroll
    for (int q = 0; q < 4; q++) {
      accp[2 * q] += c2 * __builtin_amdgcn_cvt_pk_f32_fp8((int)ws_[q], false);
      accp[2 * q + 1] += c2 * __builtin_amdgcn_cvt_pk_f32_fp8((int)ws_[q], true);
    }
  }
  float a[16];
#pragma unroll
  for (int i = 0; i < 8; i++) { a[2 * i] = accp[i][0]; a[2 * i + 1] = accp[i][1]; }
  const bool b32 = (lane & 32) != 0, b16 = (lane & 16) != 0, b8 = (lane & 8) != 0;
#pragma unroll
  for (int i = 0; i < 8; i++) { const float send = b32 ? a[i] : a[i + 8], keep = b32 ? a[i + 8] : a[i]; a[i] = keep + __shfl_xor(send, 32); }
#pragma unroll
  for (int i = 0; i < 4; i++) { const float send = b16 ? a[i] : a[i + 4], keep = b16 ? a[i + 4] : a[i]; a[i] = keep + __shfl_xor(send, 16); }
#pragma unroll
  for (int i = 0; i < 2; i++) { const float send = b8 ? a[i] : a[i + 2], keep = b8 ? a[i + 2] : a[i]; a[i] = keep + __shfl_xor(send, 8); }
  *(u32*)drow = pack2(a[0], a[1]);
}
__device__ void phase11b(const Params& p) {
  const int t = threadIdx.x, lane = t & 63, w = t >> 6, g = lane >> 3, r = lane & 7;
  const int s = blockIdx.x & 7, jb = blockIdx.x >> 3, ns = (gridDim.x - s + 7) >> 3;
  const unsigned char* Tb = (const unsigned char*)p.R5 + 1024 + s * 128;
  const unsigned loff = r * 16;
  const int* experts = (const int*)p.R7 + lane;
  const float* gates = p.R7 + (size_t)BT * 128 + lane;
  u16* x1 = p.R1 + s * 128 + r * 16 + 2 * g;
  const int first = jb * 4 + w, stride = ns * 4;
  if (first >= BT) return;
  PeTok kA, kB;
  uint4 VA[16], VB[16];
  kA = pe_load_tok(experts, gates, first);
  pe_load_tab(Tb, loff, kA.e0, kA.e1, g, VA);
  kB = pe_load_tok(experts, gates, TOKC(first + stride));
#pragma unroll 1
  for (int tok = first; tok < BT; tok += 2 * stride) {
    const int t1 = tok + stride, t2 = tok + 2 * stride, t3 = tok + 3 * stride;
    pe_load_tab(Tb, loff, kB.e0, kB.e1, g, VB);
    const PeTok kC = pe_load_tok(experts, gates, TOKC(t2));
    pe_value_store(kA, VA, x1 + (size_t)tok * 1024, lane, g);
    pe_load_tab(Tb, loff, kC.e0, kC.e1, g, VA);
    const PeTok kD = pe_load_tok(experts, gates, TOKC(t3));
    if (t1 < BT) pe_value_store(kB, VB, x1 + (size_t)t1 * 1024, lane, g);
    kA = kC; kB = kD;
  }
#undef TOKC
}

__device__ void phase11c(const Params& p) {
  const int t = threadIdx.x, lane = t & 63, w = t >> 6;
  const float* x1 = (const float*)p.R2;
  for (int tok = blockIdx.x * 4 + w; tok < BT; tok += gridDim.x * 4) {
    const float* xr = x1 + (size_t)tok * 1024 + lane * 4;
    const u16* dl = p.R1 + (size_t)tok * 1024 + lane * 4;
    float4 v[4];
    float ss = 0.f;
#pragma unroll
    for (int i = 0; i < 4; i++) {
      v[i] = *(const float4*)(xr + i * 256);
      const uint2 dd = *(const uint2*)(dl + i * 256);
      v[i].x += blo(dd.x); v[i].y += bhi(dd.x); v[i].z += blo(dd.y); v[i].w += bhi(dd.y);
      ss += v[i].x * v[i].x + v[i].y * v[i].y + v[i].z * v[i].z + v[i].w * v[i].w;
    }
    ss = wave_sum(ss);
    const float rstd = rsqrtf(ss * (1.f / 1024.f) + 1e-6f);
    float* orow = p.out + (size_t)tok * 1024 + lane * 4;
#pragma unroll
    for (int i = 0; i < 4; i++) {
      float4 gg = *(const float4*)(p.fng + i * 256 + lane * 4);
      *(float4*)(orow + i * 256) = make_float4(v[i].x * rstd * gg.x, v[i].y * rstd * gg.y, v[i].z * rstd * gg.z, v[i].w * rstd * gg.w);
    }
  }
}

__global__ void __launch_bounds__(256, 2) fwd_mega(Params p, int ph_lo, int ph_hi) {
  extern __shared__ __attribute__((aligned(16))) char smem[];
  cg::grid_group grid = cg::this_grid();
  __shared__ uint4 xb_words;
  if (threadIdx.x == 0) xb_words = make_uint4(0u, 0u, 0u, 0u);
  __syncthreads();
  const XcdBarrier xb = xcd_barrier_post(p.bar, (volatile LAS unsigned*)&xb_words);
  if (ph_lo > ph_hi) grid.sync();
constexpr int REP0=1,REP1=1,REP2=1,REP3=1,REP4=1,REP5=1,REP6=1,REP7=1,REP8=1,REP9=1,REP10=1,REP11=1,REP12=1,REP13=1,REP14=1;
#define RUN_PHASE(k, call)                         \
  if (PH_ON(k) && ph_lo <= (k) && (k) < ph_hi) {   \
    for (int rep_ = 0; rep_ < REP##k; rep_++) { call; }  \
    if ((k) + 1 < ph_hi) xcd_barrier(xb);          \
  }
  RUN_PHASE(0, phase0(p, smem))
  RUN_PHASE(1, phase1(p, smem))
  RUN_PHASE(2, phase2(p, smem, xb))
  RUN_PHASE(3, phase3(p); weights_late(p, smem))
  RUN_PHASE(4, for (int item = blockIdx.x; item < 512; item += gridDim.x) gla_item(p, item, 2, smem))
  RUN_PHASE(5, phase5(p))
  RUN_PHASE(6, phase6(p, smem))
  RUN_PHASE(7, phase7(p, smem))
  RUN_PHASE(8, phase8(p))
  RUN_PHASE(9, phase9(p, smem))
  RUN_PHASE(10, phase10(p, smem))
  RUN_PHASE(11, phase11a(p))
  RUN_PHASE(12, phase11r(p))
  RUN_PHASE(13, phase11b(p))
  RUN_PHASE(14, phase11c(p))
}

extern "C" void kernel_launch(void* const* d_in, const int* in_sizes, int n_in, void* d_out, int out_size, void* d_ws,
                              size_t ws_size, hipStream_t stream) {
  (void)in_sizes; (void)n_in; (void)out_size; (void)ws_size;
  static int grid_blocks = 0;
  if (!grid_blocks) {
    int dev = 0, cus = 0, per_cu = 0;
    hipGetDevice(&dev);
    hipDeviceGetAttribute(&cus, hipDeviceAttributeMultiprocessorCount, dev);
    hipFuncSetAttribute((const void*)fwd_mega, hipFuncAttributeMaxDynamicSharedMemorySize, LDS_BYTES);
    hipOccupancyMaxActiveBlocksPerMultiprocessor(&per_cu, (const void*)fwd_mega, 256, LDS_BYTES);
    if (per_cu < 1) per_cu = 1;
    if (per_cu > 2) per_cu = 2;
    grid_blocks = cus * per_cu;
  }
  Params p{};
  const float* const* in = (const float* const*)d_in;
  p.x = in[0]; p.norm1_g = in[1]; p.w_in = in[2]; p.conv_w = in[3]; p.conv_b = in[4]; p.wa = in[5];
  p.dupf = in[6]; p.dbf = in[7]; p.dupb = in[8]; p.dbb = in[9]; p.gng = in[10]; p.wb = in[11];
  p.gbias = in[12]; p.wo = in[13]; p.norm2_g = in[14]; p.wq = in[15]; p.keys = in[16]; p.pu = in[17];
  p.pv = in[18]; p.fng = in[19];
  p.out = (float*)d_out;
  char* ws = (char*)d_ws;
  const size_t MiB = 1u << 20;
  p.WinT = (u16*)ws;
  p.WaT = (u16*)(ws + 17039360);
  p.WbT = (u16*)(ws + 17039360 + 2097152);
  p.WoT = (u16*)(ws + 17039360 + 2 * 2097152);
  p.WqT = (u16*)(ws + 17039360 + 3 * 2097152);
  p.KeysB = (u16*)(ws + 17039360 + 3 * 2097152 + 4194304);
  p.R1 = (u16*)(ws + 27 * MiB);
  p.R2 = (u16*)(ws + 59 * MiB);
  p.R3 = (u16*)(ws + 91 * MiB);
  p.R4 = (u16*)(ws + 123 * MiB);
  p.R5 = (u16*)(ws + 155 * MiB);
  p.R6 = (u16*)(ws + 187 * MiB);
  p.R7 = (float*)(ws + 219 * MiB);
  p.z = (float*)(ws + 251 * MiB);
  p.Dd = (float*)(ws + 253 * MiB);
  p.bar = (unsigned*)(ws + 254 * MiB);
  hipMemsetAsync(p.bar, 0, XCD_BAR_WORDS * sizeof(unsigned), stream);
#if MULTI_LAUNCH
  for (int ph = 0; ph < NPHASE; ph++) {
    hipLaunchKernelGGL(fwd_mega, dim3(grid_blocks), dim3(256), LDS_BYTES, stream, p, ph, ph + 1);
  }
#else
  int lo = 0, hi = NPHASE;
  void* args[] = {&p, &lo, &hi};
  hipError_t e = hipLaunchCooperativeKernel((const void*)fwd_mega, dim3(grid_blocks), dim3(256), args, LDS_BYTES, stream);
  if (e != hipSuccess) fprintf(stderr, "cooperative launch failed: %s (grid %d)\n", hipGetErrorString(e), grid_blocks);
#endif
}
```
